# Optimizing an MI355X kernel written in HIP

```python
import math
import jax, jax.numpy as jnp
from jax import lax
import numpy as np

D_MODEL = 1024
BATCH = 8
SEQ = 4096
DEPTH = 1

EPS = 1e-6
NEG = -1e30
A_HEADS = 8
A_KV_HEADS = 2
A_HEAD_DIM = 64
WINDOW = 128
BLOCK = 128
N_BUCKETS = 32
MAX_DISTANCE = 128
B_HEADS = 8
Q_LORA = 384
KV_LORA = 256
NOPE_DIM = 64
ROPE_DIM = 32
V_DIM = 64
ROPE_THETA = 10000.0
A_WIDTH = A_HEADS * A_HEAD_DIM
B_WIDTH = B_HEADS * V_DIM
MIX_WIDTH = A_WIDTH + B_WIDTH
IN_SPLITS = (A_WIDTH, A_KV_HEADS * A_HEAD_DIM, A_KV_HEADS * A_HEAD_DIM, Q_LORA, KV_LORA, ROPE_DIM)
IN_WIDTH = sum(IN_SPLITS)
N_EXPERTS = 16
EXPERT_FF = 1024
CAPACITY_FACTOR = 2

kernel_name = "hybrid_swa_mla_expert_choice_block"


def rms_norm(t, g):
    tf = t.astype(jnp.float32)
    y = tf * lax.rsqrt(jnp.mean(tf * tf, axis=-1, keepdims=True) + EPS)
    return (y * g.astype(jnp.float32)).astype(t.dtype)


def t5_bucket(rel):
    half = N_BUCKETS // 2
    max_exact = half // 2
    base = jnp.where(rel > 0, half, 0)
    n = jnp.abs(rel)
    nf = jnp.maximum(n, 1).astype(jnp.float32)
    large = max_exact + (jnp.log(nf / max_exact) / math.log(MAX_DISTANCE / max_exact)
                         * (half - max_exact)).astype(jnp.int32)
    large = jnp.minimum(large, half - 1)
    return base + jnp.where(n < max_exact, n, large)


def rope(t, cos, sin):
    half = ROPE_DIM // 2
    t1, t2 = t[..., :half], t[..., half:]
    c, s = cos.astype(t.dtype), sin.astype(t.dtype)
    return jnp.concatenate([t1 * c - t2 * s, t1 * s + t2 * c], axis=-1)


def window_gqa(q, k, v, rel_bias, sink):
    bsz, seq = q.shape[0], q.shape[1]
    nb = seq // BLOCK
    g, r = A_KV_HEADS, A_HEADS // A_KV_HEADS
    qb = q.reshape(bsz, nb, BLOCK, g, r, A_HEAD_DIM)

    def band(t):
        tp = jnp.pad(t, ((0, 0), (BLOCK, BLOCK), (0, 0), (0, 0)))
        tp = tp.reshape(bsz, nb + 2, BLOCK, g, A_HEAD_DIM)
        return jnp.concatenate([tp[:, :-2], tp[:, 1:-1], tp[:, 2:]], axis=2)

    kb, vb = band(k), band(v)
    s = jnp.einsum('bnqgrd,bnkgd->bngrqk', qb, kb).astype(jnp.float32) * (A_HEAD_DIM ** -0.5)
    qi = jnp.arange(BLOCK)[:, None]
    kj = jnp.arange(3 * BLOCK)[None, :]
    rel = (kj - BLOCK) - qi
    bias = rel_bias[t5_bucket(rel)]
    bias = bias.transpose(2, 0, 1).reshape(g, r, BLOCK, 3 * BLOCK).astype(jnp.float32)
    kpos = jnp.arange(nb)[:, None] * BLOCK - BLOCK + jnp.arange(3 * BLOCK)[None, :]
    valid = (jnp.abs(rel) <= WINDOW)[None] & ((kpos >= 0) & (kpos < seq))[:, None, :]
    s = jnp.where(valid[None, :, None, None], s + bias, NEG)
    sink_logit = jnp.broadcast_to(sink.astype(jnp.float32).reshape(g, r, 1, 1), s.shape[:-1] + (1,))
    p = jax.nn.softmax(jnp.concatenate([s, sink_logit], axis=-1), axis=-1)[..., :-1]
    o = jnp.einsum('bngrqk,bnkgd->bnqgrd', p.astype(v.dtype), vb)
    return o.reshape(bsz, seq, A_WIDTH)


def latent_attention(c_q, c_kv, k_rope, cq_norm_g, w_qb, ckv_norm_g, w_kvb,
                     qn_g, qr_g, kn_g, kr_g):
    bsz, seq = c_q.shape[0], c_q.shape[1]
    nb = seq // BLOCK
    pos = jnp.arange(seq, dtype=jnp.float32)
    freqs = ROPE_THETA ** (-jnp.arange(0, ROPE_DIM, 2, dtype=jnp.float32) / ROPE_DIM)
    ang = pos[:, None] * freqs[None, :]
    cos, sin = jnp.cos(ang), jnp.sin(ang)

    q = jnp.einsum('bsc,cf->bsf', rms_norm(c_q, cq_norm_g), w_qb)
    q = q.reshape(bsz, seq, B_HEADS, NOPE_DIM + ROPE_DIM)
    q_nope = rms_norm(q[..., :NOPE_DIM], qn_g)
    q_rot = rope(rms_norm(q[..., NOPE_DIM:], qr_g), cos[:, None], sin[:, None])
    kv = jnp.einsum('bsc,cf->bsf', rms_norm(c_kv, ckv_norm_g), w_kvb)
    kv = kv.reshape(bsz, seq, B_HEADS, NOPE_DIM + V_DIM)
    k_nope = rms_norm(kv[..., :NOPE_DIM], kn_g)
    v = kv[..., NOPE_DIM:]
    k_rot = rope(rms_norm(k_rope, kr_g), cos, sin)
    scale = (NOPE_DIM + ROPE_DIM) ** -0.5

    qn_b = q_nope.reshape(bsz, nb, BLOCK, B_HEADS, NOPE_DIM).swapaxes(0, 1)
    qr_b = q_rot.reshape(bsz, nb, BLOCK, B_HEADS, ROPE_DIM).swapaxes(0, 1)

    def attend(blk):
        qn, qr = blk
        s = (jnp.einsum('bqhd,bkhd->bhqk', qn, k_nope)
             + jnp.einsum('bqhr,bkr->bhqk', qr, k_rot)).astype(jnp.float32) * scale
        p = jax.nn.softmax(s, axis=-1)
        return jnp.einsum('bhqk,bkhd->bqhd', p.astype(v.dtype), v)

    o = lax.map(attend, (qn_b, qr_b))
    return o.swapaxes(0, 1).reshape(bsz, seq, B_WIDTH)


def expert_choice_ffn(h, w_router, w_gate, w_up, w_down):
    bsz, seq, d = h.shape
    cap = CAPACITY_FACTOR * seq // N_EXPERTS
    aff = jax.nn.softmax(jnp.einsum('bsd,de->bse', h, w_router).astype(jnp.float32), axis=-1)
    gate, idx = lax.top_k(aff.transpose(0, 2, 1), cap)
    xe = jax.vmap(lambda hb, ib: hb[ib])(h, idx)
    a = jax.nn.silu(jnp.einsum('becd,edf->becf', xe, w_gate)) * jnp.einsum('becd,edf->becf', xe, w_up)
    ye = jnp.einsum('becf,efd->becd', a, w_down) * gate[..., None].astype(h.dtype)
    y = jax.vmap(lambda yb, ib: jnp.zeros((seq, d), yb.dtype).at[ib.reshape(-1)].add(yb.reshape(-1, d)))(ye, idx)
    return y


def setup_inputs(seed: int = 0) -> dict:
    key = jax.random.key(seed)
    ks = jax.random.split(key, 32)
    f32 = jnp.float32

    def w(k, shape, fan_in):
        return jax.random.normal(k, shape, f32) * (fan_in ** -0.5)

    def gain(k, shape):
        return 1.0 + 0.1 * jax.random.normal(k, shape, f32)

    L = DEPTH
    return {
        'x': jax.random.normal(ks[0], (BATCH, SEQ, D_MODEL), f32),
        'rel_bias': 0.3 * jax.random.normal(ks[1], (N_BUCKETS, A_HEADS), f32),
        'ln1_g': gain(ks[2], (L, D_MODEL)),
        'w_in': w(ks[3], (L, D_MODEL, IN_WIDTH), D_MODEL),
        'a_q_norm_g': gain(ks[4], (L, A_HEAD_DIM)),
        'a_k_norm_g': gain(ks[5], (L, A_HEAD_DIM)),
        'a_sink': 0.5 * jax.random.normal(ks[6], (L, A_HEADS), f32),
        'cq_norm_g': gain(ks[7], (L, Q_LORA)),
        'w_qb': w(ks[8], (L, Q_LORA, B_HEADS * (NOPE_DIM + ROPE_DIM)), Q_LORA),
        'ckv_norm_g': gain(ks[9], (L, KV_LORA)),
        'w_kvb': w(ks[10], (L, KV_LORA, B_HEADS * (NOPE_DIM + V_DIM)), KV_LORA),
        'b_qn_g': gain(ks[11], (L, NOPE_DIM)),
        'b_qr_g': gain(ks[12], (L, ROPE_DIM)),
        'b_kn_g': gain(ks[13], (L, NOPE_DIM)),
        'b_kr_g': gain(ks[14], (L, ROPE_DIM)),
        'out_a_g': gain(ks[15], (L, A_WIDTH)),
        'out_b_g': gain(ks[16], (L, B_WIDTH)),
        'w_o': w(ks[17], (L, MIX_WIDTH, D_MODEL), MIX_WIDTH),
        'ln2_g': gain(ks[18], (L, D_MODEL)),
        'w_router': w(ks[19], (L, D_MODEL, N_EXPERTS), D_MODEL),
        'w_gate': w(ks[20], (L, N_EXPERTS, D_MODEL, EXPERT_FF), D_MODEL),
        'w_up': w(ks[21], (L, N_EXPERTS, D_MODEL, EXPERT_FF), D_MODEL),
        'w_down': w(ks[22], (L, N_EXPERTS, EXPERT_FF, D_MODEL), EXPERT_FF),
    }


def reference(x, rel_bias, ln1_g, w_in, a_q_norm_g, a_k_norm_g, a_sink, cq_norm_g, w_qb,
              ckv_norm_g, w_kvb, b_qn_g, b_qr_g, b_kn_g, b_kr_g, out_a_g, out_b_g, w_o,
              ln2_g, w_router, w_gate, w_up, w_down):
    bsz, seq = x.shape[0], x.shape[1]
    offsets = [int(o) for o in np.cumsum(IN_SPLITS)[:-1]]
    for l in range(DEPTH):
        h = rms_norm(x, ln1_g[l])
        z = jnp.einsum('bsd,df->bsf', h, w_in[l])
        q_a, k_a, v_a, c_q, c_kv, k_rope = jnp.split(z, offsets, axis=-1)
        q_a = rms_norm(q_a.reshape(bsz, seq, A_HEADS, A_HEAD_DIM), a_q_norm_g[l])
        k_a = rms_norm(k_a.reshape(bsz, seq, A_KV_HEADS, A_HEAD_DIM), a_k_norm_g[l])
        v_a = v_a.reshape(bsz, seq, A_KV_HEADS, A_HEAD_DIM)
        o_a = window_gqa(q_a, k_a, v_a, rel_bias, a_sink[l])
        o_b = latent_attention(c_q, c_kv, k_rope, cq_norm_g[l], w_qb[l], ckv_norm_g[l], w_kvb[l],
                               b_qn_g[l], b_qr_g[l], b_kn_g[l], b_kr_g[l])
        o = jnp.concatenate([rms_norm(o_a, out_a_g[l]), rms_norm(o_b, out_b_g[l])], axis=-1)
        x = x + jnp.einsum('bsf,fd->bsd', o, w_o[l])
        h2 = rms_norm(x, ln2_g[l])
        x = x + expert_choice_ffn(h2, w_router[l], w_gate[l], w_up[l], w_down[l])
    return x
```

```cpp
#include <hip/hip_runtime.h>
#include <hip/hip_bf16.h>
#include <cstdio>
#include <cstdint>
namespace pg8 {
#define PG8_LAS __attribute__((address_space(3)))
typedef unsigned short bf16_t;
typedef short bf16x8 __attribute__((ext_vector_type(8)));
typedef float f32x4 __attribute__((ext_vector_type(4)));
typedef unsigned u32x4 __attribute__((ext_vector_type(4)));
constexpr int BM = 256, BK = 64, HALF = 128, HTB = HALF * BK * 2  , STAGE_BYTES = 8 * HTB, NXCD = 8, WGM = 8;

__host__ __device__ __forceinline__ int lds_byte(int r, int c) { const int st = (r >> 4) * 2 + (c >> 5), rr = r & 15, cc = c & 31, ob = rr * 64 + cc * 2; return st * 1024 + (ob ^ (((ob >> 9) & 1) << 5)); }
__host__ __device__ __forceinline__ void stage_rc(int b, int& R, int& C) { const int st = b / 1024, sb = b % 1024, swz = sb ^ (((sb >> 9) & 1) << 5); R = (st >> 1) * 16 + swz / 64; C = (st & 1) * 32 + (swz % 64) / 2; }
__host__ __device__ __forceinline__ int perm32(int rho) { const int n = rho >> 4, i = rho & 15; return 8 * (i >> 2) + 4 * n + (i & 3); }

struct Unit { int pm, pn, e; };
struct Gemm { const bf16_t* A; const bf16_t* Bt; int M, N, K; size_t estride; };

struct StaticOrder {
    int nM, nN, nwg, G, c, epan;
    __host__ __device__ void init(int M, int N, int G_, int c_, int epan_ = 0) { nM = M / BM; nN = N / BM; nwg = nM * nN; G = G_; c = c_; epan = epan_; }
    __host__ __device__ bool next(int i, Unit& u) const {
        const long L = (long)i * G + c; if (L >= nwg) return false;
        int wgid = (int)L; { const int q = nwg / NXCD, r = nwg % NXCD, xcd = wgid % NXCD, off = wgid / NXCD; wgid = (xcd < r ? xcd * (q + 1) : r * (q + 1) + (xcd - r) * q) + off; }
        const int nig = WGM * nN, gid = wgid / nig, fm = gid * WGM, gsz = (nM - fm) < WGM ? (nM - fm) : WGM;
        u.pm = fm + ((wgid % nig) % gsz); u.pn = (wgid % nig) / gsz; u.e = epan ? u.pm / epan : 0; return true;
    }
    __device__ __forceinline__ void a_ready(const Unit&) const {}
    __device__ __forceinline__ void done(const Unit&) const {}
};

__device__ __forceinline__ unsigned cvt_pk_bf16(float lo, float hi) { unsigned r; asm volatile("v_cvt_pk_bf16_f32 %0, %1, %2" : "=v"(r) : "v"(lo), "v"(hi)); return r; }
typedef float f32x2 __attribute__((ext_vector_type(2)));
__device__ __forceinline__ f32x2 gelu_pk(f32x2 v) {
    const f32x2 av = __builtin_elementwise_abs(v), d = av * 0.2316418882f + 1.0f;
    f32x2 t; t.x = __builtin_amdgcn_rcpf(d.x); t.y = __builtin_amdgcn_rcpf(d.y);
    f32x2 q = t * 0.5307027145f + (-0.7265760135f); q = q * t + 0.7107068705f; q = q * t + (-0.142248368f); q = q * t + 0.127414796f; q = q * t;
    const f32x2 s = (v * v) * (-0.72134752044f);
    f32x2 e; e.x = __builtin_amdgcn_exp2f(s.x); e.y = __builtin_amdgcn_exp2f(s.y);
    const f32x2 m = v * (q * e), r = v - m;
    f32x2 o; o.x = v.x < 0.f ? m.x : r.x; o.y = v.y < 0.f ? m.y : r.y; return o;
}

template <int ACT  > struct EpiBf16 {
    static constexpr bool PERM = true, AFTER_DRAIN = false; static_assert(ACT == 0 || ACT == 1, "EpiBf16: ACT is 0 (none) or 1 (gelu_pk)");
    bf16_t* O; int ldc; const float* bias; int split_cols; size_t split_stride; float scale0;
    __device__ __forceinline__ void operator()(const f32x4 (&acc)[2][2][4][2], const Unit& u, int wr, int wc, int fr, int fq) const {
        const int row0 = u.pm * BM + wr * 64 + fr; int colt = u.pn * BM; bf16_t* base = O;
        float sc = 1.f; if (split_cols) { const int t = colt / split_cols; base += (size_t)t * split_stride; colt -= t * split_cols; if (t == 0) sc = scale0; }
        const int col0 = colt + wc * 32 + 8 * fq, bcol0 = u.pn * BM + wc * 32 + 8 * fq;
        f32x4 bv[2][2];
#pragma unroll
        for (int bj = 0; bj < 2; ++bj)
#pragma unroll
            for (int n = 0; n < 2; ++n) bv[bj][n] = bias ? *(const f32x4*)(bias + bcol0 + bj * HALF + 4 * n) : (f32x4){0.f, 0.f, 0.f, 0.f};
#pragma unroll
        for (int ai = 0; ai < 2; ++ai)
#pragma unroll
            for (int m = 0; m < 4; ++m) { bf16_t* rowp = base + (size_t)(row0 + ai * HALF + m * 16) * ldc + col0;
#pragma unroll
                for (int bj = 0; bj < 2; ++bj) { f32x4 v0 = acc[ai][bj][m][0] + bv[bj][0], v1 = acc[ai][bj][m][1] + bv[bj][1];
                    if (ACT == 1) { f32x2 a = gelu_pk((f32x2){v0[0], v0[1]}), b = gelu_pk((f32x2){v0[2], v0[3]}), c = gelu_pk((f32x2){v1[0], v1[1]}), d = gelu_pk((f32x2){v1[2], v1[3]});
                        v0 = (f32x4){a.x, a.y, b.x, b.y}; v1 = (f32x4){c.x, c.y, d.x, d.y}; }
                    v0 = v0 * sc; v1 = v1 * sc; u32x4 w; w.x = cvt_pk_bf16(v0[0], v0[1]); w.y = cvt_pk_bf16(v0[2], v0[3]); w.z = cvt_pk_bf16(v1[0], v1[1]); w.w = cvt_pk_bf16(v1[2], v1[3]);
                    *(u32x4*)(rowp + bj * HALF) = w; } }
    }
};

struct EpiResF32 {
    static constexpr bool PERM = false, AFTER_DRAIN = false;
    const float* base; float* out; int ldc;
    __device__ __forceinline__ void operator()(const f32x4 (&acc)[2][2][4][2], const Unit& u, int wr, int wc, int fr, int fq) const {
        const int col0 = u.pn * BM + wc * 32 + 4 * fq;
#pragma unroll
        for (int ai = 0; ai < 2; ++ai)
#pragma unroll
            for (int m = 0; m < 4; ++m) { const int r = ai * HALF + wr * 64 + m * 16 + fr; const size_t off = (size_t)(u.pm * BM + r) * ldc + col0;
#pragma unroll
                for (int bj = 0; bj < 2; ++bj)
#pragma unroll
                    for (int n = 0; n < 2; ++n) { const f32x4 bs = *(const f32x4*)(base + off + bj * HALF + n * 16); *(f32x4*)(out + off + bj * HALF + n * 16) = bs + acc[ai][bj][m][n]; } }
    }
};
__device__ __forceinline__ float silu_mul(float g, float u) { return g * u * __builtin_amdgcn_rcpf(1.0f + __builtin_amdgcn_exp2f(-1.4426950408889634f * g)); }
struct EpiSwiGLU {
    static constexpr bool PERM = true, AFTER_DRAIN = false;
    bf16_t* O; int ldc;
    __device__ __forceinline__ void operator()(const f32x4 (&acc)[2][2][4][2], const Unit& u, int wr, int wc, int fr, int fq) const {
        const int row0 = u.pm * BM + wr * 64 + fr, col0 = u.pn * HALF + wc * 32 + 8 * fq;
#pragma unroll
        for (int ai = 0; ai < 2; ++ai)
#pragma unroll
            for (int m = 0; m < 4; ++m) { bf16_t* rowp = O + (size_t)(row0 + ai * HALF + m * 16) * ldc + col0;
                const f32x4 g0 = acc[ai][0][m][0], g1 = acc[ai][0][m][1], u0 = acc[ai][1][m][0], u1 = acc[ai][1][m][1];
                u32x4 w; w.x = cvt_pk_bf16(silu_mul(g0[0], u0[0]), silu_mul(g0[1], u0[1])); w.y = cvt_pk_bf16(silu_mul(g0[2], u0[2]), silu_mul(g0[3], u0[3]));
                w.z = cvt_pk_bf16(silu_mul(g1[0], u1[0]), silu_mul(g1[1], u1[1])); w.w = cvt_pk_bf16(silu_mul(g1[2], u1[2]), silu_mul(g1[3], u1[3]));
                *(u32x4*)rowp = w; }
    }
};
struct EpiRowScaleBf16 {
    static constexpr bool PERM = true, AFTER_DRAIN = false;
    bf16_t* O; int ldc; const float* rowscale;
    __device__ __forceinline__ void operator()(const f32x4 (&acc)[2][2][4][2], const Unit& u, int wr, int wc, int fr, int fq) const {
        const int row0 = u.pm * BM + wr * 64 + fr, col0 = u.pn * BM + wc * 32 + 8 * fq;
#pragma unroll
        for (int ai = 0; ai < 2; ++ai)
#pragma unroll
            for (int m = 0; m < 4; ++m) { const int row = row0 + ai * HALF + m * 16; const float sc = rowscale[row]; bf16_t* rowp = O + (size_t)row * ldc + col0;
#pragma unroll
                for (int bj = 0; bj < 2; ++bj) { const f32x4 v0 = acc[ai][bj][m][0] * sc, v1 = acc[ai][bj][m][1] * sc;
                    u32x4 w; w.x = cvt_pk_bf16(v0[0], v0[1]); w.y = cvt_pk_bf16(v0[2], v0[3]); w.z = cvt_pk_bf16(v1[0], v1[1]); w.w = cvt_pk_bf16(v1[2], v1[3]);
                    *(u32x4*)(rowp + bj * HALF) = w; } }
    }
};
template <class Epi, class Sched, bool ALIGN_EPI = false, bool SP2 = false>
__device__ __forceinline__ void gemm_phase(PG8_LAS unsigned char* lds, const Gemm g, const Sched& S, const Epi& E) {
    const int tid = threadIdx.x, wid = __builtin_amdgcn_readfirstlane(tid >> 6), lane = tid & 63, wr = wid >> 2, wc = wid & 3, fr = lane & 15, fq = lane >> 4;
    const int K = g.K, nt = K / BK;
    unsigned voffA[2], voffB[2];
#pragma unroll
    for (int i = 0; i < 2; ++i) { int R, C; stage_rc(tid * 16 + i * 8192, R, C); const int Rb = Epi::PERM ? ((R & ~31) + perm32(R & 31)) : R;
        voffA[i] = (unsigned)(R * K + C) * 2u; voffB[i] = (unsigned)(Rb * K + C) * 2u; }
    const size_t kstep = (size_t)(BK * 2);
    const size_t hstep = (size_t)HALF * K * 2;
    const size_t tstep = 2 * hstep;
    const unsigned ldsw = (unsigned)wid * 1024u;
    const int aoff = lds_byte(wr * 64 + fr, fq * 8), boff = lds_byte(wc * 32 + fr, fq * 8);
#define PG8_SA(b, h) (((b) * 2 + (h)) * HTB)
#define PG8_SB(b, h) ((4 + (b) * 2 + (h)) * HTB)
#define PG8_STAGE(bufoff, gbase, voff) do { _Pragma("unroll") for (int _i = 0; _i < 2; ++_i) \
        __builtin_amdgcn_global_load_lds((const unsigned*)((const char*)(gbase) + (voff)[_i]), (PG8_LAS unsigned*)(lds + (bufoff) + ldsw + _i * 8192), 16, 0, 0); } while (0)
#define PG8_LDA(dst, b, h) do { _Pragma("unroll") for (int m = 0; m < 4; ++m) _Pragma("unroll") for (int k = 0; k < 2; ++k) dst[m][k] = *(const PG8_LAS bf16x8*)(lds + PG8_SA(b, h) + aoff + m * 2048 + k * 1024); } while (0)
#define PG8_LDB(dst, b, h) do { _Pragma("unroll") for (int n = 0; n < 2; ++n) _Pragma("unroll") for (int k = 0; k < 2; ++k) dst[n][k] = *(const PG8_LAS bf16x8*)(lds + PG8_SB(b, h) + boff + n * 2048 + k * 1024); } while (0)
#define PG8_MMA(ai, bj, At, Bt) do { __builtin_amdgcn_s_setprio(1); _Pragma("unroll") for (int m = 0; m < 4; ++m) _Pragma("unroll") for (int n = 0; n < 2; ++n) _Pragma("unroll") for (int k = 0; k < 2; ++k) \
        acc[ai][bj][m][n] = __builtin_amdgcn_mfma_f32_16x16x32_bf16(Bt[n][k], At[m][k], acc[ai][bj][m][n], 0, 0, 0); __builtin_amdgcn_s_setprio(0); } while (0)
#define PG8_WAIT_V(n) asm volatile("s_waitcnt vmcnt(" #n ")" ::: "memory")
#define PG8_WAIT_L(n) asm volatile("s_waitcnt lgkmcnt(" #n ")" ::: "memory")
#define PG8_BAR __builtin_amdgcn_s_barrier()
#define PG8_SCHED __builtin_amdgcn_sched_barrier(0)
    Unit cur, nxt; int ui = 0;
    if (!S.next(0, cur)) return;
    f32x4 acc[2][2][4][2];
#pragma unroll
    for (int a = 0; a < 2; ++a)
#pragma unroll
        for (int b = 0; b < 2; ++b)
#pragma unroll
            for (int m = 0; m < 4; ++m)
#pragma unroll
                for (int n = 0; n < 2; ++n) acc[a][b][m][n] = (f32x4){0.f, 0.f, 0.f, 0.f};
    bf16x8 At[4][2], B0[2][2], B1[2][2];
    const char* cA = (const char*)g.A + (size_t)cur.pm * tstep; const char* cB = (const char*)g.Bt + (size_t)cur.e * g.estride + (size_t)cur.pn * tstep;
    S.a_ready(cur);
    if constexpr (SP2) {
        PG8_STAGE(PG8_SB(0, 0), cB, voffB); PG8_STAGE(PG8_SB(0, 1), cB + hstep, voffB); PG8_STAGE(PG8_SA(0, 0), cA, voffA); PG8_STAGE(PG8_SA(0, 1), cA + hstep, voffA);
        if (wr == 1) PG8_BAR;
        PG8_WAIT_V(2); PG8_BAR;
        PG8_STAGE(PG8_SB(1, 0), cB + kstep, voffB); PG8_STAGE(PG8_SA(1, 0), cA + kstep, voffA); PG8_STAGE(PG8_SB(1, 1), cB + hstep + kstep, voffB);
        PG8_WAIT_V(6); PG8_BAR;
    } else {
        PG8_STAGE(PG8_SB(0, 0), cB, voffB); PG8_STAGE(PG8_SA(0, 0), cA, voffA); PG8_STAGE(PG8_SB(0, 1), cB + hstep, voffB); PG8_STAGE(PG8_SA(0, 1), cA + hstep, voffA);
        if (wr == 1) PG8_BAR;
        PG8_WAIT_V(4); PG8_BAR;
        PG8_STAGE(PG8_SB(1, 0), cB + kstep, voffB); PG8_STAGE(PG8_SA(1, 0), cA + kstep, voffA); PG8_STAGE(PG8_SB(1, 1), cB + hstep + kstep, voffB);
        PG8_WAIT_V(6); PG8_BAR;
    }
    for (;;) {
        const bool has_next = S.next(ui + 1, nxt);
        const char* nA = has_next ? (const char*)g.A + (size_t)nxt.pm * tstep : cA; const char* nB = has_next ? (const char*)g.Bt + (size_t)nxt.e * g.estride + (size_t)nxt.pn * tstep : cB;
        for (int t = 0; t < nt; t += 2) {
            const bool last = (t == nt - 2);
            const char* a1 = cA + (size_t)(t + 1) * kstep;
            const char* a2 = last ? nA : cA + (size_t)(t + 2) * kstep; const char* b2 = last ? nB : cB + (size_t)(t + 2) * kstep;
            const char* a3 = a2 + kstep; const char* b3 = b2 + kstep;
            if (last && has_next) S.a_ready(nxt);
            if constexpr (SP2) {
            PG8_LDB(B0, 0, 0); PG8_LDB(B1, 0, 1); PG8_SCHED; PG8_LDA(At, 0, 0); PG8_STAGE(PG8_SA(1, 1), a1 + hstep, voffA);
            PG8_WAIT_V(8); PG8_WAIT_L(0); PG8_BAR; PG8_MMA(0, 0, At, B0); PG8_MMA(0, 1, At, B1); PG8_BAR; PG8_SCHED;
            PG8_LDA(At, 0, 1); PG8_STAGE(PG8_SB(0, 0), b2, voffB); PG8_STAGE(PG8_SB(0, 1), b2 + hstep, voffB); PG8_STAGE(PG8_SA(0, 0), a2, voffA);
            PG8_WAIT_V(8); PG8_WAIT_L(0); PG8_BAR; PG8_MMA(1, 0, At, B0); PG8_MMA(1, 1, At, B1); PG8_BAR; PG8_SCHED;
            PG8_LDB(B0, 1, 0); PG8_LDB(B1, 1, 1); PG8_SCHED; PG8_LDA(At, 1, 0); PG8_STAGE(PG8_SA(0, 1), a2 + hstep, voffA);
            PG8_WAIT_V(8); PG8_WAIT_L(0); PG8_BAR; PG8_MMA(0, 0, At, B0); PG8_MMA(0, 1, At, B1); PG8_BAR; PG8_SCHED;
            PG8_LDA(At, 1, 1); PG8_STAGE(PG8_SB(1, 0), b3, voffB); PG8_STAGE(PG8_SB(1, 1), b3 + hstep, voffB); PG8_STAGE(PG8_SA(1, 0), a3, voffA);
            PG8_WAIT_V(8); PG8_WAIT_L(0); PG8_BAR; PG8_MMA(1, 0, At, B0); PG8_MMA(1, 1, At, B1); PG8_BAR; PG8_SCHED;
            } else {
            PG8_LDB(B0, 0, 0); PG8_SCHED; PG8_LDA(At, 0, 0); PG8_STAGE(PG8_SA(1, 1), a1 + hstep, voffA);
            PG8_WAIT_L(8); PG8_BAR; PG8_WAIT_L(0); PG8_MMA(0, 0, At, B0); PG8_BAR; PG8_SCHED;
            PG8_LDB(B1, 0, 1); PG8_STAGE(PG8_SB(0, 0), b2, voffB);
            PG8_BAR; PG8_WAIT_L(0); PG8_MMA(0, 1, At, B1); PG8_BAR;
            PG8_LDA(At, 0, 1); PG8_STAGE(PG8_SA(0, 0), a2, voffA);
            PG8_BAR; PG8_WAIT_L(0); PG8_MMA(1, 0, At, B0); PG8_BAR; PG8_SCHED;
            PG8_STAGE(PG8_SB(0, 1), b2 + hstep, voffB);
            PG8_WAIT_V(6); PG8_BAR; PG8_MMA(1, 1, At, B1); PG8_BAR;
            PG8_LDB(B0, 1, 0); PG8_SCHED; PG8_LDA(At, 1, 0); PG8_STAGE(PG8_SA(0, 1), a2 + hstep, voffA);
            PG8_WAIT_L(8); PG8_BAR; PG8_WAIT_L(0); PG8_MMA(0, 0, At, B0); PG8_BAR; PG8_SCHED;
            PG8_LDB(B1, 1, 1); PG8_STAGE(PG8_SB(1, 0), b3, voffB);
            PG8_BAR; PG8_WAIT_L(0); PG8_MMA(0, 1, At, B1); PG8_BAR;
            PG8_LDA(At, 1, 1); PG8_STAGE(PG8_SA(1, 0), a3, voffA);
            PG8_BAR; PG8_WAIT_L(0); PG8_MMA(1, 0, At, B0); PG8_BAR; PG8_SCHED;
            PG8_STAGE(PG8_SB(1, 1), b3 + hstep, voffB);
            PG8_WAIT_V(6); PG8_BAR; PG8_MMA(1, 1, At, B1); PG8_BAR;
            }
        }
        if constexpr (ALIGN_EPI) { if (wr == 0) PG8_BAR; }
        if constexpr (!Epi::AFTER_DRAIN) { E(acc, cur, wr, wc, fr, fq); S.done(cur); }
        if (!has_next) break;
#pragma unroll
        for (int a = 0; a < 2; ++a)
#pragma unroll
            for (int b = 0; b < 2; ++b)
#pragma unroll
                for (int m = 0; m < 4; ++m)
#pragma unroll
                    for (int n = 0; n < 2; ++n) acc[a][b][m][n] = (f32x4){0.f, 0.f, 0.f, 0.f};
        cur = nxt; cA = nA; cB = nB; ++ui;
        if constexpr (ALIGN_EPI) { if (wr == 1) PG8_BAR; }
    }
    PG8_WAIT_V(0);
    if constexpr (!ALIGN_EPI) { if (wr == 0) PG8_BAR; }
    PG8_BAR;
    if constexpr (Epi::AFTER_DRAIN) { E.fused(acc, cur, wr, wc, fr, fq, lds, wid, lane); S.done(cur); }
#undef PG8_SA
#undef PG8_SB
#undef PG8_STAGE
#undef PG8_LDA
#undef PG8_LDB
#undef PG8_MMA
#undef PG8_WAIT_V
#undef PG8_WAIT_L
#undef PG8_BAR
#undef PG8_SCHED
}
}
#define GAS __attribute__((address_space(1)))
#define LAS __attribute__((address_space(3)))
typedef unsigned short bf16;
typedef unsigned v4u __attribute__((ext_vector_type(4)));
typedef float f32x4 __attribute__((ext_vector_type(4)));
typedef short bf16x8 __attribute__((ext_vector_type(8)));
typedef GAS unsigned gu32;
typedef GAS unsigned long long gu64;
#define RLX_AGENT __ATOMIC_RELAXED, __HIP_MEMORY_SCOPE_AGENT
#define LDS_WAIT() asm volatile("s_waitcnt lgkmcnt(0)" ::: "memory")
#define VM_WAIT() asm volatile("s_waitcnt vmcnt(0)" ::: "memory")
__device__ __forceinline__ unsigned long long rt() { return __builtin_amdgcn_s_memrealtime(); }
__device__ __forceinline__ unsigned f2bf(float f) { unsigned u = __builtin_bit_cast(unsigned, f); return (u + 0x7fffu + ((u >> 16) & 1u)) >> 16; }
__device__ __forceinline__ unsigned pk2(float lo, float hi) { return f2bf(lo) | (f2bf(hi) << 16); }

#define XB_TMO      128
#define XB_XCNT(j)  (256  + 64 * (j))
#define XB_XSUB(j)  (1280 + 64 * (j))
#define XB_XGEN(j)  (2304 + 64 * (j))
#define XB_TOP      3328
#define XB_TOPGEN   3392
#define XCD_BAR_WORDS 3456
#define XB_SPIN_CAP (1u << 18)

__device__ __forceinline__ unsigned xb_ld(unsigned* p)              { return __hip_atomic_load(p, __ATOMIC_RELAXED, __HIP_MEMORY_SCOPE_AGENT); }
__device__ __forceinline__ unsigned xb_add(unsigned* p, unsigned v) { return __hip_atomic_fetch_add(p, v, __ATOMIC_RELAXED, __HIP_MEMORY_SCOPE_AGENT); }
__device__ __forceinline__ unsigned xb_xcc_id() { return (unsigned)__builtin_amdgcn_s_getreg((3 << 11) | 20) & 0xFu; }
#define XB_SPIN(cond, bar) do { unsigned _sp = 0; while (cond) { __builtin_amdgcn_s_sleep(1); \
    if ((++_sp & 255u) == 0u) { if (xb_ld(&(bar)[XB_TMO])) break; if (_sp > XB_SPIN_CAP) { atomicAdd(&(bar)[XB_TMO], 1u); break; } } } } while (0)

struct XcdBarrier {
    unsigned* bar; unsigned x;
    volatile LAS unsigned* st;
};

__device__ __forceinline__ XcdBarrier xcd_barrier_post(unsigned* bar, volatile LAS unsigned* st) {
    XcdBarrier b; b.bar = bar; b.x = xb_xcc_id(); b.st = st;
    if (threadIdx.x == 0) (void)xb_add(&bar[XB_XCNT(b.x)], 1u);
    return b;
}
__device__ __forceinline__ void xcd_barrier_complete(unsigned* bar, unsigned x, unsigned& nloc, unsigned& nx) {
    const unsigned G = gridDim.x * gridDim.y * gridDim.z;
    unsigned sum, cnt, mine, sp = 0u;
    for (;;) {
        sum = 0u; cnt = 0u; mine = 0u;
#pragma unroll
        for (unsigned j = 0; j < 16; ++j) { const unsigned c = xb_ld(&bar[XB_XCNT(j)]); sum += c; cnt += (c > 0u) ? 1u : 0u; mine = (j == x) ? c : mine; }
        if (sum == G) break;
        __builtin_amdgcn_s_sleep(1);
        if ((++sp & 255u) == 0u) { if (xb_ld(&bar[XB_TMO])) break; if (sp > XB_SPIN_CAP) { atomicAdd(&bar[XB_TMO], 1u); break; } }
    }
    nloc = mine > 0u ? mine : 1u; nx = cnt > 0u ? cnt : 1u;
}

__device__ __forceinline__ void xcd_barrier(const XcdBarrier& b) {
    asm volatile("s_waitcnt vmcnt(0)" ::: "memory");
    __syncthreads();
    if (threadIdx.x == 0) {
        unsigned* bar = b.bar;
        __builtin_amdgcn_s_waitcnt(0);
        unsigned nloc = b.st[0], nx = b.st[1];
        if (nloc == 0u) { xcd_barrier_complete(bar, b.x, nloc, nx); b.st[0] = nloc; b.st[1] = nx; }
        const unsigned old = xb_add(&bar[XB_XSUB(b.x)], 1u);
        const unsigned gen = old / nloc;
        if (old + 1u == (gen + 1u) * nloc) {
            __builtin_amdgcn_fence(__ATOMIC_RELEASE, "agent");
            asm volatile("s_waitcnt vmcnt(0)" ::: "memory");
            const unsigned og = xb_add(&bar[XB_TOP], 1u);
            const unsigned tg = og / nx;
            if (og + 1u == (tg + 1u) * nx) xb_add(&bar[XB_TOPGEN], 1u);
            else XB_SPIN(xb_ld(&bar[XB_TOPGEN]) == tg, bar);
            __builtin_amdgcn_fence(__ATOMIC_ACQUIRE, "agent");
            xb_add(&bar[XB_XGEN(b.x)], 1u);
            asm volatile("s_waitcnt vmcnt(0)" ::: "memory");
        } else {
            XB_SPIN(xb_ld(&bar[XB_XGEN(b.x)]) == gen, bar);
            __builtin_amdgcn_fence(__ATOMIC_ACQUIRE, "agent");
            asm volatile("s_waitcnt vmcnt(0)" ::: "memory");
        }
    }
    __syncthreads();
}

constexpr int NWAVES = 8;
constexpr int BATCH = 8, SEQ = 4096, DM = 1024, T = BATCH * SEQ;
constexpr int INW = 1440, NZ = 1536;
constexpr int A_HEADS = 8, A_KV = 2, HD = 64, WINDOW = 128;
constexpr int BH = 8, QL = 384, KVL = 256, NOPE = 64, ROPE = 32, VD = 64, QKD = NOPE + ROPE;
constexpr int NE = 16, FF = 1024, CAP = 512, MX = NE * BATCH * CAP;
constexpr float EPS = 1e-6f, LOG2E = 1.4426950408889634f;
constexpr float QSC_A = 0.125f * LOG2E;
constexpr float QSC_B = 0.10206207261596577f * LOG2E;
constexpr int NTAB = 257;

constexpr size_t MiB = 1u << 20;
constexpr size_t WS_CTL = 0, CTL_ZERO_BYTES = 1 * MiB;
constexpr size_t WS_TAB = 1 * MiB;
constexpr size_t WS_WIN = 4 * MiB, WS_WQB = 7 * MiB, WS_WKVB = 8 * MiB, WS_WO = 9 * MiB, WS_WGU = 12 * MiB, WS_WD = 76 * MiB;
constexpr size_t WS_AFF = 108 * MiB, WS_IDX = 110 * MiB, WS_GATEV = WS_IDX + 512 * 1024, WS_SLOT = 111 * MiB;
constexpr size_t WS_XN = 114 * MiB;
constexpr size_t WS_Z = 178 * MiB;
constexpr size_t WS_QA = 274 * MiB, WS_KA = 306 * MiB, WS_VA = 314 * MiB, WS_CQ = 322 * MiB, WS_CKV = 346 * MiB, WS_KR = 362 * MiB;
constexpr size_t WS_KVRAW = 364 * MiB, WS_KBN = 428 * MiB, WS_VB = 460 * MiB, WS_END = 492 * MiB;
constexpr size_t WS_QB = WS_Z, WS_O = WS_XN, WS_H2 = WS_XN, WS_XE = WS_Z, WS_ACT = 306 * MiB, WS_YE = WS_Z;
constexpr int TAB_BIAS = 0, TAB_CONST = 8 * NTAB + 8, TAB_COS = TAB_CONST + 16, TAB_SIN = TAB_COS + SEQ * 16;
constexpr int CW_TMO = 0, CW_BAR = 4096;

constexpr int RING_OFF = 0, RING_BYTES = 131072;
constexpr int LDSCTL_OFF = RING_BYTES, MISC_OFF = LDSCTL_OFF + 320;
constexpr int LDS_BYTES = 147456;

struct Frame {
    LAS unsigned char* lds;
    volatile LAS unsigned* MISC;
    gu32* ctl;
    int tid, lane, wave;
    int vcu, G;
    const float* in[23];
    float* out;
    unsigned char* ws;
};
#define WSP(T_, off) ((T_*)(F.ws + (off)))
__device__ __forceinline__ float wave_sum(float v) {
#pragma unroll
    for (int o = 1; o < 64; o <<= 1) v += __shfl_xor(v, o);
    return v;
}
__device__ __forceinline__ float grp_sum8(float v) { v += __shfl_xor(v, 1); v += __shfl_xor(v, 2); v += __shfl_xor(v, 4); return v; }
__device__ __forceinline__ float grp_sum4(float v) { v += __shfl_xor(v, 1); v += __shfl_xor(v, 2); return v; }
__device__ __forceinline__ void unpack8(const v4u w, float (&f)[8]) {
#pragma unroll
    for (int i = 0; i < 4; ++i) { f[2 * i] = __uint_as_float(w[i] << 16); f[2 * i + 1] = __uint_as_float(w[i] & 0xffff0000u); }
}
__device__ __forceinline__ v4u pack8(const float (&f)[8]) { v4u o; o.x = pk2(f[0], f[1]); o.y = pk2(f[2], f[3]); o.z = pk2(f[4], f[5]); o.w = pk2(f[6], f[7]); return o; }

__device__ __forceinline__ int t5_bucket(int rel) {
    const int base = rel > 0 ? 16 : 0; const int n = rel < 0 ? -rel : rel;
    const float nf = (float)(n > 1 ? n : 1);
    int large = 8 + (int)(logf(nf * 0.125f) / 2.772588722239781f * 8.0f + 1e-4f);
    large = large < 15 ? large : 15;
    return base + (n < 8 ? n : large);
}

template <class RowMap>
__device__ __forceinline__ void p0_transpose_item(const float* W, int K, int N, bf16* WT, const float* gain, LAS float* scr, int item, int lane, RowMap rowmap) {
    const int nblk = N / 32, kb = item / nblk, nb = item % nblk, k0 = 64 * kb, n0 = 32 * nb;
#pragma unroll 8
    for (int i = 0; i < 32; ++i) { const int kk = 2 * i + (lane >> 5); const float g = gain ? gain[k0 + kk] : 1.0f; scr[kk * 33 + (lane & 31)] = g * W[(size_t)(k0 + kk) * N + n0 + (lane & 31)]; }
    LDS_WAIT(); asm volatile("" ::: "memory");
    const int c = lane & 7;
#pragma unroll
    for (int j = 0; j < 4; ++j) { const int n = (lane >> 3) + 8 * j; const LAS float* s = scr + (8 * c) * 33 + n;
        v4u o; o.x = pk2(s[0 * 33], s[1 * 33]); o.y = pk2(s[2 * 33], s[3 * 33]); o.z = pk2(s[4 * 33], s[5 * 33]); o.w = pk2(s[6 * 33], s[7 * 33]);
        *(GAS v4u*)(WT + (size_t)rowmap(n0 + n) * K + k0 + 8 * c) = o; }
    LDS_WAIT(); asm volatile("" ::: "memory");
}
struct RowId { __device__ __forceinline__ int operator()(int n) const { return n; } };
struct RowGU { int up; __device__ __forceinline__ int operator()(int n) const { return (n >> 7) * 256 + up * 128 + (n & 127); } };

__device__ __forceinline__ void p0_prologue(Frame& F) {
    LAS float* scr = (LAS float*)(F.lds + RING_OFF + F.wave * 16384);
    const int gw = F.vcu * NWAVES + F.wave, NGW = F.G * NWAVES;
    constexpr int I_IN = (DM / 64) * (INW / 32), I_QB = (QL / 64) * (BH * QKD / 32), I_KVB = (KVL / 64) * (BH * 128 / 32), I_O = (DM / 64) * (DM / 32), I_E = (DM / 64) * (FF / 32);
    constexpr int NITEMS = I_IN + I_QB + I_KVB + I_O + NE * 3 * I_E;
    bf16* Win_t = WSP(bf16, WS_WIN); bf16* Wqb_t = WSP(bf16, WS_WQB); bf16* Wkvb_t = WSP(bf16, WS_WKVB); bf16* Wo_t = WSP(bf16, WS_WO); bf16* Wgu_t = WSP(bf16, WS_WGU); bf16* Wd_t = WSP(bf16, WS_WD);
    for (int it = gw; it < NITEMS; it += NGW) {
        int r = it;
        if (r < I_IN) { p0_transpose_item(F.in[3], DM, INW, Win_t, F.in[2], scr, r, F.lane, RowId{}); continue; } r -= I_IN;
        if (r < I_QB) { p0_transpose_item(F.in[8], QL, BH * QKD, Wqb_t, F.in[7], scr, r, F.lane, RowId{}); continue; } r -= I_QB;
        if (r < I_KVB) { p0_transpose_item(F.in[10], KVL, BH * 128, Wkvb_t, F.in[9], scr, r, F.lane, RowId{}); continue; } r -= I_KVB;
        if (r < I_O) { const int kb = r / (DM / 32); const float* g = (kb < 8) ? F.in[15] : (F.in[16] - 512);
            p0_transpose_item(F.in[17], DM, DM, Wo_t, g, scr, r, F.lane, RowId{}); continue; } r -= I_O;
        const int e = r / (3 * I_E), q = r % (3 * I_E), which = q / I_E, item = q % I_E;
        if (which == 0) p0_transpose_item(F.in[20] + (size_t)e * DM * FF, DM, FF, Wgu_t + (size_t)e * 2 * FF * DM, nullptr, scr, item, F.lane, RowGU{0});
        else if (which == 1) p0_transpose_item(F.in[21] + (size_t)e * DM * FF, DM, FF, Wgu_t + (size_t)e * 2 * FF * DM, nullptr, scr, item, F.lane, RowGU{1});
        else p0_transpose_item(F.in[22] + (size_t)e * FF * DM, FF, DM, Wd_t + (size_t)e * DM * FF, nullptr, scr, item, F.lane, RowId{});
    }
    { const int nchunk = (NZ - INW) * DM / 8; for (int c = gw * 64 + F.lane; c < nchunk; c += NGW * 64) *(GAS v4u*)(Win_t + (size_t)INW * DM + (size_t)c * 8) = (v4u){0u, 0u, 0u, 0u}; }
    bf16* XN = WSP(bf16, WS_XN);
    for (int m = gw; m < T; m += NGW) {
        const GAS f32x4* xr = (const GAS f32x4*)(F.in[0] + (size_t)m * DM) + F.lane;
        f32x4 v[4]; float s = 0.f;
#pragma unroll
        for (int j = 0; j < 4; ++j) { v[j] = xr[64 * j]; s += (v[j].x * v[j].x + v[j].y * v[j].y) + (v[j].z * v[j].z + v[j].w * v[j].w); }
        const float rs = 1.0f / sqrtf(wave_sum(s) * (1.f / DM) + EPS);
        GAS unsigned long long* o8 = (GAS unsigned long long*)(XN + (size_t)m * DM) + F.lane;
#pragma unroll
        for (int j = 0; j < 4; ++j) o8[64 * j] = (unsigned long long)pk2(v[j].x * rs, v[j].y * rs) | ((unsigned long long)pk2(v[j].z * rs, v[j].w * rs) << 32);
    }
    float* TAB = WSP(float, WS_TAB);
    if (blockIdx.x == 0) {
        const float* rel_bias = F.in[1];
        for (int i = F.tid; i < 8 * NTAB; i += NWAVES * 64) { const int h = i / NTAB, rel = i % NTAB - 128; TAB[TAB_BIAS + i] = rel_bias[t5_bucket(rel) * A_HEADS + h] * LOG2E; }
        if (F.wave == 0) {
            const float ga = fabsf(F.in[4][F.lane] * F.in[5][F.lane]); float mb = 0.f; for (int i = F.lane; i < 32 * 8; i += 64) mb = fmaxf(mb, rel_bias[i]);
            const float gb = fabsf(F.in[11][F.lane] * F.in[13][F.lane]); const float gqr = (F.lane < 32) ? fabsf(F.in[12][F.lane]) : 0.f, gkr = (F.lane < 32) ? fabsf(F.in[14][F.lane]) : 0.f;
            float mga = ga, mgb = gb, mqr = gqr, mkr = gkr;
#pragma unroll
            for (int o = 1; o < 64; o <<= 1) { mga = fmaxf(mga, __shfl_xor(mga, o)); mgb = fmaxf(mgb, __shfl_xor(mgb, o)); mqr = fmaxf(mqr, __shfl_xor(mqr, o)); mkr = fmaxf(mkr, __shfl_xor(mkr, o)); mb = fmaxf(mb, __shfl_xor(mb, o)); }
            if (F.lane == 0) { TAB[TAB_CONST + 0] = (8.0f * mga + mb) * LOG2E + 1.0f; TAB[TAB_CONST + 1] = 0.10206207261596577f * (64.f * mgb + 32.f * mqr * mkr) * LOG2E + 1.0f; }
        }
    }
    for (int i = gw * 64 + F.lane; i < SEQ * 16; i += NGW * 64) { const int s = i >> 4, k = i & 15; const float freq = powf(10000.0f, -(float)(2 * k) / 32.0f); const float ang = (float)s * freq;
        TAB[TAB_COS + i] = cosf(ang); TAB[TAB_SIN + i] = sinf(ang); }
}

__device__ __forceinline__ void p2_fixup(Frame& F) {
    const int gw = F.vcu * NWAVES + F.wave, NGW = F.G * NWAVES, lane = F.lane;
    const bf16* Z = WSP(bf16, WS_Z); bf16* QA = WSP(bf16, WS_QA); bf16* KA = WSP(bf16, WS_KA); bf16* VA = WSP(bf16, WS_VA); bf16* CQ = WSP(bf16, WS_CQ); bf16* CKV = WSP(bf16, WS_CKV); bf16* KR = WSP(bf16, WS_KR);
    const float* TAB = WSP(float, WS_TAB);
    const float* gq = F.in[4]; const float* gk = F.in[5]; const float* gkr = F.in[14];
    float gqv[8], gkv[8], gkrv[8];
#pragma unroll
    for (int j = 0; j < 8; ++j) { gqv[j] = gq[(8 * lane) % 64 + j]; gkv[j] = gk[(8 * lane) % 64 + j]; gkrv[j] = gkr[(8 * lane) % 32 + j]; }
    for (int m = gw; m < T; m += NGW) {
        const bf16* zr = Z + (size_t)m * NZ; const int s = m % SEQ; float f[8], o[8];
        { unpack8(*(const GAS v4u*)(zr + 8 * lane), f); float ss = 0.f;
#pragma unroll
          for (int j = 0; j < 8; ++j) ss += f[j] * f[j];
          const float r = QSC_A / sqrtf(grp_sum8(ss) * (1.f / 64.f) + EPS);
#pragma unroll
          for (int j = 0; j < 8; ++j) o[j] = f[j] * r * gqv[j];
          *(GAS v4u*)(QA + (size_t)m * 512 + 8 * lane) = pack8(o); }
        { const int l2 = lane & 31; const v4u w = *(const GAS v4u*)(zr + 512 + 8 * l2); unpack8(w, f); float ss = 0.f;
#pragma unroll
          for (int j = 0; j < 8; ++j) ss += f[j] * f[j];
          const float r = 1.0f / sqrtf(grp_sum8(ss) * (1.f / 64.f) + EPS);
#pragma unroll
          for (int j = 0; j < 8; ++j) o[j] = f[j] * r * gkv[j];
          if (lane < 16) *(GAS v4u*)(KA + (size_t)m * 128 + 8 * lane) = pack8(o);
          else if (lane < 32) *(GAS v4u*)(VA + (size_t)m * 128 + 8 * (lane - 16)) = w; }
        { const int l2 = lane < 48 ? lane : 0; unpack8(*(const GAS v4u*)(zr + 768 + 8 * l2), f); float ss = 0.f;
#pragma unroll
          for (int j = 0; j < 8; ++j) ss += f[j] * f[j];
          if (lane >= 48) ss = 0.f;
          const float r = 1.0f / sqrtf(wave_sum(ss) * (1.f / 384.f) + EPS);
#pragma unroll
          for (int j = 0; j < 8; ++j) o[j] = f[j] * r;
          if (lane < 48) *(GAS v4u*)(CQ + (size_t)m * QL + 8 * lane) = pack8(o); }
        { const int l2 = lane & 31; unpack8(*(const GAS v4u*)(zr + 1152 + 8 * l2), f); float ss = 0.f;
#pragma unroll
          for (int j = 0; j < 8; ++j) ss += f[j] * f[j];
          if (lane >= 32) ss = 0.f;
          const float r = 1.0f / sqrtf(wave_sum(ss) * (1.f / 256.f) + EPS);
#pragma unroll
          for (int j = 0; j < 8; ++j) o[j] = f[j] * r;
          if (lane < 32) *(GAS v4u*)(CKV + (size_t)m * KVL + 8 * lane) = pack8(o); }
        { const int l2 = lane & 3; unpack8(*(const GAS v4u*)(zr + 1408 + 8 * l2), f); float ss = 0.f;
#pragma unroll
          for (int j = 0; j < 8; ++j) ss += f[j] * f[j];
          const float r = 1.0f / sqrtf(grp_sum4(ss) * (1.f / 32.f) + EPS);
#pragma unroll
          for (int j = 0; j < 8; ++j) { const float y = f[j] * r * gkrv[j]; const float p = __shfl_xor(y, 2); const int i = (8 * l2 + j) & 15;
              const float c = TAB[TAB_COS + s * 16 + i], sn = TAB[TAB_SIN + s * 16 + i];
              o[j] = (l2 < 2) ? (y * c - p * sn) : (p * sn + y * c); }
          if (lane < 4) *(GAS v4u*)(KR + (size_t)m * ROPE + 8 * lane) = pack8(o); }
    }
}

__device__ __forceinline__ void p4_fixup(Frame& F) {
    const int gw = F.vcu * NWAVES + F.wave, NGW = F.G * NWAVES, lane = F.lane;
    bf16* QB = WSP(bf16, WS_QB); const bf16* KVR = WSP(bf16, WS_KVRAW); bf16* KBN = WSP(bf16, WS_KBN); bf16* VB = WSP(bf16, WS_VB);
    const float* TAB = WSP(float, WS_TAB);
    float gqn[8], gkn[8], gqr[8];
#pragma unroll
    for (int j = 0; j < 8; ++j) { gqn[j] = F.in[11][8 * (lane & 7) + j]; gkn[j] = F.in[13][8 * (lane & 7) + j]; gqr[j] = F.in[12][8 * (lane & 3) + j]; }
    for (int m = gw; m < T; m += NGW) {
        const int s = m % SEQ; float f[8], o[8];
        bf16* qrow = QB + (size_t)m * (BH * QKD);
        { bf16* p = qrow + QKD * (lane >> 3) + 8 * (lane & 7); unpack8(*(const GAS v4u*)p, f); float ss = 0.f;
#pragma unroll
          for (int j = 0; j < 8; ++j) ss += f[j] * f[j];
          const float r = QSC_B / sqrtf(grp_sum8(ss) * (1.f / 64.f) + EPS);
#pragma unroll
          for (int j = 0; j < 8; ++j) o[j] = f[j] * r * gqn[j];
          *(GAS v4u*)p = pack8(o); }
        { const int l2 = lane & 31; bf16* p = qrow + QKD * (l2 >> 2) + NOPE + 8 * (l2 & 3); unpack8(*(const GAS v4u*)p, f); float ss = 0.f;
#pragma unroll
          for (int j = 0; j < 8; ++j) ss += f[j] * f[j];
          const float r = 1.0f / sqrtf(grp_sum4(ss) * (1.f / 32.f) + EPS);
#pragma unroll
          for (int j = 0; j < 8; ++j) { const float y = f[j] * r * gqr[j]; const float pp = __shfl_xor(y, 2); const int i = (8 * (l2 & 3) + j) & 15;
              const float c = TAB[TAB_COS + s * 16 + i], sn = TAB[TAB_SIN + s * 16 + i];
              o[j] = QSC_B * (((l2 & 3) < 2) ? (y * c - pp * sn) : (pp * sn + y * c)); }
          if (lane < 32) *(GAS v4u*)p = pack8(o); }
        { const bf16* p = KVR + (size_t)m * 1024 + 128 * (lane >> 3) + 8 * (lane & 7); unpack8(*(const GAS v4u*)p, f); float ss = 0.f;
#pragma unroll
          for (int j = 0; j < 8; ++j) ss += f[j] * f[j];
          const float r = 1.0f / sqrtf(grp_sum8(ss) * (1.f / 64.f) + EPS);
#pragma unroll
          for (int j = 0; j < 8; ++j) o[j] = f[j] * r * gkn[j];
          *(GAS v4u*)(KBN + (size_t)m * 512 + 64 * (lane >> 3) + 8 * (lane & 7)) = pack8(o);
          *(GAS v4u*)(VB + (size_t)m * 512 + 64 * (lane >> 3) + 8 * (lane & 7)) = *(const GAS v4u*)(p + 64); }
    }
}

__device__ __forceinline__ void p6_onorm(Frame& F) {
    const int gw = F.vcu * NWAVES + F.wave, NGW = F.G * NWAVES, lane = F.lane;
    bf16* O = WSP(bf16, WS_O);
    for (int m = gw; m < T; m += NGW) {
#pragma unroll
        for (int hf = 0; hf < 2; ++hf) { bf16* p = O + (size_t)m * DM + 512 * hf + 8 * lane; float f[8], o[8]; unpack8(*(const GAS v4u*)p, f); float ss = 0.f;
#pragma unroll
            for (int j = 0; j < 8; ++j) ss += f[j] * f[j];
            const float r = 1.0f / sqrtf(wave_sum(ss) * (1.f / 512.f) + EPS);
#pragma unroll
            for (int j = 0; j < 8; ++j) o[j] = f[j] * r;
            *(GAS v4u*)p = pack8(o); }
    }
}

__device__ __forceinline__ void p8_router(Frame& F) {
    const int gw = F.vcu * NWAVES + F.wave, NGW = F.G * NWAVES, lane = F.lane;
    bf16* H2 = WSP(bf16, WS_H2); float* AFF = WSP(float, WS_AFF);
    const float* g2 = F.in[18]; const float* wr = F.in[19];
    for (int m = gw; m < T; m += NGW) {
        const GAS f32x4* xr = (const GAS f32x4*)(F.out + (size_t)m * DM) + lane;
        f32x4 v[4]; float s = 0.f;
#pragma unroll
        for (int j = 0; j < 4; ++j) { v[j] = xr[64 * j]; s += (v[j].x * v[j].x + v[j].y * v[j].y) + (v[j].z * v[j].z + v[j].w * v[j].w); }
        const float rs = 1.0f / sqrtf(wave_sum(s) * (1.f / DM) + EPS);
        float lg[16];
#pragma unroll
        for (int e = 0; e < 16; ++e) lg[e] = 0.f;
        GAS unsigned long long* o8 = (GAS unsigned long long*)(H2 + (size_t)m * DM) + lane;
#pragma unroll
        for (int j = 0; j < 4; ++j) { const int c0 = 4 * lane + 256 * j; const f32x4 g = *(const GAS f32x4*)(g2 + c0);
            const f32x4 h = {v[j].x * rs * g.x, v[j].y * rs * g.y, v[j].z * rs * g.z, v[j].w * rs * g.w};
            o8[64 * j] = (unsigned long long)pk2(h.x, h.y) | ((unsigned long long)pk2(h.z, h.w) << 32);
#pragma unroll
            for (int i = 0; i < 4; ++i) { const float hv = h[i]; const GAS f32x4* w4 = (const GAS f32x4*)(wr + (size_t)(c0 + i) * NE);
#pragma unroll
                for (int q = 0; q < 4; ++q) { const f32x4 w = w4[q]; lg[4 * q] += hv * w.x; lg[4 * q + 1] += hv * w.y; lg[4 * q + 2] += hv * w.z; lg[4 * q + 3] += hv * w.w; } } }
        float mx = -1e30f;
#pragma unroll
        for (int e = 0; e < 16; ++e) { lg[e] = wave_sum(lg[e]); mx = fmaxf(mx, lg[e]); }
        float den = 0.f;
#pragma unroll
        for (int e = 0; e < 16; ++e) { lg[e] = expf(lg[e] - mx); den += lg[e]; }
        float mine = 0.f;
#pragma unroll
        for (int e = 0; e < 16; ++e) mine = (lane == e) ? lg[e] : mine;
        if (lane < 16) AFF[((size_t)(m / SEQ) * NE + lane) * SEQ + (m % SEQ)] = mine / den;
    }
}

__device__ __forceinline__ int block_excl_scan(int v, LAS int* tmp, int tid, int lane, int wave, int& total) {
    int inc = v;
#pragma unroll
    for (int o = 1; o < 64; o <<= 1) { const int t = __shfl_up(inc, o); if (lane >= o) inc += t; }
    if (lane == 63) tmp[wave] = inc;
    __syncthreads();
    int base = 0, tot = 0;
#pragma unroll
    for (int w = 0; w < NWAVES; ++w) { const int t = tmp[w]; if (w < wave) base += t; tot += t; }
    __syncthreads();
    total = tot; return base + inc - v;
}
__device__ __forceinline__ void p9_topk(Frame& F) {
    LAS unsigned* keys = (LAS unsigned*)(F.lds + RING_OFF);
    LAS unsigned* hist = keys + SEQ;
    LAS int* tmp = (LAS int*)(hist + 256);
    LAS unsigned* res = (LAS unsigned*)(tmp + 16);
    const int tid = F.tid, lane = F.lane, wave = F.wave;
    const float* AFF = WSP(float, WS_AFF); int* IDX = WSP(int, WS_IDX); float* GATEV = WSP(float, WS_GATEV); int* SLOT = WSP(int, WS_SLOT);
    for (int item = blockIdx.x; item < BATCH * NE; item += F.G) {
        const int b = item / NE, e = item % NE; const float* a = AFF + (size_t)item * SEQ;
        __syncthreads();
#pragma unroll
        for (int i = 0; i < 8; ++i) keys[tid + 512 * i] = __float_as_uint(a[tid + 512 * i]);
        unsigned prefix = 0u, mask = 0u; int remaining = CAP;
        for (int pass = 3; pass >= 0; --pass) {
            if (tid < 256) hist[tid] = 0u;
            __syncthreads();
#pragma unroll
            for (int i = 0; i < 8; ++i) { const unsigned k = keys[tid + 512 * i]; if ((k & mask) == prefix) __hip_atomic_fetch_add(&hist[(k >> (8 * pass)) & 255u], 1u, __ATOMIC_RELAXED, __HIP_MEMORY_SCOPE_WORKGROUP); }
            __syncthreads();
            if (wave == 0) {
                const int d0 = 4 * (63 - lane); const int c3 = (int)hist[d0 + 3], c2 = (int)hist[d0 + 2], c1 = (int)hist[d0 + 1], c0 = (int)hist[d0];
                const int tot = c3 + c2 + c1 + c0; int inc = tot;
#pragma unroll
                for (int o = 1; o < 64; o <<= 1) { const int t = __shfl_up(inc, o); if (lane >= o) inc += t; }
                int cum = inc - tot;
                const int cc[4] = {c3, c2, c1, c0};
#pragma unroll
                for (int q = 0; q < 4; ++q) { if (cum < remaining && remaining <= cum + cc[q]) { res[0] = (unsigned)(d0 + 3 - q); res[1] = (unsigned)cum; } cum += cc[q]; }
            }
            __syncthreads();
            const unsigned dg = res[0]; const int above = (int)res[1];
            prefix |= dg << (8 * pass); mask |= 255u << (8 * pass); remaining -= above;
            __syncthreads();
        }
        unsigned kk[8]; int neq = 0;
#pragma unroll
        for (int i = 0; i < 8; ++i) { kk[i] = keys[8 * tid + i]; neq += (kk[i] == prefix) ? 1 : 0; }
        int toteq; int eqbase = block_excl_scan(neq, tmp, tid, lane, wave, toteq);
        int sel[8]; int nsel = 0;
#pragma unroll
        for (int i = 0; i < 8; ++i) { const bool eq = kk[i] == prefix; sel[i] = (kk[i] > prefix || (eq && eqbase < remaining)) ? 1 : 0; eqbase += eq ? 1 : 0; nsel += sel[i]; }
        int totsel; int slot = block_excl_scan(nsel, tmp, tid, lane, wave, totsel);
        const size_t rbase = (size_t)(e * BATCH + b) * CAP;
#pragma unroll
        for (int i = 0; i < 8; ++i) { const int s = 8 * tid + i;
            if (sel[i]) { if (slot < CAP) { IDX[rbase + slot] = b * SEQ + s; GATEV[rbase + slot] = __uint_as_float(kk[i]); } SLOT[(size_t)item * SEQ + s] = slot < CAP ? slot : -1; ++slot; }
            else SLOT[(size_t)item * SEQ + s] = -1; }
    }
}

__device__ __forceinline__ void p9b_gather(Frame& F) {
    const int gw = F.vcu * NWAVES + F.wave, NGW = F.G * NWAVES, lane = F.lane;
    const bf16* H2 = WSP(bf16, WS_H2); bf16* XE = WSP(bf16, WS_XE); const int* IDX = WSP(int, WS_IDX);
    for (int r = gw; r < MX; r += NGW) { const int tok = IDX[r]; const GAS v4u* src = (const GAS v4u*)(H2 + (size_t)tok * DM) + lane; GAS v4u* dst = (GAS v4u*)(XE + (size_t)r * DM) + lane;
        const v4u a = src[0], b = src[64]; dst[0] = a; dst[64] = b; }
}

__device__ __forceinline__ void p12_combine(Frame& F) {
    const int gw = F.vcu * NWAVES + F.wave, NGW = F.G * NWAVES, lane = F.lane;
    const bf16* YE = WSP(bf16, WS_YE); const int* SLOT = WSP(int, WS_SLOT);
    for (int m = gw; m < T; m += NGW) {
        const int b = m / SEQ, s = m % SEQ;
        const int sl = (lane < NE) ? SLOT[((size_t)b * NE + lane) * SEQ + s] : -1;
        unsigned long long mask = __ballot(sl >= 0);
        GAS f32x4* xr = (GAS f32x4*)(F.out + (size_t)m * DM) + lane;
        f32x4 v[4];
#pragma unroll
        for (int j = 0; j < 4; ++j) v[j] = xr[64 * j];
        while (mask) { const int e = __builtin_ctzll(mask); mask &= mask - 1; const int slot = __shfl(sl, e);
            const GAS unsigned long long* yr = (const GAS unsigned long long*)(YE + ((size_t)(e * BATCH + b) * CAP + slot) * DM) + lane;
#pragma unroll
            for (int j = 0; j < 4; ++j) { const unsigned long long w = yr[64 * j]; const unsigned lo = (unsigned)w, hi = (unsigned)(w >> 32);
                v[j].x += __uint_as_float(lo << 16); v[j].y += __uint_as_float(lo & 0xffff0000u); v[j].z += __uint_as_float(hi << 16); v[j].w += __uint_as_float(hi & 0xffff0000u); } }
#pragma unroll
        for (int j = 0; j < 4; ++j) xr[64 * j] = v[j];
    }
}

struct Args { const float* in[23]; float* out; unsigned char* ws; int ph_lo, ph_hi, li, pad; };
constexpr int N_PHASES = 13;
__global__ void __launch_bounds__(NWAVES * 64, 2) skel_fwd(Args args) {
    extern __shared__ __attribute__((aligned(16))) unsigned char lds[];
    Frame F;
    F.lds = (LAS unsigned char*)lds;
    F.MISC = (volatile LAS unsigned*)(F.lds + MISC_OFF);
    F.tid = threadIdx.x; F.lane = F.tid & 63; F.wave = __builtin_amdgcn_readfirstlane(F.tid >> 6);
    F.G = gridDim.x; { const int bx = blockIdx.x; F.vcu = (F.G % 8 == 0) ? (bx % 8) * (F.G / 8) + bx / 8 : bx; }
    F.ws = args.ws; F.out = args.out;
#pragma unroll
    for (int i = 0; i < 23; ++i) F.in[i] = args.in[i];
    F.ctl = (gu32*)(F.ws + WS_CTL);
    for (int u = F.tid; u < (LDS_BYTES - LDSCTL_OFF) / 4; u += NWAVES * 64) ((LAS unsigned*)(F.lds + LDSCTL_OFF))[u] = 0u;
    __syncthreads();
    XcdBarrier bar = xcd_barrier_post((unsigned*)(F.ctl + CW_BAR) + args.li * XCD_BAR_WORDS, F.MISC + 8);
    const int lo = args.ph_lo, hi = args.ph_hi;
#define IN(k) (lo <= (k) && (k) < hi)
#define SEAM(k) do { if (IN(k) && IN((k) + 1)) xcd_barrier(bar); } while (0)

    if (IN(0)) { p0_prologue(F); } SEAM(0);
    if (IN(1)) {
        pg8::Gemm g{WSP(bf16, WS_XN), WSP(bf16, WS_WIN), T, NZ, DM, 0}; pg8::StaticOrder S; S.init(T, NZ, F.G, (int)blockIdx.x);
        pg8::EpiBf16<0> E{WSP(bf16, WS_Z), NZ, nullptr, 0, 0, 1.f};
        pg8::gemm_phase<pg8::EpiBf16<0>, pg8::StaticOrder, true, true>(F.lds + RING_OFF, g, S, E);
    } SEAM(1);
    if (IN(2)) { p2_fixup(F); } SEAM(2);
    if (IN(3)) {
        { pg8::Gemm g{WSP(bf16, WS_CQ), WSP(bf16, WS_WQB), T, BH * QKD, QL, 0}; pg8::StaticOrder S; S.init(T, BH * QKD, F.G, (int)blockIdx.x);
          pg8::EpiBf16<0> E{WSP(bf16, WS_QB), BH * QKD, nullptr, 0, 0, 1.f};
          pg8::gemm_phase<pg8::EpiBf16<0>, pg8::StaticOrder, true, true>(F.lds + RING_OFF, g, S, E); }
        __syncthreads();
        { pg8::Gemm g{WSP(bf16, WS_CKV), WSP(bf16, WS_WKVB), T, BH * 128, KVL, 0}; pg8::StaticOrder S; S.init(T, BH * 128, F.G, (int)(F.G - 1 - blockIdx.x));
          pg8::EpiBf16<0> E{WSP(bf16, WS_KVRAW), BH * 128, nullptr, 0, 0, 1.f};
          pg8::gemm_phase<pg8::EpiBf16<0>, pg8::StaticOrder, true, true>(F.lds + RING_OFF, g, S, E); }
    } SEAM(3);
    if (IN(4)) { p4_fixup(F); } SEAM(4);
    SEAM(5);
    if (IN(6)) { p6_onorm(F); } SEAM(6);
    if (IN(7)) {
        pg8::Gemm g{WSP(bf16, WS_O), WSP(bf16, WS_WO), T, DM, DM, 0}; pg8::StaticOrder S; S.init(T, DM, F.G, (int)blockIdx.x);
        pg8::EpiResF32 E{F.in[0], F.out, DM};
        pg8::gemm_phase<pg8::EpiResF32, pg8::StaticOrder, true, true>(F.lds + RING_OFF, g, S, E);
    } SEAM(7);
    if (IN(8)) { p8_router(F); } SEAM(8);
    if (IN(9)) { p9_topk(F); } SEAM(9);
    if (IN(10)) { p9b_gather(F); } SEAM(10);
    if (IN(11)) {
        pg8::Gemm g{WSP(bf16, WS_XE), WSP(bf16, WS_WGU), MX, 2 * FF, DM, (size_t)2 * FF * DM * 2}; pg8::StaticOrder S; S.init(MX, 2 * FF, F.G, (int)blockIdx.x, 16);
        pg8::EpiSwiGLU E{WSP(bf16, WS_ACT), FF};
        pg8::gemm_phase<pg8::EpiSwiGLU, pg8::StaticOrder, true, true>(F.lds + RING_OFF, g, S, E);
    } SEAM(11);
    if (IN(12)) {
        pg8::Gemm g{WSP(bf16, WS_ACT), WSP(bf16, WS_WD), MX, DM, FF, (size_t)DM * FF * 2}; pg8::StaticOrder S; S.init(MX, DM, F.G, (int)blockIdx.x, 16);
        pg8::EpiRowScaleBf16 E{WSP(bf16, WS_YE), DM, WSP(float, WS_GATEV)};
        pg8::gemm_phase<pg8::EpiRowScaleBf16, pg8::StaticOrder, true, true>(F.lds + RING_OFF, g, S, E);
    } SEAM(12);
    if (IN(13)) { p12_combine(F); }
#undef IN
#undef SEAM
}

__device__ __forceinline__ float bf2f(bf16 v) { return __uint_as_float((unsigned)v << 16); }
__global__ void __launch_bounds__(256) naive_attn_a(const bf16* __restrict__ QA, const bf16* __restrict__ KA, const bf16* __restrict__ VA, const float* __restrict__ TAB, const float* __restrict__ sink, bf16* __restrict__ O) {
    const int s = (blockIdx.x % (SEQ / 256)) * 256 + threadIdx.x, bh = blockIdx.x / (SEQ / 256), h = bh % A_HEADS, b = bh / A_HEADS, g = h / (A_HEADS / A_KV);
    const size_t m = (size_t)b * SEQ + s;
    float q[HD], o[HD];
#pragma unroll
    for (int d = 0; d < HD; ++d) { q[d] = bf2f(QA[m * 512 + h * HD + d]); o[d] = 0.f; }
    const float bnd = TAB[TAB_CONST + 0];
    float l = exp2f(sink[h] * LOG2E - bnd);
    for (int rel = -WINDOW; rel <= WINDOW; ++rel) { const int j = s + rel; if (j < 0 || j >= SEQ) continue;
        const bf16* kr = KA + ((size_t)b * SEQ + j) * 128 + g * HD; const bf16* vr = VA + ((size_t)b * SEQ + j) * 128 + g * HD;
        float sc = 0.f;
#pragma unroll
        for (int d = 0; d < HD; ++d) sc += q[d] * bf2f(kr[d]);
        const float p = exp2f(sc + TAB[TAB_BIAS + h * NTAB + rel + 128] - bnd); l += p;
#pragma unroll
        for (int d = 0; d < HD; ++d) o[d] += p * bf2f(vr[d]); }
    const float il = 1.0f / l;
#pragma unroll
    for (int d = 0; d < HD; ++d) O[m * DM + h * HD + d] = (bf16)f2bf(o[d] * il);
}
__global__ void __launch_bounds__(256) naive_attn_b(const bf16* __restrict__ QB, const bf16* __restrict__ KBN, const bf16* __restrict__ KR, const bf16* __restrict__ VB, const float* __restrict__ TAB, bf16* __restrict__ O) {
    const int s = (blockIdx.x % (SEQ / 256)) * 256 + threadIdx.x, bh = blockIdx.x / (SEQ / 256), h = bh % BH, b = bh / BH;
    const size_t m = (size_t)b * SEQ + s;
    float q[QKD], o[VD];
#pragma unroll
    for (int d = 0; d < QKD; ++d) q[d] = bf2f(QB[m * (BH * QKD) + h * QKD + d]);
#pragma unroll
    for (int d = 0; d < VD; ++d) o[d] = 0.f;
    const float bnd = TAB[TAB_CONST + 1];
    float l = 0.f;
    for (int j = 0; j < SEQ; ++j) { const size_t mj = (size_t)b * SEQ + j;
        const bf16* kn = KBN + mj * 512 + h * NOPE; const bf16* kr = KR + mj * ROPE; const bf16* vr = VB + mj * 512 + h * VD;
        float sc = 0.f;
#pragma unroll
        for (int d = 0; d < NOPE; ++d) sc += q[d] * bf2f(kn[d]);
#pragma unroll
        for (int d = 0; d < ROPE; ++d) sc += q[NOPE + d] * bf2f(kr[d]);
        const float p = exp2f(sc - bnd); l += p;
#pragma unroll
        for (int d = 0; d < VD; ++d) o[d] += p * bf2f(vr[d]); }
    const float il = 1.0f / l;
#pragma unroll
    for (int d = 0; d < VD; ++d) O[m * DM + 512 + h * VD + d] = (bf16)f2bf(o[d] * il);
}

extern "C" void kernel_launch(void* const* d_in, const int* in_sizes, int n_in, void* d_out, int out_size, void* d_ws, size_t ws_size, hipStream_t stream) {
    static int grid = 0;
    if (grid == 0) {
        if (n_in != 23 || in_sizes[0] != T * DM || out_size != T * DM || ws_size < WS_END) { fprintf(stderr, "kernel_launch: unexpected shapes (n_in %d, in0 %d, out %d, ws %zu)\n", n_in, n_in > 0 ? in_sizes[0] : -1, out_size, ws_size); grid = -1; return; }
        int dev = 0, cus = 0, per_cu = 0;
        if (hipGetDevice(&dev) != hipSuccess || hipDeviceGetAttribute(&cus, hipDeviceAttributeMultiprocessorCount, dev) != hipSuccess) { grid = -1; return; }
        if (hipFuncSetAttribute((const void*)skel_fwd, hipFuncAttributeMaxDynamicSharedMemorySize, LDS_BYTES) != hipSuccess) { fprintf(stderr, "kernel_launch: hipFuncSetAttribute failed\n"); grid = -1; return; }
        if (hipOccupancyMaxActiveBlocksPerMultiprocessor(&per_cu, (const void*)skel_fwd, NWAVES * 64, LDS_BYTES) != hipSuccess || per_cu < 1) fprintf(stderr, "kernel_launch: occupancy query says %d\n", per_cu);
        (void)hipGetLastError();
        grid = cus;
    }
    if (grid < 0) return;
    if (hipMemsetAsync((char*)d_ws + WS_CTL, 0, CTL_ZERO_BYTES, stream) != hipSuccess) return;
    Args a{};
    for (int i = 0; i < 23; ++i) a.in[i] = (const float*)d_in[i];
    a.out = (float*)d_out; a.ws = (unsigned char*)d_ws;
    unsigned char* ws = (unsigned char*)d_ws;
    a.ph_lo = 0; a.ph_hi = 5; a.li = 0;
    hipLaunchKernelGGL(skel_fwd, dim3(grid), dim3(NWAVES * 64), LDS_BYTES, stream, a);
    hipLaunchKernelGGL(naive_attn_a, dim3(BATCH * A_HEADS * (SEQ / 256)), dim3(256), 0, stream, (const bf16*)(ws + WS_QA), (const bf16*)(ws + WS_KA), (const bf16*)(ws + WS_VA), (const float*)(ws + WS_TAB), (const float*)d_in[6], (bf16*)(ws + WS_O));
    hipLaunchKernelGGL(naive_attn_b, dim3(BATCH * BH * (SEQ / 256)), dim3(256), 0, stream, (const bf16*)(ws + WS_QB), (const bf16*)(ws + WS_KBN), (const bf16*)(ws + WS_KR), (const bf16*)(ws + WS_VB), (const float*)(ws + WS_TAB), (bf16*)(ws + WS_O));
    a.ph_lo = 6; a.ph_hi = 14; a.li = 1;
    hipLaunchKernelGGL(skel_fwd, dim3(grid), dim3(NWAVES * 64), LDS_BYTES, stream, a);
}
```

```cpp
#include <hip/hip_runtime.h>
#include <hip/hip_bf16.h>
#include <cstdio>
#include <cstdint>
#ifndef PROBE_ATT
#define PROBE_ATT 0
#endif
#ifndef PROBE_MASK
#define PROBE_MASK 0
#endif
#ifndef NAIVE_ATTN
#define NAIVE_ATTN 0
#endif
__device__ __forceinline__ int lane_id() { int l; asm volatile("v_mbcnt_lo_u32_b32 %0, -1, 0\n\tv_mbcnt_hi_u32_b32 %0, -1, %0" : "=v"(l)); return l; }

constexpr int NWAVES = 8;
constexpr int BATCH = 8, SEQ = 4096, DM = 1024, T = BATCH * SEQ;
constexpr int INW = 1440, NZ = 1536;
constexpr int A_HEADS = 8, A_KV = 2, HD = 64, WINDOW = 128;
constexpr int BH = 8, QL = 384, KVL = 256, NOPE = 64, ROPE = 32, VD = 64, QKD = NOPE + ROPE;
constexpr int NE = 16, FF = 1024, CAP = 512, MX = NE * BATCH * CAP;
constexpr float EPS = 1e-6f, LOG2E = 1.4426950408889634f;
constexpr float QSC_A = 0.125f * LOG2E;
constexpr float QSC_B = 0.10206207261596577f * LOG2E;
constexpr int NTAB = 257;

constexpr size_t MiB = 1u << 20;
constexpr size_t WS_CTL = 0, CTL_ZERO_BYTES = 1 * MiB;
constexpr size_t WS_SSQ = 512 * 1024;
constexpr size_t WS_SSQCQ = 768 * 1024, WS_SSQCKV = 896 * 1024;
constexpr size_t WS_TAB = 1 * MiB;
constexpr size_t WS_WIN = 4 * MiB, WS_WQB = 7 * MiB, WS_WKVB = 8 * MiB, WS_WO = 9 * MiB, WS_WGU = 12 * MiB, WS_WD = 76 * MiB;
constexpr size_t WS_AFF = 108 * MiB, WS_IDX = 110 * MiB, WS_GATEV = WS_IDX + 512 * 1024, WS_SLOT = 111 * MiB;
constexpr size_t WS_XN = 114 * MiB;
constexpr size_t WS_Z = 178 * MiB;
constexpr size_t WS_QA = 274 * MiB, WS_KA = 306 * MiB, WS_VA = 314 * MiB, WS_CQ = 322 * MiB, WS_CKV = 346 * MiB, WS_KR = 362 * MiB;
constexpr size_t WS_KVRAW = 364 * MiB, WS_KBN = 428 * MiB, WS_VB = 460 * MiB, WS_END = 492 * MiB;
constexpr size_t WS_ATT = 242 * MiB;
constexpr size_t WS_X1B = 370 * MiB;
constexpr size_t WS_QB = WS_Z, WS_O = WS_XN, WS_H2 = WS_XN, WS_XE = WS_Z, WS_ACT = 306 * MiB, WS_YE = WS_Z;
constexpr int TAB_BIAS = 0, TAB_CONST = 8 * NTAB + 8, TAB_COS = TAB_CONST + 16, TAB_SIN = TAB_COS + SEQ * 16;
constexpr int CW_TMO = 0, CW_BAR = 4096;

constexpr int RING_OFF = 0, RING_BYTES = 131072;
constexpr int LDSCTL_OFF = RING_BYTES, MISC_OFF = LDSCTL_OFF + 320;
constexpr int LDS_BYTES = 147456;
namespace pg8 {
#define PG8_LAS __attribute__((address_space(3)))
typedef unsigned short bf16_t;
typedef short bf16x8 __attribute__((ext_vector_type(8)));
typedef float f32x4 __attribute__((ext_vector_type(4)));
typedef unsigned u32x4 __attribute__((ext_vector_type(4)));
constexpr int BM = 256, BK = 64, HALF = 128, HTB = HALF * BK * 2  , STAGE_BYTES = 8 * HTB, NXCD = 8, WGM = 8;

__host__ __device__ __forceinline__ int lds_byte(int r, int c) { const int st = (r >> 4) * 2 + (c >> 5), rr = r & 15, cc = c & 31, ob = rr * 64 + cc * 2; return st * 1024 + (ob ^ (((ob >> 9) & 1) << 5)); }
__host__ __device__ __forceinline__ void stage_rc(int b, int& R, int& C) { const int st = b / 1024, sb = b % 1024, swz = sb ^ (((sb >> 9) & 1) << 5); R = (st >> 1) * 16 + swz / 64; C = (st & 1) * 32 + (swz % 64) / 2; }
__host__ __device__ __forceinline__ int gray4(int q) { return q ^ (q >> 1); }
__host__ __device__ __forceinline__ int lds_byte8(int r, int cbyte) { const int st = (r >> 4) * 2 + (cbyte >> 6), rr = r & 15; return st * 1024 + rr * 64 + ((((cbyte >> 4) & 3) ^ gray4((rr >> 2) & 3)) << 4) + (cbyte & 15); }
__host__ __device__ __forceinline__ void stage_rc8(int b, int& R, int& C) { const int st = b / 1024, sb = b % 1024, rr = sb / 64, ch = ((sb % 64) / 16) ^ gray4((rr >> 2) & 3); R = (st >> 1) * 16 + rr; C = (st & 1) * 32 + ch * 8; }
__host__ __device__ __forceinline__ int perm32(int rho) { const int n = rho >> 4, i = rho & 15; return 8 * (i >> 2) + 4 * n + (i & 3); }

struct Unit { int pm, pn, e; };
struct Gemm { const bf16_t* A; const bf16_t* Bt; int M, N, K; size_t estride; const int* idx; const float* ssq; int sA, sB; unsigned gtab; int wave; };

struct StaticOrder {
    int nM, nN, nwg, G, c, epan;
    __host__ __device__ void init(int M, int N, int G_, int c_, int epan_ = 0) { nM = M / BM; nN = N / BM; nwg = nM * nN; G = G_; c = c_; epan = epan_; }
    __host__ __device__ bool next(int i, Unit& u) const {
        const long L = (long)i * G + c; if (L >= nwg) return false;
        int wgid = (int)L; { const int q = nwg / NXCD, r = nwg % NXCD, xcd = wgid % NXCD, off = wgid / NXCD; wgid = (xcd < r ? xcd * (q + 1) : r * (q + 1) + (xcd - r) * q) + off; }
        const int nig = WGM * nN, gid = wgid / nig, fm = gid * WGM, gsz = (nM - fm) < WGM ? (nM - fm) : WGM;
        u.pm = fm + ((wgid % nig) % gsz); u.pn = (wgid % nig) / gsz; u.e = epan ? u.pm / epan : 0; return true;
    }
    __device__ __forceinline__ void a_ready(const Unit&) const {}
    __device__ __forceinline__ void done(const Unit&) const {}
};

__device__ __forceinline__ unsigned cvt_pk_bf16(float lo, float hi) { unsigned r; asm volatile("v_cvt_pk_bf16_f32 %0, %1, %2" : "=v"(r) : "v"(lo), "v"(hi)); return r; }
typedef float f32x2 __attribute__((ext_vector_type(2)));
__device__ __forceinline__ f32x2 gelu_pk(f32x2 v) {
    const f32x2 av = __builtin_elementwise_abs(v), d = av * 0.2316418882f + 1.0f;
    f32x2 t; t.x = __builtin_amdgcn_rcpf(d.x); t.y = __builtin_amdgcn_rcpf(d.y);
    f32x2 q = t * 0.5307027145f + (-0.7265760135f); q = q * t + 0.7107068705f; q = q * t + (-0.142248368f); q = q * t + 0.127414796f; q = q * t;
    const f32x2 s = (v * v) * (-0.72134752044f);
    f32x2 e; e.x = __builtin_amdgcn_exp2f(s.x); e.y = __builtin_amdgcn_exp2f(s.y);
    const f32x2 m = v * (q * e), r = v - m;
    f32x2 o; o.x = v.x < 0.f ? m.x : r.x; o.y = v.y < 0.f ? m.y : r.y; return o;
}

template <int ACT  > struct EpiBf16 {
    static constexpr bool PERM = true, AFTER_DRAIN = false; static_assert(ACT == 0 || ACT == 1, "EpiBf16: ACT is 0 (none) or 1 (gelu_pk)");
    bf16_t* O; int ldc; const float* bias; int split_cols; size_t split_stride; float scale0;
    __device__ __forceinline__ void operator()(const f32x4 (&acc)[2][2][4][2], const Unit& u, int wr, int wc, int fr, int fq) const {
        const int row0 = u.pm * BM + wr * 64 + fr; int colt = u.pn * BM; bf16_t* base = O;
        float sc = 1.f; if (split_cols) { const int t = colt / split_cols; base += (size_t)t * split_stride; colt -= t * split_cols; if (t == 0) sc = scale0; }
        const int col0 = colt + wc * 32 + 8 * fq, bcol0 = u.pn * BM + wc * 32 + 8 * fq;
        f32x4 bv[2][2];
#pragma unroll
        for (int bj = 0; bj < 2; ++bj)
#pragma unroll
            for (int n = 0; n < 2; ++n) bv[bj][n] = bias ? *(const f32x4*)(bias + bcol0 + bj * HALF + 4 * n) : (f32x4){0.f, 0.f, 0.f, 0.f};
#pragma unroll
        for (int ai = 0; ai < 2; ++ai)
#pragma unroll
            for (int m = 0; m < 4; ++m) { bf16_t* rowp = base + (size_t)(row0 + ai * HALF + m * 16) * ldc + col0;
#pragma unroll
                for (int bj = 0; bj < 2; ++bj) { f32x4 v0 = acc[ai][bj][m][0] + bv[bj][0], v1 = acc[ai][bj][m][1] + bv[bj][1];
                    if (ACT == 1) { f32x2 a = gelu_pk((f32x2){v0[0], v0[1]}), b = gelu_pk((f32x2){v0[2], v0[3]}), c = gelu_pk((f32x2){v1[0], v1[1]}), d = gelu_pk((f32x2){v1[2], v1[3]});
                        v0 = (f32x4){a.x, a.y, b.x, b.y}; v1 = (f32x4){c.x, c.y, d.x, d.y}; }
                    v0 = v0 * sc; v1 = v1 * sc; u32x4 w; w.x = cvt_pk_bf16(v0[0], v0[1]); w.y = cvt_pk_bf16(v0[2], v0[3]); w.z = cvt_pk_bf16(v1[0], v1[1]); w.w = cvt_pk_bf16(v1[2], v1[3]);
                    *(u32x4*)(rowp + bj * HALF) = w; } }
    }
};

struct EpiResF32 {
    static constexpr bool PERM = true, AFTER_DRAIN = false;
    const float* base; float* out; int ldc; const float* ssq;
    __device__ __forceinline__ void operator()(const f32x4 (&acc)[2][2][4][2], const Unit& u, int wr, int wc, int fr_, int fq_) const {
        (void)fr_; (void)fq_; const int ln_ = lane_id(); const int fr = ln_ & 15, fq = ln_ >> 4;
        const int col0 = u.pn * BM + wc * 32 + 8 * fq;
#pragma unroll
        for (int ai = 0; ai < 2; ++ai)
#pragma unroll
            for (int m = 0; m < 4; ++m) { const int r = ai * HALF + wr * 64 + m * 16 + fr; const unsigned off = (unsigned)((u.pm * BM + r) * ldc + col0);
                const float rb = ssq ? __builtin_amdgcn_rsqf(ssq[2 * (u.pm * BM + r) + 1] * (1.0f / 512.0f) + 1e-6f) : 1.0f;
#pragma unroll
                for (int bj = 0; bj < 2; ++bj)
#pragma unroll
                    for (int n = 0; n < 2; ++n) { const f32x4 bs = *(const f32x4*)(base + off + bj * HALF + n * 4); *(f32x4*)(out + off + bj * HALF + n * 4) = bs + acc[ai][bj][m][n] * rb; } }
    }
};
__device__ __forceinline__ float silu_mul(float g, float u) { return g * u * __builtin_amdgcn_rcpf(1.0f + __builtin_amdgcn_exp2f(-1.4426950408889634f * g)); }
struct EpiSwiGLU {
    static constexpr bool PERM = true, AFTER_DRAIN = false;
    bf16_t* O; int ldc;
    __device__ __forceinline__ void operator()(const f32x4 (&acc)[2][2][4][2], const Unit& u, int wr, int wc, int fr_, int fq_) const {
        (void)fr_; (void)fq_; const int ln_ = lane_id(); const int fr = ln_ & 15, fq = ln_ >> 4;
        const int row0 = u.pm * BM + wr * 64 + fr, col0 = u.pn * HALF + wc * 32 + 8 * fq;
#pragma unroll
        for (int ai = 0; ai < 2; ++ai)
#pragma unroll
            for (int m = 0; m < 4; ++m) { bf16_t* rowp = O + (unsigned)((row0 + ai * HALF + m * 16) * ldc + col0);
                const f32x4 g0 = acc[ai][0][m][0], g1 = acc[ai][0][m][1], u0 = acc[ai][1][m][0], u1 = acc[ai][1][m][1];
                u32x4 w; w.x = cvt_pk_bf16(silu_mul(g0[0], u0[0]), silu_mul(g0[1], u0[1])); w.y = cvt_pk_bf16(silu_mul(g0[2], u0[2]), silu_mul(g0[3], u0[3]));
                w.z = cvt_pk_bf16(silu_mul(g1[0], u1[0]), silu_mul(g1[1], u1[1])); w.w = cvt_pk_bf16(silu_mul(g1[2], u1[2]), silu_mul(g1[3], u1[3]));
                *(u32x4*)rowp = w; }
    }
};
struct EpiRowScaleBf16 {
    static constexpr bool PERM = true, AFTER_DRAIN = false;
    bf16_t* O; int ldc; const float* rowscale;
    __device__ __forceinline__ void operator()(const f32x4 (&acc)[2][2][4][2], const Unit& u, int wr, int wc, int fr_, int fq_) const {
        (void)fr_; (void)fq_; const int ln_ = lane_id(); const int fr = ln_ & 15, fq = ln_ >> 4;
        const int row0 = u.pm * BM + wr * 64 + fr, col0 = u.pn * BM + wc * 32 + 8 * fq;
#pragma unroll
        for (int ai = 0; ai < 2; ++ai)
#pragma unroll
            for (int m = 0; m < 4; ++m) { const int row = row0 + ai * HALF + m * 16; const float sc = rowscale[row]; bf16_t* rowp = O + (unsigned)(row * ldc + col0);
#pragma unroll
                for (int bj = 0; bj < 2; ++bj) { const f32x4 v0 = acc[ai][bj][m][0] * sc, v1 = acc[ai][bj][m][1] * sc;
                    u32x4 w; w.x = cvt_pk_bf16(v0[0], v0[1]); w.y = cvt_pk_bf16(v0[2], v0[3]); w.z = cvt_pk_bf16(v1[0], v1[1]); w.w = cvt_pk_bf16(v1[2], v1[3]);
                    *(u32x4*)(rowp + bj * HALF) = w; } }
    }
};
__device__ __forceinline__ float fqsum(float v) { v += __shfl_xor(v, 16); v += __shfl_xor(v, 32); return v; }
__device__ __forceinline__ float dot4(const f32x4 a) { return (a[0] * a[0] + a[1] * a[1]) + (a[2] * a[2] + a[3] * a[3]); }
__device__ __forceinline__ u32x4 pack8g(const f32x4 a, const f32x4 b, const float (&g)[8], float r) {
    u32x4 w; w.x = cvt_pk_bf16(a[0] * r * g[0], a[1] * r * g[1]); w.y = cvt_pk_bf16(a[2] * r * g[2], a[3] * r * g[3]); w.z = cvt_pk_bf16(b[0] * r * g[4], b[1] * r * g[5]); w.w = cvt_pk_bf16(b[2] * r * g[6], b[3] * r * g[7]); return w; }
__device__ __forceinline__ u32x4 pack8s(const f32x4 a, const f32x4 b, float r) {
    u32x4 w; w.x = cvt_pk_bf16(a[0] * r, a[1] * r); w.y = cvt_pk_bf16(a[2] * r, a[3] * r); w.z = cvt_pk_bf16(b[0] * r, b[1] * r); w.w = cvt_pk_bf16(b[2] * r, b[3] * r); return w; }
constexpr float kEps = 1e-6f;
struct EpiInProj {
    static constexpr bool PERM = true, AFTER_DRAIN = false;
    unsigned char* ws; const float *gq, *gk, *gkr;
    __device__ __forceinline__ void operator()(const f32x4 (&acc)[2][2][4][2], const Unit& u, int wr, int wc, int fr_, int fq_) const {
        (void)fr_; (void)fq_; const int ln_ = lane_id(); const int fr = ln_ & 15, fq = ln_ >> 4;
        const int G = 4 * u.pn + wc;
        if (G >= 23) return;
        const int row0 = u.pm * BM + wr * 64 + fr;
        bf16_t* const QA = (bf16_t*)(ws + WS_QA); bf16_t* const KA = (bf16_t*)(ws + WS_KA); bf16_t* const VA = (bf16_t*)(ws + WS_VA); bf16_t* const CQ = (bf16_t*)(ws + WS_CQ); bf16_t* const CKV = (bf16_t*)(ws + WS_CKV); bf16_t* const KR = (bf16_t*)(ws + WS_KR);
        float* const ssq_cq = (float*)(ws + WS_SSQCQ); float* const ssq_ckv = (float*)(ws + WS_SSQCKV); const float* const cosT = (const float*)(ws + WS_TAB) + TAB_COS; const float* const sinT = (const float*)(ws + WS_TAB) + TAB_SIN;
        constexpr float qscale = QSC_A; constexpr int seq = SEQ;
        if (G < 10) {
            const float* gg = (G < 8) ? gq : gk; const float sc = (G < 8) ? qscale : 1.0f; bf16_t* dst = (G < 8) ? QA + 64 * G : KA + 64 * (G - 8); const int ld = (G < 8) ? 512 : 128;
            float g0[8], g1[8];
#pragma unroll
            for (int j = 0; j < 8; ++j) { g0[j] = gg[8 * fq + j]; g1[j] = gg[32 + 8 * fq + j]; }
#pragma unroll
            for (int ai = 0; ai < 2; ++ai)
#pragma unroll
                for (int m = 0; m < 4; ++m) { const int row = row0 + ai * HALF + m * 16;
                    const float ss = fqsum((dot4(acc[ai][0][m][0]) + dot4(acc[ai][0][m][1])) + (dot4(acc[ai][1][m][0]) + dot4(acc[ai][1][m][1])));
                    const float r = sc * __builtin_amdgcn_rsqf(ss * (1.0f / 64.0f) + kEps); bf16_t* p = dst + (unsigned)(row * ld + 8 * fq);
                    *(u32x4*)p = pack8g(acc[ai][0][m][0], acc[ai][0][m][1], g0, r); *(u32x4*)(p + 32) = pack8g(acc[ai][1][m][0], acc[ai][1][m][1], g1, r); }
        } else if (G < 22) {
            bf16_t* dst; int ld; float* sq;
            if (G < 12) { dst = VA + 64 * (G - 10); ld = 128; sq = nullptr; } else if (G < 18) { dst = CQ + 64 * (G - 12); ld = 384; sq = ssq_cq; } else { dst = CKV + 64 * (G - 18); ld = 256; sq = ssq_ckv; }
#pragma unroll
            for (int ai = 0; ai < 2; ++ai)
#pragma unroll
                for (int m = 0; m < 4; ++m) { const int row = row0 + ai * HALF + m * 16; bf16_t* p = dst + (unsigned)(row * ld + 8 * fq);
                    if (sq) { const float ss = fqsum((dot4(acc[ai][0][m][0]) + dot4(acc[ai][0][m][1])) + (dot4(acc[ai][1][m][0]) + dot4(acc[ai][1][m][1]))); if (fq == 0) atomicAdd(sq + row, ss); }
                    *(u32x4*)p = pack8s(acc[ai][0][m][0], acc[ai][0][m][1], 1.0f); *(u32x4*)(p + 32) = pack8s(acc[ai][1][m][0], acc[ai][1][m][1], 1.0f); }
        } else {
            float g0[8];
#pragma unroll
            for (int j = 0; j < 8; ++j) g0[j] = gkr[8 * fq + j];
#pragma unroll
            for (int ai = 0; ai < 2; ++ai)
#pragma unroll
                for (int m = 0; m < 4; ++m) { const int row = row0 + ai * HALF + m * 16; const int s = row % seq;
                    const float ss = fqsum(dot4(acc[ai][0][m][0]) + dot4(acc[ai][0][m][1])); const float r = __builtin_amdgcn_rsqf(ss * (1.0f / 32.0f) + kEps);
                    float o[8];
#pragma unroll
                    for (int j = 0; j < 8; ++j) { const float y = ((j < 4) ? acc[ai][0][m][0][j & 3] : acc[ai][0][m][1][j & 3]) * r * g0[j]; const float pp = __shfl_xor(y, 32);
                        const int i16 = 8 * (fq & 1) + j; const float c = cosT[s * 16 + i16], sn = sinT[s * 16 + i16]; o[j] = (fq < 2) ? (y * c - pp * sn) : (pp * sn + y * c); }
                    u32x4 w; w.x = cvt_pk_bf16(o[0], o[1]); w.y = cvt_pk_bf16(o[2], o[3]); w.z = cvt_pk_bf16(o[4], o[5]); w.w = cvt_pk_bf16(o[6], o[7]);
                    *(u32x4*)(KR + (unsigned)((((row >> 12) * 64 + ((row >> 6) & 63)) * 2048) + fq * 512 + (row & 63) * 8)) = w; }
        }
    }
};
struct EpiQB {
    static constexpr bool PERM = true, AFTER_DRAIN = false;
    unsigned char* ws; const float *gqn, *gqr;
    __device__ __forceinline__ void operator()(const f32x4 (&acc)[2][2][4][2], const Unit& u, int wr, int wc, int fr_, int fq_) const {
        (void)fr_; (void)fq_; const int ln_ = lane_id(); const int fr = ln_ & 15, fq = ln_ >> 4;
        const int row0 = u.pm * BM + wr * 64 + fr;
        bf16_t* const QB = (bf16_t*)(ws + WS_QB); const float* const ssq_cq = (const float*)(ws + WS_SSQCQ); const float* const cosT = (const float*)(ws + WS_TAB) + TAB_COS; const float* const sinT = (const float*)(ws + WS_TAB) + TAB_SIN;
        constexpr float qscale = QSC_B; constexpr int seq = SEQ;
        if (u.pn < 2) {
            const int head = 4 * u.pn + wc; float g0[8], g1[8];
#pragma unroll
            for (int j = 0; j < 8; ++j) { g0[j] = gqn[8 * fq + j]; g1[j] = gqn[32 + 8 * fq + j]; }
#pragma unroll
            for (int ai = 0; ai < 2; ++ai)
#pragma unroll
                for (int m = 0; m < 4; ++m) { const int row = row0 + ai * HALF + m * 16; const float eps2 = kEps * (ssq_cq[row] * (1.0f / 384.0f) + kEps);
                    const float ss = fqsum((dot4(acc[ai][0][m][0]) + dot4(acc[ai][0][m][1])) + (dot4(acc[ai][1][m][0]) + dot4(acc[ai][1][m][1])));
                    const float r = qscale * __builtin_amdgcn_rsqf(ss * (1.0f / 64.0f) + eps2); bf16_t* p = QB + (unsigned)(row * 768 + 96 * head + 8 * fq);
                    *(u32x4*)p = pack8g(acc[ai][0][m][0], acc[ai][0][m][1], g0, r); *(u32x4*)(p + 32) = pack8g(acc[ai][1][m][0], acc[ai][1][m][1], g1, r); }
        } else {
            float g0[8];
#pragma unroll
            for (int j = 0; j < 8; ++j) g0[j] = gqr[8 * fq + j];
#pragma unroll
            for (int ai = 0; ai < 2; ++ai)
#pragma unroll
                for (int m = 0; m < 4; ++m) { const int row = row0 + ai * HALF + m * 16; const int s = row % seq; const float eps2 = kEps * (ssq_cq[row] * (1.0f / 384.0f) + kEps);
#pragma unroll
                    for (int bj = 0; bj < 2; ++bj) { const int head = 2 * wc + bj;
                        const float ss = fqsum(dot4(acc[ai][bj][m][0]) + dot4(acc[ai][bj][m][1])); const float r = __builtin_amdgcn_rsqf(ss * (1.0f / 32.0f) + eps2);
                        float o[8];
#pragma unroll
                        for (int j = 0; j < 8; ++j) { const float y = ((j < 4) ? acc[ai][bj][m][0][j & 3] : acc[ai][bj][m][1][j & 3]) * r * g0[j]; const float pp = __shfl_xor(y, 32);
                            const int i16 = 8 * (fq & 1) + j; const float c = cosT[s * 16 + i16], sn = sinT[s * 16 + i16]; o[j] = qscale * ((fq < 2) ? (y * c - pp * sn) : (pp * sn + y * c)); }
                        u32x4 w; w.x = cvt_pk_bf16(o[0], o[1]); w.y = cvt_pk_bf16(o[2], o[3]); w.z = cvt_pk_bf16(o[4], o[5]); w.w = cvt_pk_bf16(o[6], o[7]);
                        *(u32x4*)(QB + (unsigned)(row * 768 + 96 * head + 64 + 8 * fq)) = w; } }
        }
    }
};
struct EpiKVB {
    static constexpr bool PERM = true, AFTER_DRAIN = false;
    unsigned char* ws; const float* gkn;
    __device__ __forceinline__ void operator()(const f32x4 (&acc)[2][2][4][2], const Unit& u, int wr, int wc, int fr_, int fq_) const {
        (void)fr_; (void)fq_; const int ln_ = lane_id(); const int fr = ln_ & 15, fq = ln_ >> 4;
        const int row0 = u.pm * BM + wr * 64 + fr, G = 4 * u.pn + wc, head = G >> 1;
        bf16_t* const KBN = (bf16_t*)(ws + WS_KBN); bf16_t* const VB = (bf16_t*)(ws + WS_VB); const float* const ssq_ckv = (const float*)(ws + WS_SSQCKV);
        if (!(G & 1)) {
            float g0[8], g1[8];
#pragma unroll
            for (int j = 0; j < 8; ++j) { g0[j] = gkn[8 * fq + j]; g1[j] = gkn[32 + 8 * fq + j]; }
#pragma unroll
            for (int ai = 0; ai < 2; ++ai)
#pragma unroll
                for (int m = 0; m < 4; ++m) { const int row = row0 + ai * HALF + m * 16; const float eps2 = kEps * (ssq_ckv[row] * (1.0f / 256.0f) + kEps);
                    const float ss = fqsum((dot4(acc[ai][0][m][0]) + dot4(acc[ai][0][m][1])) + (dot4(acc[ai][1][m][0]) + dot4(acc[ai][1][m][1])));
                    const float r = __builtin_amdgcn_rsqf(ss * (1.0f / 64.0f) + eps2);
                    bf16_t* p = KBN + (unsigned)(((((row >> 12) * 8 + head) * 64 + ((row >> 6) & 63)) * 4096) + fq * 512 + (row & 63) * 8);
                    *(u32x4*)p = pack8g(acc[ai][0][m][0], acc[ai][0][m][1], g0, r); *(u32x4*)(p + 4 * 512) = pack8g(acc[ai][1][m][0], acc[ai][1][m][1], g1, r); }
        } else {
#pragma unroll
            for (int ai = 0; ai < 2; ++ai)
#pragma unroll
                for (int m = 0; m < 4; ++m) { const int row = row0 + ai * HALF + m * 16; const float al = __builtin_amdgcn_rsqf(ssq_ckv[row] * (1.0f / 256.0f) + kEps); bf16_t* p = VB + (unsigned)(((((row >> 12) * 8 + head) * 64 + ((row >> 6) & 63)) * 4096) + ((row >> 4) & 3) * 512 + (row & 15) * 32 + 8 * fq);
                    *(u32x4*)p = pack8s(acc[ai][0][m][0], acc[ai][0][m][1], al); *(u32x4*)(p + 4 * 512) = pack8s(acc[ai][1][m][0], acc[ai][1][m][1], al); }
        }
    }
};

__device__ __forceinline__ float clamp448(float v) { return __builtin_fminf(__builtin_fmaxf(v, -448.0f), 448.0f); }
__device__ __forceinline__ unsigned pk4_fp8(float a, float b, float c, float d) { int w = 0; w = __builtin_amdgcn_cvt_pk_fp8_f32(clamp448(a), clamp448(b), w, false); w = __builtin_amdgcn_cvt_pk_fp8_f32(clamp448(c), clamp448(d), w, true); return (unsigned)w; }
__device__ __forceinline__ unsigned pk4_fp8_nc(float a, float b, float c, float d) { int w = 0; w = __builtin_amdgcn_cvt_pk_fp8_f32(a, b, w, false); w = __builtin_amdgcn_cvt_pk_fp8_f32(c, d, w, true); return (unsigned)w; }
struct EpiSwiGLU8 {
    static constexpr bool PERM = true, AFTER_DRAIN = false;
    unsigned char* O; int ldc; float oscale;
    __device__ __forceinline__ void operator()(const f32x4 (&acc)[2][2][4][2], const Unit& u, int wr, int wc, int fr_, int fq_) const {
        (void)fr_; (void)fq_; const int ln_ = lane_id(); const int fr = ln_ & 15, fq = ln_ >> 4;
        const int row0 = u.pm * BM + wr * 64 + fr, col0 = u.pn * HALF + wc * 32 + 8 * fq;
#pragma unroll
        for (int ai = 0; ai < 2; ++ai)
#pragma unroll
            for (int m = 0; m < 4; ++m) { unsigned char* rowp = O + (unsigned)((row0 + ai * HALF + m * 16) * ldc + col0);
                const f32x4 g0 = acc[ai][0][m][0], g1 = acc[ai][0][m][1], u0 = acc[ai][1][m][0], u1 = acc[ai][1][m][1];
                typedef unsigned u32x2 __attribute__((ext_vector_type(2))); u32x2 w;
                w.x = pk4_fp8(oscale * silu_mul(g0[0], u0[0]), oscale * silu_mul(g0[1], u0[1]), oscale * silu_mul(g0[2], u0[2]), oscale * silu_mul(g0[3], u0[3]));
                w.y = pk4_fp8(oscale * silu_mul(g1[0], u1[0]), oscale * silu_mul(g1[1], u1[1]), oscale * silu_mul(g1[2], u1[2]), oscale * silu_mul(g1[3], u1[3]));
                *(u32x2*)rowp = w; }
    }
};

struct EpiRowScaleF8 {
    static constexpr bool PERM = true, AFTER_DRAIN = false;
    unsigned char* O; int ldc; const float* rowscale; float oscale;
    __device__ __forceinline__ void operator()(const f32x4 (&acc)[2][2][4][2], const Unit& u, int wr, int wc, int fr_, int fq_) const {
        (void)fr_; (void)fq_; const int ln_ = lane_id(); const int fr = ln_ & 15, fq = ln_ >> 4;
        const int row0 = u.pm * BM + wr * 64 + fr, col0 = u.pn * BM + wc * 32 + 8 * fq;
#pragma unroll
        for (int ai = 0; ai < 2; ++ai)
#pragma unroll
            for (int m = 0; m < 4; ++m) { const int row = row0 + ai * HALF + m * 16; const float sc = rowscale[row] * oscale; unsigned char* rowp = O + (unsigned)(row * ldc + col0);
#pragma unroll
                for (int bj = 0; bj < 2; ++bj) { const f32x4 v0 = acc[ai][bj][m][0] * sc, v1 = acc[ai][bj][m][1] * sc;
                    typedef unsigned u32x2 __attribute__((ext_vector_type(2))); u32x2 w; w.x = pk4_fp8(v0[0], v0[1], v0[2], v0[3]); w.y = pk4_fp8(v1[0], v1[1], v1[2], v1[3]);
                    *(u32x2*)(rowp + bj * HALF) = w; } }
    }
};

struct EpiNormBf16 {
    static constexpr bool PERM = true, AFTER_DRAIN = false;
    bf16_t* O; int ldc; const float* ssq;
    __device__ __forceinline__ void operator()(const f32x4 (&acc)[2][2][4][2], const Unit& u, int wr, int wc, int fr_, int fq_) const {
        (void)fr_; (void)fq_; const int ln_ = lane_id(); const int fr = ln_ & 15, fq = ln_ >> 4;
        const int row0 = u.pm * BM + wr * 64 + fr, col0 = u.pn * BM + wc * 32 + 8 * fq;
#pragma unroll
        for (int ai = 0; ai < 2; ++ai)
#pragma unroll
            for (int m = 0; m < 4; ++m) { const int row = row0 + ai * HALF + m * 16; const float rb = __builtin_amdgcn_rsqf(ssq[2 * row + 1] * (1.0f / 512.0f) + 1e-6f); bf16_t* rowp = O + (unsigned)(row * ldc + col0);
#pragma unroll
                for (int bj = 0; bj < 2; ++bj) *(u32x4*)(rowp + bj * HALF) = pack8s(acc[ai][bj][m][0], acc[ai][bj][m][1], rb); }
    }
};
__device__ __forceinline__ void glds_sv(const char* sbase, unsigned voff, unsigned lds_dst) { unsigned keep;
    asm volatile("s_mov_b32 %0, m0\n\ts_mov_b32 m0, %3\n\ts_nop 0\n\tglobal_load_lds_dwordx4 %1, %2\n\ts_mov_b32 m0, %0" : "=&s"(keep) : "v"(voff), "s"(sbase), "s"(lds_dst) : "memory"); }
template <class Epi, class Sched, bool ALIGN_EPI = false, bool SP2 = false, int MODE = 0, bool F8 = false>
__device__ __forceinline__ void gemm_phase(PG8_LAS unsigned char* lds, const Gemm g, const Sched& S, const Epi& E) {
    const int lane = lane_id(), wid = g.wave, tid = wid * 64 + lane,
              wr = wid >> 2, wc = wid & 3, fr = lane & 15, fq = lane >> 4;
    int K_ = g.K; asm volatile("" : "+s"(K_));
    const int K = K_, nt = K / BK;
    unsigned voffA[2], voffB[2];
#pragma unroll
    for (int i = 0; i < 2; ++i) { int R, C; if constexpr (F8) stage_rc8(tid * 16 + i * 8192, R, C); else stage_rc(tid * 16 + i * 8192, R, C); const int Rb = Epi::PERM ? ((R & ~31) + perm32(R & 31)) : R;
        voffA[i] = (unsigned)(R * K + C) * 2u; voffB[i] = (unsigned)(Rb * K + C) * 2u; }
    const size_t r64step = (size_t)64 * K * 2;
    const size_t kstep = (size_t)(BK * 2);
    const size_t hstep = (size_t)HALF * K * 2;
    const size_t tstep = 2 * hstep;
    const unsigned ldsw = (unsigned)wid * 1024u;
    const unsigned ldsbase = (unsigned)__builtin_amdgcn_readfirstlane((int)((unsigned)(uintptr_t)lds + ldsw));
    const int aoff = lds_byte(wr * 64 + fr, fq * 8), boff = lds_byte(wc * 32 + fr, fq * 8);
    const int aoff8 = lds_byte8(wr * 64 + fr, fq * 32), boff8 = lds_byte8(wc * 32 + fr, fq * 32);
#define PG8_X16(x) ({ int t_; asm volatile("v_xor_b32 %0, 16, %1" : "=v"(t_) : "v"(x)); t_; })
    typedef int v8i32 __attribute__((ext_vector_type(8))); typedef short bf16x16 __attribute__((ext_vector_type(16)));
#define PG8_SA(b, h) (((b) * 2 + (h)) * HTB)
#define PG8_SB(b, h) ((4 + (b) * 2 + (h)) * HTB)
#define PG8_STAGE(bufoff, gbase, voff) do { _Pragma("unroll") for (int _i = 0; _i < 2; ++_i) \
        glds_sv((const char*)(gbase) + (size_t)_i * r64step, (voff)[0], ldsbase + (unsigned)((bufoff) + _i * 8192)); } while (0)
#define PG8_LDA(dst, b, h) do { if constexpr (F8) { const int a1_ = PG8_X16(aoff8); _Pragma("unroll") for (int m = 0; m < 4; ++m) { dst[m][0] = *(const PG8_LAS bf16x8*)(lds + PG8_SA(b, h) + aoff8 + m * 2048); dst[m][1] = *(const PG8_LAS bf16x8*)(lds + PG8_SA(b, h) + a1_ + m * 2048); } } \
        else { _Pragma("unroll") for (int m = 0; m < 4; ++m) _Pragma("unroll") for (int k = 0; k < 2; ++k) dst[m][k] = *(const PG8_LAS bf16x8*)(lds + PG8_SA(b, h) + aoff + k * 1024 + m * 2048); } } while (0)
#define PG8_LDB(dst, b, h) do { if constexpr (F8) { const int b1_ = PG8_X16(boff8); _Pragma("unroll") for (int n = 0; n < 2; ++n) { dst[n][0] = *(const PG8_LAS bf16x8*)(lds + PG8_SB(b, h) + boff8 + n * 2048); dst[n][1] = *(const PG8_LAS bf16x8*)(lds + PG8_SB(b, h) + b1_ + n * 2048); } } \
        else { _Pragma("unroll") for (int n = 0; n < 2; ++n) _Pragma("unroll") for (int k = 0; k < 2; ++k) dst[n][k] = *(const PG8_LAS bf16x8*)(lds + PG8_SB(b, h) + boff + k * 1024 + n * 2048); } } while (0)
#define PG8_F8FRAG(x) __builtin_bit_cast(v8i32, (bf16x16){x[0][0], x[0][1], x[0][2], x[0][3], x[0][4], x[0][5], x[0][6], x[0][7], x[1][0], x[1][1], x[1][2], x[1][3], x[1][4], x[1][5], x[1][6], x[1][7]})
#define PG8_MMA(ai, bj, At, Bt) do { __builtin_amdgcn_s_setprio(1); _Pragma("unroll") for (int m = 0; m < 4; ++m) _Pragma("unroll") for (int n = 0; n < 2; ++n) { \
        if constexpr (F8) { acc[ai][bj][m][n] = __builtin_amdgcn_mfma_scale_f32_16x16x128_f8f6f4(PG8_F8FRAG(Bt[n]), PG8_F8FRAG(At[m]), acc[ai][bj][m][n], 0, 0, 0, g.sA, 0, g.sA); }     \
        else { _Pragma("unroll") for (int k = 0; k < 2; ++k) acc[ai][bj][m][n] = __builtin_amdgcn_mfma_f32_16x16x32_bf16(Bt[n][k], At[m][k], acc[ai][bj][m][n], 0, 0, 0); } } __builtin_amdgcn_s_setprio(0); } while (0)
#define PG8_WAIT_V(n) asm volatile("s_waitcnt vmcnt(" #n ")" ::: "memory")
#define PG8_WAIT_L(n) asm volatile("s_waitcnt lgkmcnt(" #n ")" ::: "memory")
#define PG8_BAR __builtin_amdgcn_s_barrier()
#define PG8_SCHED __builtin_amdgcn_sched_barrier(0)
    Unit cur, nxt; int ui = 0;
    if (!S.next(0, cur)) return;
    f32x4 acc[2][2][4][2];
#pragma unroll
    for (int a = 0; a < 2; ++a)
#pragma unroll
        for (int b = 0; b < 2; ++b)
#pragma unroll
            for (int m = 0; m < 4; ++m)
#pragma unroll
                for (int n = 0; n < 2; ++n) acc[a][b][m][n] = (f32x4){0.f, 0.f, 0.f, 0.f};
    bf16x8 At[4][2], B0[2][2], B1[2][2];
    const char* cA = (const char*)g.A + (MODE == 1 ? (size_t)0 : (size_t)cur.pm * tstep); const char* cB = (const char*)g.Bt + (size_t)cur.e * g.estride + (size_t)cur.pn * tstep;
    PG8_LAS unsigned* const gt = (PG8_LAS unsigned*)(lds + g.gtab);
#define PG8_GFILL(slot, u) do { const int t_ = wid * 64 + lane_id(); if (t_ < BM) gt[(slot) * BM + t_] = (unsigned)g.idx[(u).pm * BM + t_] * (unsigned)(K * 2); } while (0)
    if constexpr (MODE == 1) { PG8_GFILL(0, cur); __syncthreads(); }
    int gR0_, gC0_; if constexpr (F8) stage_rc8(tid * 16, gR0_, gC0_); else stage_rc(tid * 16, gR0_, gC0_); PG8_LAS unsigned* const gtl = gt + gR0_; const unsigned gcb = (unsigned)gC0_ * 2u;
#define PG8_STA(bufoff, gbase, H, NXT) do { if constexpr (MODE == 1) { const int slot_ = ((NXT) ? ui + 1 : ui) & 1; _Pragma("unroll") for (int _i = 0; _i < 2; ++_i) { \
        const unsigned vo_ = gtl[slot_ * BM + (H) * HALF + _i * 64] + gcb; glds_sv((const char*)(gbase), vo_, ldsbase + (unsigned)((bufoff) + _i * 8192)); } } \
        else { PG8_STAGE(bufoff, (gbase) + ((H) ? hstep : (size_t)0), voffA); } } while (0)
    S.a_ready(cur);
    if constexpr (SP2) {
        PG8_STAGE(PG8_SB(0, 0), cB, voffB); PG8_STAGE(PG8_SB(0, 1), cB + hstep, voffB); PG8_STA(PG8_SA(0, 0), cA, 0, false); PG8_STA(PG8_SA(0, 1), cA, 1, false);
        if (wr == 1) PG8_BAR;
        PG8_WAIT_V(2); PG8_BAR;
        PG8_STAGE(PG8_SB(1, 0), cB + kstep, voffB); PG8_STA(PG8_SA(1, 0), cA + kstep, 0, false); PG8_STAGE(PG8_SB(1, 1), cB + hstep + kstep, voffB);
        PG8_WAIT_V(6); PG8_BAR;
    } else {
        PG8_STAGE(PG8_SB(0, 0), cB, voffB); PG8_STAGE(PG8_SA(0, 0), cA, voffA); PG8_STAGE(PG8_SB(0, 1), cB + hstep, voffB); PG8_STAGE(PG8_SA(0, 1), cA + hstep, voffA);
        if (wr == 1) PG8_BAR;
        PG8_WAIT_V(4); PG8_BAR;
        PG8_STAGE(PG8_SB(1, 0), cB + kstep, voffB); PG8_STAGE(PG8_SA(1, 0), cA + kstep, voffA); PG8_STAGE(PG8_SB(1, 1), cB + hstep + kstep, voffB);
        PG8_WAIT_V(6); PG8_BAR;
    }
    for (;;) {
        const bool has_next = S.next(ui + 1, nxt);
        if constexpr (MODE == 1) { if (has_next) PG8_GFILL((ui + 1) & 1, nxt); else PG8_GFILL((ui + 1) & 1, cur); }
        const char* nA = (MODE == 1) ? cA : (has_next ? (const char*)g.A + (size_t)nxt.pm * tstep : cA); const char* nB = has_next ? (const char*)g.Bt + (size_t)nxt.e * g.estride + (size_t)nxt.pn * tstep : cB;
        for (int t = 0; t < nt; t += 2) {
            const bool last = (t == nt - 2);
            if constexpr (MODE == 2) { if (t == nt / 2) {
#pragma unroll
                for (int ai = 0; ai < 2; ++ai)
#pragma unroll
                    for (int m = 0; m < 4; ++m) { const int row = cur.pm * BM + ai * HALF + wr * 64 + m * 16 + fr; const float sa = g.ssq[2 * row], sb = g.ssq[2 * row + 1];
                        const float ratio = __builtin_amdgcn_rsqf(sa * (1.0f / 512.0f) + 1e-6f) * __builtin_amdgcn_sqrtf(sb * (1.0f / 512.0f) + 1e-6f);
#pragma unroll
                        for (int bj = 0; bj < 2; ++bj)
#pragma unroll
                            for (int n = 0; n < 2; ++n) acc[ai][bj][m][n] *= ratio; } } }
            const char* a1 = cA + (size_t)(t + 1) * kstep;
            const char* a2 = last ? nA : cA + (size_t)(t + 2) * kstep; const char* b2 = last ? nB : cB + (size_t)(t + 2) * kstep;
            const char* a3 = a2 + kstep; const char* b3 = b2 + kstep;
            if (last && has_next) S.a_ready(nxt);
            if constexpr (SP2) {
            PG8_LDB(B0, 0, 0); PG8_LDB(B1, 0, 1); PG8_SCHED; PG8_LDA(At, 0, 0); PG8_STA(PG8_SA(1, 1), a1, 1, false);
            PG8_WAIT_V(8); PG8_WAIT_L(0); PG8_BAR; PG8_MMA(0, 0, At, B0); PG8_MMA(0, 1, At, B1); PG8_BAR; PG8_SCHED;
            PG8_LDA(At, 0, 1); PG8_STAGE(PG8_SB(0, 0), b2, voffB); PG8_STAGE(PG8_SB(0, 1), b2 + hstep, voffB); PG8_STA(PG8_SA(0, 0), a2, 0, last);
            PG8_WAIT_V(8); PG8_WAIT_L(0); PG8_BAR; PG8_MMA(1, 0, At, B0); PG8_MMA(1, 1, At, B1); PG8_BAR; PG8_SCHED;
            PG8_LDB(B0, 1, 0); PG8_LDB(B1, 1, 1); PG8_SCHED; PG8_LDA(At, 1, 0); PG8_STA(PG8_SA(0, 1), a2, 1, last);
            PG8_WAIT_V(8); PG8_WAIT_L(0); PG8_BAR; PG8_MMA(0, 0, At, B0); PG8_MMA(0, 1, At, B1); PG8_BAR; PG8_SCHED;
            PG8_LDA(At, 1, 1); PG8_STAGE(PG8_SB(1, 0), b3, voffB); PG8_STAGE(PG8_SB(1, 1), b3 + hstep, voffB); PG8_STA(PG8_SA(1, 0), a3, 0, last);
            PG8_WAIT_V(8); PG8_WAIT_L(0); PG8_BAR; PG8_MMA(1, 0, At, B0); PG8_MMA(1, 1, At, B1); PG8_BAR; PG8_SCHED;
            } else {
            PG8_LDB(B0, 0, 0); PG8_SCHED; PG8_LDA(At, 0, 0); PG8_STAGE(PG8_SA(1, 1), a1 + hstep, voffA);
            PG8_WAIT_L(8); PG8_BAR; PG8_WAIT_L(0); PG8_MMA(0, 0, At, B0); PG8_BAR; PG8_SCHED;
            PG8_LDB(B1, 0, 1); PG8_STAGE(PG8_SB(0, 0), b2, voffB);
            PG8_BAR; PG8_WAIT_L(0); PG8_MMA(0, 1, At, B1); PG8_BAR;
            PG8_LDA(At, 0, 1); PG8_STAGE(PG8_SA(0, 0), a2, voffA);
            PG8_BAR; PG8_WAIT_L(0); PG8_MMA(1, 0, At, B0); PG8_BAR; PG8_SCHED;
            PG8_STAGE(PG8_SB(0, 1), b2 + hstep, voffB);
            PG8_WAIT_V(6); PG8_BAR; PG8_MMA(1, 1, At, B1); PG8_BAR;
            PG8_LDB(B0, 1, 0); PG8_SCHED; PG8_LDA(At, 1, 0); PG8_STAGE(PG8_SA(0, 1), a2 + hstep, voffA);
            PG8_WAIT_L(8); PG8_BAR; PG8_WAIT_L(0); PG8_MMA(0, 0, At, B0); PG8_BAR; PG8_SCHED;
            PG8_LDB(B1, 1, 1); PG8_STAGE(PG8_SB(1, 0), b3, voffB);
            PG8_BAR; PG8_WAIT_L(0); PG8_MMA(0, 1, At, B1); PG8_BAR;
            PG8_LDA(At, 1, 1); PG8_STAGE(PG8_SA(1, 0), a3, voffA);
            PG8_BAR; PG8_WAIT_L(0); PG8_MMA(1, 0, At, B0); PG8_BAR; PG8_SCHED;
            PG8_STAGE(PG8_SB(1, 1), b3 + hstep, voffB);
            PG8_WAIT_V(6); PG8_BAR; PG8_MMA(1, 1, At, B1); PG8_BAR;
            }
        }
        if constexpr (ALIGN_EPI) { if (wr == 0) PG8_BAR; }
        if constexpr (!Epi::AFTER_DRAIN) { E(acc, cur, wr, wc, fr, fq); S.done(cur); }
        if (!has_next) break;
#pragma unroll
        for (int a = 0; a < 2; ++a)
#pragma unroll
            for (int b = 0; b < 2; ++b)
#pragma unroll
                for (int m = 0; m < 4; ++m)
#pragma unroll
                    for (int n = 0; n < 2; ++n) acc[a][b][m][n] = (f32x4){0.f, 0.f, 0.f, 0.f};
        cur = nxt; cA = nA; cB = nB; ++ui;
        if constexpr (ALIGN_EPI) { if (wr == 1) PG8_BAR; }
    }
    PG8_WAIT_V(0);
    if constexpr (!ALIGN_EPI) { if (wr == 0) PG8_BAR; }
    PG8_BAR;
    if constexpr (Epi::AFTER_DRAIN) { E.fused(acc, cur, wr, wc, fr, fq, lds, wid, lane); S.done(cur); }
#undef PG8_SA
#undef PG8_SB
#undef PG8_STAGE
#undef PG8_LDA
#undef PG8_LDB
#undef PG8_MMA
#undef PG8_F8FRAG
#undef PG8_X16
#undef PG8_WAIT_V
#undef PG8_WAIT_L
#undef PG8_BAR
#undef PG8_SCHED
#undef PG8_STA
#undef PG8_GFILL
}
}
#define GAS __attribute__((address_space(1)))
#define LAS __attribute__((address_space(3)))
typedef unsigned short bf16;
typedef unsigned v4u __attribute__((ext_vector_type(4)));
typedef float f32x4 __attribute__((ext_vector_type(4)));
typedef short bf16x8 __attribute__((ext_vector_type(8)));
typedef GAS unsigned gu32;
typedef GAS unsigned long long gu64;
#define RLX_AGENT __ATOMIC_RELAXED, __HIP_MEMORY_SCOPE_AGENT
#define LDS_WAIT() asm volatile("s_waitcnt lgkmcnt(0)" ::: "memory")
#define VM_WAIT() asm volatile("s_waitcnt vmcnt(0)" ::: "memory")
__device__ __forceinline__ unsigned long long rt() { return __builtin_amdgcn_s_memrealtime(); }
__device__ __forceinline__ unsigned f2bf(float f) { unsigned u = __builtin_bit_cast(unsigned, f); return (u + 0x7fffu + ((u >> 16) & 1u)) >> 16; }
__device__ __forceinline__ unsigned pk2(float lo, float hi) { return f2bf(lo) | (f2bf(hi) << 16); }

#define XB_TMO      128
#define XB_XCNT(j)  (256  + 64 * (j))
#define XB_XSUB(j)  (1280 + 64 * (j))
#define XB_XGEN(j)  (2304 + 64 * (j))
#define XB_TOP      3328
#define XB_TOPGEN   3392
#define XCD_BAR_WORDS 3456
#define XB_SPIN_CAP (1u << 18)

__device__ __forceinline__ unsigned xb_ld(unsigned* p)              { return __hip_atomic_load(p, __ATOMIC_RELAXED, __HIP_MEMORY_SCOPE_AGENT); }
__device__ __forceinline__ unsigned xb_add(unsigned* p, unsigned v) { return __hip_atomic_fetch_add(p, v, __ATOMIC_RELAXED, __HIP_MEMORY_SCOPE_AGENT); }
__device__ __forceinline__ unsigned xb_xcc_id() { return (unsigned)__builtin_amdgcn_s_getreg((3 << 11) | 20) & 0xFu; }
#define XB_SPIN(cond, bar) do { unsigned _sp = 0; while (cond) { __builtin_amdgcn_s_sleep(1); \
    if ((++_sp & 255u) == 0u) { if (xb_ld(&(bar)[XB_TMO])) break; if (_sp > XB_SPIN_CAP) { atomicAdd(&(bar)[XB_TMO], 1u); break; } } } } while (0)

struct XcdBarrier {
    int wave;
    unsigned* bar; unsigned x;
    volatile LAS unsigned* st;
};

__device__ __forceinline__ XcdBarrier xcd_barrier_post(unsigned* bar, volatile LAS unsigned* st) {
    XcdBarrier b; b.wave = __builtin_amdgcn_readfirstlane((int)(threadIdx.x >> 6)); b.bar = bar; b.x = xb_xcc_id(); b.st = st;
    if (threadIdx.x == 0) (void)xb_add(&bar[XB_XCNT(b.x)], 1u);
    return b;
}
__device__ __forceinline__ void xcd_barrier_complete(unsigned* bar, unsigned x, unsigned& nloc, unsigned& nx) {
    const unsigned G = gridDim.x * gridDim.y * gridDim.z;
    unsigned sum, cnt, mine, sp = 0u;
    for (;;) {
        sum = 0u; cnt = 0u; mine = 0u;
#pragma unroll
        for (unsigned j = 0; j < 16; ++j) { const unsigned c = xb_ld(&bar[XB_XCNT(j)]); sum += c; cnt += (c > 0u) ? 1u : 0u; mine = (j == x) ? c : mine; }
        if (sum == G) break;
        __builtin_amdgcn_s_sleep(1);
        if ((++sp & 255u) == 0u) { if (xb_ld(&bar[XB_TMO])) break; if (sp > XB_SPIN_CAP) { atomicAdd(&bar[XB_TMO], 1u); break; } }
    }
    nloc = mine > 0u ? mine : 1u; nx = cnt > 0u ? cnt : 1u;
}

__device__ __forceinline__ void xcd_barrier(const XcdBarrier& b) {
    asm volatile("s_waitcnt vmcnt(0)" ::: "memory");
    __syncthreads();
    if (b.wave == 0 && lane_id() == 0) {
        unsigned* bar = b.bar;
        __builtin_amdgcn_s_waitcnt(0);
        unsigned nloc = b.st[0], nx = b.st[1];
        if (nloc == 0u) { xcd_barrier_complete(bar, b.x, nloc, nx); b.st[0] = nloc; b.st[1] = nx; }
        const unsigned old = xb_add(&bar[XB_XSUB(b.x)], 1u);
        const unsigned gen = old / nloc;
        if (old + 1u == (gen + 1u) * nloc) {
            __builtin_amdgcn_fence(__ATOMIC_RELEASE, "agent");
            asm volatile("s_waitcnt vmcnt(0)" ::: "memory");
            const unsigned og = xb_add(&bar[XB_TOP], 1u);
            const unsigned tg = og / nx;
            if (og + 1u == (tg + 1u) * nx) xb_add(&bar[XB_TOPGEN], 1u);
            else XB_SPIN(xb_ld(&bar[XB_TOPGEN]) == tg, bar);
            __builtin_amdgcn_fence(__ATOMIC_ACQUIRE, "agent");
            xb_add(&bar[XB_XGEN(b.x)], 1u);
            asm volatile("s_waitcnt vmcnt(0)" ::: "memory");
        } else {
            XB_SPIN(xb_ld(&bar[XB_XGEN(b.x)]) == gen, bar);
            __builtin_amdgcn_fence(__ATOMIC_ACQUIRE, "agent");
            asm volatile("s_waitcnt vmcnt(0)" ::: "memory");
        }
    }
    __syncthreads();
}

struct Frame {
    LAS unsigned char* lds;
    volatile LAS unsigned* MISC;
    gu32* ctl;
    int wave;
    int vcu, G;
    const float* in[23];
    float* out;
    unsigned char* ws;
};
#define WSP(T_, off) ((T_*)(F.ws + (off)))
__device__ __forceinline__ float wave_sum(float v) {
#pragma unroll
    for (int o = 1; o < 64; o <<= 1) v += __shfl_xor(v, o);
    return v;
}
__device__ __forceinline__ float grp_sum8(float v) { v += __shfl_xor(v, 1); v += __shfl_xor(v, 2); v += __shfl_xor(v, 4); return v; }
__device__ __forceinline__ float grp_sum4(float v) { v += __shfl_xor(v, 1); v += __shfl_xor(v, 2); return v; }
__device__ __forceinline__ void unpack8(const v4u w, float (&f)[8]) {
#pragma unroll
    for (int i = 0; i < 4; ++i) { f[2 * i] = __uint_as_float(w[i] << 16); f[2 * i + 1] = __uint_as_float(w[i] & 0xffff0000u); }
}
__device__ __forceinline__ v4u pack8(const float (&f)[8]) { v4u o; o.x = pk2(f[0], f[1]); o.y = pk2(f[2], f[3]); o.z = pk2(f[4], f[5]); o.w = pk2(f[6], f[7]); return o; }

__device__ __forceinline__ int t5_bucket(int rel) {
    const int base = rel > 0 ? 16 : 0; const int n = rel < 0 ? -rel : rel;
    const float nf = (float)(n > 1 ? n : 1);
    int large = 8 + (int)(logf(nf * 0.125f) / 2.772588722239781f * 8.0f + 1e-4f);
    large = large < 15 ? large : 15;
    return base + (n < 8 ? n : large);
}

template <class RowMap>
__device__ __forceinline__ void p0_transpose_item(const float* W, int K, int N, bf16* WT, const float* gain, LAS float* scr, int item, int lane, RowMap rowmap) {
    const int nblk = N / 32, kb = item / nblk, nb = item % nblk, k0 = 64 * kb, n0 = 32 * nb;
#pragma unroll 4
    for (int i = 0; i < 32; ++i) { const int kk = 2 * i + (lane >> 5); const float g = gain ? gain[k0 + kk] : 1.0f; scr[kk * 33 + (lane & 31)] = g * W[(size_t)(k0 + kk) * N + n0 + (lane & 31)]; }
    LDS_WAIT(); asm volatile("" ::: "memory");
    const int c = lane & 7;
#pragma unroll
    for (int j = 0; j < 4; ++j) { const int n = (lane >> 3) + 8 * j; const LAS float* s = scr + (8 * c) * 33 + n;
        v4u o; o.x = pk2(s[0 * 33], s[1 * 33]); o.y = pk2(s[2 * 33], s[3 * 33]); o.z = pk2(s[4 * 33], s[5 * 33]); o.w = pk2(s[6 * 33], s[7 * 33]);
        *(GAS v4u*)(WT + (size_t)rowmap(n0 + n) * K + k0 + 8 * c) = o; }
    LDS_WAIT(); asm volatile("" ::: "memory");
}
struct RowId { __device__ __forceinline__ int operator()(int n) const { return n; } };
struct RowG64 { __device__ __forceinline__ int operator()(int n) const { return (n & ~255) + 128 * ((n >> 5) & 1) + 32 * ((n >> 6) & 3) + (n & 31); } };
struct RowQB { __device__ __forceinline__ int operator()(int n) const { const int h = n / 96, dd = n % 96; return dd < 64 ? (h >> 2) * 256 + 128 * (dd >> 5) + 32 * (h & 3) + (dd & 31) : 512 + 128 * (h & 1) + 32 * (h >> 1) + (dd - 64); } };
struct RowGU { int up; __device__ __forceinline__ int operator()(int n) const { return (n >> 7) * 256 + up * 128 + (n & 127); } };

template <class RowMap>
__device__ __forceinline__ void p0_transpose_item_f8(const float* W, int K, int N, unsigned char* WT, float wscale, LAS float* scr, int item, int lane, RowMap rowmap) {
    const int nblk = N / 32, kb = item / nblk, nb = item % nblk, k0 = 64 * kb, n0 = 32 * nb;
#pragma unroll 4
    for (int i = 0; i < 32; ++i) { const int kk = 2 * i + (lane >> 5); scr[kk * 33 + (lane & 31)] = wscale * W[(size_t)(k0 + kk) * N + n0 + (lane & 31)]; }
    LDS_WAIT(); asm volatile("" ::: "memory");
    const int c = lane & 3;
#pragma unroll
    for (int j = 0; j < 2; ++j) { const int n = (lane >> 2) + 16 * j; const LAS float* s = scr + (16 * c) * 33 + n;
        v4u o; o.x = pg8::pk4_fp8(s[0 * 33], s[1 * 33], s[2 * 33], s[3 * 33]); o.y = pg8::pk4_fp8(s[4 * 33], s[5 * 33], s[6 * 33], s[7 * 33]);
        o.z = pg8::pk4_fp8(s[8 * 33], s[9 * 33], s[10 * 33], s[11 * 33]); o.w = pg8::pk4_fp8(s[12 * 33], s[13 * 33], s[14 * 33], s[15 * 33]);
        *(GAS v4u*)(WT + (size_t)rowmap(n0 + n) * K + k0 + 16 * c) = o; }
    LDS_WAIT(); asm volatile("" ::: "memory");
}
__device__ __forceinline__ void p0_prologue(Frame& F) {
    LAS float* scr = (LAS float*)(F.lds + RING_OFF + F.wave * 16384);
    const int gw = F.vcu * NWAVES + F.wave, NGW = F.G * NWAVES;
    constexpr int I_IN = (DM / 64) * (INW / 32), I_QB = (QL / 64) * (BH * QKD / 32), I_KVB = (KVL / 64) * (BH * 128 / 32), I_O = (DM / 64) * (DM / 32), I_E = (DM / 64) * (FF / 32);
    constexpr int NITEMS = I_IN + I_QB + I_KVB + I_O + NE * 3 * I_E;
    bf16* Win_t = WSP(bf16, WS_WIN); bf16* Wqb_t = WSP(bf16, WS_WQB); bf16* Wkvb_t = WSP(bf16, WS_WKVB); bf16* Wo_t = WSP(bf16, WS_WO); bf16* Wgu_t = WSP(bf16, WS_WGU); bf16* Wd_t = WSP(bf16, WS_WD);
    const int nitems = (F.G == 256) ? NITEMS - NE * 3 * I_E : NITEMS;
    for (int it = gw; it < nitems; it += NGW) {
        int r = it;
        if (r < I_IN) { p0_transpose_item(F.in[3], DM, INW, Win_t, F.in[2], scr, r, lane_id(), RowG64{}); continue; } r -= I_IN;
        if (r < I_QB) { p0_transpose_item(F.in[8], QL, BH * QKD, Wqb_t, F.in[7], scr, r, lane_id(), RowQB{}); continue; } r -= I_QB;
        if (r < I_KVB) { p0_transpose_item(F.in[10], KVL, BH * 128, Wkvb_t, F.in[9], scr, r, lane_id(), RowG64{}); continue; } r -= I_KVB;
        if (r < I_O) { const int kb = r / (DM / 32); const float* g = (kb < 8) ? F.in[15] : (F.in[16] - 512);
            p0_transpose_item(F.in[17], DM, DM, Wo_t, g, scr, r, lane_id(), RowId{}); continue; } r -= I_O;
        const int e = r / (3 * I_E), q = r % (3 * I_E), which = q / I_E, item = q % I_E;
        if (which == 0) p0_transpose_item_f8(F.in[20] + (size_t)e * DM * FF, DM, FF, (unsigned char*)Wgu_t + (size_t)e * 2 * FF * DM, 32.0f, scr, item, lane_id(), RowGU{0});
        else if (which == 1) p0_transpose_item_f8(F.in[21] + (size_t)e * DM * FF, DM, FF, (unsigned char*)Wgu_t + (size_t)e * 2 * FF * DM, 32.0f, scr, item, lane_id(), RowGU{1});
        else p0_transpose_item_f8(F.in[22] + (size_t)e * FF * DM, FF, DM, (unsigned char*)Wd_t + (size_t)e * DM * FF, 16.0f, scr, item, lane_id(), RowId{});
    }
    { const int nchunk = (NZ - INW) * DM / 8; for (int c = gw * 64 + lane_id(); c < nchunk; c += NGW * 64) { const int n = INW + c / (DM / 8), k8 = c % (DM / 8); *(GAS v4u*)(Win_t + (size_t)RowG64{}(n) * DM + (size_t)k8 * 8) = (v4u){0u, 0u, 0u, 0u}; } }
    bf16* XN = WSP(bf16, WS_XN);
    for (int m = gw; m < T; m += NGW) {
        const GAS f32x4* xr = (const GAS f32x4*)(F.in[0] + (size_t)m * DM) + lane_id();
        f32x4 v[4]; float s = 0.f;
#pragma unroll
        for (int j = 0; j < 4; ++j) { v[j] = xr[64 * j]; s += (v[j].x * v[j].x + v[j].y * v[j].y) + (v[j].z * v[j].z + v[j].w * v[j].w); }
        const float rs = 1.0f / sqrtf(wave_sum(s) * (1.f / DM) + EPS);
        GAS unsigned long long* o8 = (GAS unsigned long long*)(XN + (size_t)m * DM) + lane_id();
#pragma unroll
        for (int j = 0; j < 4; ++j) o8[64 * j] = (unsigned long long)pk2(v[j].x * rs, v[j].y * rs) | ((unsigned long long)pk2(v[j].z * rs, v[j].w * rs) << 32);
    }
    float* TAB = WSP(float, WS_TAB);
    if (blockIdx.x == 0) {
        const float* rel_bias = F.in[1];
        for (int i = (F.wave * 64 + lane_id()); i < 8 * NTAB; i += NWAVES * 64) { const int h = i / NTAB, rel = i % NTAB - 128; TAB[TAB_BIAS + i] = rel_bias[t5_bucket(rel) * A_HEADS + h] * LOG2E; }
        if (F.wave == 0) {
            const float ga = fabsf(F.in[4][lane_id()] * F.in[5][lane_id()]); float mb = 0.f; for (int i = lane_id(); i < 32 * 8; i += 64) mb = fmaxf(mb, rel_bias[i]);
            const float gb = fabsf(F.in[11][lane_id()] * F.in[13][lane_id()]); const float gqr = (lane_id() < 32) ? fabsf(F.in[12][lane_id()]) : 0.f, gkr = (lane_id() < 32) ? fabsf(F.in[14][lane_id()]) : 0.f;
            float mga = ga, mgb = gb, mqr = gqr, mkr = gkr;
#pragma unroll
            for (int o = 1; o < 64; o <<= 1) { mga = fmaxf(mga, __shfl_xor(mga, o)); mgb = fmaxf(mgb, __shfl_xor(mgb, o)); mqr = fmaxf(mqr, __shfl_xor(mqr, o)); mkr = fmaxf(mkr, __shfl_xor(mkr, o)); mb = fmaxf(mb, __shfl_xor(mb, o)); }
            if (lane_id() == 0) { TAB[TAB_CONST + 0] = (8.0f * mga + mb) * LOG2E + 1.0f; TAB[TAB_CONST + 1] = 0.10206207261596577f * (64.f * mgb + 32.f * mqr * mkr) * LOG2E + 1.0f; }
        }
    }
    for (int i = gw * 64 + lane_id(); i < SEQ * 16; i += NGW * 64) { const int s = i >> 4, k = i & 15; const float freq = powf(10000.0f, -(float)(2 * k) / 32.0f); const float ang = (float)s * freq;
        TAB[TAB_COS + i] = cosf(ang); TAB[TAB_SIN + i] = sinf(ang); }
}

__device__ __forceinline__ void p2_fixup(Frame& F) {
    const int gw = F.vcu * NWAVES + F.wave, NGW = F.G * NWAVES; const int lane = lane_id();
    const bf16* Z = WSP(bf16, WS_Z); bf16* QA = WSP(bf16, WS_QA); bf16* KA = WSP(bf16, WS_KA); bf16* VA = WSP(bf16, WS_VA); bf16* CQ = WSP(bf16, WS_CQ); bf16* CKV = WSP(bf16, WS_CKV); bf16* KR = WSP(bf16, WS_KR);
    const float* TAB = WSP(float, WS_TAB);
    const float* gq = F.in[4]; const float* gk = F.in[5]; const float* gkr = F.in[14];
    float gqv[8], gkv[8], gkrv[8];
#pragma unroll
    for (int j = 0; j < 8; ++j) { gqv[j] = gq[(8 * lane) % 64 + j]; gkv[j] = gk[(8 * lane) % 64 + j]; gkrv[j] = gkr[(8 * lane) % 32 + j]; }
    for (int m = gw; m < T; m += NGW) {
        const bf16* zr = Z + (size_t)m * NZ; const int s = m % SEQ; float f[8], o[8];
        { unpack8(*(const GAS v4u*)(zr + 8 * lane), f); float ss = 0.f;
#pragma unroll
          for (int j = 0; j < 8; ++j) ss += f[j] * f[j];
          const float r = QSC_A / sqrtf(grp_sum8(ss) * (1.f / 64.f) + EPS);
#pragma unroll
          for (int j = 0; j < 8; ++j) o[j] = f[j] * r * gqv[j];
          *(GAS v4u*)(QA + (size_t)m * 512 + 8 * lane) = pack8(o); }
        { const int l2 = lane & 31; const v4u w = *(const GAS v4u*)(zr + 512 + 8 * l2); unpack8(w, f); float ss = 0.f;
#pragma unroll
          for (int j = 0; j < 8; ++j) ss += f[j] * f[j];
          const float r = 1.0f / sqrtf(grp_sum8(ss) * (1.f / 64.f) + EPS);
#pragma unroll
          for (int j = 0; j < 8; ++j) o[j] = f[j] * r * gkv[j];
          if (lane < 16) *(GAS v4u*)(KA + (size_t)m * 128 + 8 * lane) = pack8(o);
          else if (lane < 32) *(GAS v4u*)(VA + (size_t)m * 128 + 8 * (lane - 16)) = w; }
        { const int l2 = lane < 48 ? lane : 0; unpack8(*(const GAS v4u*)(zr + 768 + 8 * l2), f); float ss = 0.f;
#pragma unroll
          for (int j = 0; j < 8; ++j) ss += f[j] * f[j];
          if (lane >= 48) ss = 0.f;
          const float r = 1.0f / sqrtf(wave_sum(ss) * (1.f / 384.f) + EPS);
#pragma unroll
          for (int j = 0; j < 8; ++j) o[j] = f[j] * r;
          if (lane < 48) *(GAS v4u*)(CQ + (size_t)m * QL + 8 * lane) = pack8(o); }
        { const int l2 = lane & 31; unpack8(*(const GAS v4u*)(zr + 1152 + 8 * l2), f); float ss = 0.f;
#pragma unroll
          for (int j = 0; j < 8; ++j) ss += f[j] * f[j];
          if (lane >= 32) ss = 0.f;
          const float r = 1.0f / sqrtf(wave_sum(ss) * (1.f / 256.f) + EPS);
#pragma unroll
          for (int j = 0; j < 8; ++j) o[j] = f[j] * r;
          if (lane < 32) *(GAS v4u*)(CKV + (size_t)m * KVL + 8 * lane) = pack8(o); }
        { const int l2 = lane & 3; unpack8(*(const GAS v4u*)(zr + 1408 + 8 * l2), f); float ss = 0.f;
#pragma unroll
          for (int j = 0; j < 8; ++j) ss += f[j] * f[j];
          const float r = 1.0f / sqrtf(grp_sum4(ss) * (1.f / 32.f) + EPS);
#pragma unroll
          for (int j = 0; j < 8; ++j) { const float y = f[j] * r * gkrv[j]; const float p = __shfl_xor(y, 2); const int i = (8 * l2 + j) & 15;
              const float c = TAB[TAB_COS + s * 16 + i], sn = TAB[TAB_SIN + s * 16 + i];
              o[j] = (l2 < 2) ? (y * c - p * sn) : (p * sn + y * c); }
          if (lane < 4) *(GAS v4u*)(KR + (size_t)m * ROPE + 8 * lane) = pack8(o); }
    }
}

__device__ __forceinline__ void p4_fixup(Frame& F) {
    const int gw = F.vcu * NWAVES + F.wave, NGW = F.G * NWAVES; const int lane = lane_id();
    bf16* QB = WSP(bf16, WS_QB); const bf16* KVR = WSP(bf16, WS_KVRAW); bf16* KBN = WSP(bf16, WS_KBN); bf16* VB = WSP(bf16, WS_VB);
    const float* TAB = WSP(float, WS_TAB);
    float gqn[8], gkn[8], gqr[8];
#pragma unroll
    for (int j = 0; j < 8; ++j) { gqn[j] = F.in[11][8 * (lane & 7) + j]; gkn[j] = F.in[13][8 * (lane & 7) + j]; gqr[j] = F.in[12][8 * (lane & 3) + j]; }
    for (int m = gw; m < T; m += NGW) {
        const int s = m % SEQ; float f[8], o[8];
        bf16* qrow = QB + (size_t)m * (BH * QKD);
        { bf16* p = qrow + QKD * (lane >> 3) + 8 * (lane & 7); unpack8(*(const GAS v4u*)p, f); float ss = 0.f;
#pragma unroll
          for (int j = 0; j < 8; ++j) ss += f[j] * f[j];
          const float r = QSC_B / sqrtf(grp_sum8(ss) * (1.f / 64.f) + EPS);
#pragma unroll
          for (int j = 0; j < 8; ++j) o[j] = f[j] * r * gqn[j];
          *(GAS v4u*)p = pack8(o); }
        { const int l2 = lane & 31; bf16* p = qrow + QKD * (l2 >> 2) + NOPE + 8 * (l2 & 3); unpack8(*(const GAS v4u*)p, f); float ss = 0.f;
#pragma unroll
          for (int j = 0; j < 8; ++j) ss += f[j] * f[j];
          const float r = 1.0f / sqrtf(grp_sum4(ss) * (1.f / 32.f) + EPS);
#pragma unroll
          for (int j = 0; j < 8; ++j) { const float y = f[j] * r * gqr[j]; const float pp = __shfl_xor(y, 2); const int i = (8 * (l2 & 3) + j) & 15;
              const float c = TAB[TAB_COS + s * 16 + i], sn = TAB[TAB_SIN + s * 16 + i];
              o[j] = QSC_B * (((l2 & 3) < 2) ? (y * c - pp * sn) : (pp * sn + y * c)); }
          if (lane < 32) *(GAS v4u*)p = pack8(o); }
        { const bf16* p = KVR + (size_t)m * 1024 + 128 * (lane >> 3) + 8 * (lane & 7); unpack8(*(const GAS v4u*)p, f); float ss = 0.f;
#pragma unroll
          for (int j = 0; j < 8; ++j) ss += f[j] * f[j];
          const float r = 1.0f / sqrtf(grp_sum8(ss) * (1.f / 64.f) + EPS);
#pragma unroll
          for (int j = 0; j < 8; ++j) o[j] = f[j] * r * gkn[j];
          *(GAS v4u*)(KBN + (size_t)m * 512 + 64 * (lane >> 3) + 8 * (lane & 7)) = pack8(o);
          *(GAS v4u*)(VB + (size_t)m * 512 + 64 * (lane >> 3) + 8 * (lane & 7)) = *(const GAS v4u*)(p + 64); }
    }
}

__device__ __forceinline__ void p6_onorm(Frame& F) {
    const int gw = F.vcu * NWAVES + F.wave, NGW = F.G * NWAVES; const int lane = lane_id();
    bf16* O = WSP(bf16, WS_O);
    for (int m = gw; m < T; m += NGW) {
#pragma unroll
        for (int hf = 0; hf < 2; ++hf) { bf16* p = O + (size_t)m * DM + 512 * hf + 8 * lane; float f[8], o[8]; unpack8(*(const GAS v4u*)p, f); float ss = 0.f;
#pragma unroll
            for (int j = 0; j < 8; ++j) ss += f[j] * f[j];
            const float r = 1.0f / sqrtf(wave_sum(ss) * (1.f / 512.f) + EPS);
#pragma unroll
            for (int j = 0; j < 8; ++j) o[j] = f[j] * r;
            *(GAS v4u*)p = pack8(o); }
    }
}

__device__ __forceinline__ float red16(float (&v)[16], int lane) {
    const bool b5 = lane & 32, b4 = lane & 16, b3 = lane & 8, b2 = lane & 4; float w8[8], w4[4], w2[2];
#pragma unroll
    for (int i = 0; i < 8; ++i) { const float mine = b5 ? v[8 + i] : v[i], oth = b5 ? v[i] : v[8 + i]; w8[i] = mine + __shfl_xor(oth, 32); }
#pragma unroll
    for (int i = 0; i < 4; ++i) { const float mine = b4 ? w8[4 + i] : w8[i], oth = b4 ? w8[i] : w8[4 + i]; w4[i] = mine + __shfl_xor(oth, 16); }
#pragma unroll
    for (int i = 0; i < 2; ++i) { const float mine = b3 ? w4[2 + i] : w4[i], oth = b3 ? w4[i] : w4[2 + i]; w2[i] = mine + __shfl_xor(oth, 8); }
    const float mine = b2 ? w2[1] : w2[0], oth = b2 ? w2[0] : w2[1]; float y = mine + __shfl_xor(oth, 4);
    y += __shfl_xor(y, 1); y += __shfl_xor(y, 2); return y;
}
__device__ __forceinline__ void p8_router(Frame& F) {
    const int gw = F.vcu * NWAVES + F.wave, NGW = F.G * NWAVES; const int lane = lane_id();
    unsigned char* H2 = WSP(unsigned char, WS_H2); float* AFF = WSP(float, WS_AFF); const bf16* ATT = WSP(bf16, WS_ATT); bf16* X1B = WSP(bf16, WS_X1B);
    const float* g2 = F.in[18]; const float* wr = F.in[19];
    LAS float* wl = (LAS float*)(F.lds + RING_OFF);
    __syncthreads();
    for (int i = (F.wave * 64 + lane_id()); i < DM * NE; i += NWAVES * 64) wl[(i & 15) * DM + (i >> 4)] = wr[i];
    __syncthreads();
    const LAS float* wlane = wl + 4 * lane;
    for (int m = gw; m < T; m += NGW) {
        f32x4 x[4]; float ss = 0.f;
#pragma unroll
        for (int k = 0; k < 4; ++k) { x[k] = *(const GAS f32x4*)(F.in[0] + (size_t)m * DM + 4 * lane + 256 * k); const unsigned long long aw = *(const GAS unsigned long long*)(ATT + (size_t)m * DM + 4 * lane + 256 * k);
            const unsigned alo = (unsigned)aw, ahi = (unsigned)(aw >> 32); x[k].x += __uint_as_float(alo << 16); x[k].y += __uint_as_float(alo & 0xffff0000u); x[k].z += __uint_as_float(ahi << 16); x[k].w += __uint_as_float(ahi & 0xffff0000u);
            ss += (x[k].x * x[k].x + x[k].y * x[k].y) + (x[k].z * x[k].z + x[k].w * x[k].w); }
        const float rs = __builtin_amdgcn_rsqf(wave_sum(ss) * (1.f / DM) + EPS);
#pragma unroll
        for (int k = 0; k < 4; ++k) { const f32x4 g = *(const GAS f32x4*)(g2 + 4 * lane + 256 * k);
            *(GAS unsigned long long*)(X1B + (size_t)m * DM + 4 * lane + 256 * k) = (unsigned long long)pk2(x[k].x, x[k].y) | ((unsigned long long)pk2(x[k].z, x[k].w) << 32);
            x[k].x *= rs * g.x; x[k].y *= rs * g.y; x[k].z *= rs * g.z; x[k].w *= rs * g.w;
            *(GAS unsigned*)(H2 + (size_t)m * DM + 4 * lane + 256 * k) = pg8::pk4_fp8(32.0f * x[k].x, 32.0f * x[k].y, 32.0f * x[k].z, 32.0f * x[k].w); }
        float lg[16];
#pragma unroll
        for (int e = 0; e < 16; ++e) { float a0 = 0.f;
#pragma unroll
            for (int k = 0; k < 4; ++k) { const f32x4 w = *(const LAS f32x4*)(wlane + e * DM + 256 * k); a0 += (x[k].x * w.x + x[k].y * w.y) + (x[k].z * w.z + x[k].w * w.w); }
            lg[e] = a0; if ((e & 3) == 3) asm volatile("" ::: "memory"); }
        const float y = red16(lg, lane); float mx = y;
#pragma unroll
        for (int o = 4; o < 64; o <<= 1) mx = fmaxf(mx, __shfl_xor(mx, o));
        const float ex = __builtin_amdgcn_exp2f((y - mx) * LOG2E); float den = ex;
#pragma unroll
        for (int o = 4; o < 64; o <<= 1) den += __shfl_xor(den, o);
        if ((lane & 3) == 0) AFF[((size_t)(m / SEQ) * NE + ((lane >> 2) & 15)) * SEQ + (m % SEQ)] = ex / den;
    }
    __syncthreads();
}

__device__ __forceinline__ int block_excl_scan(int v, LAS int* tmp, int tid, int lane, int wave, int& total) {
    int inc = v;
#pragma unroll
    for (int o = 1; o < 64; o <<= 1) { const int t = __shfl_up(inc, o); if (lane >= o) inc += t; }
    if (lane == 63) tmp[wave] = inc;
    __syncthreads();
    int base = 0, tot = 0;
#pragma unroll
    for (int w = 0; w < NWAVES; ++w) { const int t = tmp[w]; if (w < wave) base += t; tot += t; }
    __syncthreads();
    total = tot; return base + inc - v;
}
__device__ __forceinline__ void p9_topk(Frame& F) {
    LAS unsigned* keys = (LAS unsigned*)(F.lds + RING_OFF);
    LAS unsigned* hist = keys + SEQ;
    LAS int* tmp = (LAS int*)(hist + 256);
    LAS unsigned* res = (LAS unsigned*)(tmp + 16);
    const int lane = lane_id(), wave = F.wave, tid = wave * 64 + lane;
    const float* AFF = WSP(float, WS_AFF); int* IDX = WSP(int, WS_IDX); float* GATEV = WSP(float, WS_GATEV); int* SLOT = WSP(int, WS_SLOT);
    for (int item = blockIdx.x; item < BATCH * NE; item += F.G) {
        const int b = item / NE, e = item % NE; const float* a = AFF + (size_t)item * SEQ;
        __syncthreads();
#pragma unroll
        for (int i = 0; i < 8; ++i) keys[tid + 512 * i] = __float_as_uint(a[tid + 512 * i]);
        __syncthreads();
        unsigned kk[8];
#pragma unroll
        for (int i = 0; i < 8; ++i) kk[i] = keys[8 * tid + i];
        LAS int* cnt2 = tmp;
#define P9_COUNT(v, step, out) do { int c_ = 0; _Pragma("unroll") for (int i = 0; i < 8; ++i) c_ += (int)__popcll(__ballot(kk[i] >= (v))); \
            if (lane == 0) cnt2[((step) & 1) * 8 + wave] = c_; __syncthreads(); int s_ = 0; _Pragma("unroll") for (int w = 0; w < NWAVES; ++w) s_ += cnt2[((step) & 1) * 8 + w]; out = s_; } while (0)
        unsigned prefix = 0u; int step = 0;
        for (int bit = 29; bit >= 0; --bit) { const unsigned cand = prefix | (1u << bit); int c; P9_COUNT(cand, step, c); ++step; if (c >= CAP) prefix = cand; }
        int cgt; P9_COUNT(prefix + 1u, step, cgt); ++step;
        int remaining = CAP - cgt;
        __syncthreads();
#undef P9_COUNT
        int neq = 0;
#pragma unroll
        for (int i = 0; i < 8; ++i) neq += (kk[i] == prefix) ? 1 : 0;
        int toteq; int eqbase = block_excl_scan(neq, tmp, tid, lane, wave, toteq);
        int sel[8]; int nsel = 0;
#pragma unroll
        for (int i = 0; i < 8; ++i) { const bool eq = kk[i] == prefix; sel[i] = (kk[i] > prefix || (eq && eqbase < remaining)) ? 1 : 0; eqbase += eq ? 1 : 0; nsel += sel[i]; }
        int totsel; int slot = block_excl_scan(nsel, tmp, tid, lane, wave, totsel);
        const size_t rbase = (size_t)(e * BATCH + b) * CAP;
#pragma unroll
        for (int i = 0; i < 8; ++i) { const int s = 8 * tid + i;
            if (sel[i]) { if (slot < CAP) { IDX[rbase + slot] = b * SEQ + s; GATEV[rbase + slot] = __uint_as_float(kk[i]); } SLOT[(size_t)item * SEQ + s] = slot < CAP ? slot : -1; ++slot; }
            else SLOT[(size_t)item * SEQ + s] = -1; }
    }
}

__device__ __forceinline__ void p9b_gather(Frame& F) {
    const int gw = F.vcu * NWAVES + F.wave, NGW = F.G * NWAVES; const int lane = lane_id();
    const unsigned char* H2 = WSP(unsigned char, WS_H2); unsigned char* XE = WSP(unsigned char, WS_XE); const int* IDX = WSP(int, WS_IDX);
    for (int r = gw * 2; r < MX; r += NGW * 2) { const int tok0 = IDX[r], tok1 = IDX[r + 1];
        const v4u a = *((const GAS v4u*)(H2 + (size_t)tok0 * DM) + lane), b = *((const GAS v4u*)(H2 + (size_t)tok1 * DM) + lane);
        *((GAS v4u*)(XE + (size_t)r * DM) + lane) = a; *((GAS v4u*)(XE + (size_t)(r + 1) * DM) + lane) = b; }
}

__device__ __forceinline__ void p12_combine(Frame& F) {
    const int gw = F.vcu * NWAVES + F.wave, NGW = F.G * NWAVES; const int lane = lane_id();
    const unsigned char* YE = WSP(unsigned char, WS_YE); const int* SLOT = WSP(int, WS_SLOT); const bf16* X1B = WSP(bf16, WS_X1B);
    typedef float f32x2v __attribute__((ext_vector_type(2)));
    for (int m = gw; m < T; m += NGW) {
        const int b = m / SEQ, s = m % SEQ;
        const int sl = (lane < NE) ? SLOT[((size_t)b * NE + lane) * SEQ + s] : -1;
        unsigned long long mask = __ballot(sl >= 0);
        GAS f32x4* xr = (GAS f32x4*)(F.out + (size_t)m * DM) + lane; const GAS unsigned long long* x1 = (const GAS unsigned long long*)(X1B + (size_t)m * DM) + lane;
        f32x4 v[4];
#pragma unroll
        for (int j = 0; j < 4; ++j) { const unsigned long long aw = x1[64 * j]; const unsigned alo = (unsigned)aw, ahi = (unsigned)(aw >> 32);
            v[j].x = __uint_as_float(alo << 16); v[j].y = __uint_as_float(alo & 0xffff0000u); v[j].z = __uint_as_float(ahi << 16); v[j].w = __uint_as_float(ahi & 0xffff0000u); }
        f32x4 a[4];
#pragma unroll
        for (int j = 0; j < 4; ++j) a[j] = (f32x4){0.f, 0.f, 0.f, 0.f};
        while (mask) { const int e = __builtin_ctzll(mask); mask &= mask - 1; const int slot = __shfl(sl, e);
            const GAS unsigned* yr = (const GAS unsigned*)(YE + ((size_t)(e * BATCH + b) * CAP + slot) * DM) + lane;
#pragma unroll
            for (int j = 0; j < 4; ++j) { const int w = (int)yr[64 * j]; const f32x2v lo = __builtin_amdgcn_cvt_pk_f32_fp8(w, false), hi = __builtin_amdgcn_cvt_pk_f32_fp8(w, true);
                a[j].x += lo.x; a[j].y += lo.y; a[j].z += hi.x; a[j].w += hi.y; } }
#pragma unroll
        for (int j = 0; j < 4; ++j) xr[64 * j] = v[j] + a[j] * (1.0f / 64.0f);
    }
}


#ifndef MLA_UNIT
#define MLA_UNIT mla_unit2
#endif
namespace att {
using bf16x8 = __attribute__((ext_vector_type(8))) short;
using s16x4 = __attribute__((ext_vector_type(4))) short;
using f32x16 = __attribute__((ext_vector_type(16))) float;
using u32x4 = __attribute__((ext_vector_type(4))) unsigned;
constexpr int KSLOT = 12288, VSLOT = 8192, NSLOT = 3;
constexpr int LK = 0, LV = NSLOT * KSLOT, LWS = LV + NSLOT * VSLOT, LTAB = LWS + NWAVES * 256, ATT_LDS = LTAB + 4 * 512 * 4;
constexpr int CV_F32 = ATT_LDS, CV_F8 = CV_F32 + NWAVES * 4096, CV_END = CV_F8 + NWAVES * 2176;
static_assert(CV_END <= RING_BYTES, "attention LDS");
struct ConvJob { int item0; };
__device__ __forceinline__ int crow(int r, int hi) { return (r & 3) + 8 * (r >> 2) + 4 * hi; }
__device__ __forceinline__ void glds16(const void* gsrc, unsigned lds_dst) { unsigned keep;
    asm volatile("s_mov_b32 %0, m0\n\ts_mov_b32 m0, %2\n\ts_nop 0\n\tglobal_load_lds_dwordx4 %1, off\n\ts_mov_b32 m0, %0" : "=&s"(keep) : "v"(gsrc), "s"(lds_dst) : "memory"); }
__device__ __forceinline__ void glds16s(const void* sbase, unsigned voff, unsigned lds_dst) { unsigned keep;
    asm volatile("s_mov_b32 %0, m0\n\ts_mov_b32 m0, %3\n\ts_nop 0\n\tglobal_load_lds_dwordx4 %1, %2\n\ts_mov_b32 m0, %0" : "=&s"(keep) : "v"(voff), "s"(sbase), "s"(lds_dst) : "memory"); }
__device__ __forceinline__ void glds16s_nt(const void* sbase, unsigned voff, unsigned lds_dst) { unsigned keep;
    asm volatile("s_mov_b32 %0, m0\n\ts_mov_b32 m0, %3\n\ts_nop 0\n\tglobal_load_lds_dwordx4 %1, %2 nt\n\ts_mov_b32 m0, %0" : "=&s"(keep) : "v"(voff), "s"(sbase), "s"(lds_dst) : "memory"); }
__device__ __forceinline__ const bf16* sptr(const bf16* p) { const unsigned long long a = (unsigned long long)p; const unsigned lo = (unsigned)__builtin_amdgcn_readfirstlane((int)(unsigned)a), hi = (unsigned)__builtin_amdgcn_readfirstlane((int)(unsigned)(a >> 32)); return (const bf16*)(((unsigned long long)hi << 32) | lo); }
__device__ __forceinline__ unsigned rfl(unsigned v) { return (unsigned)__builtin_amdgcn_readfirstlane((int)v); }
typedef float f32x2_t __attribute__((ext_vector_type(2))); typedef __bf16 bf16x2_t __attribute__((ext_vector_type(2)));
__device__ __forceinline__ unsigned cvtpk(float lo, float hi) { f32x2_t v = {lo, hi}; bf16x2_t b = __builtin_convertvector(v, bf16x2_t); return __builtin_bit_cast(unsigned, b); }
#define ATT_SBAR() __builtin_amdgcn_sched_barrier(0)
__device__ __forceinline__ void pv(f32x16* o, int vb, bf16x8 pa0, bf16x8 pa1, bf16x8 pa2, bf16x8 pa3) {
#pragma unroll
    for (int d0 = 0; d0 < 2; ++d0) { s16x4 lo[4], hi[4];
#pragma unroll
        for (int ks = 0; ks < 4; ++ks) {
            asm volatile("ds_read_b64_tr_b16 %0,%1 offset:%c2" : "=&v"(lo[ks]) : "v"(vb), "i"(d0 * 4096 + ks * 1024) : "memory");
            asm volatile("ds_read_b64_tr_b16 %0,%1 offset:%c2" : "=&v"(hi[ks]) : "v"(vb), "i"(d0 * 4096 + ks * 1024 + 512) : "memory"); }
        asm volatile("s_waitcnt lgkmcnt(0)" ::: "memory"); ATT_SBAR();
#define ATT_PK(k) (bf16x8){lo[k][0], lo[k][1], lo[k][2], lo[k][3], hi[k][0], hi[k][1], hi[k][2], hi[k][3]}
        o[d0] = __builtin_amdgcn_mfma_f32_32x32x16_bf16(pa0, ATT_PK(0), o[d0], 0, 0, 0);
        o[d0] = __builtin_amdgcn_mfma_f32_32x32x16_bf16(pa1, ATT_PK(1), o[d0], 0, 0, 0);
        o[d0] = __builtin_amdgcn_mfma_f32_32x32x16_bf16(pa2, ATT_PK(2), o[d0], 0, 0, 0);
        o[d0] = __builtin_amdgcn_mfma_f32_32x32x16_bf16(pa3, ATT_PK(3), o[d0], 0, 0, 0);
#undef ATT_PK
    }
}
__device__ __forceinline__ void ssq_accum(const float (&part)[16], int le, float* ssq) {
    const bool b4 = le & 16, b3 = le & 8, b2 = le & 4, b1 = le & 2; float p8[8], p4[4], p2[2];
#pragma unroll
    for (int i = 0; i < 8; ++i) { const float mine = b4 ? part[8 + i] : part[i], oth = b4 ? part[i] : part[8 + i]; p8[i] = mine + __shfl_xor(oth, 16); }
#pragma unroll
    for (int i = 0; i < 4; ++i) { const float mine = b3 ? p8[4 + i] : p8[i], oth = b3 ? p8[i] : p8[4 + i]; p4[i] = mine + __shfl_xor(oth, 8); }
#pragma unroll
    for (int i = 0; i < 2; ++i) { const float mine = b2 ? p4[2 + i] : p4[i], oth = b2 ? p4[i] : p4[2 + i]; p2[i] = mine + __shfl_xor(oth, 4); }
    const float mine = b1 ? p2[1] : p2[0], oth = b1 ? p2[0] : p2[1]; float y = mine + __shfl_xor(oth, 2);
    y += __shfl_xor(y, 1);
    const int r = (b4 ? 8 : 0) + (b3 ? 4 : 0) + (b2 ? 2 : 0) + (b1 ? 1 : 0);
    if ((le & 1) == 0) atomicAdd(ssq + 2 * crow(r, le >> 5), y);
}
#define ATT_WAIT_BAR(N) asm volatile("s_waitcnt vmcnt(" #N ") lgkmcnt(0)\n\ts_barrier" ::: "memory")
__device__ __forceinline__ u32x4 pack_p(const f32x16& p, int base) { u32x4 w; w.x = cvtpk(p[base], p[base + 1]); w.y = cvtpk(p[base + 2], p[base + 3]); w.z = cvtpk(p[base + 4], p[base + 5]); w.w = cvtpk(p[base + 6], p[base + 7]); return w; }

typedef __attribute__((address_space(3))) const char* lds_cptr;
typedef short v4i16_t __attribute__((ext_vector_type(4)));
__device__ __forceinline__ s16x4 vtr(lds_cptr p) { return __builtin_bit_cast(s16x4, __builtin_amdgcn_ds_read_tr16_b64_v4i16((__attribute__((address_space(3))) v4i16_t*)p)); }
__device__ __forceinline__ void mla_unit2(LAS unsigned char* lds, int b, int h, int qb, const bf16* QB, const bf16* KBN, const bf16* KR, const bf16* VB, bf16* O, float* SSQ, bool shift, float nb, const ConvJob cj, int wid, int lane) {
    const int r32 = lane & 31, hi = lane >> 5;
    const unsigned lds0 = (unsigned)(uintptr_t)lds;
    const size_t rowb = (size_t)b * SEQ; const int q0 = qb * 256;
    const bf16* ksrc0 = sptr(KBN + (size_t)((b * BH + h) * 64) * 4096 + wid * 512);
    const bf16* ksrc1 = sptr(KR + (size_t)(b * 64) * 2048 + (wid & 3) * 512);
    const bf16* vsrc = sptr(VB + (size_t)((b * BH + h) * 64) * 4096 + wid * 512);
    const unsigned kl0 = lane * 16u, kl1 = kl0, vl = kl0;
    const unsigned kdst0 = lds0 + LK + wid * 1024, kdst1 = lds0 + LK + (8 + (wid & 3)) * 1024, vdst = lds0 + LV + wid * 1024;
#define DMA_K(t, sl) do { glds16s(ksrc0 + (size_t)(t) * 4096, kl0, rfl(kdst0 + (sl) * KSLOT)); if (wid < 4) glds16s(ksrc1 + (size_t)(t) * 2048, kl1, rfl(kdst1 + (sl) * KSLOT)); } while (0)
#define DMA_V(t, sl) glds16s(vsrc + (size_t)(t) * 4096, vl, rfl(vdst + (sl) * VSLOT))
#define WAITB(N4, N8) do { if (wid < 4) ATT_WAIT_BAR(N4); else ATT_WAIT_BAR(N8); } while (0)
    constexpr int NT = SEQ / 64;
    DMA_K(0, 0); DMA_V(0, 0); DMA_K(1, 1); DMA_K(2, 2);
    bf16x8 qf[6];
    { const bf16* qp = QB + (rowb + q0 + 32 * wid + r32) * (BH * QKD) + QKD * h + 8 * hi;
#pragma unroll
      for (int s = 0; s < 6; ++s) qf[s] = *(const bf16x8*)(qp + 16 * s); }
    f32x16 o[2]; o[0] = f32x16{}; o[1] = f32x16{};
    float l_reg = 0.f;
    const lds_cptr kp0 = (lds_cptr)lds + LK + hi * 1024 + r32 * 16;
    const lds_cptr vp0 = (lds_cptr)lds + LV + ((lane >> 4) & 1) * 32 + (lane & 3) * 8 + (4 * hi + ((lane & 15) >> 2)) * 64;
    bf16x8 kf[12];
#define KLD(kp, i) kf[i] = *(const __attribute__((address_space(3))) bf16x8*)((kp) + ((i) >> 1) * 2048 + ((i) & 1) * 512)
    WAITB(5, 3);
#pragma unroll
    for (int i = 0; i < 12; ++i) KLD(kp0, i);
    f32x16 pA0, pA1, pB0, pB1;
    pA0 = f32x16{}; pA1 = f32x16{};
#pragma unroll
    for (int s = 0; s < 6; ++s) { pA0 = __builtin_amdgcn_mfma_f32_32x32x16_bf16(kf[2 * s], qf[s], pA0, 0, 0, 0); pA1 = __builtin_amdgcn_mfma_f32_32x32x16_bf16(kf[2 * s + 1], qf[s], pA1, 0, 0, 0); }
    if (shift) {
#pragma unroll
        for (int r = 0; r < 16; ++r) { pA0[r] += nb; pA1[r] += nb; } }
#pragma unroll
    for (int r = 0; r < 16; ++r) { pA0[r] = __builtin_amdgcn_exp2f(pA0[r]); pA1[r] = __builtin_amdgcn_exp2f(pA1[r]); }
    WAITB(2, 1);
    DMA_K(3, 0); DMA_V(1, 1);
#pragma unroll
    for (int i = 0; i < 12; ++i) KLD(kp0 + KSLOT, i);
    WAITB(3, 2);
    s16x4 vl0, vh0, vl1, vh1, vl2, vh2, vl3, vh3; u32x4 pw0, pw1, pw2, pw3;
    int i_prev = 0, i_cur = 1, i_next = 2;
#define ROT() do { const int t_ = i_prev; i_prev = i_cur; i_cur = i_next; i_next = t_; } while (0)
#define PIN(x) asm volatile("" : "+v"(x))
#define VOFF(i) (((i) >> 2) * 4096 + ((i) & 3) * 1024)
#define VRD(B, i) do { vl##B = vtr(vp_ + VOFF(i)); vh##B = vtr(vp_ + VOFF(i) + 512); } while (0)
#define VFR(B) (bf16x8){vl##B[0], vl##B[1], vl##B[2], vl##B[3], vh##B[0], vh##B[1], vh##B[2], vh##B[3]}
#define PAF(k) __builtin_bit_cast(bf16x8, pw##k)
#define EX(v) __builtin_amdgcn_exp2f(v)
#define QK0(C, i, s) C = __builtin_amdgcn_mfma_f32_32x32x16_bf16(kf[i], qf[s], f32x16{}, 0, 0, 0)
#define QKN(C, i, s) C = __builtin_amdgcn_mfma_f32_32x32x16_bf16(kf[i], qf[s], C, 0, 0, 0)
#define KN(i) do { if (GL_) { KLD(kn_, i); } } while (0)
#define GA0(MF, KI, P, B, PW, X0, X1) do { MF; KN(KI); sacc += P[B]; sacc += P[B + 1]; sacc += P[B + 2]; PIN(sacc); PW[0] = cvtpk(P[B], P[B + 1]); PIN(PW); X0; X1; ATT_SBAR(); } while (0)
#define GA1(MF, KI, P, B, PW, X0, X1) do { MF; KN(KI); sacc += P[B + 3]; sacc += P[B + 4]; sacc += P[B + 5]; PIN(sacc); PW[1] = cvtpk(P[B + 2], P[B + 3]); PW[2] = cvtpk(P[B + 4], P[B + 5]); PIN(PW); X0; X1; ATT_SBAR(); } while (0)
#define GA2(MF, KI, P, B, PW, X0, X1) do { MF; KN(KI); sacc += P[B + 6]; sacc += P[B + 7]; PIN(sacc); PW[3] = cvtpk(P[B + 6], P[B + 7]); PIN(PW); X0; X1; ATT_SBAR(); } while (0)
#define GB(MF, RD, E0, E1, E2) do { MF; RD; E0; E1; E2; ATT_SBAR(); } while (0)
#define NOP_ (void)0
#define STEP(C0, C1, P0, P1, t, GK, GV, GL) do { ATT_SBAR(); \
    constexpr bool GL_ = GL; \
    if (GK) { DMA_K((t) + 3, i_cur); } if (GV) { DMA_V((t) + 1, i_next); } \
    const lds_cptr vp_ = vp0 + i_prev * VSLOT; const lds_cptr kn_ = kp0 + i_next * KSLOT; \
    float sacc = 0.f; \
    GA0(QK0(C0, 0, 0), 0, P0, 0, pw0, NOP_, NOP_); \
    GA1(QKN(C0, 2, 1), 2, P0, 0, pw0, NOP_, NOP_); \
    GA2(QKN(C0, 4, 2), 4, P0, 0, pw0, NOP_, NOP_); \
    GA0(QKN(C0, 6, 3), 6, P0, 8, pw1, NOP_, NOP_); \
    GA1(QKN(C0, 8, 4), 8, P0, 8, pw1, NOP_, NOP_); \
    GA2(QKN(C0, 10, 5), 10, P0, 8, pw1, NOP_, NOP_); \
    GA0(QK0(C1, 1, 0), 1, P1, 0, pw2, NOP_, NOP_); \
    GA1(QKN(C1, 3, 1), 3, P1, 0, pw2, NOP_, NOP_); \
    if (__builtin_expect(shift, 0)) { _Pragma("unroll") for (int r_ = 0; r_ < 16; ++r_) C0[r_] += nb; PIN(C0); } ATT_SBAR(); \
    GA2(QKN(C1, 5, 2), 5, P1, 0, pw2, C0[0] = EX(C0[0]), C0[1] = EX(C0[1])); \
    GA0(QKN(C1, 7, 3), 7, P1, 8, pw3, C0[2] = EX(C0[2]), VRD(0, 0)); \
    GA1(QKN(C1, 9, 4), 9, P1, 8, pw3, C0[3] = EX(C0[3]), VRD(1, 4)); \
    GA2(QKN(C1, 11, 5), 11, P1, 8, pw3, C0[4] = EX(C0[4]), VRD(2, 1)); \
    l_reg += sacc; C0[5] = EX(C0[5]); C0[6] = EX(C0[6]); C0[7] = EX(C0[7]); PIN(C0); ATT_SBAR(); \
    if (__builtin_expect(shift, 0)) { _Pragma("unroll") for (int r_ = 0; r_ < 16; ++r_) C1[r_] += nb; PIN(C1); } ATT_SBAR(); \
    GB(o[0] = __builtin_amdgcn_mfma_f32_32x32x16_bf16(PAF(0), VFR(0), o[0], 0, 0, 0), VRD(3, 5), C0[8] = EX(C0[8]), C0[9] = EX(C0[9]), C0[10] = EX(C0[10])); \
    GB(o[1] = __builtin_amdgcn_mfma_f32_32x32x16_bf16(PAF(0), VFR(1), o[1], 0, 0, 0), VRD(0, 2), C0[11] = EX(C0[11]), C0[12] = EX(C0[12]), C0[13] = EX(C0[13])); \
    GB(o[0] = __builtin_amdgcn_mfma_f32_32x32x16_bf16(PAF(1), VFR(2), o[0], 0, 0, 0), VRD(1, 6), C0[14] = EX(C0[14]), C0[15] = EX(C0[15]), C1[0] = EX(C1[0])); \
    GB(o[1] = __builtin_amdgcn_mfma_f32_32x32x16_bf16(PAF(1), VFR(3), o[1], 0, 0, 0), VRD(2, 3), C1[1] = EX(C1[1]), C1[2] = EX(C1[2]), C1[3] = EX(C1[3])); \
    GB(o[0] = __builtin_amdgcn_mfma_f32_32x32x16_bf16(PAF(2), VFR(0), o[0], 0, 0, 0), VRD(3, 7), C1[4] = EX(C1[4]), C1[5] = EX(C1[5]), C1[6] = EX(C1[6])); \
    GB(o[1] = __builtin_amdgcn_mfma_f32_32x32x16_bf16(PAF(2), VFR(1), o[1], 0, 0, 0), NOP_, C1[7] = EX(C1[7]), C1[8] = EX(C1[8]), C1[9] = EX(C1[9])); \
    GB(o[0] = __builtin_amdgcn_mfma_f32_32x32x16_bf16(PAF(3), VFR(2), o[0], 0, 0, 0), NOP_, C1[10] = EX(C1[10]), C1[11] = EX(C1[11]), C1[12] = EX(C1[12])); \
    GB(o[1] = __builtin_amdgcn_mfma_f32_32x32x16_bf16(PAF(3), VFR(3), o[1], 0, 0, 0), NOP_, C1[13] = EX(C1[13]), C1[14] = EX(C1[14]), C1[15] = EX(C1[15])); \
    PIN(C0); PIN(C1); \
    } while (0)
    const bool cv_on = cj.item0 >= 0;
    int cv_p = 0, cv_j = 0; const float* cv_src = nullptr; unsigned char* cv_dst = nullptr; float cv_sc = 0.f;
    LAS float* const cvf = (LAS float*)(lds + CV_F32 + wid * 4096);
    LAS unsigned* const cv8 = (LAS unsigned*)(lds + CV_F8 + wid * 2176);
    const unsigned cv_loff = (unsigned)(lane >> 3) * 4096u + (unsigned)(lane & 7) * 16u;
#define CV_CONSUME(d0) do { _Pragma("unroll") for (int q_ = 0; q_ < 4; ++q_) { const LAS float* s_ = cvf + q_ * 256 + hi * 128 + r32; \
        cv8[r32 * 17 + 2 * ((d0) + q_) + hi] = pg8::pk4_fp8_nc(cv_sc * s_[0], cv_sc * s_[32], cv_sc * s_[64], cv_sc * s_[96]); } } while (0)
#define CV_ISSUE(d0) do { _Pragma("unroll") for (int q_ = 0; q_ < 4; ++q_) glds16s_nt(cv_src + (size_t)(8 * ((d0) + q_)) * 1024, cv_loff, rfl(lds0 + CV_F32 + wid * 4096 + q_ * 1024)); } while (0)
#define CONV() do { \
    if (cv_p == 0) { const int r_ = cj.item0 + cv_j, e_ = r_ / 1536, q_ = r_ % 1536, wh_ = q_ >> 9, it_ = q_ & 511, k0_ = (it_ >> 5) * 64, n0_ = (it_ & 31) * 32; \
        const unsigned char* ka_ = (const unsigned char*)__builtin_amdgcn_kernarg_segment_ptr();     \
        const float* w_ = *(const float* const*)(ka_ + 8 * (20 + wh_)); unsigned char* ws_ = *(unsigned char* const*)(ka_ + 8 * 24); cv_src = w_ + (size_t)e_ * 1048576 + (size_t)k0_ * 1024 + n0_; \
        if (wh_ < 2) { cv_dst = ws_ + WS_WGU + (size_t)e_ * 2097152 + (size_t)((n0_ >> 7) * 256 + wh_ * 128 + (n0_ & 127)) * 1024 + k0_; cv_sc = 32.0f; } \
        else { cv_dst = ws_ + WS_WD + (size_t)e_ * 1048576 + (size_t)n0_ * 1024 + k0_; cv_sc = 16.0f; } \
        CV_ISSUE(0); } \
    else if (cv_p == 2) { CV_CONSUME(0); CV_ISSUE(4); } \
    else if (cv_p == 4) { CV_CONSUME(4); \
        _Pragma("unroll") for (int r2_ = 0; r2_ < 2; ++r2_) { const int id_ = lane + 64 * r2_, n2_ = id_ >> 2, c_ = id_ & 3; const LAS unsigned* q2_ = cv8 + n2_ * 17 + 4 * c_; \
            v4u w4_; w4_.x = q2_[0]; w4_.y = q2_[1]; w4_.z = q2_[2]; w4_.w = q2_[3]; *(GAS v4u*)(cv_dst + (size_t)n2_ * 1024 + 16 * c_) = w4_; } } \
    } while (0)
    int t = 1;
    for (; t + 3 < NT; t += 2) {
        STEP(pB0, pB1, pA0, pA1, t, true, true, true);      WAITB(3, 2); ROT();
        const int cvk = !cv_on ? 0 : (cv_p == 0 || cv_p == 2) ? 4 : (cv_p == 4) ? 2 : 0;
        if (cvk) { CONV(); }
        STEP(pA0, pA1, pB0, pB1, t + 1, true, true, true);  if (cvk == 4) WAITB(7, 6); else if (cvk == 2) WAITB(5, 4); else WAITB(3, 2); ROT();
        if (cv_on) { if (++cv_p == 10) { cv_p = 0; ++cv_j; } }
    }
#undef CONV
#undef CV_ISSUE
#undef CV_CONSUME
    STEP(pB0, pB1, pA0, pA1, NT - 3, false, true, true);   ATT_WAIT_BAR(1); ROT();
    STEP(pA0, pA1, pB0, pB1, NT - 2, false, true, true);   ATT_WAIT_BAR(1); ROT();
    STEP(pB0, pB1, pA0, pA1, NT - 1, false, false, false); ATT_WAIT_BAR(0); ROT();
    { float sacc = 0.f;
#pragma unroll
      for (int r = 0; r < 16; ++r) sacc += pB0[r] + pB1[r];
      l_reg += sacc;
      const u32x4 w0 = pack_p(pB0, 0), w1 = pack_p(pB0, 8), w2 = pack_p(pB1, 0), w3 = pack_p(pB1, 8);
      pv(o, (int)(lds0 + LV) + ((lane >> 4) & 1) * 32 + (lane & 3) * 8 + (4 * hi + ((lane & 15) >> 2)) * 64 + i_prev * VSLOT,
         __builtin_bit_cast(bf16x8, w0), __builtin_bit_cast(bf16x8, w1), __builtin_bit_cast(bf16x8, w2), __builtin_bit_cast(bf16x8, w3)); }
#undef STEP
#undef NOP_
#undef GB
#undef GA0
#undef GA1
#undef GA2
#undef KN
#undef QK0
#undef QKN
#undef EX
#undef PAF
#undef VFR
#undef VRD
#undef VOFF
#undef PIN
#undef ROT
#undef KLD
#undef WAITB
#undef DMA_K
#undef DMA_V
    float l = l_reg; l += __shfl_xor(l, 32);
    const int le = lane_id();
    const int r32e = le & 31, hie = le >> 5;
    LAS float* wsf = (LAS float*)(lds + LWS) + wid * 64;
    if (hie == 0) wsf[r32e] = l;
    asm volatile("s_waitcnt lgkmcnt(0)" ::: "memory");
    bf16* Ow = (bf16*)sptr(O + (rowb + q0 + 32 * wid) * DM + 512 + VD * h);
    float part[16];
#pragma unroll
    for (int r = 0; r < 16; ++r) { const int q = crow(r, hie); const float il = __builtin_amdgcn_rcpf(wsf[q]); const unsigned off = (unsigned)(q * DM + r32e); const float v0 = o[0][r] * il, v1 = o[1][r] * il;
        part[r] = v0 * v0 + v1 * v1; Ow[off] = (bf16)f2bf(v0); Ow[off + 32] = (bf16)f2bf(v1); }
    ssq_accum(part, le, SSQ + 2 * (rowb + q0 + 32 * wid) + 1);
    asm volatile("s_waitcnt lgkmcnt(0)\n\ts_barrier" ::: "memory");
}

__device__ __forceinline__ void swa_fill_table(LAS unsigned char* lds, int g, const float* TAB, int tid) {
    const float bnd = TAB[TAB_CONST + 0]; LAS float* tb = (LAS float*)(lds + LTAB);
    for (int i = tid; i < 4 * 512; i += NWAVES * 64) { const int hh = i >> 9, idx = (i & 511) - 63; tb[i] = (idx >= 0 && idx <= 2 * WINDOW) ? TAB[TAB_BIAS + (4 * g + hh) * NTAB + idx] - bnd : -1e30f; }
}
__device__ __forceinline__ void swa_unit(LAS unsigned char* lds, int b, int nh, int g, const bf16* QA, const bf16* KA, const bf16* VA, bf16* O, float* SSQ, const float* TAB, const float* sink, int wid, int lane, int tid) {
    const int r32 = lane & 31, hi = lane >> 5, hr = wid >> 1, rh = wid & 1, h = 4 * g + hr;
    const unsigned lds0 = (unsigned)(uintptr_t)lds;
    const size_t rowb = (size_t)b * SEQ;
    const int kt0 = (nh - 2 < 0) ? 0 : nh - 2, kt1 = (nh + 3 > SEQ / 64) ? SEQ / 64 : nh + 3, NT = kt1 - kt0;
    const bf16* ksrc = sptr(KA + (rowb + (size_t)kt0 * 64) * 128 + 64 * g + 8 * wid);
    const bf16* vsrc = sptr(VA + (rowb + (size_t)kt0 * 64 + 16 * (wid & 3)) * 128 + 64 * g + (wid >> 2) * 32);
    const unsigned kl = lane * 256u, vl = (lane >> 2) * 256u + (lane & 3) * 16u;
    constexpr int SK = 0, SV = 73728, SSLOT = 8192;
    const unsigned kdst = lds0 + SK + wid * 1024, vdst = lds0 + SV + wid * 1024;
#define SWA_DMA(t, sl) do { glds16s(ksrc + (size_t)(t) * 64 * 128, kl, rfl(kdst + (sl) * SSLOT)); glds16s(vsrc + (size_t)(t) * 64 * 128, vl, rfl(vdst + (sl) * SSLOT)); } while (0)
    for (int t_ = 0; t_ < NT; ++t_) SWA_DMA(t_, t_);
    const float bnd = TAB[TAB_CONST + 0];
    bf16x8 qf[4];
    { const bf16* qp = QA + (rowb + 64 * nh + 32 * rh + r32) * 512 + HD * h + 8 * hi;
#pragma unroll
      for (int s = 0; s < 4; ++s) qf[s] = *(const bf16x8*)(qp + 16 * s); }
    f32x16 o[2]; o[0] = f32x16{}; o[1] = f32x16{};
    float l = 0.f;
    const LAS unsigned char* kbase = lds + SK + hi * 1024 + r32 * 16;
    const int vb0 = (int)(lds0 + SV) + ((lane >> 4) & 1) * 32 + (lane & 3) * 8 + (4 * hi + ((lane & 15) >> 2)) * 64;
    const LAS float* tbl = (const LAS float*)(lds + LTAB) + hr * 512 + 63 + 4 * hi - 32 * rh - r32 + 64 * (kt0 - (nh - 2));
    for (int t = 0; t < NT; ++t) {
        { const int rem = NT - 1 - t;
          if (rem == 4) ATT_WAIT_BAR(8); else if (rem == 3) ATT_WAIT_BAR(6); else if (rem == 2) ATT_WAIT_BAR(4); else if (rem == 1) ATT_WAIT_BAR(2); else ATT_WAIT_BAR(0); }
        const int sl = t;
        const LAS unsigned char* kp = kbase + sl * SSLOT;
        const LAS float* tt = tbl + 64 * t;
        f32x16 p0, p1;
#pragma unroll
        for (int r = 0; r < 16; ++r) { const int off = (r & 3) + 8 * (r >> 2); p0[r] = tt[off]; p1[r] = tt[off + 32]; }
#pragma unroll
        for (int s = 0; s < 4; ++s) { const bf16x8 a0 = *(const LAS bf16x8*)(kp + s * 2048), a1 = *(const LAS bf16x8*)(kp + s * 2048 + 512);
            p0 = __builtin_amdgcn_mfma_f32_32x32x16_bf16(a0, qf[s], p0, 0, 0, 0); p1 = __builtin_amdgcn_mfma_f32_32x32x16_bf16(a1, qf[s], p1, 0, 0, 0); }
        float sa = 0.f, sb = 0.f;
#pragma unroll
        for (int r = 0; r < 16; ++r) { p0[r] = __builtin_amdgcn_exp2f(p0[r]); p1[r] = __builtin_amdgcn_exp2f(p1[r]); sa += p0[r]; sb += p1[r]; }
        l += sa + sb;
        const u32x4 w0 = pack_p(p0, 0), w1 = pack_p(p0, 8), w2 = pack_p(p1, 0), w3 = pack_p(p1, 8);
        pv(o, vb0 + sl * SSLOT, __builtin_bit_cast(bf16x8, w0), __builtin_bit_cast(bf16x8, w1), __builtin_bit_cast(bf16x8, w2), __builtin_bit_cast(bf16x8, w3));
    }
#undef SWA_DMA
    l += __shfl_xor(l, 32); l += __builtin_amdgcn_exp2f(sink[h] * LOG2E - bnd);
    const int le = lane_id();
    const int r32e = le & 31, hie = le >> 5;
    LAS float* wsf = (LAS float*)(lds + LWS) + wid * 64;
    if (hie == 0) wsf[r32e] = l;
    asm volatile("s_waitcnt lgkmcnt(0)" ::: "memory");
    bf16* Ow = (bf16*)sptr(O + (rowb + 64 * nh + 32 * rh) * DM + HD * h);
    float part[16];
#pragma unroll
    for (int r = 0; r < 16; ++r) { const int q = crow(r, hie); const float il = __builtin_amdgcn_rcpf(wsf[q]); const unsigned off = (unsigned)(q * DM + r32e); const float v0 = o[0][r] * il, v1 = o[1][r] * il;
        part[r] = v0 * v0 + v1 * v1; Ow[off] = (bf16)f2bf(v0); Ow[off + 32] = (bf16)f2bf(v1); }
    ssq_accum(part, le, SSQ + 2 * (rowb + 64 * nh + 32 * rh));
    asm volatile("s_waitcnt lgkmcnt(0)\n\ts_barrier" ::: "memory");
}
__device__ __forceinline__ void swa_unit3(LAS unsigned char* lds, int b, int n128, int g, const bf16* QA, const bf16* KA, const bf16* VA, bf16* O, float* SSQ, const float* TAB, const float* sink, int wid, int lane) {
    const int r32 = lane & 31, hi = lane >> 5, hr = wid >> 1, rh = wid & 1, h = 4 * g + hr;
    const unsigned lds0 = (unsigned)(uintptr_t)lds;
    const size_t rowb = (size_t)b * SEQ;
    const int kta = (2 * n128 - 2 < 0) ? 0 : 2 * n128 - 2, ktb = (2 * n128 + 4 > SEQ / 64) ? SEQ / 64 : 2 * n128 + 4, NTA = ktb - kta;
    const bf16* ksrc = sptr(KA + (rowb + (size_t)kta * 64) * 128 + 64 * g + 8 * wid);
    const bf16* vsrc = sptr(VA + (rowb + (size_t)kta * 64 + 16 * (wid & 3)) * 128 + 64 * g + (wid >> 2) * 32);
    const unsigned kl = lane * 256u, vl = (lane >> 2) * 256u + (lane & 3) * 16u;
    constexpr int SK = 0, SV = 73728, SSLOT = 8192;
    const unsigned kdst = lds0 + SK + wid * 1024, vdst = lds0 + SV + wid * 1024;
#define DMA_K(t, sl) glds16s(ksrc + (size_t)(t) * 64 * 128, kl, rfl(kdst + (sl) * SSLOT))
#define DMA_V(t, sl) glds16s(vsrc + (size_t)(t) * 64 * 128, vl, rfl(vdst + (sl) * SSLOT))
    for (int t_ = 0; t_ < NTA; ++t_) DMA_K(t_, t_);
    for (int t_ = 0; t_ < NTA; ++t_) DMA_V(t_, t_);
    const float bnd = TAB[TAB_CONST + 0];
    for (int sub = 0; sub < 2; ++sub) {
    const int nh = 2 * n128 + sub; const int kt0 = (nh - 2 < 0) ? 0 : nh - 2, kt1 = (nh + 3 > SEQ / 64) ? SEQ / 64 : nh + 3, NT = kt1 - kt0, s0 = kt0 - kta;
    bf16x8 qf[4];
    { const bf16* qp = QA + (rowb + 64 * nh + 32 * rh + r32) * 512 + HD * h + 8 * hi;
#pragma unroll
      for (int s = 0; s < 4; ++s) qf[s] = *(const bf16x8*)(qp + 16 * s); }
    f32x16 o[2]; o[0] = f32x16{}; o[1] = f32x16{};
    float l_reg = 0.f;
    const lds_cptr kp0 = (lds_cptr)lds + SK + s0 * SSLOT + hi * 1024 + r32 * 16;
    const lds_cptr vp0 = (lds_cptr)lds + SV + s0 * SSLOT + ((lane >> 4) & 1) * 32 + (lane & 3) * 8 + (4 * hi + ((lane & 15) >> 2)) * 64;
    const LAS float* tbl = (const LAS float*)(lds + LTAB) + hr * 512 + 63 + 4 * hi - 32 * rh - r32 + 64 * (kt0 - (nh - 2));
    bf16x8 kf[8];
#define KLD(kp, i) kf[i] = *(const __attribute__((address_space(3))) bf16x8*)((kp) + ((i) >> 1) * 2048 + ((i) & 1) * 512)
#define BIAS(C0, C1, tt_) do { _Pragma("unroll") for (int r_ = 0; r_ < 16; ++r_) { C0[r_] = (tt_)[(r_ & 3) + 8 * (r_ >> 2)]; C1[r_] = (tt_)[(r_ & 3) + 8 * (r_ >> 2) + 32]; } } while (0)
    if (sub == 0) { if (NTA == 6) ATT_WAIT_BAR(11); else ATT_WAIT_BAR(7); }
#pragma unroll
    for (int i = 0; i < 8; ++i) KLD(kp0, i);
    f32x16 pA0, pA1, pB0, pB1;
    BIAS(pA0, pA1, tbl);
#pragma unroll
    for (int s = 0; s < 4; ++s) { pA0 = __builtin_amdgcn_mfma_f32_32x32x16_bf16(kf[2 * s], qf[s], pA0, 0, 0, 0); pA1 = __builtin_amdgcn_mfma_f32_32x32x16_bf16(kf[2 * s + 1], qf[s], pA1, 0, 0, 0); }
#pragma unroll
    for (int r = 0; r < 16; ++r) { pA0[r] = __builtin_amdgcn_exp2f(pA0[r]); pA1[r] = __builtin_amdgcn_exp2f(pA1[r]); }
    BIAS(pB0, pB1, tbl + 64);
    if (sub == 0) ATT_WAIT_BAR(0);
#pragma unroll
    for (int i = 0; i < 8; ++i) KLD(kp0 + SSLOT, i);
    s16x4 vl0, vh0, vl1, vh1, vl2, vh2, vl3, vh3; u32x4 pw0, pw1, pw2, pw3;
#define ROT() do { } while (0)
#define PIN(x) asm volatile("" : "+v"(x))
#define VOFF(i) (((i) >> 2) * 4096 + ((i) & 3) * 1024)
#define VRD(B, i) do { vl##B = vtr(vp_ + VOFF(i)); vh##B = vtr(vp_ + VOFF(i) + 512); } while (0)
#define VFR(B) (bf16x8){vl##B[0], vl##B[1], vl##B[2], vl##B[3], vh##B[0], vh##B[1], vh##B[2], vh##B[3]}
#define PAF(k) __builtin_bit_cast(bf16x8, pw##k)
#define EX(v) __builtin_amdgcn_exp2f(v)
#define QKN(C, i, s) C = __builtin_amdgcn_mfma_f32_32x32x16_bf16(kf[i], qf[s], C, 0, 0, 0)
#define KN(i) do { if (gl_) { KLD(kn_, i); } } while (0)
#define GA(MF, KI, P, B, PW, W, X0, X1) do { MF; KN(KI); sacc += P[B]; sacc += P[B + 1]; sacc += P[B + 2]; sacc += P[B + 3]; PIN(sacc); PW[W] = cvtpk(P[B], P[B + 1]); PW[W + 1] = cvtpk(P[B + 2], P[B + 3]); PIN(PW); X0; X1; ATT_SBAR(); } while (0)
#define GB(MF, RD, E0, E1, E2, E3, NB) do { MF; RD; E0; E1; E2; E3; NB; ATT_SBAR(); } while (0)
#define NOP_ (void)0
#define NBIAS(P0, P1, q) do { if (gl_) { P0[2 * (q)] = tn_[((2 * (q)) & 3) + 8 * ((2 * (q)) >> 2)]; P0[2 * (q) + 1] = tn_[((2 * (q) + 1) & 3) + 8 * ((2 * (q) + 1) >> 2)]; \
        P1[2 * (q)] = tn_[((2 * (q)) & 3) + 8 * ((2 * (q)) >> 2) + 32]; P1[2 * (q) + 1] = tn_[((2 * (q) + 1) & 3) + 8 * ((2 * (q) + 1) >> 2) + 32]; } } while (0)
#define STEP(C0, C1, P0, P1, t) do { ATT_SBAR(); \
    const bool gl_ = (t) + 1 < NT; \
    const lds_cptr vp_ = vp0 + ((t) - 1) * SSLOT; const lds_cptr kn_ = kp0 + ((t) + 1) * SSLOT; const LAS float* tn_ = tbl + 64 * ((t) + 1); \
    float sacc = 0.f; \
    GA(QKN(C0, 0, 0), 0, P0, 0, pw0, 0, NOP_, NOP_); \
    GA(QKN(C0, 2, 1), 2, P0, 4, pw0, 2, NOP_, NOP_); \
    GA(QKN(C0, 4, 2), 4, P0, 8, pw1, 0, NOP_, NOP_); \
    GA(QKN(C0, 6, 3), 6, P0, 12, pw1, 2, NOP_, NOP_); \
    GA(QKN(C1, 1, 0), 1, P1, 0, pw2, 0, NOP_, NOP_); \
    GA(QKN(C1, 3, 1), 3, P1, 4, pw2, 2, NOP_, VRD(0, 0)); \
    GA(QKN(C1, 5, 2), 5, P1, 8, pw3, 0, C0[0] = EX(C0[0]), VRD(1, 4)); \
    GA(QKN(C1, 7, 3), 7, P1, 12, pw3, 2, C0[1] = EX(C0[1]), VRD(2, 1)); \
    l_reg += sacc; C0[2] = EX(C0[2]); C0[3] = EX(C0[3]); PIN(C0); ATT_SBAR(); \
    GB(o[0] = __builtin_amdgcn_mfma_f32_32x32x16_bf16(PAF(0), VFR(0), o[0], 0, 0, 0), VRD(3, 5), C0[4] = EX(C0[4]), C0[5] = EX(C0[5]), C0[6] = EX(C0[6]), C0[7] = EX(C0[7]), NBIAS(P0, P1, 0)); \
    GB(o[1] = __builtin_amdgcn_mfma_f32_32x32x16_bf16(PAF(0), VFR(1), o[1], 0, 0, 0), VRD(0, 2), C0[8] = EX(C0[8]), C0[9] = EX(C0[9]), C0[10] = EX(C0[10]), C0[11] = EX(C0[11]), NBIAS(P0, P1, 1)); \
    GB(o[0] = __builtin_amdgcn_mfma_f32_32x32x16_bf16(PAF(1), VFR(2), o[0], 0, 0, 0), VRD(1, 6), C0[12] = EX(C0[12]), C0[13] = EX(C0[13]), C0[14] = EX(C0[14]), C0[15] = EX(C0[15]), NBIAS(P0, P1, 2)); \
    GB(o[1] = __builtin_amdgcn_mfma_f32_32x32x16_bf16(PAF(1), VFR(3), o[1], 0, 0, 0), VRD(2, 3), C1[0] = EX(C1[0]), C1[1] = EX(C1[1]), C1[2] = EX(C1[2]), C1[3] = EX(C1[3]), NBIAS(P0, P1, 3)); \
    GB(o[0] = __builtin_amdgcn_mfma_f32_32x32x16_bf16(PAF(2), VFR(0), o[0], 0, 0, 0), VRD(3, 7), C1[4] = EX(C1[4]), C1[5] = EX(C1[5]), C1[6] = EX(C1[6]), C1[7] = EX(C1[7]), NBIAS(P0, P1, 4)); \
    GB(o[1] = __builtin_amdgcn_mfma_f32_32x32x16_bf16(PAF(2), VFR(1), o[1], 0, 0, 0), NOP_, C1[8] = EX(C1[8]), C1[9] = EX(C1[9]), C1[10] = EX(C1[10]), C1[11] = EX(C1[11]), NBIAS(P0, P1, 5)); \
    GB(o[0] = __builtin_amdgcn_mfma_f32_32x32x16_bf16(PAF(3), VFR(2), o[0], 0, 0, 0), NOP_, C1[12] = EX(C1[12]), C1[13] = EX(C1[13]), NOP_, NOP_, NBIAS(P0, P1, 6)); \
    GB(o[1] = __builtin_amdgcn_mfma_f32_32x32x16_bf16(PAF(3), VFR(3), o[1], 0, 0, 0), NOP_, C1[14] = EX(C1[14]), C1[15] = EX(C1[15]), NOP_, NOP_, NBIAS(P0, P1, 7)); \
    PIN(C0); PIN(C1); \
    } while (0)
#define DRAIN(P0, P1) do { float sacc = 0.f; _Pragma("unroll") for (int r_ = 0; r_ < 16; ++r_) sacc += P0[r_] + P1[r_]; l_reg += sacc; \
      const u32x4 w0 = pack_p(P0, 0), w1 = pack_p(P0, 8), w2 = pack_p(P1, 0), w3 = pack_p(P1, 8); \
      pv(o, (int)(lds0 + SV) + ((lane >> 4) & 1) * 32 + (lane & 3) * 8 + (4 * hi + ((lane & 15) >> 2)) * 64 + (s0 + NT - 1) * SSLOT, \
         __builtin_bit_cast(bf16x8, w0), __builtin_bit_cast(bf16x8, w1), __builtin_bit_cast(bf16x8, w2), __builtin_bit_cast(bf16x8, w3)); } while (0)
    STEP(pB0, pB1, pA0, pA1, 1);
    STEP(pA0, pA1, pB0, pB1, 2);
    if (NT > 3) { STEP(pB0, pB1, pA0, pA1, 3);
        if (NT > 4) { STEP(pA0, pA1, pB0, pB1, 4); DRAIN(pA0, pA1); } else { DRAIN(pB0, pB1); } }
    else { DRAIN(pA0, pA1); }
#undef DRAIN
#undef STEP
#undef NBIAS
#undef NOP_
#undef GB
#undef GA
#undef KN
#undef QKN
#undef EX
#undef PAF
#undef VFR
#undef VRD
#undef VOFF
#undef PIN
#undef ROT
#undef BIAS
#undef KLD
#undef DMA_K
#undef DMA_V
    float l = l_reg; l += __shfl_xor(l, 32); l += __builtin_amdgcn_exp2f(sink[h] * LOG2E - bnd);
    const int le = lane_id();
    const int r32e = le & 31, hie = le >> 5;
    LAS float* wsf = (LAS float*)(lds + LWS) + wid * 64;
    if (hie == 0) wsf[r32e] = l;
    asm volatile("s_waitcnt lgkmcnt(0)" ::: "memory");
    bf16* Ow = (bf16*)sptr(O + (rowb + 64 * nh + 32 * rh) * DM + HD * h);
    float part[16];
#pragma unroll
    for (int r = 0; r < 16; ++r) { const int q = crow(r, hie); const float il = __builtin_amdgcn_rcpf(wsf[q]); const unsigned off = (unsigned)(q * DM + r32e); const float v0 = o[0][r] * il, v1 = o[1][r] * il;
        part[r] = v0 * v0 + v1 * v1; Ow[off] = (bf16)f2bf(v0); Ow[off + 32] = (bf16)f2bf(v1); }
    ssq_accum(part, le, SSQ + 2 * (rowb + 64 * nh + 32 * rh));
    }
    asm volatile("s_waitcnt lgkmcnt(0)\n\ts_barrier" ::: "memory");
}

#undef ATT_SBAR
#undef ATT_WAIT_BAR
}

__device__ __forceinline__ void p5_attention(Frame& F, bool probe_dup = false) {
    const int lane_ = lane_id();
    const bf16* QB = WSP(bf16, WS_QB); const bf16* KBN = WSP(bf16, WS_KBN); const bf16* KR = WSP(bf16, WS_KR); const bf16* VB = WSP(bf16, WS_VB);
    const bf16* QA = WSP(bf16, WS_QA); const bf16* KA = WSP(bf16, WS_KA); const bf16* VA = WSP(bf16, WS_VA); bf16* O = WSP(bf16, WS_O);
    const float* TAB = WSP(float, WS_TAB); float* SSQ = probe_dup ? WSP(float, WS_KVRAW) : WSP(float, WS_SSQ);
    constexpr int NU_B = BATCH * BH * (SEQ / 256), NU_A = BATCH * (SEQ / 64) * A_KV;
#ifndef NO_MLA
    { const float bndB = __uint_as_float((unsigned)__builtin_amdgcn_readfirstlane((int)__float_as_uint(TAB[TAB_CONST + 1])));
      const bool shift = bndB > 64.0f; const float nb = shift ? -bndB : 0.f;
      for (int i = 0; i < (NU_B + F.G - 1) / F.G; ++i) {
        const int u = (F.G == 256) ? (F.vcu >> 2) * 16 + (F.vcu & 3) * 4 + i : i * F.G + F.vcu;
        if (u >= NU_B) break;
        const att::ConvJob cj{(F.G == 256 && !probe_dup) ? ((F.vcu * 4 + i) * NWAVES + F.wave) * 3 : -1};
        att::mla_unit2(F.lds + RING_OFF, (u >> 4) / BH, (u >> 4) % BH, u & 15, QB, KBN, KR, VB, O, SSQ, shift, nb, cj, F.wave, lane_);
      } }
#endif
#ifndef NO_SWA
    { const int lane2 = lane_id();
      int gcur = -1;
      for (int u = F.vcu; u < NU_A / 2; u += F.G) { if ((u & 1) != gcur) { gcur = u & 1; asm volatile("s_waitcnt lgkmcnt(0)\n\ts_barrier" ::: "memory"); att::swa_fill_table(F.lds + RING_OFF, gcur, TAB, F.wave * 64 + lane2); }
        att::swa_unit3(F.lds + RING_OFF, u >> 6, (u >> 1) & 31, u & 1, QA, KA, VA, O, SSQ, TAB, F.in[6], F.wave, lane2); } }
#endif
}

struct Args { const float* in[23]; float* out; unsigned char* ws; int ph_lo, ph_hi, li, pad; };
constexpr int N_PHASES = 13;
__global__ void __launch_bounds__(NWAVES * 64, 2) skel_fwd(Args args) {
    extern __shared__ __attribute__((aligned(16))) unsigned char lds[];
    Frame F;
    F.lds = (LAS unsigned char*)lds;
    F.MISC = (volatile LAS unsigned*)(F.lds + MISC_OFF);
    F.wave = __builtin_amdgcn_readfirstlane((int)(threadIdx.x >> 6));
    F.G = gridDim.x; { const int bx = blockIdx.x; F.vcu = (F.G % 8 == 0) ? (bx % 8) * (F.G / 8) + bx / 8 : bx; }
    F.ws = args.ws; F.out = args.out;
#pragma unroll
    for (int i = 0; i < 23; ++i) F.in[i] = args.in[i];
    F.ctl = (gu32*)(F.ws + WS_CTL);
    for (int u = threadIdx.x; u < (LDS_BYTES - LDSCTL_OFF) / 4; u += NWAVES * 64) ((LAS unsigned*)(F.lds + LDSCTL_OFF))[u] = 0u;
    __syncthreads();
    XcdBarrier bar = xcd_barrier_post((unsigned*)(F.ctl + CW_BAR) + args.li * XCD_BAR_WORDS, F.MISC + 8);
    const int lo = args.ph_lo, hi = args.ph_hi;
#define IN(k) (lo <= (k) && (k) < hi)
#define SEAM(k) do { if (IN(k) && IN((k) + 1)) xcd_barrier(bar); } while (0)

#define PH(k, ...) do { if (IN(k)) { __VA_ARGS__; if ((PROBE_MASK >> (k)) & 1) { xcd_barrier(bar); __VA_ARGS__; } } SEAM(k); } while (0)
    PH(0, p0_prologue(F));
    PH(1, {
        pg8::Gemm g{WSP(bf16, WS_XN), WSP(bf16, WS_WIN), T, NZ, DM, 0, nullptr, nullptr, 0, 0, 0, F.wave}; pg8::StaticOrder S; S.init(T, NZ, F.G, (int)blockIdx.x);
        pg8::EpiInProj E{F.ws, F.in[4], F.in[5], F.in[14]};
        pg8::gemm_phase<pg8::EpiInProj, pg8::StaticOrder, true, true>(F.lds + RING_OFF, g, S, E); });
    PH(3, {
        { pg8::Gemm g{WSP(bf16, WS_CQ), WSP(bf16, WS_WQB), T, BH * QKD, QL, 0, nullptr, nullptr, 0, 0, 0, F.wave}; pg8::StaticOrder S; S.init(T, BH * QKD, F.G, (int)blockIdx.x);
          pg8::EpiQB E{F.ws, F.in[11], F.in[12]};
          pg8::gemm_phase<pg8::EpiQB, pg8::StaticOrder, true, true>(F.lds + RING_OFF, g, S, E); }
        __syncthreads();
        { pg8::Gemm g{WSP(bf16, WS_CKV), WSP(bf16, WS_WKVB), T, BH * 128, KVL, 0, nullptr, nullptr, 0, 0, 0, F.wave}; pg8::StaticOrder S; S.init(T, BH * 128, F.G, (int)(F.G - 1 - blockIdx.x));
          pg8::EpiKVB E{F.ws, F.in[13]};
          pg8::gemm_phase<pg8::EpiKVB, pg8::StaticOrder, true, true>(F.lds + RING_OFF, g, S, E); } });
#if !NAIVE_ATTN
    PH(5, p5_attention(F));
#if PROBE_ATT
    xcd_barrier(bar); p5_attention(F, true); xcd_barrier(bar);
#endif
#endif
    PH(7, {
        pg8::Gemm g{WSP(bf16, WS_O), WSP(bf16, WS_WO), T, DM, DM, 0, nullptr, WSP(float, WS_SSQ), 0, 0, 0, F.wave}; pg8::StaticOrder S; S.init(T, DM, F.G, (int)blockIdx.x);
        pg8::EpiNormBf16 E{WSP(bf16, WS_ATT), DM, WSP(float, WS_SSQ)};
        pg8::gemm_phase<pg8::EpiNormBf16, pg8::StaticOrder, true, true, 2>(F.lds + RING_OFF, g, S, E); });
    PH(8, p8_router(F));
    PH(9, p9_topk(F));
    PH(11, {
        pg8::Gemm g{WSP(bf16, WS_H2), WSP(bf16, WS_WGU), MX, 2 * FF, DM / 2, (size_t)2 * FF * DM, WSP(int, WS_IDX), nullptr, 0x7a7a7a7a, 0x7a7a7a7a, (unsigned)(LDSCTL_OFF + 1024 - RING_OFF), F.wave}; pg8::StaticOrder S; S.init(MX, 2 * FF, F.G, (int)blockIdx.x, 16);
        pg8::EpiSwiGLU8 E{WSP(unsigned char, WS_ACT), FF, 16.0f};
        pg8::gemm_phase<pg8::EpiSwiGLU8, pg8::StaticOrder, true, true, 1, true>(F.lds + RING_OFF, g, S, E); });
    PH(12, {
        pg8::Gemm g{WSP(bf16, WS_ACT), WSP(bf16, WS_WD), MX, DM, FF / 2, (size_t)DM * FF, nullptr, nullptr, 0x7b7b7b7b, 0x7b7b7b7b, 0, F.wave}; pg8::StaticOrder S; S.init(MX, DM, F.G, (int)blockIdx.x, 16);
        pg8::EpiRowScaleF8 E{WSP(unsigned char, WS_YE), DM, WSP(float, WS_GATEV), 64.0f};
        pg8::gemm_phase<pg8::EpiRowScaleF8, pg8::StaticOrder, true, true, 0, true>(F.lds + RING_OFF, g, S, E); });
    PH(13, p12_combine(F));
#undef PH
#undef IN
#undef SEAM
}

#if NAIVE_ATTN
__device__ __forceinline__ float bf2f(bf16 v) { return __uint_as_float((unsigned)v << 16); }
__global__ void __launch_bounds__(256) naive_attn_a(const bf16* __restrict__ QA, const bf16* __restrict__ KA, const bf16* __restrict__ VA, const float* __restrict__ TAB, const float* __restrict__ sink, bf16* __restrict__ O) {
    const int s = (blockIdx.x % (SEQ / 256)) * 256 + threadIdx.x, bh = blockIdx.x / (SEQ / 256), h = bh % A_HEADS, b = bh / A_HEADS, g = h / (A_HEADS / A_KV);
    const size_t m = (size_t)b * SEQ + s;
    float q[HD], o[HD];
#pragma unroll
    for (int d = 0; d < HD; ++d) { q[d] = bf2f(QA[m * 512 + h * HD + d]); o[d] = 0.f; }
    const float bnd = TAB[TAB_CONST + 0];
    float l = exp2f(sink[h] * LOG2E - bnd);
    for (int rel = -WINDOW; rel <= WINDOW; ++rel) { const int j = s + rel; if (j < 0 || j >= SEQ) continue;
        const bf16* kr = KA + ((size_t)b * SEQ + j) * 128 + g * HD; const bf16* vr = VA + ((size_t)b * SEQ + j) * 128 + g * HD;
        float sc = 0.f;
#pragma unroll
        for (int d = 0; d < HD; ++d) sc += q[d] * bf2f(kr[d]);
        const float p = exp2f(sc + TAB[TAB_BIAS + h * NTAB + rel + 128] - bnd); l += p;
#pragma unroll
        for (int d = 0; d < HD; ++d) o[d] += p * bf2f(vr[d]); }
    const float il = 1.0f / l;
#pragma unroll
    for (int d = 0; d < HD; ++d) O[m * DM + h * HD + d] = (bf16)f2bf(o[d] * il);
}
__global__ void __launch_bounds__(256) naive_attn_b(const bf16* __restrict__ QB, const bf16* __restrict__ KBN, const bf16* __restrict__ KR, const bf16* __restrict__ VB, const float* __restrict__ TAB, bf16* __restrict__ O) {
    const int s = (blockIdx.x % (SEQ / 256)) * 256 + threadIdx.x, bh = blockIdx.x / (SEQ / 256), h = bh % BH, b = bh / BH;
    const size_t m = (size_t)b * SEQ + s;
    float q[QKD], o[VD];
#pragma unroll
    for (int d = 0; d < QKD; ++d) q[d] = bf2f(QB[m * (BH * QKD) + h * QKD + d]);
#pragma unroll
    for (int d = 0; d < VD; ++d) o[d] = 0.f;
    const float bnd = TAB[TAB_CONST + 1];
    float l = 0.f;
    for (int j = 0; j < SEQ; ++j) { const size_t mj = (size_t)b * SEQ + j;
        const bf16* kn = KBN + mj * 512 + h * NOPE; const bf16* kr = KR + mj * ROPE; const bf16* vr = VB + mj * 512 + h * VD;
        float sc = 0.f;
#pragma unroll
        for (int d = 0; d < NOPE; ++d) sc += q[d] * bf2f(kn[d]);
#pragma unroll
        for (int d = 0; d < ROPE; ++d) sc += q[NOPE + d] * bf2f(kr[d]);
        const float p = exp2f(sc - bnd); l += p;
#pragma unroll
        for (int d = 0; d < VD; ++d) o[d] += p * bf2f(vr[d]); }
    const float il = 1.0f / l;
#pragma unroll
    for (int d = 0; d < VD; ++d) O[m * DM + 512 + h * VD + d] = (bf16)f2bf(o[d] * il);
}

#endif
extern "C" void kernel_launch(void* const* d_in, const int* in_sizes, int n_in, void* d_out, int out_size, void* d_ws, size_t ws_size, hipStream_t stream) {
    static int grid = 0;
    if (grid == 0) {
        if (n_in != 23 || in_sizes[0] != T * DM || out_size != T * DM || ws_size < WS_END) { fprintf(stderr, "kernel_launch: unexpected shapes (n_in %d, in0 %d, out %d, ws %zu)\n", n_in, n_in > 0 ? in_sizes[0] : -1, out_size, ws_size); grid = -1; return; }
        int dev = 0, cus = 0, per_cu = 0;
        if (hipGetDevice(&dev) != hipSuccess || hipDeviceGetAttribute(&cus, hipDeviceAttributeMultiprocessorCount, dev) != hipSuccess) { grid = -1; return; }
        if (hipFuncSetAttribute((const void*)skel_fwd, hipFuncAttributeMaxDynamicSharedMemorySize, LDS_BYTES) != hipSuccess) { fprintf(stderr, "kernel_launch: hipFuncSetAttribute failed\n"); grid = -1; return; }
        if (hipOccupancyMaxActiveBlocksPerMultiprocessor(&per_cu, (const void*)skel_fwd, NWAVES * 64, LDS_BYTES) != hipSuccess || per_cu < 1) fprintf(stderr, "kernel_launch: occupancy query says %d\n", per_cu);
        (void)hipGetLastError();
        grid = cus;
    }
    if (grid < 0) return;
    if (hipMemsetAsync((char*)d_ws + WS_CTL, 0, CTL_ZERO_BYTES, stream) != hipSuccess) return;
    Args a{};
    for (int i = 0; i < 23; ++i) a.in[i] = (const float*)d_in[i];
    a.out = (float*)d_out; a.ws = (unsigned char*)d_ws;
    unsigned char* ws = (unsigned char*)d_ws;
#if NAIVE_ATTN
    a.ph_lo = 0; a.ph_hi = 5; a.li = 0;
    hipLaunchKernelGGL(skel_fwd, dim3(grid), dim3(NWAVES * 64), LDS_BYTES, stream, a);
    hipLaunchKernelGGL(naive_attn_a, dim3(BATCH * A_HEADS * (SEQ / 256)), dim3(256), 0, stream, (const bf16*)(ws + WS_QA), (const bf16*)(ws + WS_KA), (const bf16*)(ws + WS_VA), (const float*)(ws + WS_TAB), (const float*)d_in[6], (bf16*)(ws + WS_O));
    hipLaunchKernelGGL(naive_attn_b, dim3(BATCH * BH * (SEQ / 256)), dim3(256), 0, stream, (const bf16*)(ws + WS_QB), (const bf16*)(ws + WS_KBN), (const bf16*)(ws + WS_KR), (const bf16*)(ws + WS_VB), (const float*)(ws + WS_TAB), (bf16*)(ws + WS_O));
    a.ph_lo = 6; a.ph_hi = 14; a.li = 1;
    hipLaunchKernelGGL(skel_fwd, dim3(grid), dim3(NWAVES * 64), LDS_BYTES, stream, a);
#else
    a.ph_lo = 0; a.ph_hi = 14; a.li = 0;
    hipLaunchKernelGGL(skel_fwd, dim3(grid), dim3(NWAVES * 64), LDS_BYTES, stream, a);
#endif
}
```

```cpp
#include <hip/hip_runtime.h>
#include <hip/hip_bf16.h>
#include <cstdio>
#include <cstdint>
#ifndef PROBE_ATT
#define PROBE_ATT 0
#endif
#ifndef PROBE_MASK
#define PROBE_MASK 0
#endif
#ifndef NAIVE_ATTN
#define NAIVE_ATTN 0
#endif
__device__ __forceinline__ int lane_id() { int l; asm volatile("v_mbcnt_lo_u32_b32 %0, -1, 0\n\tv_mbcnt_hi_u32_b32 %0, -1, %0" : "=v"(l)); return l; }

constexpr int NWAVES = 8;
constexpr int BATCH = 8, SEQ = 4096, DM = 1024, T = BATCH * SEQ;
constexpr int INW = 1440, NZ = 1536;
constexpr int A_HEADS = 8, A_KV = 2, HD = 64, WINDOW = 128;
constexpr int BH = 8, QL = 384, KVL = 256, NOPE = 64, ROPE = 32, VD = 64, QKD = NOPE + ROPE;
constexpr int NE = 16, FF = 1024, CAP = 512, MX = NE * BATCH * CAP;
constexpr float EPS = 1e-6f, LOG2E = 1.4426950408889634f;
constexpr float QSC_A = 0.125f * LOG2E;
constexpr float QSC_B = 0.10206207261596577f * LOG2E;
constexpr int NTAB = 257;

constexpr size_t MiB = 1u << 20;
constexpr size_t WS_CTL = 0, CTL_ZERO_BYTES = 1 * MiB;
constexpr size_t WS_SSQ = 512 * 1024;
constexpr size_t WS_SSQCQ = 768 * 1024, WS_SSQCKV = 896 * 1024;
constexpr size_t WS_TAB = 1 * MiB;
constexpr size_t WS_WIN = 4 * MiB, WS_WQB = 7 * MiB, WS_WKVB = 8 * MiB, WS_WO = 9 * MiB, WS_WGU = 12 * MiB, WS_WD = 76 * MiB;
constexpr size_t WS_AFF = 108 * MiB, WS_IDX = 110 * MiB, WS_GATEV = WS_IDX + 512 * 1024, WS_SLOT = 111 * MiB;
constexpr size_t WS_XN = 114 * MiB;
constexpr size_t WS_Z = 178 * MiB;
constexpr size_t WS_QA = 274 * MiB, WS_KA = 306 * MiB, WS_VA = 314 * MiB, WS_CQ = 322 * MiB, WS_CKV = 346 * MiB, WS_KR = 362 * MiB;
constexpr size_t WS_KVRAW = 364 * MiB, WS_KBN = 428 * MiB, WS_VB = 460 * MiB, WS_END = 492 * MiB;
constexpr size_t WS_ATT = 242 * MiB;
constexpr size_t WS_QN8 = 242 * MiB;
constexpr size_t WS_X1B = 370 * MiB;
constexpr size_t WS_QB = WS_Z, WS_O = WS_XN, WS_H2 = WS_XN, WS_XE = WS_Z, WS_ACT = 306 * MiB, WS_YE = WS_Z;
constexpr int TAB_BIAS = 0, TAB_CONST = 8 * NTAB + 8, TAB_COS = TAB_CONST + 16, TAB_SIN = TAB_COS + SEQ * 16;
constexpr int CW_TMO = 0, CW_BAR = 4096;

constexpr int RING_OFF = 0, RING_BYTES = 131072;
constexpr int LDSCTL_OFF = RING_BYTES, MISC_OFF = LDSCTL_OFF + 320;
constexpr int LDS_BYTES = 147456;
namespace pg8 {
#define PG8_LAS __attribute__((address_space(3)))
typedef unsigned short bf16_t;
typedef short bf16x8 __attribute__((ext_vector_type(8)));
typedef float f32x4 __attribute__((ext_vector_type(4)));
typedef unsigned u32x4 __attribute__((ext_vector_type(4)));
constexpr int BM = 256, BK = 64, HALF = 128, HTB = HALF * BK * 2  , STAGE_BYTES = 8 * HTB, NXCD = 8, WGM = 8;

__host__ __device__ __forceinline__ int lds_byte(int r, int c) { const int st = (r >> 4) * 2 + (c >> 5), rr = r & 15, cc = c & 31, ob = rr * 64 + cc * 2; return st * 1024 + (ob ^ (((ob >> 9) & 1) << 5)); }
__host__ __device__ __forceinline__ void stage_rc(int b, int& R, int& C) { const int st = b / 1024, sb = b % 1024, swz = sb ^ (((sb >> 9) & 1) << 5); R = (st >> 1) * 16 + swz / 64; C = (st & 1) * 32 + (swz % 64) / 2; }
__host__ __device__ __forceinline__ int gray4(int q) { return q ^ (q >> 1); }
__host__ __device__ __forceinline__ int lds_byte8(int r, int cbyte) { const int st = (r >> 4) * 2 + (cbyte >> 6), rr = r & 15; return st * 1024 + rr * 64 + ((((cbyte >> 4) & 3) ^ gray4((rr >> 2) & 3)) << 4) + (cbyte & 15); }
__host__ __device__ __forceinline__ void stage_rc8(int b, int& R, int& C) { const int st = b / 1024, sb = b % 1024, rr = sb / 64, ch = ((sb % 64) / 16) ^ gray4((rr >> 2) & 3); R = (st >> 1) * 16 + rr; C = (st & 1) * 32 + ch * 8; }
__host__ __device__ __forceinline__ int perm32(int rho) { const int n = rho >> 4, i = rho & 15; return 8 * (i >> 2) + 4 * n + (i & 3); }

struct Unit { int pm, pn, e; };
struct Gemm { const bf16_t* A; const bf16_t* Bt; int M, N, K; size_t estride; const int* idx; const float* ssq; int sA, sB; unsigned gtab; int wave; };

struct StaticOrder {
    int nM, nN, nwg, G, c, epan;
    __host__ __device__ void init(int M, int N, int G_, int c_, int epan_ = 0) { nM = M / BM; nN = N / BM; nwg = nM * nN; G = G_; c = c_; epan = epan_; }
    __host__ __device__ bool next(int i, Unit& u) const {
        const long L = (long)i * G + c; if (L >= nwg) return false;
        int wgid = (int)L; { const int q = nwg / NXCD, r = nwg % NXCD, xcd = wgid % NXCD, off = wgid / NXCD; wgid = (xcd < r ? xcd * (q + 1) : r * (q + 1) + (xcd - r) * q) + off; }
        const int nig = WGM * nN, gid = wgid / nig, fm = gid * WGM, gsz = (nM - fm) < WGM ? (nM - fm) : WGM;
        u.pm = fm + ((wgid % nig) % gsz); u.pn = (wgid % nig) / gsz; u.e = epan ? u.pm / epan : 0; return true;
    }
    __device__ __forceinline__ void a_ready(const Unit&) const {}
    __device__ __forceinline__ void done(const Unit&) const {}
};

__device__ __forceinline__ unsigned cvt_pk_bf16(float lo, float hi) { unsigned r; asm volatile("v_cvt_pk_bf16_f32 %0, %1, %2" : "=v"(r) : "v"(lo), "v"(hi)); return r; }
typedef float f32x2 __attribute__((ext_vector_type(2)));
__device__ __forceinline__ f32x2 gelu_pk(f32x2 v) {
    const f32x2 av = __builtin_elementwise_abs(v), d = av * 0.2316418882f + 1.0f;
    f32x2 t; t.x = __builtin_amdgcn_rcpf(d.x); t.y = __builtin_amdgcn_rcpf(d.y);
    f32x2 q = t * 0.5307027145f + (-0.7265760135f); q = q * t + 0.7107068705f; q = q * t + (-0.142248368f); q = q * t + 0.127414796f; q = q * t;
    const f32x2 s = (v * v) * (-0.72134752044f);
    f32x2 e; e.x = __builtin_amdgcn_exp2f(s.x); e.y = __builtin_amdgcn_exp2f(s.y);
    const f32x2 m = v * (q * e), r = v - m;
    f32x2 o; o.x = v.x < 0.f ? m.x : r.x; o.y = v.y < 0.f ? m.y : r.y; return o;
}

template <int ACT  > struct EpiBf16 {
    static constexpr bool PERM = true, AFTER_DRAIN = false; static_assert(ACT == 0 || ACT == 1, "EpiBf16: ACT is 0 (none) or 1 (gelu_pk)");
    bf16_t* O; int ldc; const float* bias; int split_cols; size_t split_stride; float scale0;
    __device__ __forceinline__ void operator()(const f32x4 (&acc)[2][2][4][2], const Unit& u, int wr, int wc, int fr, int fq) const {
        const int row0 = u.pm * BM + wr * 64 + fr; int colt = u.pn * BM; bf16_t* base = O;
        float sc = 1.f; if (split_cols) { const int t = colt / split_cols; base += (size_t)t * split_stride; colt -= t * split_cols; if (t == 0) sc = scale0; }
        const int col0 = colt + wc * 32 + 8 * fq, bcol0 = u.pn * BM + wc * 32 + 8 * fq;
        f32x4 bv[2][2];
#pragma unroll
        for (int bj = 0; bj < 2; ++bj)
#pragma unroll
            for (int n = 0; n < 2; ++n) bv[bj][n] = bias ? *(const f32x4*)(bias + bcol0 + bj * HALF + 4 * n) : (f32x4){0.f, 0.f, 0.f, 0.f};
#pragma unroll
        for (int ai = 0; ai < 2; ++ai)
#pragma unroll
            for (int m = 0; m < 4; ++m) { bf16_t* rowp = base + (size_t)(row0 + ai * HALF + m * 16) * ldc + col0;
#pragma unroll
                for (int bj = 0; bj < 2; ++bj) { f32x4 v0 = acc[ai][bj][m][0] + bv[bj][0], v1 = acc[ai][bj][m][1] + bv[bj][1];
                    if (ACT == 1) { f32x2 a = gelu_pk((f32x2){v0[0], v0[1]}), b = gelu_pk((f32x2){v0[2], v0[3]}), c = gelu_pk((f32x2){v1[0], v1[1]}), d = gelu_pk((f32x2){v1[2], v1[3]});
                        v0 = (f32x4){a.x, a.y, b.x, b.y}; v1 = (f32x4){c.x, c.y, d.x, d.y}; }
                    v0 = v0 * sc; v1 = v1 * sc; u32x4 w; w.x = cvt_pk_bf16(v0[0], v0[1]); w.y = cvt_pk_bf16(v0[2], v0[3]); w.z = cvt_pk_bf16(v1[0], v1[1]); w.w = cvt_pk_bf16(v1[2], v1[3]);
                    *(u32x4*)(rowp + bj * HALF) = w; } }
    }
};

struct EpiResF32 {
    static constexpr bool PERM = true, AFTER_DRAIN = false;
    const float* base; float* out; int ldc; const float* ssq;
    __device__ __forceinline__ void operator()(const f32x4 (&acc)[2][2][4][2], const Unit& u, int wr, int wc, int fr_, int fq_) const {
        (void)fr_; (void)fq_; const int ln_ = lane_id(); const int fr = ln_ & 15, fq = ln_ >> 4;
        const int col0 = u.pn * BM + wc * 32 + 8 * fq;
#pragma unroll
        for (int ai = 0; ai < 2; ++ai)
#pragma unroll
            for (int m = 0; m < 4; ++m) { const int r = ai * HALF + wr * 64 + m * 16 + fr; const unsigned off = (unsigned)((u.pm * BM + r) * ldc + col0);
                const float rb = ssq ? __builtin_amdgcn_rsqf(ssq[2 * (u.pm * BM + r) + 1] * (1.0f / 512.0f) + 1e-6f) : 1.0f;
#pragma unroll
                for (int bj = 0; bj < 2; ++bj)
#pragma unroll
                    for (int n = 0; n < 2; ++n) { const f32x4 bs = *(const f32x4*)(base + off + bj * HALF + n * 4); *(f32x4*)(out + off + bj * HALF + n * 4) = bs + acc[ai][bj][m][n] * rb; } }
    }
};
__device__ __forceinline__ float silu_mul(float g, float u) { return g * u * __builtin_amdgcn_rcpf(1.0f + __builtin_amdgcn_exp2f(-1.4426950408889634f * g)); }
struct EpiSwiGLU {
    static constexpr bool PERM = true, AFTER_DRAIN = false;
    bf16_t* O; int ldc;
    __device__ __forceinline__ void operator()(const f32x4 (&acc)[2][2][4][2], const Unit& u, int wr, int wc, int fr_, int fq_) const {
        (void)fr_; (void)fq_; const int ln_ = lane_id(); const int fr = ln_ & 15, fq = ln_ >> 4;
        const int row0 = u.pm * BM + wr * 64 + fr, col0 = u.pn * HALF + wc * 32 + 8 * fq;
#pragma unroll
        for (int ai = 0; ai < 2; ++ai)
#pragma unroll
            for (int m = 0; m < 4; ++m) { bf16_t* rowp = O + (unsigned)((row0 + ai * HALF + m * 16) * ldc + col0);
                const f32x4 g0 = acc[ai][0][m][0], g1 = acc[ai][0][m][1], u0 = acc[ai][1][m][0], u1 = acc[ai][1][m][1];
                u32x4 w; w.x = cvt_pk_bf16(silu_mul(g0[0], u0[0]), silu_mul(g0[1], u0[1])); w.y = cvt_pk_bf16(silu_mul(g0[2], u0[2]), silu_mul(g0[3], u0[3]));
                w.z = cvt_pk_bf16(silu_mul(g1[0], u1[0]), silu_mul(g1[1], u1[1])); w.w = cvt_pk_bf16(silu_mul(g1[2], u1[2]), silu_mul(g1[3], u1[3]));
                *(u32x4*)rowp = w; }
    }
};
struct EpiRowScaleBf16 {
    static constexpr bool PERM = true, AFTER_DRAIN = false;
    bf16_t* O; int ldc; const float* rowscale;
    __device__ __forceinline__ void operator()(const f32x4 (&acc)[2][2][4][2], const Unit& u, int wr, int wc, int fr_, int fq_) const {
        (void)fr_; (void)fq_; const int ln_ = lane_id(); const int fr = ln_ & 15, fq = ln_ >> 4;
        const int row0 = u.pm * BM + wr * 64 + fr, col0 = u.pn * BM + wc * 32 + 8 * fq;
#pragma unroll
        for (int ai = 0; ai < 2; ++ai)
#pragma unroll
            for (int m = 0; m < 4; ++m) { const int row = row0 + ai * HALF + m * 16; const float sc = rowscale[row]; bf16_t* rowp = O + (unsigned)(row * ldc + col0);
#pragma unroll
                for (int bj = 0; bj < 2; ++bj) { const f32x4 v0 = acc[ai][bj][m][0] * sc, v1 = acc[ai][bj][m][1] * sc;
                    u32x4 w; w.x = cvt_pk_bf16(v0[0], v0[1]); w.y = cvt_pk_bf16(v0[2], v0[3]); w.z = cvt_pk_bf16(v1[0], v1[1]); w.w = cvt_pk_bf16(v1[2], v1[3]);
                    *(u32x4*)(rowp + bj * HALF) = w; } }
    }
};
__device__ __forceinline__ float fqsum(float v) { v += __shfl_xor(v, 16); v += __shfl_xor(v, 32); return v; }
__device__ __forceinline__ float dot4(const f32x4 a) { return (a[0] * a[0] + a[1] * a[1]) + (a[2] * a[2] + a[3] * a[3]); }
__device__ __forceinline__ u32x4 pack8g(const f32x4 a, const f32x4 b, const float (&g)[8], float r) {
    u32x4 w; w.x = cvt_pk_bf16(a[0] * r * g[0], a[1] * r * g[1]); w.y = cvt_pk_bf16(a[2] * r * g[2], a[3] * r * g[3]); w.z = cvt_pk_bf16(b[0] * r * g[4], b[1] * r * g[5]); w.w = cvt_pk_bf16(b[2] * r * g[6], b[3] * r * g[7]); return w; }
typedef unsigned u32x2_t __attribute__((ext_vector_type(2)));
__device__ __forceinline__ float clampf8(float v) { return __builtin_amdgcn_fmed3f(v, -448.0f, 448.0f); }
__device__ __forceinline__ u32x2_t pack8g_f8(const f32x4 a, const f32x4 b, const float (&g)[8], float r) {
    int w0 = 0, w1 = 0;
    w0 = __builtin_amdgcn_cvt_pk_fp8_f32(clampf8(a[0] * r * g[0]), clampf8(a[1] * r * g[1]), w0, false); w0 = __builtin_amdgcn_cvt_pk_fp8_f32(clampf8(a[2] * r * g[2]), clampf8(a[3] * r * g[3]), w0, true);
    w1 = __builtin_amdgcn_cvt_pk_fp8_f32(clampf8(b[0] * r * g[4]), clampf8(b[1] * r * g[5]), w1, false); w1 = __builtin_amdgcn_cvt_pk_fp8_f32(clampf8(b[2] * r * g[6]), clampf8(b[3] * r * g[7]), w1, true);
    return (u32x2_t){(unsigned)w0, (unsigned)w1}; }
__device__ __forceinline__ u32x4 pack8s(const f32x4 a, const f32x4 b, float r) {
    u32x4 w; w.x = cvt_pk_bf16(a[0] * r, a[1] * r); w.y = cvt_pk_bf16(a[2] * r, a[3] * r); w.z = cvt_pk_bf16(b[0] * r, b[1] * r); w.w = cvt_pk_bf16(b[2] * r, b[3] * r); return w; }
constexpr float kEps = 1e-6f;
struct EpiInProj {
    static constexpr bool PERM = true, AFTER_DRAIN = false;
    unsigned char* ws; const float *gq, *gk, *gkr;
    __device__ __forceinline__ void operator()(const f32x4 (&acc)[2][2][4][2], const Unit& u, int wr, int wc, int fr_, int fq_) const {
        (void)fr_; (void)fq_; const int ln_ = lane_id(); const int fr = ln_ & 15, fq = ln_ >> 4;
        const int G = 4 * u.pn + wc;
        if (G >= 23) return;
        const int row0 = u.pm * BM + wr * 64 + fr;
        bf16_t* const QA = (bf16_t*)(ws + WS_QA); bf16_t* const KA = (bf16_t*)(ws + WS_KA); bf16_t* const VA = (bf16_t*)(ws + WS_VA); bf16_t* const CQ = (bf16_t*)(ws + WS_CQ); bf16_t* const CKV = (bf16_t*)(ws + WS_CKV); bf16_t* const KR = (bf16_t*)(ws + WS_KR);
        float* const ssq_cq = (float*)(ws + WS_SSQCQ); float* const ssq_ckv = (float*)(ws + WS_SSQCKV); const float* const cosT = (const float*)(ws + WS_TAB) + TAB_COS; const float* const sinT = (const float*)(ws + WS_TAB) + TAB_SIN;
        constexpr float qscale = QSC_A; constexpr int seq = SEQ;
        if (G < 10) {
            const float* gg = (G < 8) ? gq : gk; const float sc = (G < 8) ? qscale : 1.0f; bf16_t* dst = (G < 8) ? QA + 64 * G : KA + 64 * (G - 8); const int ld = (G < 8) ? 512 : 128;
            float g0[8], g1[8];
#pragma unroll
            for (int j = 0; j < 8; ++j) { g0[j] = gg[8 * fq + j]; g1[j] = gg[32 + 8 * fq + j]; }
#pragma unroll
            for (int ai = 0; ai < 2; ++ai)
#pragma unroll
                for (int m = 0; m < 4; ++m) { const int row = row0 + ai * HALF + m * 16;
                    const float ss = fqsum((dot4(acc[ai][0][m][0]) + dot4(acc[ai][0][m][1])) + (dot4(acc[ai][1][m][0]) + dot4(acc[ai][1][m][1])));
                    const float r = sc * __builtin_amdgcn_rsqf(ss * (1.0f / 64.0f) + kEps); bf16_t* p = dst + (unsigned)(row * ld + 8 * fq);
                    *(u32x4*)p = pack8g(acc[ai][0][m][0], acc[ai][0][m][1], g0, r); *(u32x4*)(p + 32) = pack8g(acc[ai][1][m][0], acc[ai][1][m][1], g1, r); }
        } else if (G < 22) {
            bf16_t* dst; int ld; float* sq;
            if (G < 12) { dst = VA + 64 * (G - 10); ld = 128; sq = nullptr; } else if (G < 18) { dst = CQ + 64 * (G - 12); ld = 384; sq = ssq_cq; } else { dst = CKV + 64 * (G - 18); ld = 256; sq = ssq_ckv; }
#pragma unroll
            for (int ai = 0; ai < 2; ++ai)
#pragma unroll
                for (int m = 0; m < 4; ++m) { const int row = row0 + ai * HALF + m * 16; bf16_t* p = dst + (unsigned)(row * ld + 8 * fq);
                    if (sq) { const float ss = fqsum((dot4(acc[ai][0][m][0]) + dot4(acc[ai][0][m][1])) + (dot4(acc[ai][1][m][0]) + dot4(acc[ai][1][m][1]))); if (fq == 0) atomicAdd(sq + row, ss); }
                    *(u32x4*)p = pack8s(acc[ai][0][m][0], acc[ai][0][m][1], 1.0f); *(u32x4*)(p + 32) = pack8s(acc[ai][1][m][0], acc[ai][1][m][1], 1.0f); }
        } else {
            float g0[8];
#pragma unroll
            for (int j = 0; j < 8; ++j) g0[j] = gkr[8 * fq + j];
#pragma unroll
            for (int ai = 0; ai < 2; ++ai)
#pragma unroll
                for (int m = 0; m < 4; ++m) { const int row = row0 + ai * HALF + m * 16; const int s = row % seq;
                    const float ss = fqsum(dot4(acc[ai][0][m][0]) + dot4(acc[ai][0][m][1])); const float r = __builtin_amdgcn_rsqf(ss * (1.0f / 32.0f) + kEps);
                    float o[8];
#pragma unroll
                    for (int j = 0; j < 8; ++j) { const float y = ((j < 4) ? acc[ai][0][m][0][j & 3] : acc[ai][0][m][1][j & 3]) * r * g0[j]; const float pp = __shfl_xor(y, 32);
                        const int i16 = 8 * (fq & 1) + j; const float c = cosT[s * 16 + i16], sn = sinT[s * 16 + i16]; o[j] = (fq < 2) ? (y * c - pp * sn) : (pp * sn + y * c); }
                    u32x4 w; w.x = cvt_pk_bf16(o[0], o[1]); w.y = cvt_pk_bf16(o[2], o[3]); w.z = cvt_pk_bf16(o[4], o[5]); w.w = cvt_pk_bf16(o[6], o[7]);
                    *(u32x4*)(KR + (unsigned)((((row >> 12) * 64 + ((row >> 6) & 63)) * 2048) + fq * 512 + (row & 63) * 8)) = w; }
        }
    }
};
struct EpiQB {
    static constexpr bool PERM = true, AFTER_DRAIN = false;
    unsigned char* ws; const float *gqn, *gqr;
    __device__ __forceinline__ void operator()(const f32x4 (&acc)[2][2][4][2], const Unit& u, int wr, int wc, int fr_, int fq_) const {
        (void)fr_; (void)fq_; const int ln_ = lane_id(); const int fr = ln_ & 15, fq = ln_ >> 4;
        const int row0 = u.pm * BM + wr * 64 + fr;
        bf16_t* const QB = (bf16_t*)(ws + WS_QB); const float* const ssq_cq = (const float*)(ws + WS_SSQCQ); const float* const cosT = (const float*)(ws + WS_TAB) + TAB_COS; const float* const sinT = (const float*)(ws + WS_TAB) + TAB_SIN;
        constexpr float qscale = QSC_B; constexpr int seq = SEQ;
        if (u.pn < 2) {
            const int head = 4 * u.pn + wc; float g0[8], g1[8];
#pragma unroll
            for (int j = 0; j < 8; ++j) { g0[j] = gqn[8 * fq + j]; g1[j] = gqn[32 + 8 * fq + j]; }
#pragma unroll
            for (int ai = 0; ai < 2; ++ai)
#pragma unroll
                for (int m = 0; m < 4; ++m) { const int row = row0 + ai * HALF + m * 16; const float eps2 = kEps * (ssq_cq[row] * (1.0f / 384.0f) + kEps);
                    const float ss = fqsum((dot4(acc[ai][0][m][0]) + dot4(acc[ai][0][m][1])) + (dot4(acc[ai][1][m][0]) + dot4(acc[ai][1][m][1])));
                    const float r = (64.0f * qscale) * __builtin_amdgcn_rsqf(ss * (1.0f / 64.0f) + eps2); unsigned char* p = ws + WS_QN8 + (unsigned)(row * 512 + 64 * head + 8 * fq);
                    *(u32x2_t*)p = pack8g_f8(acc[ai][0][m][0], acc[ai][0][m][1], g0, r); *(u32x2_t*)(p + 32) = pack8g_f8(acc[ai][1][m][0], acc[ai][1][m][1], g1, r); }
        } else {
            float g0[8];
#pragma unroll
            for (int j = 0; j < 8; ++j) g0[j] = gqr[8 * fq + j];
#pragma unroll
            for (int ai = 0; ai < 2; ++ai)
#pragma unroll
                for (int m = 0; m < 4; ++m) { const int row = row0 + ai * HALF + m * 16; const int s = row % seq; const float eps2 = kEps * (ssq_cq[row] * (1.0f / 384.0f) + kEps);
#pragma unroll
                    for (int bj = 0; bj < 2; ++bj) { const int head = 2 * wc + bj;
                        const float ss = fqsum(dot4(acc[ai][bj][m][0]) + dot4(acc[ai][bj][m][1])); const float r = __builtin_amdgcn_rsqf(ss * (1.0f / 32.0f) + eps2);
                        float o[8];
#pragma unroll
                        for (int j = 0; j < 8; ++j) { const float y = ((j < 4) ? acc[ai][bj][m][0][j & 3] : acc[ai][bj][m][1][j & 3]) * r * g0[j]; const float pp = __shfl_xor(y, 32);
                            const int i16 = 8 * (fq & 1) + j; const float c = cosT[s * 16 + i16], sn = sinT[s * 16 + i16]; o[j] = qscale * ((fq < 2) ? (y * c - pp * sn) : (pp * sn + y * c)); }
                        u32x4 w; w.x = cvt_pk_bf16(o[0], o[1]); w.y = cvt_pk_bf16(o[2], o[3]); w.z = cvt_pk_bf16(o[4], o[5]); w.w = cvt_pk_bf16(o[6], o[7]);
                        *(u32x4*)(QB + (unsigned)(row * 768 + 96 * head + 64 + 8 * fq)) = w; } }
        }
    }
};
struct EpiKVB {
    static constexpr bool PERM = true, AFTER_DRAIN = false;
    unsigned char* ws; const float* gkn;
    __device__ __forceinline__ void operator()(const f32x4 (&acc)[2][2][4][2], const Unit& u, int wr, int wc, int fr_, int fq_) const {
        (void)fr_; (void)fq_; const int ln_ = lane_id(); const int fr = ln_ & 15, fq = ln_ >> 4;
        const int row0 = u.pm * BM + wr * 64 + fr, G = 4 * u.pn + wc, head = G >> 1;
        bf16_t* const KBN = (bf16_t*)(ws + WS_KBN); bf16_t* const VB = (bf16_t*)(ws + WS_VB); const float* const ssq_ckv = (const float*)(ws + WS_SSQCKV);
        if (!(G & 1)) {
            float g0[8], g1[8];
#pragma unroll
            for (int j = 0; j < 8; ++j) { g0[j] = gkn[8 * fq + j]; g1[j] = gkn[32 + 8 * fq + j]; }
#pragma unroll
            for (int ai = 0; ai < 2; ++ai)
#pragma unroll
                for (int m = 0; m < 4; ++m) { const int row = row0 + ai * HALF + m * 16; const float eps2 = kEps * (ssq_ckv[row] * (1.0f / 256.0f) + kEps);
                    const float ss = fqsum((dot4(acc[ai][0][m][0]) + dot4(acc[ai][0][m][1])) + (dot4(acc[ai][1][m][0]) + dot4(acc[ai][1][m][1])));
                    const float r = 8.0f * __builtin_amdgcn_rsqf(ss * (1.0f / 64.0f) + eps2);
                    unsigned char* p = (unsigned char*)KBN + (unsigned)(((((row >> 12) * 8 + head) * 64 + ((row >> 6) & 63)) * 4096) + (fq >> 1) * 1024 + (row & 63) * 16 + (fq & 1) * 8);
                    *(u32x2_t*)p = pack8g_f8(acc[ai][0][m][0], acc[ai][0][m][1], g0, r); *(u32x2_t*)(p + 2048) = pack8g_f8(acc[ai][1][m][0], acc[ai][1][m][1], g1, r); }
        } else {
#pragma unroll
            for (int ai = 0; ai < 2; ++ai)
#pragma unroll
                for (int m = 0; m < 4; ++m) { const int row = row0 + ai * HALF + m * 16; const float al = __builtin_amdgcn_rsqf(ssq_ckv[row] * (1.0f / 256.0f) + kEps); bf16_t* p = VB + (unsigned)(((((row >> 12) * 8 + head) * 64 + ((row >> 6) & 63)) * 4096) + ((row >> 4) & 3) * 512 + (row & 15) * 32 + 8 * fq);
                    *(u32x4*)p = pack8s(acc[ai][0][m][0], acc[ai][0][m][1], al); *(u32x4*)(p + 4 * 512) = pack8s(acc[ai][1][m][0], acc[ai][1][m][1], al); }
        }
    }
};

__device__ __forceinline__ float clamp448(float v) { return __builtin_fminf(__builtin_fmaxf(v, -448.0f), 448.0f); }
__device__ __forceinline__ unsigned pk4_fp8(float a, float b, float c, float d) { int w = 0; w = __builtin_amdgcn_cvt_pk_fp8_f32(clamp448(a), clamp448(b), w, false); w = __builtin_amdgcn_cvt_pk_fp8_f32(clamp448(c), clamp448(d), w, true); return (unsigned)w; }
__device__ __forceinline__ unsigned pk4_fp8_nc(float a, float b, float c, float d) { int w = 0; w = __builtin_amdgcn_cvt_pk_fp8_f32(a, b, w, false); w = __builtin_amdgcn_cvt_pk_fp8_f32(c, d, w, true); return (unsigned)w; }
struct EpiSwiGLU8 {
    static constexpr bool PERM = true, AFTER_DRAIN = false;
    unsigned char* O; int ldc; float oscale;
    __device__ __forceinline__ void operator()(const f32x4 (&acc)[2][2][4][2], const Unit& u, int wr, int wc, int fr_, int fq_) const {
        (void)fr_; (void)fq_; const int ln_ = lane_id(); const int fr = ln_ & 15, fq = ln_ >> 4;
        const int row0 = u.pm * BM + wr * 64 + fr, col0 = u.pn * HALF + wc * 32 + 8 * fq;
#pragma unroll
        for (int ai = 0; ai < 2; ++ai)
#pragma unroll
            for (int m = 0; m < 4; ++m) { unsigned char* rowp = O + (unsigned)((row0 + ai * HALF + m * 16) * ldc + col0);
                const f32x4 g0 = acc[ai][0][m][0], g1 = acc[ai][0][m][1], u0 = acc[ai][1][m][0], u1 = acc[ai][1][m][1];
                typedef unsigned u32x2 __attribute__((ext_vector_type(2))); u32x2 w;
                w.x = pk4_fp8(oscale * silu_mul(g0[0], u0[0]), oscale * silu_mul(g0[1], u0[1]), oscale * silu_mul(g0[2], u0[2]), oscale * silu_mul(g0[3], u0[3]));
                w.y = pk4_fp8(oscale * silu_mul(g1[0], u1[0]), oscale * silu_mul(g1[1], u1[1]), oscale * silu_mul(g1[2], u1[2]), oscale * silu_mul(g1[3], u1[3]));
                *(u32x2*)rowp = w; }
    }
};

struct EpiRowScaleF8 {
    static constexpr bool PERM = true, AFTER_DRAIN = false;
    unsigned char* O; int ldc; const float* rowscale; float oscale;
    __device__ __forceinline__ void operator()(const f32x4 (&acc)[2][2][4][2], const Unit& u, int wr, int wc, int fr_, int fq_) const {
        (void)fr_; (void)fq_; const int ln_ = lane_id(); const int fr = ln_ & 15, fq = ln_ >> 4;
        const int row0 = u.pm * BM + wr * 64 + fr, col0 = u.pn * BM + wc * 32 + 8 * fq;
#pragma unroll
        for (int ai = 0; ai < 2; ++ai)
#pragma unroll
            for (int m = 0; m < 4; ++m) { const int row = row0 + ai * HALF + m * 16; const float sc = rowscale[row] * oscale; unsigned char* rowp = O + (unsigned)(row * ldc + col0);
#pragma unroll
                for (int bj = 0; bj < 2; ++bj) { const f32x4 v0 = acc[ai][bj][m][0] * sc, v1 = acc[ai][bj][m][1] * sc;
                    typedef unsigned u32x2 __attribute__((ext_vector_type(2))); u32x2 w; w.x = pk4_fp8(v0[0], v0[1], v0[2], v0[3]); w.y = pk4_fp8(v1[0], v1[1], v1[2], v1[3]);
                    *(u32x2*)(rowp + bj * HALF) = w; } }
    }
};

struct EpiNormBf16 {
    static constexpr bool PERM = true, AFTER_DRAIN = false;
    bf16_t* O; int ldc; const float* ssq;
    __device__ __forceinline__ void operator()(const f32x4 (&acc)[2][2][4][2], const Unit& u, int wr, int wc, int fr_, int fq_) const {
        (void)fr_; (void)fq_; const int ln_ = lane_id(); const int fr = ln_ & 15, fq = ln_ >> 4;
        const int row0 = u.pm * BM + wr * 64 + fr, col0 = u.pn * BM + wc * 32 + 8 * fq;
#pragma unroll
        for (int ai = 0; ai < 2; ++ai)
#pragma unroll
            for (int m = 0; m < 4; ++m) { const int row = row0 + ai * HALF + m * 16; const float rb = __builtin_amdgcn_rsqf(ssq[2 * row + 1] * (1.0f / 512.0f) + 1e-6f); bf16_t* rowp = O + (unsigned)(row * ldc + col0);
#pragma unroll
                for (int bj = 0; bj < 2; ++bj) *(u32x4*)(rowp + bj * HALF) = pack8s(acc[ai][bj][m][0], acc[ai][bj][m][1], rb); }
    }
};
__device__ __forceinline__ void glds_sv(const char* sbase, unsigned voff, unsigned lds_dst) { unsigned keep;
    asm volatile("s_mov_b32 %0, m0\n\ts_mov_b32 m0, %3\n\ts_nop 0\n\tglobal_load_lds_dwordx4 %1, %2\n\ts_mov_b32 m0, %0" : "=&s"(keep) : "v"(voff), "s"(sbase), "s"(lds_dst) : "memory"); }
template <class Epi, class Sched, bool ALIGN_EPI = false, bool SP2 = false, int MODE = 0, bool F8 = false>
__device__ __forceinline__ void gemm_phase(PG8_LAS unsigned char* lds, const Gemm g, const Sched& S, const Epi& E) {
    const int lane = lane_id(), wid = g.wave, tid = wid * 64 + lane,
              wr = wid >> 2, wc = wid & 3, fr = lane & 15, fq = lane >> 4;
    int K_ = g.K; asm volatile("" : "+s"(K_));
    const int K = K_, nt = K / BK;
    unsigned voffA[2], voffB[2];
#pragma unroll
    for (int i = 0; i < 2; ++i) { int R, C; if constexpr (F8) stage_rc8(tid * 16 + i * 8192, R, C); else stage_rc(tid * 16 + i * 8192, R, C); const int Rb = Epi::PERM ? ((R & ~31) + perm32(R & 31)) : R;
        voffA[i] = (unsigned)(R * K + C) * 2u; voffB[i] = (unsigned)(Rb * K + C) * 2u; }
    const size_t r64step = (size_t)64 * K * 2;
    const size_t kstep = (size_t)(BK * 2);
    const size_t hstep = (size_t)HALF * K * 2;
    const size_t tstep = 2 * hstep;
    const unsigned ldsw = (unsigned)wid * 1024u;
    const unsigned ldsbase = (unsigned)__builtin_amdgcn_readfirstlane((int)((unsigned)(uintptr_t)lds + ldsw));
    const int aoff = lds_byte(wr * 64 + fr, fq * 8), boff = lds_byte(wc * 32 + fr, fq * 8);
    const int aoff8 = lds_byte8(wr * 64 + fr, fq * 32), boff8 = lds_byte8(wc * 32 + fr, fq * 32);
#define PG8_X16(x) ({ int t_; asm volatile("v_xor_b32 %0, 16, %1" : "=v"(t_) : "v"(x)); t_; })
    typedef int v8i32 __attribute__((ext_vector_type(8))); typedef short bf16x16 __attribute__((ext_vector_type(16)));
#define PG8_SA(b, h) (((b) * 2 + (h)) * HTB)
#define PG8_SB(b, h) ((4 + (b) * 2 + (h)) * HTB)
#define PG8_STAGE(bufoff, gbase, voff) do { _Pragma("unroll") for (int _i = 0; _i < 2; ++_i) \
        glds_sv((const char*)(gbase) + (size_t)_i * r64step, (voff)[0], ldsbase + (unsigned)((bufoff) + _i * 8192)); } while (0)
#define PG8_LDA(dst, b, h) do { if constexpr (F8) { const int a1_ = PG8_X16(aoff8); _Pragma("unroll") for (int m = 0; m < 4; ++m) { dst[m][0] = *(const PG8_LAS bf16x8*)(lds + PG8_SA(b, h) + aoff8 + m * 2048); dst[m][1] = *(const PG8_LAS bf16x8*)(lds + PG8_SA(b, h) + a1_ + m * 2048); } } \
        else { _Pragma("unroll") for (int m = 0; m < 4; ++m) _Pragma("unroll") for (int k = 0; k < 2; ++k) dst[m][k] = *(const PG8_LAS bf16x8*)(lds + PG8_SA(b, h) + aoff + k * 1024 + m * 2048); } } while (0)
#define PG8_LDB(dst, b, h) do { if constexpr (F8) { const int b1_ = PG8_X16(boff8); _Pragma("unroll") for (int n = 0; n < 2; ++n) { dst[n][0] = *(const PG8_LAS bf16x8*)(lds + PG8_SB(b, h) + boff8 + n * 2048); dst[n][1] = *(const PG8_LAS bf16x8*)(lds + PG8_SB(b, h) + b1_ + n * 2048); } } \
        else { _Pragma("unroll") for (int n = 0; n < 2; ++n) _Pragma("unroll") for (int k = 0; k < 2; ++k) dst[n][k] = *(const PG8_LAS bf16x8*)(lds + PG8_SB(b, h) + boff + k * 1024 + n * 2048); } } while (0)
#define PG8_F8FRAG(x) __builtin_bit_cast(v8i32, (bf16x16){x[0][0], x[0][1], x[0][2], x[0][3], x[0][4], x[0][5], x[0][6], x[0][7], x[1][0], x[1][1], x[1][2], x[1][3], x[1][4], x[1][5], x[1][6], x[1][7]})
#define PG8_MMA(ai, bj, At, Bt) do { __builtin_amdgcn_s_setprio(1); _Pragma("unroll") for (int m = 0; m < 4; ++m) _Pragma("unroll") for (int n = 0; n < 2; ++n) { \
        if constexpr (F8) { acc[ai][bj][m][n] = __builtin_amdgcn_mfma_scale_f32_16x16x128_f8f6f4(PG8_F8FRAG(Bt[n]), PG8_F8FRAG(At[m]), acc[ai][bj][m][n], 0, 0, 0, g.sA, 0, g.sA); }     \
        else { _Pragma("unroll") for (int k = 0; k < 2; ++k) acc[ai][bj][m][n] = __builtin_amdgcn_mfma_f32_16x16x32_bf16(Bt[n][k], At[m][k], acc[ai][bj][m][n], 0, 0, 0); } } __builtin_amdgcn_s_setprio(0); } while (0)
#define PG8_WAIT_V(n) asm volatile("s_waitcnt vmcnt(" #n ")" ::: "memory")
#define PG8_WAIT_L(n) asm volatile("s_waitcnt lgkmcnt(" #n ")" ::: "memory")
#define PG8_BAR __builtin_amdgcn_s_barrier()
#define PG8_SCHED __builtin_amdgcn_sched_barrier(0)
    Unit cur, nxt; int ui = 0;
    if (!S.next(0, cur)) return;
    f32x4 acc[2][2][4][2];
#pragma unroll
    for (int a = 0; a < 2; ++a)
#pragma unroll
        for (int b = 0; b < 2; ++b)
#pragma unroll
            for (int m = 0; m < 4; ++m)
#pragma unroll
                for (int n = 0; n < 2; ++n) acc[a][b][m][n] = (f32x4){0.f, 0.f, 0.f, 0.f};
    bf16x8 At[4][2], B0[2][2], B1[2][2];
    const char* cA = (const char*)g.A + (MODE == 1 ? (size_t)0 : (size_t)cur.pm * tstep); const char* cB = (const char*)g.Bt + (size_t)cur.e * g.estride + (size_t)cur.pn * tstep;
    PG8_LAS unsigned* const gt = (PG8_LAS unsigned*)(lds + g.gtab);
#define PG8_GFILL(slot, u) do { const int t_ = wid * 64 + lane_id(); if (t_ < BM) gt[(slot) * BM + t_] = (unsigned)g.idx[(u).pm * BM + t_] * (unsigned)(K * 2); } while (0)
    if constexpr (MODE == 1) { PG8_GFILL(0, cur); __syncthreads(); }
    int gR0_, gC0_; if constexpr (F8) stage_rc8(tid * 16, gR0_, gC0_); else stage_rc(tid * 16, gR0_, gC0_); PG8_LAS unsigned* const gtl = gt + gR0_; const unsigned gcb = (unsigned)gC0_ * 2u;
#define PG8_STA(bufoff, gbase, H, NXT) do { if constexpr (MODE == 1) { const int slot_ = ((NXT) ? ui + 1 : ui) & 1; _Pragma("unroll") for (int _i = 0; _i < 2; ++_i) { \
        const unsigned vo_ = gtl[slot_ * BM + (H) * HALF + _i * 64] + gcb; glds_sv((const char*)(gbase), vo_, ldsbase + (unsigned)((bufoff) + _i * 8192)); } } \
        else { PG8_STAGE(bufoff, (gbase) + ((H) ? hstep : (size_t)0), voffA); } } while (0)
    S.a_ready(cur);
    if constexpr (SP2) {
        PG8_STAGE(PG8_SB(0, 0), cB, voffB); PG8_STAGE(PG8_SB(0, 1), cB + hstep, voffB); PG8_STA(PG8_SA(0, 0), cA, 0, false); PG8_STA(PG8_SA(0, 1), cA, 1, false);
        if (wr == 1) PG8_BAR;
        PG8_WAIT_V(2); PG8_BAR;
        PG8_STAGE(PG8_SB(1, 0), cB + kstep, voffB); PG8_STA(PG8_SA(1, 0), cA + kstep, 0, false); PG8_STAGE(PG8_SB(1, 1), cB + hstep + kstep, voffB);
        PG8_WAIT_V(6); PG8_BAR;
    } else {
        PG8_STAGE(PG8_SB(0, 0), cB, voffB); PG8_STAGE(PG8_SA(0, 0), cA, voffA); PG8_STAGE(PG8_SB(0, 1), cB + hstep, voffB); PG8_STAGE(PG8_SA(0, 1), cA + hstep, voffA);
        if (wr == 1) PG8_BAR;
        PG8_WAIT_V(4); PG8_BAR;
        PG8_STAGE(PG8_SB(1, 0), cB + kstep, voffB); PG8_STAGE(PG8_SA(1, 0), cA + kstep, voffA); PG8_STAGE(PG8_SB(1, 1), cB + hstep + kstep, voffB);
        PG8_WAIT_V(6); PG8_BAR;
    }
    for (;;) {
        const bool has_next = S.next(ui + 1, nxt);
        if constexpr (MODE == 1) { if (has_next) PG8_GFILL((ui + 1) & 1, nxt); else PG8_GFILL((ui + 1) & 1, cur); }
        const char* nA = (MODE == 1) ? cA : (has_next ? (const char*)g.A + (size_t)nxt.pm * tstep : cA); const char* nB = has_next ? (const char*)g.Bt + (size_t)nxt.e * g.estride + (size_t)nxt.pn * tstep : cB;
        for (int t = 0; t < nt; t += 2) {
            const bool last = (t == nt - 2);
            if constexpr (MODE == 2) { if (t == nt / 2) {
#pragma unroll
                for (int ai = 0; ai < 2; ++ai)
#pragma unroll
                    for (int m = 0; m < 4; ++m) { const int row = cur.pm * BM + ai * HALF + wr * 64 + m * 16 + fr; const float sa = g.ssq[2 * row], sb = g.ssq[2 * row + 1];
                        const float ratio = __builtin_amdgcn_rsqf(sa * (1.0f / 512.0f) + 1e-6f) * __builtin_amdgcn_sqrtf(sb * (1.0f / 512.0f) + 1e-6f);
#pragma unroll
                        for (int bj = 0; bj < 2; ++bj)
#pragma unroll
                            for (int n = 0; n < 2; ++n) acc[ai][bj][m][n] *= ratio; } } }
            const char* a1 = cA + (size_t)(t + 1) * kstep;
            const char* a2 = last ? nA : cA + (size_t)(t + 2) * kstep; const char* b2 = last ? nB : cB + (size_t)(t + 2) * kstep;
            const char* a3 = a2 + kstep; const char* b3 = b2 + kstep;
            if (last && has_next) S.a_ready(nxt);
            if constexpr (SP2) {
            PG8_LDB(B0, 0, 0); PG8_LDB(B1, 0, 1); PG8_SCHED; PG8_LDA(At, 0, 0); PG8_STA(PG8_SA(1, 1), a1, 1, false);
            PG8_WAIT_V(8); PG8_WAIT_L(0); PG8_BAR; PG8_MMA(0, 0, At, B0); PG8_MMA(0, 1, At, B1); PG8_BAR; PG8_SCHED;
            PG8_LDA(At, 0, 1); PG8_STAGE(PG8_SB(0, 0), b2, voffB); PG8_STAGE(PG8_SB(0, 1), b2 + hstep, voffB); PG8_STA(PG8_SA(0, 0), a2, 0, last);
            PG8_WAIT_V(8); PG8_WAIT_L(0); PG8_BAR; PG8_MMA(1, 0, At, B0); PG8_MMA(1, 1, At, B1); PG8_BAR; PG8_SCHED;
            PG8_LDB(B0, 1, 0); PG8_LDB(B1, 1, 1); PG8_SCHED; PG8_LDA(At, 1, 0); PG8_STA(PG8_SA(0, 1), a2, 1, last);
            PG8_WAIT_V(8); PG8_WAIT_L(0); PG8_BAR; PG8_MMA(0, 0, At, B0); PG8_MMA(0, 1, At, B1); PG8_BAR; PG8_SCHED;
            PG8_LDA(At, 1, 1); PG8_STAGE(PG8_SB(1, 0), b3, voffB); PG8_STAGE(PG8_SB(1, 1), b3 + hstep, voffB); PG8_STA(PG8_SA(1, 0), a3, 0, last);
            PG8_WAIT_V(8); PG8_WAIT_L(0); PG8_BAR; PG8_MMA(1, 0, At, B0); PG8_MMA(1, 1, At, B1); PG8_BAR; PG8_SCHED;
            } else {
            PG8_LDB(B0, 0, 0); PG8_SCHED; PG8_LDA(At, 0, 0); PG8_STAGE(PG8_SA(1, 1), a1 + hstep, voffA);
            PG8_WAIT_L(8); PG8_BAR; PG8_WAIT_L(0); PG8_MMA(0, 0, At, B0); PG8_BAR; PG8_SCHED;
            PG8_LDB(B1, 0, 1); PG8_STAGE(PG8_SB(0, 0), b2, voffB);
            PG8_BAR; PG8_WAIT_L(0); PG8_MMA(0, 1, At, B1); PG8_BAR;
            PG8_LDA(At, 0, 1); PG8_STAGE(PG8_SA(0, 0), a2, voffA);
            PG8_BAR; PG8_WAIT_L(0); PG8_MMA(1, 0, At, B0); PG8_BAR; PG8_SCHED;
            PG8_STAGE(PG8_SB(0, 1), b2 + hstep, voffB);
            PG8_WAIT_V(6); PG8_BAR; PG8_MMA(1, 1, At, B1); PG8_BAR;
            PG8_LDB(B0, 1, 0); PG8_SCHED; PG8_LDA(At, 1, 0); PG8_STAGE(PG8_SA(0, 1), a2 + hstep, voffA);
            PG8_WAIT_L(8); PG8_BAR; PG8_WAIT_L(0); PG8_MMA(0, 0, At, B0); PG8_BAR; PG8_SCHED;
            PG8_LDB(B1, 1, 1); PG8_STAGE(PG8_SB(1, 0), b3, voffB);
            PG8_BAR; PG8_WAIT_L(0); PG8_MMA(0, 1, At, B1); PG8_BAR;
            PG8_LDA(At, 1, 1); PG8_STAGE(PG8_SA(1, 0), a3, voffA);
            PG8_BAR; PG8_WAIT_L(0); PG8_MMA(1, 0, At, B0); PG8_BAR; PG8_SCHED;
            PG8_STAGE(PG8_SB(1, 1), b3 + hstep, voffB);
            PG8_WAIT_V(6); PG8_BAR; PG8_MMA(1, 1, At, B1); PG8_BAR;
            }
        }
        if constexpr (ALIGN_EPI) { if (wr == 0) PG8_BAR; }
        if constexpr (!Epi::AFTER_DRAIN) { E(acc, cur, wr, wc, fr, fq); S.done(cur); }
        if (!has_next) break;
#pragma unroll
        for (int a = 0; a < 2; ++a)
#pragma unroll
            for (int b = 0; b < 2; ++b)
#pragma unroll
                for (int m = 0; m < 4; ++m)
#pragma unroll
                    for (int n = 0; n < 2; ++n) acc[a][b][m][n] = (f32x4){0.f, 0.f, 0.f, 0.f};
        cur = nxt; cA = nA; cB = nB; ++ui;
        if constexpr (ALIGN_EPI) { if (wr == 1) PG8_BAR; }
    }
    PG8_WAIT_V(0);
    if constexpr (!ALIGN_EPI) { if (wr == 0) PG8_BAR; }
    PG8_BAR;
    if constexpr (Epi::AFTER_DRAIN) { E.fused(acc, cur, wr, wc, fr, fq, lds, wid, lane); S.done(cur); }
#undef PG8_SA
#undef PG8_SB
#undef PG8_STAGE
#undef PG8_LDA
#undef PG8_LDB
#undef PG8_MMA
#undef PG8_F8FRAG
#undef PG8_X16
#undef PG8_WAIT_V
#undef PG8_WAIT_L
#undef PG8_BAR
#undef PG8_SCHED
#undef PG8_STA
#undef PG8_GFILL
}
}
#define GAS __attribute__((address_space(1)))
#define LAS __attribute__((address_space(3)))
typedef unsigned short bf16;
typedef unsigned v4u __attribute__((ext_vector_type(4)));
typedef float f32x4 __attribute__((ext_vector_type(4)));
typedef short bf16x8 __attribute__((ext_vector_type(8)));
typedef GAS unsigned gu32;
typedef GAS unsigned long long gu64;
#define RLX_AGENT __ATOMIC_RELAXED, __HIP_MEMORY_SCOPE_AGENT
#define LDS_WAIT() asm volatile("s_waitcnt lgkmcnt(0)" ::: "memory")
#define VM_WAIT() asm volatile("s_waitcnt vmcnt(0)" ::: "memory")
__device__ __forceinline__ unsigned long long rt() { return __builtin_amdgcn_s_memrealtime(); }
__device__ __forceinline__ unsigned f2bf(float f) { unsigned u = __builtin_bit_cast(unsigned, f); return (u + 0x7fffu + ((u >> 16) & 1u)) >> 16; }
__device__ __forceinline__ unsigned pk2(float lo, float hi) { return f2bf(lo) | (f2bf(hi) << 16); }

#define XB_TMO      128
#define XB_XCNT(j)  (256  + 64 * (j))
#define XB_XSUB(j)  (1280 + 64 * (j))
#define XB_XGEN(j)  (2304 + 64 * (j))
#define XB_TOP      3328
#define XB_TOPGEN   3392
#define XCD_BAR_WORDS 3456
#define XB_SPIN_CAP (1u << 18)

__device__ __forceinline__ unsigned xb_ld(unsigned* p)              { return __hip_atomic_load(p, __ATOMIC_RELAXED, __HIP_MEMORY_SCOPE_AGENT); }
__device__ __forceinline__ unsigned xb_add(unsigned* p, unsigned v) { return __hip_atomic_fetch_add(p, v, __ATOMIC_RELAXED, __HIP_MEMORY_SCOPE_AGENT); }
__device__ __forceinline__ unsigned xb_xcc_id() { return (unsigned)__builtin_amdgcn_s_getreg((3 << 11) | 20) & 0xFu; }
#define XB_SPIN(cond, bar) do { unsigned _sp = 0; while (cond) { __builtin_amdgcn_s_sleep(1); \
    if ((++_sp & 255u) == 0u) { if (xb_ld(&(bar)[XB_TMO])) break; if (_sp > XB_SPIN_CAP) { atomicAdd(&(bar)[XB_TMO], 1u); break; } } } } while (0)

struct XcdBarrier {
    int wave;
    unsigned* bar; unsigned x;
    volatile LAS unsigned* st;
};

__device__ __forceinline__ XcdBarrier xcd_barrier_post(unsigned* bar, volatile LAS unsigned* st) {
    XcdBarrier b; b.wave = __builtin_amdgcn_readfirstlane((int)(threadIdx.x >> 6)); b.bar = bar; b.x = xb_xcc_id(); b.st = st;
    if (threadIdx.x == 0) (void)xb_add(&bar[XB_XCNT(b.x)], 1u);
    return b;
}
__device__ __forceinline__ void xcd_barrier_complete(unsigned* bar, unsigned x, unsigned& nloc, unsigned& nx) {
    const unsigned G = gridDim.x * gridDim.y * gridDim.z;
    unsigned sum, cnt, mine, sp = 0u;
    for (;;) {
        sum = 0u; cnt = 0u; mine = 0u;
#pragma unroll
        for (unsigned j = 0; j < 16; ++j) { const unsigned c = xb_ld(&bar[XB_XCNT(j)]); sum += c; cnt += (c > 0u) ? 1u : 0u; mine = (j == x) ? c : mine; }
        if (sum == G) break;
        __builtin_amdgcn_s_sleep(1);
        if ((++sp & 255u) == 0u) { if (xb_ld(&bar[XB_TMO])) break; if (sp > XB_SPIN_CAP) { atomicAdd(&bar[XB_TMO], 1u); break; } }
    }
    nloc = mine > 0u ? mine : 1u; nx = cnt > 0u ? cnt : 1u;
}

__device__ __forceinline__ void xcd_barrier(const XcdBarrier& b) {
    asm volatile("s_waitcnt vmcnt(0)" ::: "memory");
    __syncthreads();
    if (b.wave == 0 && lane_id() == 0) {
        unsigned* bar = b.bar;
        __builtin_amdgcn_s_waitcnt(0);
        unsigned nloc = b.st[0], nx = b.st[1];
        if (nloc == 0u) { xcd_barrier_complete(bar, b.x, nloc, nx); b.st[0] = nloc; b.st[1] = nx; }
        const unsigned old = xb_add(&bar[XB_XSUB(b.x)], 1u);
        const unsigned gen = old / nloc;
        if (old + 1u == (gen + 1u) * nloc) {
            __builtin_amdgcn_fence(__ATOMIC_RELEASE, "agent");
            asm volatile("s_waitcnt vmcnt(0)" ::: "memory");
            const unsigned og = xb_add(&bar[XB_TOP], 1u);
            const unsigned tg = og / nx;
            if (og + 1u == (tg + 1u) * nx) xb_add(&bar[XB_TOPGEN], 1u);
            else XB_SPIN(xb_ld(&bar[XB_TOPGEN]) == tg, bar);
            __builtin_amdgcn_fence(__ATOMIC_ACQUIRE, "agent");
            xb_add(&bar[XB_XGEN(b.x)], 1u);
            asm volatile("s_waitcnt vmcnt(0)" ::: "memory");
        } else {
            XB_SPIN(xb_ld(&bar[XB_XGEN(b.x)]) == gen, bar);
            __builtin_amdgcn_fence(__ATOMIC_ACQUIRE, "agent");
            asm volatile("s_waitcnt vmcnt(0)" ::: "memory");
        }
    }
    __syncthreads();
}

struct Frame {
    LAS unsigned char* lds;
    volatile LAS unsigned* MISC;
    gu32* ctl;
    int wave;
    int vcu, G;
    const float* in[23];
    float* out;
    unsigned char* ws;
};
#define WSP(T_, off) ((T_*)(F.ws + (off)))
__device__ __forceinline__ float wave_sum(float v) {
#pragma unroll
    for (int o = 1; o < 64; o <<= 1) v += __shfl_xor(v, o);
    return v;
}
__device__ __forceinline__ float grp_sum8(float v) { v += __shfl_xor(v, 1); v += __shfl_xor(v, 2); v += __shfl_xor(v, 4); return v; }
__device__ __forceinline__ float grp_sum4(float v) { v += __shfl_xor(v, 1); v += __shfl_xor(v, 2); return v; }
__device__ __forceinline__ void unpack8(const v4u w, float (&f)[8]) {
#pragma unroll
    for (int i = 0; i < 4; ++i) { f[2 * i] = __uint_as_float(w[i] << 16); f[2 * i + 1] = __uint_as_float(w[i] & 0xffff0000u); }
}
__device__ __forceinline__ v4u pack8(const float (&f)[8]) { v4u o; o.x = pk2(f[0], f[1]); o.y = pk2(f[2], f[3]); o.z = pk2(f[4], f[5]); o.w = pk2(f[6], f[7]); return o; }

__device__ __forceinline__ int t5_bucket(int rel) {
    const int base = rel > 0 ? 16 : 0; const int n = rel < 0 ? -rel : rel;
    const float nf = (float)(n > 1 ? n : 1);
    int large = 8 + (int)(logf(nf * 0.125f) / 2.772588722239781f * 8.0f + 1e-4f);
    large = large < 15 ? large : 15;
    return base + (n < 8 ? n : large);
}

template <class RowMap>
__device__ __forceinline__ void p0_transpose_item(const float* W, int K, int N, bf16* WT, const float* gain, LAS float* scr, int item, int lane, RowMap rowmap) {
    const int nblk = N / 32, kb = item / nblk, nb = item % nblk, k0 = 64 * kb, n0 = 32 * nb;
#pragma unroll 4
    for (int i = 0; i < 32; ++i) { const int kk = 2 * i + (lane >> 5); const float g = gain ? gain[k0 + kk] : 1.0f; scr[kk * 33 + (lane & 31)] = g * W[(size_t)(k0 + kk) * N + n0 + (lane & 31)]; }
    LDS_WAIT(); asm volatile("" ::: "memory");
    const int c = lane & 7;
#pragma unroll
    for (int j = 0; j < 4; ++j) { const int n = (lane >> 3) + 8 * j; const LAS float* s = scr + (8 * c) * 33 + n;
        v4u o; o.x = pk2(s[0 * 33], s[1 * 33]); o.y = pk2(s[2 * 33], s[3 * 33]); o.z = pk2(s[4 * 33], s[5 * 33]); o.w = pk2(s[6 * 33], s[7 * 33]);
        *(GAS v4u*)(WT + (size_t)rowmap(n0 + n) * K + k0 + 8 * c) = o; }
    LDS_WAIT(); asm volatile("" ::: "memory");
}
struct RowId { __device__ __forceinline__ int operator()(int n) const { return n; } };
struct RowG64 { __device__ __forceinline__ int operator()(int n) const { return (n & ~255) + 128 * ((n >> 5) & 1) + 32 * ((n >> 6) & 3) + (n & 31); } };
struct RowQB { __device__ __forceinline__ int operator()(int n) const { const int h = n / 96, dd = n % 96; return dd < 64 ? (h >> 2) * 256 + 128 * (dd >> 5) + 32 * (h & 3) + (dd & 31) : 512 + 128 * (h & 1) + 32 * (h >> 1) + (dd - 64); } };
struct RowGU { int up; __device__ __forceinline__ int operator()(int n) const { return (n >> 7) * 256 + up * 128 + (n & 127); } };

template <class RowMap>
__device__ __forceinline__ void p0_transpose_item_f8(const float* W, int K, int N, unsigned char* WT, float wscale, LAS float* scr, int item, int lane, RowMap rowmap) {
    const int nblk = N / 32, kb = item / nblk, nb = item % nblk, k0 = 64 * kb, n0 = 32 * nb;
#pragma unroll 4
    for (int i = 0; i < 32; ++i) { const int kk = 2 * i + (lane >> 5); scr[kk * 33 + (lane & 31)] = wscale * W[(size_t)(k0 + kk) * N + n0 + (lane & 31)]; }
    LDS_WAIT(); asm volatile("" ::: "memory");
    const int c = lane & 3;
#pragma unroll
    for (int j = 0; j < 2; ++j) { const int n = (lane >> 2) + 16 * j; const LAS float* s = scr + (16 * c) * 33 + n;
        v4u o; o.x = pg8::pk4_fp8(s[0 * 33], s[1 * 33], s[2 * 33], s[3 * 33]); o.y = pg8::pk4_fp8(s[4 * 33], s[5 * 33], s[6 * 33], s[7 * 33]);
        o.z = pg8::pk4_fp8(s[8 * 33], s[9 * 33], s[10 * 33], s[11 * 33]); o.w = pg8::pk4_fp8(s[12 * 33], s[13 * 33], s[14 * 33], s[15 * 33]);
        *(GAS v4u*)(WT + (size_t)rowmap(n0 + n) * K + k0 + 16 * c) = o; }
    LDS_WAIT(); asm volatile("" ::: "memory");
}
__device__ __forceinline__ void p0_prologue(Frame& F) {
    LAS float* scr = (LAS float*)(F.lds + RING_OFF + F.wave * 16384);
    const int gw = F.vcu * NWAVES + F.wave, NGW = F.G * NWAVES;
    constexpr int I_IN = (DM / 64) * (INW / 32), I_QB = (QL / 64) * (BH * QKD / 32), I_KVB = (KVL / 64) * (BH * 128 / 32), I_O = (DM / 64) * (DM / 32), I_E = (DM / 64) * (FF / 32);
    constexpr int NITEMS = I_IN + I_QB + I_KVB + I_O + NE * 3 * I_E;
    bf16* Win_t = WSP(bf16, WS_WIN); bf16* Wqb_t = WSP(bf16, WS_WQB); bf16* Wkvb_t = WSP(bf16, WS_WKVB); bf16* Wo_t = WSP(bf16, WS_WO); bf16* Wgu_t = WSP(bf16, WS_WGU); bf16* Wd_t = WSP(bf16, WS_WD);
    const int nitems = (F.G == 256) ? NITEMS - NE * 3 * I_E : NITEMS;
    for (int it = gw; it < nitems; it += NGW) {
        int r = it;
        if (r < I_IN) { p0_transpose_item(F.in[3], DM, INW, Win_t, F.in[2], scr, r, lane_id(), RowG64{}); continue; } r -= I_IN;
        if (r < I_QB) { p0_transpose_item(F.in[8], QL, BH * QKD, Wqb_t, F.in[7], scr, r, lane_id(), RowQB{}); continue; } r -= I_QB;
        if (r < I_KVB) { p0_transpose_item(F.in[10], KVL, BH * 128, Wkvb_t, F.in[9], scr, r, lane_id(), RowG64{}); continue; } r -= I_KVB;
        if (r < I_O) { const int kb = r / (DM / 32); const float* g = (kb < 8) ? F.in[15] : (F.in[16] - 512);
            p0_transpose_item(F.in[17], DM, DM, Wo_t, g, scr, r, lane_id(), RowId{}); continue; } r -= I_O;
        const int e = r / (3 * I_E), q = r % (3 * I_E), which = q / I_E, item = q % I_E;
        if (which == 0) p0_transpose_item_f8(F.in[20] + (size_t)e * DM * FF, DM, FF, (unsigned char*)Wgu_t + (size_t)e * 2 * FF * DM, 32.0f, scr, item, lane_id(), RowGU{0});
        else if (which == 1) p0_transpose_item_f8(F.in[21] + (size_t)e * DM * FF, DM, FF, (unsigned char*)Wgu_t + (size_t)e * 2 * FF * DM, 32.0f, scr, item, lane_id(), RowGU{1});
        else p0_transpose_item_f8(F.in[22] + (size_t)e * FF * DM, FF, DM, (unsigned char*)Wd_t + (size_t)e * DM * FF, 16.0f, scr, item, lane_id(), RowId{});
    }
    { const int nchunk = (NZ - INW) * DM / 8; for (int c = gw * 64 + lane_id(); c < nchunk; c += NGW * 64) { const int n = INW + c / (DM / 8), k8 = c % (DM / 8); *(GAS v4u*)(Win_t + (size_t)RowG64{}(n) * DM + (size_t)k8 * 8) = (v4u){0u, 0u, 0u, 0u}; } }
    bf16* XN = WSP(bf16, WS_XN);
    for (int m = gw; m < T; m += NGW) {
        const GAS f32x4* xr = (const GAS f32x4*)(F.in[0] + (size_t)m * DM) + lane_id();
        f32x4 v[4]; float s = 0.f;
#pragma unroll
        for (int j = 0; j < 4; ++j) { v[j] = xr[64 * j]; s += (v[j].x * v[j].x + v[j].y * v[j].y) + (v[j].z * v[j].z + v[j].w * v[j].w); }
        const float rs = 1.0f / sqrtf(wave_sum(s) * (1.f / DM) + EPS);
        GAS unsigned long long* o8 = (GAS unsigned long long*)(XN + (size_t)m * DM) + lane_id();
#pragma unroll
        for (int j = 0; j < 4; ++j) o8[64 * j] = (unsigned long long)pk2(v[j].x * rs, v[j].y * rs) | ((unsigned long long)pk2(v[j].z * rs, v[j].w * rs) << 32);
    }
    float* TAB = WSP(float, WS_TAB);
    if (blockIdx.x == 0) {
        const float* rel_bias = F.in[1];
        for (int i = (F.wave * 64 + lane_id()); i < 8 * NTAB; i += NWAVES * 64) { const int h = i / NTAB, rel = i % NTAB - 128; TAB[TAB_BIAS + i] = rel_bias[t5_bucket(rel) * A_HEADS + h] * LOG2E; }
        if (F.wave == 0) {
            const float ga = fabsf(F.in[4][lane_id()] * F.in[5][lane_id()]); float mb = 0.f; for (int i = lane_id(); i < 32 * 8; i += 64) mb = fmaxf(mb, rel_bias[i]);
            const float gb = fabsf(F.in[11][lane_id()] * F.in[13][lane_id()]); const float gqr = (lane_id() < 32) ? fabsf(F.in[12][lane_id()]) : 0.f, gkr = (lane_id() < 32) ? fabsf(F.in[14][lane_id()]) : 0.f;
            float mga = ga, mgb = gb, mqr = gqr, mkr = gkr;
#pragma unroll
            for (int o = 1; o < 64; o <<= 1) { mga = fmaxf(mga, __shfl_xor(mga, o)); mgb = fmaxf(mgb, __shfl_xor(mgb, o)); mqr = fmaxf(mqr, __shfl_xor(mqr, o)); mkr = fmaxf(mkr, __shfl_xor(mkr, o)); mb = fmaxf(mb, __shfl_xor(mb, o)); }
            if (lane_id() == 0) { TAB[TAB_CONST + 0] = (8.0f * mga + mb) * LOG2E + 1.0f; TAB[TAB_CONST + 1] = 0.10206207261596577f * (64.f * mgb + 32.f * mqr * mkr) * LOG2E + 1.0f; }
        }
    }
    for (int i = gw * 64 + lane_id(); i < SEQ * 16; i += NGW * 64) { const int s = i >> 4, k = i & 15; const float freq = powf(10000.0f, -(float)(2 * k) / 32.0f); const float ang = (float)s * freq;
        TAB[TAB_COS + i] = cosf(ang); TAB[TAB_SIN + i] = sinf(ang); }
}

__device__ __forceinline__ void p2_fixup(Frame& F) {
    const int gw = F.vcu * NWAVES + F.wave, NGW = F.G * NWAVES; const int lane = lane_id();
    const bf16* Z = WSP(bf16, WS_Z); bf16* QA = WSP(bf16, WS_QA); bf16* KA = WSP(bf16, WS_KA); bf16* VA = WSP(bf16, WS_VA); bf16* CQ = WSP(bf16, WS_CQ); bf16* CKV = WSP(bf16, WS_CKV); bf16* KR = WSP(bf16, WS_KR);
    const float* TAB = WSP(float, WS_TAB);
    const float* gq = F.in[4]; const float* gk = F.in[5]; const float* gkr = F.in[14];
    float gqv[8], gkv[8], gkrv[8];
#pragma unroll
    for (int j = 0; j < 8; ++j) { gqv[j] = gq[(8 * lane) % 64 + j]; gkv[j] = gk[(8 * lane) % 64 + j]; gkrv[j] = gkr[(8 * lane) % 32 + j]; }
    for (int m = gw; m < T; m += NGW) {
        const bf16* zr = Z + (size_t)m * NZ; const int s = m % SEQ; float f[8], o[8];
        { unpack8(*(const GAS v4u*)(zr + 8 * lane), f); float ss = 0.f;
#pragma unroll
          for (int j = 0; j < 8; ++j) ss += f[j] * f[j];
          const float r = QSC_A / sqrtf(grp_sum8(ss) * (1.f / 64.f) + EPS);
#pragma unroll
          for (int j = 0; j < 8; ++j) o[j] = f[j] * r * gqv[j];
          *(GAS v4u*)(QA + (size_t)m * 512 + 8 * lane) = pack8(o); }
        { const int l2 = lane & 31; const v4u w = *(const GAS v4u*)(zr + 512 + 8 * l2); unpack8(w, f); float ss = 0.f;
#pragma unroll
          for (int j = 0; j < 8; ++j) ss += f[j] * f[j];
          const float r = 1.0f / sqrtf(grp_sum8(ss) * (1.f / 64.f) + EPS);
#pragma unroll
          for (int j = 0; j < 8; ++j) o[j] = f[j] * r * gkv[j];
          if (lane < 16) *(GAS v4u*)(KA + (size_t)m * 128 + 8 * lane) = pack8(o);
          else if (lane < 32) *(GAS v4u*)(VA + (size_t)m * 128 + 8 * (lane - 16)) = w; }
        { const int l2 = lane < 48 ? lane : 0; unpack8(*(const GAS v4u*)(zr + 768 + 8 * l2), f); float ss = 0.f;
#pragma unroll
          for (int j = 0; j < 8; ++j) ss += f[j] * f[j];
          if (lane >= 48) ss = 0.f;
          const float r = 1.0f / sqrtf(wave_sum(ss) * (1.f / 384.f) + EPS);
#pragma unroll
          for (int j = 0; j < 8; ++j) o[j] = f[j] * r;
          if (lane < 48) *(GAS v4u*)(CQ + (size_t)m * QL + 8 * lane) = pack8(o); }
        { const int l2 = lane & 31; unpack8(*(const GAS v4u*)(zr + 1152 + 8 * l2), f); float ss = 0.f;
#pragma unroll
          for (int j = 0; j < 8; ++j) ss += f[j] * f[j];
          if (lane >= 32) ss = 0.f;
          const float r = 1.0f / sqrtf(wave_sum(ss) * (1.f / 256.f) + EPS);
#pragma unroll
          for (int j = 0; j < 8; ++j) o[j] = f[j] * r;
          if (lane < 32) *(GAS v4u*)(CKV + (size_t)m * KVL + 8 * lane) = pack8(o); }
        { const int l2 = lane & 3; unpack8(*(const GAS v4u*)(zr + 1408 + 8 * l2), f); float ss = 0.f;
#pragma unroll
          for (int j = 0; j < 8; ++j) ss += f[j] * f[j];
          const float r = 1.0f / sqrtf(grp_sum4(ss) * (1.f / 32.f) + EPS);
#pragma unroll
          for (int j = 0; j < 8; ++j) { const float y = f[j] * r * gkrv[j]; const float p = __shfl_xor(y, 2); const int i = (8 * l2 + j) & 15;
              const float c = TAB[TAB_COS + s * 16 + i], sn = TAB[TAB_SIN + s * 16 + i];
              o[j] = (l2 < 2) ? (y * c - p * sn) : (p * sn + y * c); }
          if (lane < 4) *(GAS v4u*)(KR + (size_t)m * ROPE + 8 * lane) = pack8(o); }
    }
}

__device__ __forceinline__ void p4_fixup(Frame& F) {
    const int gw = F.vcu * NWAVES + F.wave, NGW = F.G * NWAVES; const int lane = lane_id();
    bf16* QB = WSP(bf16, WS_QB); const bf16* KVR = WSP(bf16, WS_KVRAW); bf16* KBN = WSP(bf16, WS_KBN); bf16* VB = WSP(bf16, WS_VB);
    const float* TAB = WSP(float, WS_TAB);
    float gqn[8], gkn[8], gqr[8];
#pragma unroll
    for (int j = 0; j < 8; ++j) { gqn[j] = F.in[11][8 * (lane & 7) + j]; gkn[j] = F.in[13][8 * (lane & 7) + j]; gqr[j] = F.in[12][8 * (lane & 3) + j]; }
    for (int m = gw; m < T; m += NGW) {
        const int s = m % SEQ; float f[8], o[8];
        bf16* qrow = QB + (size_t)m * (BH * QKD);
        { bf16* p = qrow + QKD * (lane >> 3) + 8 * (lane & 7); unpack8(*(const GAS v4u*)p, f); float ss = 0.f;
#pragma unroll
          for (int j = 0; j < 8; ++j) ss += f[j] * f[j];
          const float r = QSC_B / sqrtf(grp_sum8(ss) * (1.f / 64.f) + EPS);
#pragma unroll
          for (int j = 0; j < 8; ++j) o[j] = f[j] * r * gqn[j];
          *(GAS v4u*)p = pack8(o); }
        { const int l2 = lane & 31; bf16* p = qrow + QKD * (l2 >> 2) + NOPE + 8 * (l2 & 3); unpack8(*(const GAS v4u*)p, f); float ss = 0.f;
#pragma unroll
          for (int j = 0; j < 8; ++j) ss += f[j] * f[j];
          const float r = 1.0f / sqrtf(grp_sum4(ss) * (1.f / 32.f) + EPS);
#pragma unroll
          for (int j = 0; j < 8; ++j) { const float y = f[j] * r * gqr[j]; const float pp = __shfl_xor(y, 2); const int i = (8 * (l2 & 3) + j) & 15;
              const float c = TAB[TAB_COS + s * 16 + i], sn = TAB[TAB_SIN + s * 16 + i];
              o[j] = QSC_B * (((l2 & 3) < 2) ? (y * c - pp * sn) : (pp * sn + y * c)); }
          if (lane < 32) *(GAS v4u*)p = pack8(o); }
        { const bf16* p = KVR + (size_t)m * 1024 + 128 * (lane >> 3) + 8 * (lane & 7); unpack8(*(const GAS v4u*)p, f); float ss = 0.f;
#pragma unroll
          for (int j = 0; j < 8; ++j) ss += f[j] * f[j];
          const float r = 1.0f / sqrtf(grp_sum8(ss) * (1.f / 64.f) + EPS);
#pragma unroll
          for (int j = 0; j < 8; ++j) o[j] = f[j] * r * gkn[j];
          *(GAS v4u*)(KBN + (size_t)m * 512 + 64 * (lane >> 3) + 8 * (lane & 7)) = pack8(o);
          *(GAS v4u*)(VB + (size_t)m * 512 + 64 * (lane >> 3) + 8 * (lane & 7)) = *(const GAS v4u*)(p + 64); }
    }
}

__device__ __forceinline__ void p6_onorm(Frame& F) {
    const int gw = F.vcu * NWAVES + F.wave, NGW = F.G * NWAVES; const int lane = lane_id();
    bf16* O = WSP(bf16, WS_O);
    for (int m = gw; m < T; m += NGW) {
#pragma unroll
        for (int hf = 0; hf < 2; ++hf) { bf16* p = O + (size_t)m * DM + 512 * hf + 8 * lane; float f[8], o[8]; unpack8(*(const GAS v4u*)p, f); float ss = 0.f;
#pragma unroll
            for (int j = 0; j < 8; ++j) ss += f[j] * f[j];
            const float r = 1.0f / sqrtf(wave_sum(ss) * (1.f / 512.f) + EPS);
#pragma unroll
            for (int j = 0; j < 8; ++j) o[j] = f[j] * r;
            *(GAS v4u*)p = pack8(o); }
    }
}

__device__ __forceinline__ float red16(float (&v)[16], int lane) {
    const bool b5 = lane & 32, b4 = lane & 16, b3 = lane & 8, b2 = lane & 4; float w8[8], w4[4], w2[2];
#pragma unroll
    for (int i = 0; i < 8; ++i) { const float mine = b5 ? v[8 + i] : v[i], oth = b5 ? v[i] : v[8 + i]; w8[i] = mine + __shfl_xor(oth, 32); }
#pragma unroll
    for (int i = 0; i < 4; ++i) { const float mine = b4 ? w8[4 + i] : w8[i], oth = b4 ? w8[i] : w8[4 + i]; w4[i] = mine + __shfl_xor(oth, 16); }
#pragma unroll
    for (int i = 0; i < 2; ++i) { const float mine = b3 ? w4[2 + i] : w4[i], oth = b3 ? w4[i] : w4[2 + i]; w2[i] = mine + __shfl_xor(oth, 8); }
    const float mine = b2 ? w2[1] : w2[0], oth = b2 ? w2[0] : w2[1]; float y = mine + __shfl_xor(oth, 4);
    y += __shfl_xor(y, 1); y += __shfl_xor(y, 2); return y;
}
__device__ __forceinline__ void p8_router(Frame& F) {
    const int gw = F.vcu * NWAVES + F.wave, NGW = F.G * NWAVES; const int lane = lane_id();
    unsigned char* H2 = WSP(unsigned char, WS_H2); float* AFF = WSP(float, WS_AFF); const bf16* ATT = WSP(bf16, WS_ATT); bf16* X1B = WSP(bf16, WS_X1B);
    const float* g2 = F.in[18]; const float* wr = F.in[19];
    LAS float* wl = (LAS float*)(F.lds + RING_OFF);
    __syncthreads();
    for (int i = (F.wave * 64 + lane_id()); i < DM * NE; i += NWAVES * 64) wl[(i & 15) * DM + (i >> 4)] = wr[i];
    __syncthreads();
    const LAS float* wlane = wl + 4 * lane;
    for (int m = gw; m < T; m += NGW) {
        f32x4 x[4]; float ss = 0.f;
#pragma unroll
        for (int k = 0; k < 4; ++k) { x[k] = *(const GAS f32x4*)(F.in[0] + (size_t)m * DM + 4 * lane + 256 * k); const unsigned long long aw = *(const GAS unsigned long long*)(ATT + (size_t)m * DM + 4 * lane + 256 * k);
            const unsigned alo = (unsigned)aw, ahi = (unsigned)(aw >> 32); x[k].x += __uint_as_float(alo << 16); x[k].y += __uint_as_float(alo & 0xffff0000u); x[k].z += __uint_as_float(ahi << 16); x[k].w += __uint_as_float(ahi & 0xffff0000u);
            ss += (x[k].x * x[k].x + x[k].y * x[k].y) + (x[k].z * x[k].z + x[k].w * x[k].w); }
        const float rs = __builtin_amdgcn_rsqf(wave_sum(ss) * (1.f / DM) + EPS);
#pragma unroll
        for (int k = 0; k < 4; ++k) { const f32x4 g = *(const GAS f32x4*)(g2 + 4 * lane + 256 * k);
            *(GAS unsigned long long*)(X1B + (size_t)m * DM + 4 * lane + 256 * k) = (unsigned long long)pk2(x[k].x, x[k].y) | ((unsigned long long)pk2(x[k].z, x[k].w) << 32);
            x[k].x *= rs * g.x; x[k].y *= rs * g.y; x[k].z *= rs * g.z; x[k].w *= rs * g.w;
            *(GAS unsigned*)(H2 + (size_t)m * DM + 4 * lane + 256 * k) = pg8::pk4_fp8(32.0f * x[k].x, 32.0f * x[k].y, 32.0f * x[k].z, 32.0f * x[k].w); }
        float lg[16];
#pragma unroll
        for (int e = 0; e < 16; ++e) { float a0 = 0.f;
#pragma unroll
            for (int k = 0; k < 4; ++k) { const f32x4 w = *(const LAS f32x4*)(wlane + e * DM + 256 * k); a0 += (x[k].x * w.x + x[k].y * w.y) + (x[k].z * w.z + x[k].w * w.w); }
            lg[e] = a0; if ((e & 3) == 3) asm volatile("" ::: "memory"); }
        const float y = red16(lg, lane); float mx = y;
#pragma unroll
        for (int o = 4; o < 64; o <<= 1) mx = fmaxf(mx, __shfl_xor(mx, o));
        const float ex = __builtin_amdgcn_exp2f((y - mx) * LOG2E); float den = ex;
#pragma unroll
        for (int o = 4; o < 64; o <<= 1) den += __shfl_xor(den, o);
        if ((lane & 3) == 0) AFF[((size_t)(m / SEQ) * NE + ((lane >> 2) & 15)) * SEQ + (m % SEQ)] = ex / den;
    }
    __syncthreads();
}

__device__ __forceinline__ int block_excl_scan(int v, LAS int* tmp, int tid, int lane, int wave, int& total) {
    int inc = v;
#pragma unroll
    for (int o = 1; o < 64; o <<= 1) { const int t = __shfl_up(inc, o); if (lane >= o) inc += t; }
    if (lane == 63) tmp[wave] = inc;
    __syncthreads();
    int base = 0, tot = 0;
#pragma unroll
    for (int w = 0; w < NWAVES; ++w) { const int t = tmp[w]; if (w < wave) base += t; tot += t; }
    __syncthreads();
    total = tot; return base + inc - v;
}
__device__ __forceinline__ void p9_topk(Frame& F) {
    LAS unsigned* keys = (LAS unsigned*)(F.lds + RING_OFF);
    LAS unsigned* hist = keys + SEQ;
    LAS int* tmp = (LAS int*)(hist + 256);
    LAS unsigned* res = (LAS unsigned*)(tmp + 16);
    const int lane = lane_id(), wave = F.wave, tid = wave * 64 + lane;
    const float* AFF = WSP(float, WS_AFF); int* IDX = WSP(int, WS_IDX); float* GATEV = WSP(float, WS_GATEV); int* SLOT = WSP(int, WS_SLOT);
    for (int item = blockIdx.x; item < BATCH * NE; item += F.G) {
        const int b = item / NE, e = item % NE; const float* a = AFF + (size_t)item * SEQ;
        __syncthreads();
#pragma unroll
        for (int i = 0; i < 8; ++i) keys[tid + 512 * i] = __float_as_uint(a[tid + 512 * i]);
        __syncthreads();
        unsigned kk[8];
#pragma unroll
        for (int i = 0; i < 8; ++i) kk[i] = keys[8 * tid + i];
        LAS int* cnt2 = tmp;
#define P9_COUNT(v, step, out) do { int c_ = 0; _Pragma("unroll") for (int i = 0; i < 8; ++i) c_ += (int)__popcll(__ballot(kk[i] >= (v))); \
            if (lane == 0) cnt2[((step) & 1) * 8 + wave] = c_; __syncthreads(); int s_ = 0; _Pragma("unroll") for (int w = 0; w < NWAVES; ++w) s_ += cnt2[((step) & 1) * 8 + w]; out = s_; } while (0)
        unsigned prefix = 0u; int step = 0;
        for (int bit = 29; bit >= 0; --bit) { const unsigned cand = prefix | (1u << bit); int c; P9_COUNT(cand, step, c); ++step; if (c >= CAP) prefix = cand; }
        int cgt; P9_COUNT(prefix + 1u, step, cgt); ++step;
        int remaining = CAP - cgt;
        __syncthreads();
#undef P9_COUNT
        int neq = 0;
#pragma unroll
        for (int i = 0; i < 8; ++i) neq += (kk[i] == prefix) ? 1 : 0;
        int toteq; int eqbase = block_excl_scan(neq, tmp, tid, lane, wave, toteq);
        int sel[8]; int nsel = 0;
#pragma unroll
        for (int i = 0; i < 8; ++i) { const bool eq = kk[i] == prefix; sel[i] = (kk[i] > prefix || (eq && eqbase < remaining)) ? 1 : 0; eqbase += eq ? 1 : 0; nsel += sel[i]; }
        int totsel; int slot = block_excl_scan(nsel, tmp, tid, lane, wave, totsel);
        const size_t rbase = (size_t)(e * BATCH + b) * CAP;
#pragma unroll
        for (int i = 0; i < 8; ++i) { const int s = 8 * tid + i;
            if (sel[i]) { if (slot < CAP) { IDX[rbase + slot] = b * SEQ + s; GATEV[rbase + slot] = __uint_as_float(kk[i]); } SLOT[(size_t)item * SEQ + s] = slot < CAP ? slot : -1; ++slot; }
            else SLOT[(size_t)item * SEQ + s] = -1; }
    }
}

__device__ __forceinline__ void p9b_gather(Frame& F) {
    const int gw = F.vcu * NWAVES + F.wave, NGW = F.G * NWAVES; const int lane = lane_id();
    const unsigned char* H2 = WSP(unsigned char, WS_H2); unsigned char* XE = WSP(unsigned char, WS_XE); const int* IDX = WSP(int, WS_IDX);
    for (int r = gw * 2; r < MX; r += NGW * 2) { const int tok0 = IDX[r], tok1 = IDX[r + 1];
        const v4u a = *((const GAS v4u*)(H2 + (size_t)tok0 * DM) + lane), b = *((const GAS v4u*)(H2 + (size_t)tok1 * DM) + lane);
        *((GAS v4u*)(XE + (size_t)r * DM) + lane) = a; *((GAS v4u*)(XE + (size_t)(r + 1) * DM) + lane) = b; }
}

__device__ __forceinline__ void p12_combine(Frame& F) {
    const int gw = F.vcu * NWAVES + F.wave, NGW = F.G * NWAVES; const int lane = lane_id();
    const unsigned char* YE = WSP(unsigned char, WS_YE); const int* SLOT = WSP(int, WS_SLOT); const bf16* X1B = WSP(bf16, WS_X1B);
    typedef float f32x2v __attribute__((ext_vector_type(2)));
    for (int m = gw; m < T; m += NGW) {
        const int b = m / SEQ, s = m % SEQ;
        const int sl = (lane < NE) ? SLOT[((size_t)b * NE + lane) * SEQ + s] : -1;
        unsigned long long mask = __ballot(sl >= 0);
        GAS f32x4* xr = (GAS f32x4*)(F.out + (size_t)m * DM) + lane; const GAS unsigned long long* x1 = (const GAS unsigned long long*)(X1B + (size_t)m * DM) + lane;
        f32x4 v[4];
#pragma unroll
        for (int j = 0; j < 4; ++j) { const unsigned long long aw = x1[64 * j]; const unsigned alo = (unsigned)aw, ahi = (unsigned)(aw >> 32);
            v[j].x = __uint_as_float(alo << 16); v[j].y = __uint_as_float(alo & 0xffff0000u); v[j].z = __uint_as_float(ahi << 16); v[j].w = __uint_as_float(ahi & 0xffff0000u); }
        f32x4 a[4];
#pragma unroll
        for (int j = 0; j < 4; ++j) a[j] = (f32x4){0.f, 0.f, 0.f, 0.f};
        while (mask) { const int e = __builtin_ctzll(mask); mask &= mask - 1; const int slot = __shfl(sl, e);
            const GAS unsigned* yr = (const GAS unsigned*)(YE + ((size_t)(e * BATCH + b) * CAP + slot) * DM) + lane;
#pragma unroll
            for (int j = 0; j < 4; ++j) { const int w = (int)yr[64 * j]; const f32x2v lo = __builtin_amdgcn_cvt_pk_f32_fp8(w, false), hi = __builtin_amdgcn_cvt_pk_f32_fp8(w, true);
                a[j].x += lo.x; a[j].y += lo.y; a[j].z += hi.x; a[j].w += hi.y; } }
#pragma unroll
        for (int j = 0; j < 4; ++j) xr[64 * j] = v[j] + a[j] * (1.0f / 64.0f);
    }
}


#ifndef MLA_UNIT
#define MLA_UNIT mla_unit2
#endif
namespace att {
using bf16x8 = __attribute__((ext_vector_type(8))) short;
using s16x4 = __attribute__((ext_vector_type(4))) short;
using f32x16 = __attribute__((ext_vector_type(16))) float;
using u32x4 = __attribute__((ext_vector_type(4))) unsigned;
constexpr int KSLOT = 12288, VSLOT = 8192, NSLOT = 3;
constexpr int LK = 0, LV = NSLOT * KSLOT, LWS = LV + NSLOT * VSLOT, LTAB = LWS + NWAVES * 256, ATT_LDS = LTAB + 4 * 512 * 4;
constexpr int CV_F32 = ATT_LDS, CV_F8 = CV_F32 + NWAVES * 2048, CV_END = CV_F8 + NWAVES * 2176;
static_assert(CV_END <= RING_BYTES, "attention LDS");
struct ConvJob { int item0; };
__device__ __forceinline__ int crow(int r, int hi) { return (r & 3) + 8 * (r >> 2) + 4 * hi; }
__device__ __forceinline__ void glds16(const void* gsrc, unsigned lds_dst) { unsigned keep;
    asm volatile("s_mov_b32 %0, m0\n\ts_mov_b32 m0, %2\n\ts_nop 0\n\tglobal_load_lds_dwordx4 %1, off\n\ts_mov_b32 m0, %0" : "=&s"(keep) : "v"(gsrc), "s"(lds_dst) : "memory"); }
__device__ __forceinline__ void glds16s(const void* sbase, unsigned voff, unsigned lds_dst) { unsigned keep;
    asm volatile("s_mov_b32 %0, m0\n\ts_mov_b32 m0, %3\n\ts_nop 0\n\tglobal_load_lds_dwordx4 %1, %2\n\ts_mov_b32 m0, %0" : "=&s"(keep) : "v"(voff), "s"(sbase), "s"(lds_dst) : "memory"); }
__device__ __forceinline__ void glds16s_nt(const void* sbase, unsigned voff, unsigned lds_dst) { unsigned keep;
    asm volatile("s_mov_b32 %0, m0\n\ts_mov_b32 m0, %3\n\ts_nop 0\n\tglobal_load_lds_dwordx4 %1, %2 nt\n\ts_mov_b32 m0, %0" : "=&s"(keep) : "v"(voff), "s"(sbase), "s"(lds_dst) : "memory"); }
__device__ __forceinline__ const bf16* sptr(const bf16* p) { const unsigned long long a = (unsigned long long)p; const unsigned lo = (unsigned)__builtin_amdgcn_readfirstlane((int)(unsigned)a), hi = (unsigned)__builtin_amdgcn_readfirstlane((int)(unsigned)(a >> 32)); return (const bf16*)(((unsigned long long)hi << 32) | lo); }
__device__ __forceinline__ unsigned rfl(unsigned v) { return (unsigned)__builtin_amdgcn_readfirstlane((int)v); }
typedef float f32x2_t __attribute__((ext_vector_type(2))); typedef __bf16 bf16x2_t __attribute__((ext_vector_type(2)));
__device__ __forceinline__ unsigned cvtpk(float lo, float hi) { f32x2_t v = {lo, hi}; bf16x2_t b = __builtin_convertvector(v, bf16x2_t); return __builtin_bit_cast(unsigned, b); }
#define ATT_SBAR() __builtin_amdgcn_sched_barrier(0)
__device__ __forceinline__ void pv(f32x16* o, int vb, bf16x8 pa0, bf16x8 pa1, bf16x8 pa2, bf16x8 pa3) {
#pragma unroll
    for (int d0 = 0; d0 < 2; ++d0) { s16x4 lo[4], hi[4];
#pragma unroll
        for (int ks = 0; ks < 4; ++ks) {
            asm volatile("ds_read_b64_tr_b16 %0,%1 offset:%c2" : "=&v"(lo[ks]) : "v"(vb), "i"(d0 * 4096 + ks * 1024) : "memory");
            asm volatile("ds_read_b64_tr_b16 %0,%1 offset:%c2" : "=&v"(hi[ks]) : "v"(vb), "i"(d0 * 4096 + ks * 1024 + 512) : "memory"); }
        asm volatile("s_waitcnt lgkmcnt(0)" ::: "memory"); ATT_SBAR();
#define ATT_PK(k) (bf16x8){lo[k][0], lo[k][1], lo[k][2], lo[k][3], hi[k][0], hi[k][1], hi[k][2], hi[k][3]}
        o[d0] = __builtin_amdgcn_mfma_f32_32x32x16_bf16(pa0, ATT_PK(0), o[d0], 0, 0, 0);
        o[d0] = __builtin_amdgcn_mfma_f32_32x32x16_bf16(pa1, ATT_PK(1), o[d0], 0, 0, 0);
        o[d0] = __builtin_amdgcn_mfma_f32_32x32x16_bf16(pa2, ATT_PK(2), o[d0], 0, 0, 0);
        o[d0] = __builtin_amdgcn_mfma_f32_32x32x16_bf16(pa3, ATT_PK(3), o[d0], 0, 0, 0);
#undef ATT_PK
    }
}
__device__ __forceinline__ void ssq_accum(const float (&part)[16], int le, float* ssq) {
    const bool b4 = le & 16, b3 = le & 8, b2 = le & 4, b1 = le & 2; float p8[8], p4[4], p2[2];
#pragma unroll
    for (int i = 0; i < 8; ++i) { const float mine = b4 ? part[8 + i] : part[i], oth = b4 ? part[i] : part[8 + i]; p8[i] = mine + __shfl_xor(oth, 16); }
#pragma unroll
    for (int i = 0; i < 4; ++i) { const float mine = b3 ? p8[4 + i] : p8[i], oth = b3 ? p8[i] : p8[4 + i]; p4[i] = mine + __shfl_xor(oth, 8); }
#pragma unroll
    for (int i = 0; i < 2; ++i) { const float mine = b2 ? p4[2 + i] : p4[i], oth = b2 ? p4[i] : p4[2 + i]; p2[i] = mine + __shfl_xor(oth, 4); }
    const float mine = b1 ? p2[1] : p2[0], oth = b1 ? p2[0] : p2[1]; float y = mine + __shfl_xor(oth, 2);
    y += __shfl_xor(y, 1);
    const int r = (b4 ? 8 : 0) + (b3 ? 4 : 0) + (b2 ? 2 : 0) + (b1 ? 1 : 0);
    if ((le & 1) == 0) atomicAdd(ssq + 2 * crow(r, le >> 5), y);
}
#define ATT_WAIT_BAR(N) asm volatile("s_waitcnt vmcnt(" #N ") lgkmcnt(0)\n\ts_barrier" ::: "memory")
__device__ __forceinline__ u32x4 pack_p(const f32x16& p, int base) { u32x4 w; w.x = cvtpk(p[base], p[base + 1]); w.y = cvtpk(p[base + 2], p[base + 3]); w.z = cvtpk(p[base + 4], p[base + 5]); w.w = cvtpk(p[base + 6], p[base + 7]); return w; }

typedef __attribute__((address_space(3))) const char* lds_cptr;
typedef short v4i16_t __attribute__((ext_vector_type(4)));
__device__ __forceinline__ s16x4 vtr(lds_cptr p) { return __builtin_bit_cast(s16x4, __builtin_amdgcn_ds_read_tr16_b64_v4i16((__attribute__((address_space(3))) v4i16_t*)p)); }
__device__ __forceinline__ void mla_unit2(LAS unsigned char* lds, int b, int h, int qb, const bf16* QB, const unsigned char* QN8, const unsigned char* KN8, const bf16* KR, const bf16* VB, bf16* O, float* SSQ, bool shift, float nb, const ConvJob cj, int wid, int lane) {
    const int r32 = lane & 31, hi = lane >> 5;
    const unsigned lds0 = (unsigned)(uintptr_t)lds;
    const size_t rowb = (size_t)b * SEQ; const int q0 = qb * 256;
    const char* ksrc = (const char*)sptr((const bf16*)((wid < 4) ? (const unsigned char*)(KR + (size_t)(b * 64) * 2048) + (wid & 3) * 1024 : KN8 + (size_t)((b * BH + h) * 64) * 4096 + (wid & 3) * 1024));
    const bf16* vsrc = sptr(VB + (size_t)((b * BH + h) * 64) * 4096 + wid * 512);
    const unsigned kl0 = lane * 16u, vl = kl0;
    constexpr int KS8 = 8192;
    const unsigned kdst = lds0 + LK + ((wid < 4 ? 4 : 0) + (wid & 3)) * 1024, vdst = lds0 + LV + wid * 1024;
#define DMA_K(t, sl) glds16s(ksrc + (size_t)(t) * 4096, kl0, rfl(kdst + (sl) * KS8))
#define DMA_V(t, sl) glds16s(vsrc + (size_t)(t) * 4096, vl, rfl(vdst + (sl) * VSLOT))
#define WAITB(N4, N8) ATT_WAIT_BAR(N8)
    constexpr int NT = SEQ / 64;
    DMA_K(0, 0); DMA_V(0, 0); DMA_K(1, 1); DMA_K(2, 2);
    typedef int v8i32 __attribute__((ext_vector_type(8))); typedef int v4i32 __attribute__((ext_vector_type(4)));
#define CAT8(a_, b_) (v8i32){a_[0], a_[1], a_[2], a_[3], b_[0], b_[1], b_[2], b_[3]}
    const int sK = 0x7c7c7c7c, sQ = 0x79797979;
    v8i32 qn8; bf16x8 qf[2];
    { const unsigned char* qp8 = QN8 + (rowb + q0 + 32 * wid + r32) * (BH * NOPE) + NOPE * h + 32 * hi; const v4i32 a_ = *(const v4i32*)qp8, b_ = *(const v4i32*)(qp8 + 16); qn8 = CAT8(a_, b_);
      const bf16* qp = QB + (rowb + q0 + 32 * wid + r32) * (BH * QKD) + QKD * h + NOPE + 8 * hi;
#pragma unroll
      for (int s = 0; s < 2; ++s) qf[s] = *(const bf16x8*)(qp + 16 * s); }
    f32x16 o[2]; o[0] = f32x16{}; o[1] = f32x16{};
    float l_reg = 0.f;
    const lds_cptr kp0 = (lds_cptr)lds + LK + hi * 2048 + r32 * 16;
    const lds_cptr kr0 = (lds_cptr)lds + LK + 4096 + hi * 1024 + r32 * 16;
    const lds_cptr vp0 = (lds_cptr)lds + LV + ((lane >> 4) & 1) * 32 + (lane & 3) * 8 + (4 * hi + ((lane & 15) >> 2)) * 64;
    v8i32 kf8[2]; bf16x8 kfr[4];
#define KLD8(kp_, kh) do { const v4i32 a_ = *(const __attribute__((address_space(3))) v4i32*)((kp_) + (kh) * 512), b_ = *(const __attribute__((address_space(3))) v4i32*)((kp_) + 1024 + (kh) * 512); kf8[kh] = CAT8(a_, b_); } while (0)
#define KLDR(kp_, i) kfr[i] = *(const __attribute__((address_space(3))) bf16x8*)((kp_) + ((i) >> 1) * 2048 + ((i) & 1) * 512)
#define QKF8(kh) __builtin_amdgcn_mfma_scale_f32_32x32x64_f8f6f4(kf8[kh], qn8, f32x16{}, 0, 0, 0, sK, 0, sQ)
    WAITB(5, 3);
    KLD8(kp0, 0); KLD8(kp0, 1);
#pragma unroll
    for (int i = 0; i < 4; ++i) KLDR(kr0, i);
    f32x16 pA0, pA1, pB0, pB1;
    pA0 = QKF8(0); pA1 = QKF8(1);
#pragma unroll
    for (int s = 0; s < 2; ++s) { pA0 = __builtin_amdgcn_mfma_f32_32x32x16_bf16(kfr[2 * s], qf[s], pA0, 0, 0, 0); pA1 = __builtin_amdgcn_mfma_f32_32x32x16_bf16(kfr[2 * s + 1], qf[s], pA1, 0, 0, 0); }
    if (shift) {
#pragma unroll
        for (int r = 0; r < 16; ++r) { pA0[r] += nb; pA1[r] += nb; } }
#pragma unroll
    for (int r = 0; r < 16; ++r) { pA0[r] = __builtin_amdgcn_exp2f(pA0[r]); pA1[r] = __builtin_amdgcn_exp2f(pA1[r]); }
    WAITB(2, 1);
    DMA_K(3, 0); DMA_V(1, 1);
    KLD8(kp0 + KS8, 0); KLD8(kp0 + KS8, 1);
#pragma unroll
    for (int i = 0; i < 4; ++i) KLDR(kr0 + KS8, i);
    WAITB(3, 2);
    s16x4 vl0, vh0, vl1, vh1, vl2, vh2, vl3, vh3; u32x4 pw0, pw1, pw2, pw3;
    int i_prev = 0, i_cur = 1, i_next = 2;
#define ROT() do { const int t_ = i_prev; i_prev = i_cur; i_cur = i_next; i_next = t_; } while (0)
#define PIN(x) asm volatile("" : "+v"(x))
#define VOFF(i) (((i) >> 2) * 4096 + ((i) & 3) * 1024)
#define VRD(B, i) do { vl##B = vtr(vp_ + VOFF(i)); vh##B = vtr(vp_ + VOFF(i) + 512); } while (0)
#define VFR(B) (bf16x8){vl##B[0], vl##B[1], vl##B[2], vl##B[3], vh##B[0], vh##B[1], vh##B[2], vh##B[3]}
#define PAF(k) __builtin_bit_cast(bf16x8, pw##k)
#define EX(v) __builtin_amdgcn_exp2f(v)
#define QK0(C, kh) C = QKF8(kh)
#define QKN(C, i, s) C = __builtin_amdgcn_mfma_f32_32x32x16_bf16(kfr[i], qf[s], C, 0, 0, 0)
#define KN8(kh) do { if (GL_) { KLD8(kn_, kh); } } while (0)
#define KNR(i) do { if (GL_) { KLDR(krn_, i); } } while (0)
#define ADD4(P, B) do { sacc += P[B]; sacc += P[(B) + 1]; sacc += P[(B) + 2]; sacc += P[(B) + 3]; PIN(sacc); } while (0)
#define CVT2(P, B, PW, W) do { PW[W] = cvtpk(P[B], P[(B) + 1]); PW[(W) + 1] = cvtpk(P[(B) + 2], P[(B) + 3]); PIN(PW); } while (0)
#define GB(MF, RD, E0, E1, E2) do { MF; RD; E0; E1; E2; ATT_SBAR(); } while (0)
#define NOP_ (void)0
#define STEP(C0, C1, P0, P1, t, GK, GV, GL) do { ATT_SBAR(); \
    constexpr bool GL_ = GL; \
    if (GK) { DMA_K((t) + 3, i_cur); } if (GV) { DMA_V((t) + 1, i_next); } \
    const lds_cptr vp_ = vp0 + i_prev * VSLOT; const lds_cptr kn_ = kp0 + i_next * KS8, krn_ = kr0 + i_next * KS8; \
    float sacc = 0.f; \
      \
    QK0(C0, 0); KN8(0); ADD4(P0, 0); CVT2(P0, 0, pw0, 0); ADD4(P0, 4); CVT2(P0, 4, pw0, 2); ATT_SBAR(); \
    QKN(C0, 0, 0); KNR(0); ADD4(P0, 8); CVT2(P0, 8, pw1, 0); ATT_SBAR(); \
    QKN(C0, 2, 1); KNR(2); ADD4(P0, 12); CVT2(P0, 12, pw1, 2); ATT_SBAR(); \
    QK0(C1, 1); KN8(1); ADD4(P1, 0); CVT2(P1, 0, pw2, 0); ADD4(P1, 4); CVT2(P1, 4, pw2, 2); ATT_SBAR(); \
    if (__builtin_expect(shift, 0)) { _Pragma("unroll") for (int r_ = 0; r_ < 16; ++r_) C0[r_] += nb; PIN(C0); } ATT_SBAR(); \
    QKN(C1, 1, 0); KNR(1); ADD4(P1, 8); CVT2(P1, 8, pw3, 0); C0[0] = EX(C0[0]); C0[1] = EX(C0[1]); VRD(0, 0); ATT_SBAR(); \
    QKN(C1, 3, 1); KNR(3); ADD4(P1, 12); CVT2(P1, 12, pw3, 2); C0[2] = EX(C0[2]); C0[3] = EX(C0[3]); VRD(1, 4); ATT_SBAR(); \
    l_reg += sacc; VRD(2, 1); C0[4] = EX(C0[4]); C0[5] = EX(C0[5]); C0[6] = EX(C0[6]); C0[7] = EX(C0[7]); PIN(C0); ATT_SBAR(); \
    if (__builtin_expect(shift, 0)) { _Pragma("unroll") for (int r_ = 0; r_ < 16; ++r_) C1[r_] += nb; PIN(C1); } ATT_SBAR(); \
    GB(o[0] = __builtin_amdgcn_mfma_f32_32x32x16_bf16(PAF(0), VFR(0), o[0], 0, 0, 0), VRD(3, 5), C0[8] = EX(C0[8]), C0[9] = EX(C0[9]), C0[10] = EX(C0[10])); \
    GB(o[1] = __builtin_amdgcn_mfma_f32_32x32x16_bf16(PAF(0), VFR(1), o[1], 0, 0, 0), VRD(0, 2), C0[11] = EX(C0[11]), C0[12] = EX(C0[12]), C0[13] = EX(C0[13])); \
    GB(o[0] = __builtin_amdgcn_mfma_f32_32x32x16_bf16(PAF(1), VFR(2), o[0], 0, 0, 0), VRD(1, 6), C0[14] = EX(C0[14]), C0[15] = EX(C0[15]), C1[0] = EX(C1[0])); \
    GB(o[1] = __builtin_amdgcn_mfma_f32_32x32x16_bf16(PAF(1), VFR(3), o[1], 0, 0, 0), VRD(2, 3), C1[1] = EX(C1[1]), C1[2] = EX(C1[2]), C1[3] = EX(C1[3])); \
    GB(o[0] = __builtin_amdgcn_mfma_f32_32x32x16_bf16(PAF(2), VFR(0), o[0], 0, 0, 0), VRD(3, 7), C1[4] = EX(C1[4]), C1[5] = EX(C1[5]), C1[6] = EX(C1[6])); \
    GB(o[1] = __builtin_amdgcn_mfma_f32_32x32x16_bf16(PAF(2), VFR(1), o[1], 0, 0, 0), NOP_, C1[7] = EX(C1[7]), C1[8] = EX(C1[8]), C1[9] = EX(C1[9])); \
    GB(o[0] = __builtin_amdgcn_mfma_f32_32x32x16_bf16(PAF(3), VFR(2), o[0], 0, 0, 0), NOP_, C1[10] = EX(C1[10]), C1[11] = EX(C1[11]), C1[12] = EX(C1[12])); \
    GB(o[1] = __builtin_amdgcn_mfma_f32_32x32x16_bf16(PAF(3), VFR(3), o[1], 0, 0, 0), NOP_, C1[13] = EX(C1[13]), C1[14] = EX(C1[14]), C1[15] = EX(C1[15])); \
    PIN(C0); PIN(C1); \
    } while (0)
    const bool cv_on = cj.item0 >= 0;
    int cv_p = 0, cv_j = 0; const float* cv_src = nullptr; unsigned char* cv_dst = nullptr; float cv_sc = 0.f;
    LAS float* const cvf = (LAS float*)(lds + CV_F32 + wid * 2048);
    LAS unsigned* const cv8 = (LAS unsigned*)(lds + CV_F8 + wid * 2176);
    const unsigned cv_loff = (unsigned)(lane >> 3) * 4096u + (unsigned)(lane & 7) * 16u;
#define CONV() do { \
    if (cv_p == 0) { const int r_ = cj.item0 + cv_j, e_ = r_ / 1536, q_ = r_ % 1536, wh_ = q_ >> 9, it_ = q_ & 511, k0_ = (it_ >> 5) * 64, n0_ = (it_ & 31) * 32; \
        const unsigned char* ka_ = (const unsigned char*)__builtin_amdgcn_kernarg_segment_ptr();     \
        const float* w_ = *(const float* const*)(ka_ + 8 * (20 + wh_)); unsigned char* ws_ = *(unsigned char* const*)(ka_ + 8 * 24); cv_src = w_ + (size_t)e_ * 1048576 + (size_t)k0_ * 1024 + n0_; \
        if (wh_ < 2) { cv_dst = ws_ + WS_WGU + (size_t)e_ * 2097152 + (size_t)((n0_ >> 7) * 256 + wh_ * 128 + (n0_ & 127)) * 1024 + k0_; cv_sc = 32.0f; } \
        else { cv_dst = ws_ + WS_WD + (size_t)e_ * 1048576 + (size_t)n0_ * 1024 + k0_; cv_sc = 16.0f; } } \
    if (cv_p >= 1 && cv_p <= 8) { const int d_ = cv_p - 1; const LAS float* s_ = cvf + (d_ & 1) * 256 + hi * 128 + r32; \
        cv8[r32 * 17 + 2 * d_ + hi] = pg8::pk4_fp8_nc(cv_sc * s_[0], cv_sc * s_[32], cv_sc * s_[64], cv_sc * s_[96]); } \
    if (cv_p < 8) { glds16s_nt(cv_src + (size_t)(8 * cv_p) * 1024, cv_loff, rfl(lds0 + CV_F32 + wid * 2048 + (cv_p & 1) * 1024)); } \
    else { const int id_ = lane + 64 * (cv_p - 8), n2_ = id_ >> 2, c_ = id_ & 3; const LAS unsigned* q2_ = cv8 + n2_ * 17 + 4 * c_; \
        v4u w4_; w4_.x = q2_[0]; w4_.y = q2_[1]; w4_.z = q2_[2]; w4_.w = q2_[3]; *(GAS v4u*)(cv_dst + (size_t)n2_ * 1024 + 16 * c_) = w4_; } \
    if (++cv_p == 10) { cv_p = 0; ++cv_j; } } while (0)
    int t = 1;
    for (; t + 3 < NT; t += 2) {
        STEP(pB0, pB1, pA0, pA1, t, true, true, true);      WAITB(3, 2); ROT();
        if (cv_on) { CONV(); }
        STEP(pA0, pA1, pB0, pB1, t + 1, true, true, true);  if (cv_on) WAITB(4, 3); else WAITB(3, 2); ROT();
    }
#undef CONV
    STEP(pB0, pB1, pA0, pA1, NT - 3, false, true, true);   ATT_WAIT_BAR(1); ROT();
    STEP(pA0, pA1, pB0, pB1, NT - 2, false, true, true);   ATT_WAIT_BAR(1); ROT();
    STEP(pB0, pB1, pA0, pA1, NT - 1, false, false, false); ATT_WAIT_BAR(0); ROT();
    { float sacc = 0.f;
#pragma unroll
      for (int r = 0; r < 16; ++r) sacc += pB0[r] + pB1[r];
      l_reg += sacc;
      const u32x4 w0 = pack_p(pB0, 0), w1 = pack_p(pB0, 8), w2 = pack_p(pB1, 0), w3 = pack_p(pB1, 8);
      pv(o, (int)(lds0 + LV) + ((lane >> 4) & 1) * 32 + (lane & 3) * 8 + (4 * hi + ((lane & 15) >> 2)) * 64 + i_prev * VSLOT,
         __builtin_bit_cast(bf16x8, w0), __builtin_bit_cast(bf16x8, w1), __builtin_bit_cast(bf16x8, w2), __builtin_bit_cast(bf16x8, w3)); }
#undef STEP
#undef NOP_
#undef GB
#undef ADD4
#undef CVT2
#undef KN8
#undef KNR
#undef QK0
#undef QKN
#undef QKF8
#undef KLD8
#undef KLDR
#undef CAT8
#undef EX
#undef PAF
#undef VFR
#undef VRD
#undef VOFF
#undef PIN
#undef ROT
#undef WAITB
#undef DMA_K
#undef DMA_V
    float l = l_reg; l += __shfl_xor(l, 32);
    const int le = lane_id();
    const int r32e = le & 31, hie = le >> 5;
    LAS float* wsf = (LAS float*)(lds + LWS) + wid * 64;
    if (hie == 0) wsf[r32e] = l;
    asm volatile("s_waitcnt lgkmcnt(0)" ::: "memory");
    bf16* Ow = (bf16*)sptr(O + (rowb + q0 + 32 * wid) * DM + 512 + VD * h);
    float part[16];
#pragma unroll
    for (int r = 0; r < 16; ++r) { const int q = crow(r, hie); const float il = __builtin_amdgcn_rcpf(wsf[q]); const unsigned off = (unsigned)(q * DM + r32e); const float v0 = o[0][r] * il, v1 = o[1][r] * il;
        part[r] = v0 * v0 + v1 * v1; Ow[off] = (bf16)f2bf(v0); Ow[off + 32] = (bf16)f2bf(v1); }
    ssq_accum(part, le, SSQ + 2 * (rowb + q0 + 32 * wid) + 1);
    asm volatile("s_waitcnt lgkmcnt(0)\n\ts_barrier" ::: "memory");
}

__device__ __forceinline__ void swa_fill_table(LAS unsigned char* lds, int g, const float* TAB, int tid) {
    const float bnd = TAB[TAB_CONST + 0]; LAS float* tb = (LAS float*)(lds + LTAB);
    for (int i = tid; i < 4 * 512; i += NWAVES * 64) { const int hh = i >> 9, idx = (i & 511) - 63; tb[i] = (idx >= 0 && idx <= 2 * WINDOW) ? TAB[TAB_BIAS + (4 * g + hh) * NTAB + idx] - bnd : -1e30f; }
}
__device__ __forceinline__ void swa_unit(LAS unsigned char* lds, int b, int nh, int g, const bf16* QA, const bf16* KA, const bf16* VA, bf16* O, float* SSQ, const float* TAB, const float* sink, int wid, int lane, int tid) {
    const int r32 = lane & 31, hi = lane >> 5, hr = wid >> 1, rh = wid & 1, h = 4 * g + hr;
    const unsigned lds0 = (unsigned)(uintptr_t)lds;
    const size_t rowb = (size_t)b * SEQ;
    const int kt0 = (nh - 2 < 0) ? 0 : nh - 2, kt1 = (nh + 3 > SEQ / 64) ? SEQ / 64 : nh + 3, NT = kt1 - kt0;
    const bf16* ksrc = sptr(KA + (rowb + (size_t)kt0 * 64) * 128 + 64 * g + 8 * wid);
    const bf16* vsrc = sptr(VA + (rowb + (size_t)kt0 * 64 + 16 * (wid & 3)) * 128 + 64 * g + (wid >> 2) * 32);
    const unsigned kl = lane * 256u, vl = (lane >> 2) * 256u + (lane & 3) * 16u;
    constexpr int SK = 0, SV = 73728, SSLOT = 8192;
    const unsigned kdst = lds0 + SK + wid * 1024, vdst = lds0 + SV + wid * 1024;
#define SWA_DMA(t, sl) do { glds16s(ksrc + (size_t)(t) * 64 * 128, kl, rfl(kdst + (sl) * SSLOT)); glds16s(vsrc + (size_t)(t) * 64 * 128, vl, rfl(vdst + (sl) * SSLOT)); } while (0)
    for (int t_ = 0; t_ < NT; ++t_) SWA_DMA(t_, t_);
    const float bnd = TAB[TAB_CONST + 0];
    bf16x8 qf[4];
    { const bf16* qp = QA + (rowb + 64 * nh + 32 * rh + r32) * 512 + HD * h + 8 * hi;
#pragma unroll
      for (int s = 0; s < 4; ++s) qf[s] = *(const bf16x8*)(qp + 16 * s); }
    f32x16 o[2]; o[0] = f32x16{}; o[1] = f32x16{};
    float l = 0.f;
    const LAS unsigned char* kbase = lds + SK + hi * 1024 + r32 * 16;
    const int vb0 = (int)(lds0 + SV) + ((lane >> 4) & 1) * 32 + (lane & 3) * 8 + (4 * hi + ((lane & 15) >> 2)) * 64;
    const LAS float* tbl = (const LAS float*)(lds + LTAB) + hr * 512 + 63 + 4 * hi - 32 * rh - r32 + 64 * (kt0 - (nh - 2));
    for (int t = 0; t < NT; ++t) {
        { const int rem = NT - 1 - t;
          if (rem == 4) ATT_WAIT_BAR(8); else if (rem == 3) ATT_WAIT_BAR(6); else if (rem == 2) ATT_WAIT_BAR(4); else if (rem == 1) ATT_WAIT_BAR(2); else ATT_WAIT_BAR(0); }
        const int sl = t;
        const LAS unsigned char* kp = kbase + sl * SSLOT;
        const LAS float* tt = tbl + 64 * t;
        f32x16 p0, p1;
#pragma unroll
        for (int r = 0; r < 16; ++r) { const int off = (r & 3) + 8 * (r >> 2); p0[r] = tt[off]; p1[r] = tt[off + 32]; }
#pragma unroll
        for (int s = 0; s < 4; ++s) { const bf16x8 a0 = *(const LAS bf16x8*)(kp + s * 2048), a1 = *(const LAS bf16x8*)(kp + s * 2048 + 512);
            p0 = __builtin_amdgcn_mfma_f32_32x32x16_bf16(a0, qf[s], p0, 0, 0, 0); p1 = __builtin_amdgcn_mfma_f32_32x32x16_bf16(a1, qf[s], p1, 0, 0, 0); }
        float sa = 0.f, sb = 0.f;
#pragma unroll
        for (int r = 0; r < 16; ++r) { p0[r] = __builtin_amdgcn_exp2f(p0[r]); p1[r] = __builtin_amdgcn_exp2f(p1[r]); sa += p0[r]; sb += p1[r]; }
        l += sa + sb;
        const u32x4 w0 = pack_p(p0, 0), w1 = pack_p(p0, 8), w2 = pack_p(p1, 0), w3 = pack_p(p1, 8);
        pv(o, vb0 + sl * SSLOT, __builtin_bit_cast(bf16x8, w0), __builtin_bit_cast(bf16x8, w1), __builtin_bit_cast(bf16x8, w2), __builtin_bit_cast(bf16x8, w3));
    }
#undef SWA_DMA
    l += __shfl_xor(l, 32); l += __builtin_amdgcn_exp2f(sink[h] * LOG2E - bnd);
    const int le = lane_id();
    const int r32e = le & 31, hie = le >> 5;
    LAS float* wsf = (LAS float*)(lds + LWS) + wid * 64;
    if (hie == 0) wsf[r32e] = l;
    asm volatile("s_waitcnt lgkmcnt(0)" ::: "memory");
    bf16* Ow = (bf16*)sptr(O + (rowb + 64 * nh + 32 * rh) * DM + HD * h);
    float part[16];
#pragma unroll
    for (int r = 0; r < 16; ++r) { const int q = crow(r, hie); const float il = __builtin_amdgcn_rcpf(wsf[q]); const unsigned off = (unsigned)(q * DM + r32e); const float v0 = o[0][r] * il, v1 = o[1][r] * il;
        part[r] = v0 * v0 + v1 * v1; Ow[off] = (bf16)f2bf(v0); Ow[off + 32] = (bf16)f2bf(v1); }
    ssq_accum(part, le, SSQ + 2 * (rowb + 64 * nh + 32 * rh));
    asm volatile("s_waitcnt lgkmcnt(0)\n\ts_barrier" ::: "memory");
}
__device__ __forceinline__ void swa_unit3(LAS unsigned char* lds, int b, int n128, int g, const bf16* QA, const bf16* KA, const bf16* VA, bf16* O, float* SSQ, const float* TAB, const float* sink, int wid, int lane) {
    const int r32 = lane & 31, hi = lane >> 5, hr = wid >> 1, rh = wid & 1, h = 4 * g + hr;
    const unsigned lds0 = (unsigned)(uintptr_t)lds;
    const size_t rowb = (size_t)b * SEQ;
    const int kta = (2 * n128 - 2 < 0) ? 0 : 2 * n128 - 2, ktb = (2 * n128 + 4 > SEQ / 64) ? SEQ / 64 : 2 * n128 + 4, NTA = ktb - kta;
    const bf16* ksrc = sptr(KA + (rowb + (size_t)kta * 64) * 128 + 64 * g + 8 * wid);
    const bf16* vsrc = sptr(VA + (rowb + (size_t)kta * 64 + 16 * (wid & 3)) * 128 + 64 * g + (wid >> 2) * 32);
    const unsigned kl = lane * 256u, vl = (lane >> 2) * 256u + (lane & 3) * 16u;
    constexpr int SK = 0, SV = 73728, SSLOT = 8192;
    const unsigned kdst = lds0 + SK + wid * 1024, vdst = lds0 + SV + wid * 1024;
#define DMA_K(t, sl) glds16s(ksrc + (size_t)(t) * 64 * 128, kl, rfl(kdst + (sl) * SSLOT))
#define DMA_V(t, sl) glds16s(vsrc + (size_t)(t) * 64 * 128, vl, rfl(vdst + (sl) * SSLOT))
    for (int t_ = 0; t_ < NTA; ++t_) DMA_K(t_, t_);
    for (int t_ = 0; t_ < NTA; ++t_) DMA_V(t_, t_);
    const float bnd = TAB[TAB_CONST + 0];
    for (int sub = 0; sub < 2; ++sub) {
    const int nh = 2 * n128 + sub; const int kt0 = (nh - 2 < 0) ? 0 : nh - 2, kt1 = (nh + 3 > SEQ / 64) ? SEQ / 64 : nh + 3, NT = kt1 - kt0, s0 = kt0 - kta;
    bf16x8 qf[4];
    { const bf16* qp = QA + (rowb + 64 * nh + 32 * rh + r32) * 512 + HD * h + 8 * hi;
#pragma unroll
      for (int s = 0; s < 4; ++s) qf[s] = *(const bf16x8*)(qp + 16 * s); }
    f32x16 o[2]; o[0] = f32x16{}; o[1] = f32x16{};
    float l_reg = 0.f;
    const lds_cptr kp0 = (lds_cptr)lds + SK + s0 * SSLOT + hi * 1024 + r32 * 16;
    const lds_cptr vp0 = (lds_cptr)lds + SV + s0 * SSLOT + ((lane >> 4) & 1) * 32 + (lane & 3) * 8 + (4 * hi + ((lane & 15) >> 2)) * 64;
    const LAS float* tbl = (const LAS float*)(lds + LTAB) + hr * 512 + 63 + 4 * hi - 32 * rh - r32 + 64 * (kt0 - (nh - 2));
    bf16x8 kf[8];
#define KLD(kp, i) kf[i] = *(const __attribute__((address_space(3))) bf16x8*)((kp) + ((i) >> 1) * 2048 + ((i) & 1) * 512)
#define BIAS(C0, C1, tt_) do { _Pragma("unroll") for (int r_ = 0; r_ < 16; ++r_) { C0[r_] = (tt_)[(r_ & 3) + 8 * (r_ >> 2)]; C1[r_] = (tt_)[(r_ & 3) + 8 * (r_ >> 2) + 32]; } } while (0)
    if (sub == 0) { if (NTA == 6) ATT_WAIT_BAR(11); else ATT_WAIT_BAR(7); }
#pragma unroll
    for (int i = 0; i < 8; ++i) KLD(kp0, i);
    f32x16 pA0, pA1, pB0, pB1;
    BIAS(pA0, pA1, tbl);
#pragma unroll
    for (int s = 0; s < 4; ++s) { pA0 = __builtin_amdgcn_mfma_f32_32x32x16_bf16(kf[2 * s], qf[s], pA0, 0, 0, 0); pA1 = __builtin_amdgcn_mfma_f32_32x32x16_bf16(kf[2 * s + 1], qf[s], pA1, 0, 0, 0); }
#pragma unroll
    for (int r = 0; r < 16; ++r) { pA0[r] = __builtin_amdgcn_exp2f(pA0[r]); pA1[r] = __builtin_amdgcn_exp2f(pA1[r]); }
    BIAS(pB0, pB1, tbl + 64);
    if (sub == 0) ATT_WAIT_BAR(0);
#pragma unroll
    for (int i = 0; i < 8; ++i) KLD(kp0 + SSLOT, i);
    s16x4 vl0, vh0, vl1, vh1, vl2, vh2, vl3, vh3; u32x4 pw0, pw1, pw2, pw3;
#define ROT() do { } while (0)
#define PIN(x) asm volatile("" : "+v"(x))
#define VOFF(i) (((i) >> 2) * 4096 + ((i) & 3) * 1024)
#define VRD(B, i) do { vl##B = vtr(vp_ + VOFF(i)); vh##B = vtr(vp_ + VOFF(i) + 512); } while (0)
#define VFR(B) (bf16x8){vl##B[0], vl##B[1], vl##B[2], vl##B[3], vh##B[0], vh##B[1], vh##B[2], vh##B[3]}
#define PAF(k) __builtin_bit_cast(bf16x8, pw##k)
#define EX(v) __builtin_amdgcn_exp2f(v)
#define QKN(C, i, s) C = __builtin_amdgcn_mfma_f32_32x32x16_bf16(kf[i], qf[s], C, 0, 0, 0)
#define KN(i) do { if (gl_) { KLD(kn_, i); } } while (0)
#define GA(MF, KI, P, B, PW, W, X0, X1) do { MF; KN(KI); sacc += P[B]; sacc += P[B + 1]; sacc += P[B + 2]; sacc += P[B + 3]; PIN(sacc); PW[W] = cvtpk(P[B], P[B + 1]); PW[W + 1] = cvtpk(P[B + 2], P[B + 3]); PIN(PW); X0; X1; ATT_SBAR(); } while (0)
#define GB(MF, RD, E0, E1, E2, E3, NB) do { MF; RD; E0; E1; E2; E3; NB; ATT_SBAR(); } while (0)
#define NOP_ (void)0
#define NBIAS(P0, P1, q) do { if (gl_) { P0[2 * (q)] = tn_[((2 * (q)) & 3) + 8 * ((2 * (q)) >> 2)]; P0[2 * (q) + 1] = tn_[((2 * (q) + 1) & 3) + 8 * ((2 * (q) + 1) >> 2)]; \
        P1[2 * (q)] = tn_[((2 * (q)) & 3) + 8 * ((2 * (q)) >> 2) + 32]; P1[2 * (q) + 1] = tn_[((2 * (q) + 1) & 3) + 8 * ((2 * (q) + 1) >> 2) + 32]; } } while (0)
#define STEP(C0, C1, P0, P1, t) do { ATT_SBAR(); \
    const bool gl_ = (t) + 1 < NT; \
    const lds_cptr vp_ = vp0 + ((t) - 1) * SSLOT; const lds_cptr kn_ = kp0 + ((t) + 1) * SSLOT; const LAS float* tn_ = tbl + 64 * ((t) + 1); \
    float sacc = 0.f; \
    GA(QKN(C0, 0, 0), 0, P0, 0, pw0, 0, NOP_, NOP_); \
    GA(QKN(C0, 2, 1), 2, P0, 4, pw0, 2, NOP_, NOP_); \
    GA(QKN(C0, 4, 2), 4, P0, 8, pw1, 0, NOP_, NOP_); \
    GA(QKN(C0, 6, 3), 6, P0, 12, pw1, 2, NOP_, NOP_); \
    GA(QKN(C1, 1, 0), 1, P1, 0, pw2, 0, NOP_, NOP_); \
    GA(QKN(C1, 3, 1), 3, P1, 4, pw2, 2, NOP_, VRD(0, 0)); \
    GA(QKN(C1, 5, 2), 5, P1, 8, pw3, 0, C0[0] = EX(C0[0]), VRD(1, 4)); \
    GA(QKN(C1, 7, 3), 7, P1, 12, pw3, 2, C0[1] = EX(C0[1]), VRD(2, 1)); \
    l_reg += sacc; C0[2] = EX(C0[2]); C0[3] = EX(C0[3]); PIN(C0); ATT_SBAR(); \
    GB(o[0] = __builtin_amdgcn_mfma_f32_32x32x16_bf16(PAF(0), VFR(0), o[0], 0, 0, 0), VRD(3, 5), C0[4] = EX(C0[4]), C0[5] = EX(C0[5]), C0[6] = EX(C0[6]), C0[7] = EX(C0[7]), NBIAS(P0, P1, 0)); \
    GB(o[1] = __builtin_amdgcn_mfma_f32_32x32x16_bf16(PAF(0), VFR(1), o[1], 0, 0, 0), VRD(0, 2), C0[8] = EX(C0[8]), C0[9] = EX(C0[9]), C0[10] = EX(C0[10]), C0[11] = EX(C0[11]), NBIAS(P0, P1, 1)); \
    GB(o[0] = __builtin_amdgcn_mfma_f32_32x32x16_bf16(PAF(1), VFR(2), o[0], 0, 0, 0), VRD(1, 6), C0[12] = EX(C0[12]), C0[13] = EX(C0[13]), C0[14] = EX(C0[14]), C0[15] = EX(C0[15]), NBIAS(P0, P1, 2)); \
    GB(o[1] = __builtin_amdgcn_mfma_f32_32x32x16_bf16(PAF(1), VFR(3), o[1], 0, 0, 0), VRD(2, 3), C1[0] = EX(C1[0]), C1[1] = EX(C1[1]), C1[2] = EX(C1[2]), C1[3] = EX(C1[3]), NBIAS(P0, P1, 3)); \
    GB(o[0] = __builtin_amdgcn_mfma_f32_32x32x16_bf16(PAF(2), VFR(0), o[0], 0, 0, 0), VRD(3, 7), C1[4] = EX(C1[4]), C1[5] = EX(C1[5]), C1[6] = EX(C1[6]), C1[7] = EX(C1[7]), NBIAS(P0, P1, 4)); \
    GB(o[1] = __builtin_amdgcn_mfma_f32_32x32x16_bf16(PAF(2), VFR(1), o[1], 0, 0, 0), NOP_, C1[8] = EX(C1[8]), C1[9] = EX(C1[9]), C1[10] = EX(C1[10]), C1[11] = EX(C1[11]), NBIAS(P0, P1, 5)); \
    GB(o[0] = __builtin_amdgcn_mfma_f32_32x32x16_bf16(PAF(3), VFR(2), o[0], 0, 0, 0), NOP_, C1[12] = EX(C1[12]), C1[13] = EX(C1[13]), NOP_, NOP_, NBIAS(P0, P1, 6)); \
    GB(o[1] = __builtin_amdgcn_mfma_f32_32x32x16_bf16(PAF(3), VFR(3), o[1], 0, 0, 0), NOP_, C1[14] = EX(C1[14]), C1[15] = EX(C1[15]), NOP_, NOP_, NBIAS(P0, P1, 7)); \
    PIN(C0); PIN(C1); \
    } while (0)
#define DRAIN(P0, P1) do { float sacc = 0.f; _Pragma("unroll") for (int r_ = 0; r_ < 16; ++r_) sacc += P0[r_] + P1[r_]; l_reg += sacc; \
      const u32x4 w0 = pack_p(P0, 0), w1 = pack_p(P0, 8), w2 = pack_p(P1, 0), w3 = pack_p(P1, 8); \
      pv(o, (int)(lds0 + SV) + ((lane >> 4) & 1) * 32 + (lane & 3) * 8 + (4 * hi + ((lane & 15) >> 2)) * 64 + (s0 + NT - 1) * SSLOT, \
         __builtin_bit_cast(bf16x8, w0), __builtin_bit_cast(bf16x8, w1), __builtin_bit_cast(bf16x8, w2), __builtin_bit_cast(bf16x8, w3)); } while (0)
    STEP(pB0, pB1, pA0, pA1, 1);
    STEP(pA0, pA1, pB0, pB1, 2);
    if (NT > 3) { STEP(pB0, pB1, pA0, pA1, 3);
        if (NT > 4) { STEP(pA0, pA1, pB0, pB1, 4); DRAIN(pA0, pA1); } else { DRAIN(pB0, pB1); } }
    else { DRAIN(pA0, pA1); }
#undef DRAIN
#undef STEP
#undef NBIAS
#undef NOP_
#undef GB
#undef GA
#undef KN
#undef QKN
#undef EX
#undef PAF
#undef VFR
#undef VRD
#undef VOFF
#undef PIN
#undef ROT
#undef BIAS
#undef KLD
#undef DMA_K
#undef DMA_V
    float l = l_reg; l += __shfl_xor(l, 32); l += __builtin_amdgcn_exp2f(sink[h] * LOG2E - bnd);
    const int le = lane_id();
    const int r32e = le & 31, hie = le >> 5;
    LAS float* wsf = (LAS float*)(lds + LWS) + wid * 64;
    if (hie == 0) wsf[r32e] = l;
    asm volatile("s_waitcnt lgkmcnt(0)" ::: "memory");
    bf16* Ow = (bf16*)sptr(O + (rowb + 64 * nh + 32 * rh) * DM + HD * h);
    float part[16];
#pragma unroll
    for (int r = 0; r < 16; ++r) { const int q = crow(r, hie); const float il = __builtin_amdgcn_rcpf(wsf[q]); const unsigned off = (unsigned)(q * DM + r32e); const float v0 = o[0][r] * il, v1 = o[1][r] * il;
        part[r] = v0 * v0 + v1 * v1; Ow[off] = (bf16)f2bf(v0); Ow[off + 32] = (bf16)f2bf(v1); }
    ssq_accum(part, le, SSQ + 2 * (rowb + 64 * nh + 32 * rh));
    }
    asm volatile("s_waitcnt lgkmcnt(0)\n\ts_barrier" ::: "memory");
}

#undef ATT_SBAR
#undef ATT_WAIT_BAR
}

__device__ __forceinline__ void p5_attention(Frame& F, bool probe_dup = false) {
    const int lane_ = lane_id();
    const bf16* QB = WSP(bf16, WS_QB); const unsigned char* KN8 = WSP(unsigned char, WS_KBN); const unsigned char* QN8 = WSP(unsigned char, WS_QN8); const bf16* KR = WSP(bf16, WS_KR); const bf16* VB = WSP(bf16, WS_VB);
    const bf16* QA = WSP(bf16, WS_QA); const bf16* KA = WSP(bf16, WS_KA); const bf16* VA = WSP(bf16, WS_VA); bf16* O = WSP(bf16, WS_O);
    const float* TAB = WSP(float, WS_TAB); float* SSQ = probe_dup ? WSP(float, WS_KVRAW) : WSP(float, WS_SSQ);
    constexpr int NU_B = BATCH * BH * (SEQ / 256), NU_A = BATCH * (SEQ / 64) * A_KV;
#ifndef NO_MLA
    { const float bndB = __uint_as_float((unsigned)__builtin_amdgcn_readfirstlane((int)__float_as_uint(TAB[TAB_CONST + 1])));
      const bool shift = bndB > 64.0f; const float nb = shift ? -bndB : 0.f;
      for (int i = 0; i < (NU_B + F.G - 1) / F.G; ++i) {
        const int u = (F.G == 256) ? (F.vcu >> 2) * 16 + (F.vcu & 3) * 4 + i : i * F.G + F.vcu;
        if (u >= NU_B) break;
        const att::ConvJob cj{(F.G == 256 && !probe_dup) ? ((F.vcu * 4 + i) * NWAVES + F.wave) * 3 : -1};
        att::mla_unit2(F.lds + RING_OFF, (u >> 4) / BH, (u >> 4) % BH, u & 15, QB, QN8, KN8, KR, VB, O, SSQ, shift, nb, cj, F.wave, lane_);
      } }
#endif
#ifndef NO_SWA
    { const int lane2 = lane_id();
      int gcur = -1;
      for (int u = F.vcu; u < NU_A / 2; u += F.G) { if ((u & 1) != gcur) { gcur = u & 1; asm volatile("s_waitcnt lgkmcnt(0)\n\ts_barrier" ::: "memory"); att::swa_fill_table(F.lds + RING_OFF, gcur, TAB, F.wave * 64 + lane2); }
        att::swa_unit3(F.lds + RING_OFF, u >> 6, (u >> 1) & 31, u & 1, QA, KA, VA, O, SSQ, TAB, F.in[6], F.wave, lane2); } }
#endif
}

struct Args { const float* in[23]; float* out; unsigned char* ws; int ph_lo, ph_hi, li, pad; };
constexpr int N_PHASES = 13;
__global__ void __launch_bounds__(NWAVES * 64, 2) skel_fwd(Args args) {
    extern __shared__ __attribute__((aligned(16))) unsigned char lds[];
    Frame F;
    F.lds = (LAS unsigned char*)lds;
    F.MISC = (volatile LAS unsigned*)(F.lds + MISC_OFF);
    F.wave = __builtin_amdgcn_readfirstlane((int)(threadIdx.x >> 6));
    F.G = gridDim.x; { const int bx = blockIdx.x; F.vcu = (F.G % 8 == 0) ? (bx % 8) * (F.G / 8) + bx / 8 : bx; }
    F.ws = args.ws; F.out = args.out;
#pragma unroll
    for (int i = 0; i < 23; ++i) F.in[i] = args.in[i];
    F.ctl = (gu32*)(F.ws + WS_CTL);
    for (int u = threadIdx.x; u < (LDS_BYTES - LDSCTL_OFF) / 4; u += NWAVES * 64) ((LAS unsigned*)(F.lds + LDSCTL_OFF))[u] = 0u;
    __syncthreads();
    XcdBarrier bar = xcd_barrier_post((unsigned*)(F.ctl + CW_BAR) + args.li * XCD_BAR_WORDS, F.MISC + 8);
    const int lo = args.ph_lo, hi = args.ph_hi;
#define IN(k) (lo <= (k) && (k) < hi)
#define SEAM(k) do { if (IN(k) && IN((k) + 1)) xcd_barrier(bar); } while (0)

#define PH(k, ...) do { if (IN(k)) { __VA_ARGS__; if ((PROBE_MASK >> (k)) & 1) { xcd_barrier(bar); __VA_ARGS__; } } SEAM(k); } while (0)
    PH(0, p0_prologue(F));
    PH(1, {
        pg8::Gemm g{WSP(bf16, WS_XN), WSP(bf16, WS_WIN), T, NZ, DM, 0, nullptr, nullptr, 0, 0, 0, F.wave}; pg8::StaticOrder S; S.init(T, NZ, F.G, (int)blockIdx.x);
        pg8::EpiInProj E{F.ws, F.in[4], F.in[5], F.in[14]};
        pg8::gemm_phase<pg8::EpiInProj, pg8::StaticOrder, true, true>(F.lds + RING_OFF, g, S, E); });
    PH(3, {
        { pg8::Gemm g{WSP(bf16, WS_CQ), WSP(bf16, WS_WQB), T, BH * QKD, QL, 0, nullptr, nullptr, 0, 0, 0, F.wave}; pg8::StaticOrder S; S.init(T, BH * QKD, F.G, (int)blockIdx.x);
          pg8::EpiQB E{F.ws, F.in[11], F.in[12]};
          pg8::gemm_phase<pg8::EpiQB, pg8::StaticOrder, true, true>(F.lds + RING_OFF, g, S, E); }
        __syncthreads();
        { pg8::Gemm g{WSP(bf16, WS_CKV), WSP(bf16, WS_WKVB), T, BH * 128, KVL, 0, nullptr, nullptr, 0, 0, 0, F.wave}; pg8::StaticOrder S; S.init(T, BH * 128, F.G, (int)(F.G - 1 - blockIdx.x));
          pg8::EpiKVB E{F.ws, F.in[13]};
          pg8::gemm_phase<pg8::EpiKVB, pg8::StaticOrder, true, true>(F.lds + RING_OFF, g, S, E); } });
#if !NAIVE_ATTN
    PH(5, p5_attention(F));
#if PROBE_ATT
    xcd_barrier(bar); p5_attention(F, true); xcd_barrier(bar);
#endif
#endif
    PH(7, {
        pg8::Gemm g{WSP(bf16, WS_O), WSP(bf16, WS_WO), T, DM, DM, 0, nullptr, WSP(float, WS_SSQ), 0, 0, 0, F.wave}; pg8::StaticOrder S; S.init(T, DM, F.G, (int)blockIdx.x);
        pg8::EpiNormBf16 E{WSP(bf16, WS_ATT), DM, WSP(float, WS_SSQ)};
        pg8::gemm_phase<pg8::EpiNormBf16, pg8::StaticOrder, true, true, 2>(F.lds + RING_OFF, g, S, E); });
    PH(8, p8_router(F));
    PH(9, p9_topk(F));
    PH(11, {
        pg8::Gemm g{WSP(bf16, WS_H2), WSP(bf16, WS_WGU), MX, 2 * FF, DM / 2, (size_t)2 * FF * DM, WSP(int, WS_IDX), nullptr, 0x7a7a7a7a, 0x7a7a7a7a, (unsigned)(LDSCTL_OFF + 1024 - RING_OFF), F.wave}; pg8::StaticOrder S; S.init(MX, 2 * FF, F.G, (int)blockIdx.x, 16);
        pg8::EpiSwiGLU8 E{WSP(unsigned char, WS_ACT), FF, 16.0f};
        pg8::gemm_phase<pg8::EpiSwiGLU8, pg8::StaticOrder, true, true, 1, true>(F.lds + RING_OFF, g, S, E); });
    PH(12, {
        pg8::Gemm g{WSP(bf16, WS_ACT), WSP(bf16, WS_WD), MX, DM, FF / 2, (size_t)DM * FF, nullptr, nullptr, 0x7b7b7b7b, 0x7b7b7b7b, 0, F.wave}; pg8::StaticOrder S; S.init(MX, DM, F.G, (int)blockIdx.x, 16);
        pg8::EpiRowScaleF8 E{WSP(unsigned char, WS_YE), DM, WSP(float, WS_GATEV), 64.0f};
        pg8::gemm_phase<pg8::EpiRowScaleF8, pg8::StaticOrder, true, true, 0, true>(F.lds + RING_OFF, g, S, E); });
    PH(13, p12_combine(F));
#undef PH
#undef IN
#undef SEAM
}

#if NAIVE_ATTN
__device__ __forceinline__ float bf2f(bf16 v) { return __uint_as_float((unsigned)v << 16); }
__global__ void __launch_bounds__(256) naive_attn_a(const bf16* __restrict__ QA, const bf16* __restrict__ KA, const bf16* __restrict__ VA, const float* __restrict__ TAB, const float* __restrict__ sink, bf16* __restrict__ O) {
    const int s = (blockIdx.x % (SEQ / 256)) * 256 + threadIdx.x, bh = blockIdx.x / (SEQ / 256), h = bh % A_HEADS, b = bh / A_HEADS, g = h / (A_HEADS / A_KV);
    const size_t m = (size_t)b * SEQ + s;
    float q[HD], o[HD];
#pragma unroll
    for (int d = 0; d < HD; ++d) { q[d] = bf2f(QA[m * 512 + h * HD + d]); o[d] = 0.f; }
    const float bnd = TAB[TAB_CONST + 0];
    float l = exp2f(sink[h] * LOG2E - bnd);
    for (int rel = -WINDOW; rel <= WINDOW; ++rel) { const int j = s + rel; if (j < 0 || j >= SEQ) continue;
        const bf16* kr = KA + ((size_t)b * SEQ + j) * 128 + g * HD; const bf16* vr = VA + ((size_t)b * SEQ + j) * 128 + g * HD;
        float sc = 0.f;
#pragma unroll
        for (int d = 0; d < HD; ++d) sc += q[d] * bf2f(kr[d]);
        const float p = exp2f(sc + TAB[TAB_BIAS + h * NTAB + rel + 128] - bnd); l += p;
#pragma unroll
        for (int d = 0; d < HD; ++d) o[d] += p * bf2f(vr[d]); }
    const float il = 1.0f / l;
#pragma unroll
    for (int d = 0; d < HD; ++d) O[m * DM + h * HD + d] = (bf16)f2bf(o[d] * il);
}
__global__ void __launch_bounds__(256) naive_attn_b(const bf16* __restrict__ QB, const bf16* __restrict__ KBN, const bf16* __restrict__ KR, const bf16* __restrict__ VB, const float* __restrict__ TAB, bf16* __restrict__ O) {
    const int s = (blockIdx.x % (SEQ / 256)) * 256 + threadIdx.x, bh = blockIdx.x / (SEQ / 256), h = bh % BH, b = bh / BH;
    const size_t m = (size_t)b * SEQ + s;
    float q[QKD], o[VD];
#pragma unroll
    for (int d = 0; d < QKD; ++d) q[d] = bf2f(QB[m * (BH * QKD) + h * QKD + d]);
#pragma unroll
    for (int d = 0; d < VD; ++d) o[d] = 0.f;
    const float bnd = TAB[TAB_CONST + 1];
    float l = 0.f;
    for (int j = 0; j < SEQ; ++j) { const size_t mj = (size_t)b * SEQ + j;
        const bf16* kn = KBN + mj * 512 + h * NOPE; const bf16* kr = KR + mj * ROPE; const bf16* vr = VB + mj * 512 + h * VD;
        float sc = 0.f;
#pragma unroll
        for (int d = 0; d < NOPE; ++d) sc += q[d] * bf2f(kn[d]);
#pragma unroll
        for (int d = 0; d < ROPE; ++d) sc += q[NOPE + d] * bf2f(kr[d]);
        const float p = exp2f(sc - bnd); l += p;
#pragma unroll
        for (int d = 0; d < VD; ++d) o[d] += p * bf2f(vr[d]); }
    const float il = 1.0f / l;
#pragma unroll
    for (int d = 0; d < VD; ++d) O[m * DM + 512 + h * VD + d] = (bf16)f2bf(o[d] * il);
}

#endif
extern "C" void kernel_launch(void* const* d_in, const int* in_sizes, int n_in, void* d_out, int out_size, void* d_ws, size_t ws_size, hipStream_t stream) {
    static int grid = 0;
    if (grid == 0) {
        if (n_in != 23 || in_sizes[0] != T * DM || out_size != T * DM || ws_size < WS_END) { fprintf(stderr, "kernel_launch: unexpected shapes (n_in %d, in0 %d, out %d, ws %zu)\n", n_in, n_in > 0 ? in_sizes[0] : -1, out_size, ws_size); grid = -1; return; }
        int dev = 0, cus = 0, per_cu = 0;
        if (hipGetDevice(&dev) != hipSuccess || hipDeviceGetAttribute(&cus, hipDeviceAttributeMultiprocessorCount, dev) != hipSuccess) { grid = -1; return; }
        if (hipFuncSetAttribute((const void*)skel_fwd, hipFuncAttributeMaxDynamicSharedMemorySize, LDS_BYTES) != hipSuccess) { fprintf(stderr, "kernel_launch: hipFuncSetAttribute failed\n"); grid = -1; return; }
        if (hipOccupancyMaxActiveBlocksPerMultiprocessor(&per_cu, (const void*)skel_fwd, NWAVES * 64, LDS_BYTES) != hipSuccess || per_cu < 1) fprintf(stderr, "kernel_launch: occupancy query says %d\n", per_cu);
        (void)hipGetLastError();
        grid = cus;
    }
    if (grid < 0) return;
    if (hipMemsetAsync((char*)d_ws + WS_CTL, 0, CTL_ZERO_BYTES, stream) != hipSuccess) return;
    Args a{};
    for (int i = 0; i < 23; ++i) a.in[i] = (const float*)d_in[i];
    a.out = (float*)d_out; a.ws = (unsigned char*)d_ws;
    unsigned char* ws = (unsigned char*)d_ws;
#if NAIVE_ATTN
    a.ph_lo = 0; a.ph_hi = 5; a.li = 0;
    hipLaunchKernelGGL(skel_fwd, dim3(grid), dim3(NWAVES * 64), LDS_BYTES, stream, a);
    hipLaunchKernelGGL(naive_attn_a, dim3(BATCH * A_HEADS * (SEQ / 256)), dim3(256), 0, stream, (const bf16*)(ws + WS_QA), (const bf16*)(ws + WS_KA), (const bf16*)(ws + WS_VA), (const float*)(ws + WS_TAB), (const float*)d_in[6], (bf16*)(ws + WS_O));
    hipLaunchKernelGGL(naive_attn_b, dim3(BATCH * BH * (SEQ / 256)), dim3(256), 0, stream, (const bf16*)(ws + WS_QB), (const bf16*)(ws + WS_KBN), (const bf16*)(ws + WS_KR), (const bf16*)(ws + WS_VB), (const float*)(ws + WS_TAB), (bf16*)(ws + WS_O));
    a.ph_lo = 6; a.ph_hi = 14; a.li = 1;
    hipLaunchKernelGGL(skel_fwd, dim3(grid), dim3(NWAVES * 64), LDS_BYTES, stream, a);
#else
    a.ph_lo = 0; a.ph_hi = 14; a.li = 0;
    hipLaunchKernelGGL(skel_fwd, dim3(grid), dim3(NWAVES * 64), LDS_BYTES, stream, a);
#endif
}
```

```cpp
#include <hip/hip_runtime.h>
#include <hip/hip_bf16.h>
#include <cstdio>
#include <cstdint>
#ifndef PROBE_ATT
#define PROBE_ATT 0
#endif
#ifndef PROBE_MASK
#define PROBE_MASK 0
#endif
#ifndef NAIVE_ATTN
#define NAIVE_ATTN 0
#endif
__device__ __forceinline__ int lane_id() { int l; asm volatile("v_mbcnt_lo_u32_b32 %0, -1, 0\n\tv_mbcnt_hi_u32_b32 %0, -1, %0" : "=v"(l)); return l; }

constexpr int NWAVES = 8;
constexpr int BATCH = 8, SEQ = 4096, DM = 1024, T = BATCH * SEQ;
constexpr int INW = 1440, NZ = 1536;
constexpr int A_HEADS = 8, A_KV = 2, HD = 64, WINDOW = 128;
constexpr int BH = 8, QL = 384, KVL = 256, NOPE = 64, ROPE = 32, VD = 64, QKD = NOPE + ROPE;
constexpr int NE = 16, FF = 1024, CAP = 512, MX = NE * BATCH * CAP;
constexpr float EPS = 1e-6f, LOG2E = 1.4426950408889634f;
constexpr float QSC_A = 0.125f * LOG2E;
constexpr float QSC_B = 0.10206207261596577f * LOG2E;
constexpr int NTAB = 257;

constexpr size_t MiB = 1u << 20;
constexpr size_t WS_CTL = 0, CTL_ZERO_BYTES = 1 * MiB;
constexpr size_t WS_SSQ = 512 * 1024;
constexpr size_t WS_SSQCQ = 768 * 1024, WS_SSQCKV = 896 * 1024;
constexpr size_t WS_TAB = 1 * MiB;
constexpr size_t WS_WIN = 4 * MiB, WS_WQB = 7 * MiB, WS_WKVB = 8 * MiB, WS_WO = 9 * MiB, WS_WGU = 12 * MiB, WS_WD = 76 * MiB;
constexpr size_t WS_AFF = 108 * MiB, WS_IDX = 110 * MiB, WS_GATEV = WS_IDX + 512 * 1024, WS_SLOT = 111 * MiB;
constexpr size_t WS_XN = 114 * MiB;
constexpr size_t WS_Z = 178 * MiB;
constexpr size_t WS_QA = 274 * MiB, WS_KA = 306 * MiB, WS_VA = 314 * MiB, WS_CQ = 322 * MiB, WS_CKV = 346 * MiB, WS_KR = 362 * MiB;
constexpr size_t WS_KVRAW = 364 * MiB, WS_KBN = 428 * MiB, WS_VB = 460 * MiB, WS_END = 492 * MiB;
constexpr size_t WS_ATT = 242 * MiB;
constexpr size_t WS_QN8 = 242 * MiB;
constexpr size_t WS_X1B = 370 * MiB;
constexpr size_t WS_QB = WS_Z, WS_O = WS_XN, WS_H2 = WS_XN, WS_XE = WS_Z, WS_ACT = 306 * MiB, WS_YE = WS_Z;
constexpr int TAB_BIAS = 0, TAB_CONST = 8 * NTAB + 8, TAB_COS = TAB_CONST + 16, TAB_SIN = TAB_COS + SEQ * 16;
constexpr int CW_TMO = 0, CW_BAR = 4096;

constexpr int RING_OFF = 0, RING_BYTES = 131072;
constexpr int LDSCTL_OFF = RING_BYTES, MISC_OFF = LDSCTL_OFF + 320;
constexpr int LDS_BYTES = 147456;
namespace pg8 {
#define PG8_LAS __attribute__((address_space(3)))
typedef unsigned short bf16_t;
typedef short bf16x8 __attribute__((ext_vector_type(8)));
typedef float f32x4 __attribute__((ext_vector_type(4)));
typedef unsigned u32x4 __attribute__((ext_vector_type(4)));
constexpr int BM = 256, BK = 64, HALF = 128, HTB = HALF * BK * 2  , STAGE_BYTES = 8 * HTB, NXCD = 8, WGM = 8;

__host__ __device__ __forceinline__ int lds_byte(int r, int c) { const int st = (r >> 4) * 2 + (c >> 5), rr = r & 15, cc = c & 31, ob = rr * 64 + cc * 2; return st * 1024 + (ob ^ (((ob >> 9) & 1) << 5)); }
__host__ __device__ __forceinline__ void stage_rc(int b, int& R, int& C) { const int st = b / 1024, sb = b % 1024, swz = sb ^ (((sb >> 9) & 1) << 5); R = (st >> 1) * 16 + swz / 64; C = (st & 1) * 32 + (swz % 64) / 2; }
__host__ __device__ __forceinline__ int gray4(int q) { return q ^ (q >> 1); }
__host__ __device__ __forceinline__ int lds_byte8(int r, int cbyte) { const int st = (r >> 4) * 2 + (cbyte >> 6), rr = r & 15; return st * 1024 + rr * 64 + ((((cbyte >> 4) & 3) ^ gray4((rr >> 2) & 3)) << 4) + (cbyte & 15); }
__host__ __device__ __forceinline__ void stage_rc8(int b, int& R, int& C) { const int st = b / 1024, sb = b % 1024, rr = sb / 64, ch = ((sb % 64) / 16) ^ gray4((rr >> 2) & 3); R = (st >> 1) * 16 + rr; C = (st & 1) * 32 + ch * 8; }
__host__ __device__ __forceinline__ int perm32(int rho) { const int n = rho >> 4, i = rho & 15; return 8 * (i >> 2) + 4 * n + (i & 3); }

struct Unit { int pm, pn, e; };
struct Gemm { const bf16_t* A; const bf16_t* Bt; int M, N, K; size_t estride; const int* idx; const float* ssq; int sA, sB; unsigned gtab; int wave; };

struct StaticOrder {
    int nM, nN, nwg, G, c, epan;
    __host__ __device__ void init(int M, int N, int G_, int c_, int epan_ = 0) { nM = M / BM; nN = N / BM; nwg = nM * nN; G = G_; c = c_; epan = epan_; }
    __host__ __device__ bool next(int i, Unit& u) const {
        const long L = (long)i * G + c; if (L >= nwg) return false;
        int wgid = (int)L; { const int q = nwg / NXCD, r = nwg % NXCD, xcd = wgid % NXCD, off = wgid / NXCD; wgid = (xcd < r ? xcd * (q + 1) : r * (q + 1) + (xcd - r) * q) + off; }
        const int nig = WGM * nN, gid = wgid / nig, fm = gid * WGM, gsz = (nM - fm) < WGM ? (nM - fm) : WGM;
        u.pm = fm + ((wgid % nig) % gsz); u.pn = (wgid % nig) / gsz; u.e = epan ? u.pm / epan : 0; return true;
    }
    __device__ __forceinline__ void a_ready(const Unit&) const {}
    __device__ __forceinline__ void done(const Unit&) const {}
};

__device__ __forceinline__ unsigned cvt_pk_bf16(float lo, float hi) { unsigned r; asm volatile("v_cvt_pk_bf16_f32 %0, %1, %2" : "=v"(r) : "v"(lo), "v"(hi)); return r; }
typedef float f32x2 __attribute__((ext_vector_type(2)));
__device__ __forceinline__ f32x2 gelu_pk(f32x2 v) {
    const f32x2 av = __builtin_elementwise_abs(v), d = av * 0.2316418882f + 1.0f;
    f32x2 t; t.x = __builtin_amdgcn_rcpf(d.x); t.y = __builtin_amdgcn_rcpf(d.y);
    f32x2 q = t * 0.5307027145f + (-0.7265760135f); q = q * t + 0.7107068705f; q = q * t + (-0.142248368f); q = q * t + 0.127414796f; q = q * t;
    const f32x2 s = (v * v) * (-0.72134752044f);
    f32x2 e; e.x = __builtin_amdgcn_exp2f(s.x); e.y = __builtin_amdgcn_exp2f(s.y);
    const f32x2 m = v * (q * e), r = v - m;
    f32x2 o; o.x = v.x < 0.f ? m.x : r.x; o.y = v.y < 0.f ? m.y : r.y; return o;
}

template <int ACT  > struct EpiBf16 {
    static constexpr bool PERM = true, AFTER_DRAIN = false; static_assert(ACT == 0 || ACT == 1, "EpiBf16: ACT is 0 (none) or 1 (gelu_pk)");
    bf16_t* O; int ldc; const float* bias; int split_cols; size_t split_stride; float scale0;
    __device__ __forceinline__ void operator()(const f32x4 (&acc)[2][2][4][2], const Unit& u, int wr, int wc, int fr, int fq) const {
        const int row0 = u.pm * BM + wr * 64 + fr; int colt = u.pn * BM; bf16_t* base = O;
        float sc = 1.f; if (split_cols) { const int t = colt / split_cols; base += (size_t)t * split_stride; colt -= t * split_cols; if (t == 0) sc = scale0; }
        const int col0 = colt + wc * 32 + 8 * fq, bcol0 = u.pn * BM + wc * 32 + 8 * fq;
        f32x4 bv[2][2];
#pragma unroll
        for (int bj = 0; bj < 2; ++bj)
#pragma unroll
            for (int n = 0; n < 2; ++n) bv[bj][n] = bias ? *(const f32x4*)(bias + bcol0 + bj * HALF + 4 * n) : (f32x4){0.f, 0.f, 0.f, 0.f};
#pragma unroll
        for (int ai = 0; ai < 2; ++ai)
#pragma unroll
            for (int m = 0; m < 4; ++m) { bf16_t* rowp = base + (size_t)(row0 + ai * HALF + m * 16) * ldc + col0;
#pragma unroll
                for (int bj = 0; bj < 2; ++bj) { f32x4 v0 = acc[ai][bj][m][0] + bv[bj][0], v1 = acc[ai][bj][m][1] + bv[bj][1];
                    if (ACT == 1) { f32x2 a = gelu_pk((f32x2){v0[0], v0[1]}), b = gelu_pk((f32x2){v0[2], v0[3]}), c = gelu_pk((f32x2){v1[0], v1[1]}), d = gelu_pk((f32x2){v1[2], v1[3]});
                        v0 = (f32x4){a.x, a.y, b.x, b.y}; v1 = (f32x4){c.x, c.y, d.x, d.y}; }
                    v0 = v0 * sc; v1 = v1 * sc; u32x4 w; w.x = cvt_pk_bf16(v0[0], v0[1]); w.y = cvt_pk_bf16(v0[2], v0[3]); w.z = cvt_pk_bf16(v1[0], v1[1]); w.w = cvt_pk_bf16(v1[2], v1[3]);
                    *(u32x4*)(rowp + bj * HALF) = w; } }
    }
};

struct EpiResF32 {
    static constexpr bool PERM = true, AFTER_DRAIN = false;
    const float* base; float* out; int ldc; const float* ssq;
    __device__ __forceinline__ void operator()(const f32x4 (&acc)[2][2][4][2], const Unit& u, int wr, int wc, int fr_, int fq_) const {
        (void)fr_; (void)fq_; const int ln_ = lane_id(); const int fr = ln_ & 15, fq = ln_ >> 4;
        const int col0 = u.pn * BM + wc * 32 + 8 * fq;
#pragma unroll
        for (int ai = 0; ai < 2; ++ai)
#pragma unroll
            for (int m = 0; m < 4; ++m) { const int r = ai * HALF + wr * 64 + m * 16 + fr; const unsigned off = (unsigned)((u.pm * BM + r) * ldc + col0);
                const float rb = ssq ? __builtin_amdgcn_rsqf(ssq[2 * (u.pm * BM + r) + 1] * (1.0f / 512.0f) + 1e-6f) : 1.0f;
#pragma unroll
                for (int bj = 0; bj < 2; ++bj)
#pragma unroll
                    for (int n = 0; n < 2; ++n) { const f32x4 bs = *(const f32x4*)(base + off + bj * HALF + n * 4); *(f32x4*)(out + off + bj * HALF + n * 4) = bs + acc[ai][bj][m][n] * rb; } }
    }
};
__device__ __forceinline__ float silu_mul(float g, float u) { return g * u * __builtin_amdgcn_rcpf(1.0f + __builtin_amdgcn_exp2f(-1.4426950408889634f * g)); }
struct EpiSwiGLU {
    static constexpr bool PERM = true, AFTER_DRAIN = false;
    bf16_t* O; int ldc;
    __device__ __forceinline__ void operator()(const f32x4 (&acc)[2][2][4][2], const Unit& u, int wr, int wc, int fr_, int fq_) const {
        (void)fr_; (void)fq_; const int ln_ = lane_id(); const int fr = ln_ & 15, fq = ln_ >> 4;
        const int row0 = u.pm * BM + wr * 64 + fr, col0 = u.pn * HALF + wc * 32 + 8 * fq;
#pragma unroll
        for (int ai = 0; ai < 2; ++ai)
#pragma unroll
            for (int m = 0; m < 4; ++m) { bf16_t* rowp = O + (unsigned)((row0 + ai * HALF + m * 16) * ldc + col0);
                const f32x4 g0 = acc[ai][0][m][0], g1 = acc[ai][0][m][1], u0 = acc[ai][1][m][0], u1 = acc[ai][1][m][1];
                u32x4 w; w.x = cvt_pk_bf16(silu_mul(g0[0], u0[0]), silu_mul(g0[1], u0[1])); w.y = cvt_pk_bf16(silu_mul(g0[2], u0[2]), silu_mul(g0[3], u0[3]));
                w.z = cvt_pk_bf16(silu_mul(g1[0], u1[0]), silu_mul(g1[1], u1[1])); w.w = cvt_pk_bf16(silu_mul(g1[2], u1[2]), silu_mul(g1[3], u1[3]));
                *(u32x4*)rowp = w; }
    }
};
struct EpiRowScaleBf16 {
    static constexpr bool PERM = true, AFTER_DRAIN = false;
    bf16_t* O; int ldc; const float* rowscale;
    __device__ __forceinline__ void operator()(const f32x4 (&acc)[2][2][4][2], const Unit& u, int wr, int wc, int fr_, int fq_) const {
        (void)fr_; (void)fq_; const int ln_ = lane_id(); const int fr = ln_ & 15, fq = ln_ >> 4;
        const int row0 = u.pm * BM + wr * 64 + fr, col0 = u.pn * BM + wc * 32 + 8 * fq;
#pragma unroll
        for (int ai = 0; ai < 2; ++ai)
#pragma unroll
            for (int m = 0; m < 4; ++m) { const int row = row0 + ai * HALF + m * 16; const float sc = rowscale[row]; bf16_t* rowp = O + (unsigned)(row * ldc + col0);
#pragma unroll
                for (int bj = 0; bj < 2; ++bj) { const f32x4 v0 = acc[ai][bj][m][0] * sc, v1 = acc[ai][bj][m][1] * sc;
                    u32x4 w; w.x = cvt_pk_bf16(v0[0], v0[1]); w.y = cvt_pk_bf16(v0[2], v0[3]); w.z = cvt_pk_bf16(v1[0], v1[1]); w.w = cvt_pk_bf16(v1[2], v1[3]);
                    *(u32x4*)(rowp + bj * HALF) = w; } }
    }
};
__device__ __forceinline__ float fqsum(float v) { v += __shfl_xor(v, 16); v += __shfl_xor(v, 32); return v; }
__device__ __forceinline__ float dot4(const f32x4 a) { return (a[0] * a[0] + a[1] * a[1]) + (a[2] * a[2] + a[3] * a[3]); }
__device__ __forceinline__ u32x4 pack8g(const f32x4 a, const f32x4 b, const float (&g)[8], float r) {
    u32x4 w; w.x = cvt_pk_bf16(a[0] * r * g[0], a[1] * r * g[1]); w.y = cvt_pk_bf16(a[2] * r * g[2], a[3] * r * g[3]); w.z = cvt_pk_bf16(b[0] * r * g[4], b[1] * r * g[5]); w.w = cvt_pk_bf16(b[2] * r * g[6], b[3] * r * g[7]); return w; }
typedef unsigned u32x2_t __attribute__((ext_vector_type(2)));
__device__ __forceinline__ float clampf8(float v) { return __builtin_amdgcn_fmed3f(v, -448.0f, 448.0f); }
__device__ __forceinline__ u32x2_t pack8g_f8(const f32x4 a, const f32x4 b, const float (&g)[8], float r) {
    int w0 = 0, w1 = 0;
    w0 = __builtin_amdgcn_cvt_pk_fp8_f32(clampf8(a[0] * r * g[0]), clampf8(a[1] * r * g[1]), w0, false); w0 = __builtin_amdgcn_cvt_pk_fp8_f32(clampf8(a[2] * r * g[2]), clampf8(a[3] * r * g[3]), w0, true);
    w1 = __builtin_amdgcn_cvt_pk_fp8_f32(clampf8(b[0] * r * g[4]), clampf8(b[1] * r * g[5]), w1, false); w1 = __builtin_amdgcn_cvt_pk_fp8_f32(clampf8(b[2] * r * g[6]), clampf8(b[3] * r * g[7]), w1, true);
    return (u32x2_t){(unsigned)w0, (unsigned)w1}; }
__device__ __forceinline__ u32x4 pack8s(const f32x4 a, const f32x4 b, float r) {
    u32x4 w; w.x = cvt_pk_bf16(a[0] * r, a[1] * r); w.y = cvt_pk_bf16(a[2] * r, a[3] * r); w.z = cvt_pk_bf16(b[0] * r, b[1] * r); w.w = cvt_pk_bf16(b[2] * r, b[3] * r); return w; }
constexpr float kEps = 1e-6f;
struct EpiInProj {
    static constexpr bool PERM = true, AFTER_DRAIN = false;
    unsigned char* ws; const float *gq, *gk, *gkr;
    __device__ __forceinline__ void operator()(const f32x4 (&acc)[2][2][4][2], const Unit& u, int wr, int wc, int fr_, int fq_) const {
        (void)fr_; (void)fq_; const int ln_ = lane_id(); const int fr = ln_ & 15, fq = ln_ >> 4;
        const int G = 4 * u.pn + wc;
        if (G >= 23) return;
        const int row0 = u.pm * BM + wr * 64 + fr;
        bf16_t* const QA = (bf16_t*)(ws + WS_QA); bf16_t* const KA = (bf16_t*)(ws + WS_KA); bf16_t* const VA = (bf16_t*)(ws + WS_VA); bf16_t* const CQ = (bf16_t*)(ws + WS_CQ); bf16_t* const CKV = (bf16_t*)(ws + WS_CKV); bf16_t* const KR = (bf16_t*)(ws + WS_KR);
        float* const ssq_cq = (float*)(ws + WS_SSQCQ); float* const ssq_ckv = (float*)(ws + WS_SSQCKV); const float* const cosT = (const float*)(ws + WS_TAB) + TAB_COS; const float* const sinT = (const float*)(ws + WS_TAB) + TAB_SIN;
        constexpr float qscale = QSC_A; constexpr int seq = SEQ;
        if (G < 10) {
            const float* gg = (G < 8) ? gq : gk; const float sc = (G < 8) ? qscale : 1.0f; bf16_t* dst = (G < 8) ? QA + 64 * G : KA + 64 * (G - 8); const int ld = (G < 8) ? 512 : 128;
            float g0[8], g1[8];
#pragma unroll
            for (int j = 0; j < 8; ++j) { g0[j] = gg[8 * fq + j]; g1[j] = gg[32 + 8 * fq + j]; }
#pragma unroll
            for (int ai = 0; ai < 2; ++ai)
#pragma unroll
                for (int m = 0; m < 4; ++m) { const int row = row0 + ai * HALF + m * 16;
                    const float ss = fqsum((dot4(acc[ai][0][m][0]) + dot4(acc[ai][0][m][1])) + (dot4(acc[ai][1][m][0]) + dot4(acc[ai][1][m][1])));
                    const float r = sc * __builtin_amdgcn_rsqf(ss * (1.0f / 64.0f) + kEps); bf16_t* p = dst + (unsigned)(row * ld + 8 * fq);
                    *(u32x4*)p = pack8g(acc[ai][0][m][0], acc[ai][0][m][1], g0, r); *(u32x4*)(p + 32) = pack8g(acc[ai][1][m][0], acc[ai][1][m][1], g1, r); }
        } else if (G < 22) {
            bf16_t* dst; int ld; float* sq;
            if (G < 12) { dst = VA + 64 * (G - 10); ld = 128; sq = nullptr; } else if (G < 18) { dst = CQ + 64 * (G - 12); ld = 384; sq = ssq_cq; } else { dst = CKV + 64 * (G - 18); ld = 256; sq = ssq_ckv; }
#pragma unroll
            for (int ai = 0; ai < 2; ++ai)
#pragma unroll
                for (int m = 0; m < 4; ++m) { const int row = row0 + ai * HALF + m * 16; bf16_t* p = dst + (unsigned)(row * ld + 8 * fq);
                    if (sq) { const float ss = fqsum((dot4(acc[ai][0][m][0]) + dot4(acc[ai][0][m][1])) + (dot4(acc[ai][1][m][0]) + dot4(acc[ai][1][m][1]))); if (fq == 0) atomicAdd(sq + row, ss); }
                    *(u32x4*)p = pack8s(acc[ai][0][m][0], acc[ai][0][m][1], 1.0f); *(u32x4*)(p + 32) = pack8s(acc[ai][1][m][0], acc[ai][1][m][1], 1.0f); }
        } else {
            float g0[8];
#pragma unroll
            for (int j = 0; j < 8; ++j) g0[j] = gkr[8 * fq + j];
#pragma unroll
            for (int ai = 0; ai < 2; ++ai)
#pragma unroll
                for (int m = 0; m < 4; ++m) { const int row = row0 + ai * HALF + m * 16; const int s = row % seq;
                    const float ss = fqsum(dot4(acc[ai][0][m][0]) + dot4(acc[ai][0][m][1])); const float r = __builtin_amdgcn_rsqf(ss * (1.0f / 32.0f) + kEps);
                    float o[8];
#pragma unroll
                    for (int j = 0; j < 8; ++j) { const float y = ((j < 4) ? acc[ai][0][m][0][j & 3] : acc[ai][0][m][1][j & 3]) * r * g0[j]; const float pp = __shfl_xor(y, 32);
                        const int i16 = 8 * (fq & 1) + j; const float c = cosT[s * 16 + i16], sn = sinT[s * 16 + i16]; o[j] = (fq < 2) ? (y * c - pp * sn) : (pp * sn + y * c); }
                    u32x4 w; w.x = cvt_pk_bf16(o[0], o[1]); w.y = cvt_pk_bf16(o[2], o[3]); w.z = cvt_pk_bf16(o[4], o[5]); w.w = cvt_pk_bf16(o[6], o[7]);
                    *(u32x4*)(KR + (unsigned)((((row >> 12) * 64 + ((row >> 6) & 63)) * 2048) + fq * 512 + (row & 63) * 8)) = w; }
        }
    }
};
struct EpiQB {
    static constexpr bool PERM = true, AFTER_DRAIN = false;
    unsigned char* ws; const float *gqn, *gqr;
    __device__ __forceinline__ void operator()(const f32x4 (&acc)[2][2][4][2], const Unit& u, int wr, int wc, int fr_, int fq_) const {
        (void)fr_; (void)fq_; const int ln_ = lane_id(); const int fr = ln_ & 15, fq = ln_ >> 4;
        const int row0 = u.pm * BM + wr * 64 + fr;
        bf16_t* const QB = (bf16_t*)(ws + WS_QB); const float* const ssq_cq = (const float*)(ws + WS_SSQCQ); const float* const cosT = (const float*)(ws + WS_TAB) + TAB_COS; const float* const sinT = (const float*)(ws + WS_TAB) + TAB_SIN;
        constexpr float qscale = QSC_B; constexpr int seq = SEQ;
        if (u.pn < 2) {
            const int head = 4 * u.pn + wc; float g0[8], g1[8];
#pragma unroll
            for (int j = 0; j < 8; ++j) { g0[j] = gqn[8 * fq + j]; g1[j] = gqn[32 + 8 * fq + j]; }
#pragma unroll
            for (int ai = 0; ai < 2; ++ai)
#pragma unroll
                for (int m = 0; m < 4; ++m) { const int row = row0 + ai * HALF + m * 16; const float eps2 = kEps * (ssq_cq[row] * (1.0f / 384.0f) + kEps);
                    const float ss = fqsum((dot4(acc[ai][0][m][0]) + dot4(acc[ai][0][m][1])) + (dot4(acc[ai][1][m][0]) + dot4(acc[ai][1][m][1])));
                    const float r = (64.0f * qscale) * __builtin_amdgcn_rsqf(ss * (1.0f / 64.0f) + eps2); unsigned char* p = ws + WS_QN8 + (unsigned)(row * 512 + 64 * head + 8 * fq);
                    *(u32x2_t*)p = pack8g_f8(acc[ai][0][m][0], acc[ai][0][m][1], g0, r); *(u32x2_t*)(p + 32) = pack8g_f8(acc[ai][1][m][0], acc[ai][1][m][1], g1, r); }
        } else {
            float g0[8];
#pragma unroll
            for (int j = 0; j < 8; ++j) g0[j] = gqr[8 * fq + j];
#pragma unroll
            for (int ai = 0; ai < 2; ++ai)
#pragma unroll
                for (int m = 0; m < 4; ++m) { const int row = row0 + ai * HALF + m * 16; const int s = row % seq; const float eps2 = kEps * (ssq_cq[row] * (1.0f / 384.0f) + kEps);
#pragma unroll
                    for (int bj = 0; bj < 2; ++bj) { const int head = 2 * wc + bj;
                        const float ss = fqsum(dot4(acc[ai][bj][m][0]) + dot4(acc[ai][bj][m][1])); const float r = __builtin_amdgcn_rsqf(ss * (1.0f / 32.0f) + eps2);
                        float o[8];
#pragma unroll
                        for (int j = 0; j < 8; ++j) { const float y = ((j < 4) ? acc[ai][bj][m][0][j & 3] : acc[ai][bj][m][1][j & 3]) * r * g0[j]; const float pp = __shfl_xor(y, 32);
                            const int i16 = 8 * (fq & 1) + j; const float c = cosT[s * 16 + i16], sn = sinT[s * 16 + i16]; o[j] = qscale * ((fq < 2) ? (y * c - pp * sn) : (pp * sn + y * c)); }
                        u32x4 w; w.x = cvt_pk_bf16(o[0], o[1]); w.y = cvt_pk_bf16(o[2], o[3]); w.z = cvt_pk_bf16(o[4], o[5]); w.w = cvt_pk_bf16(o[6], o[7]);
                        *(u32x4*)(QB + (unsigned)(row * 768 + 96 * head + 64 + 8 * fq)) = w; } }
        }
    }
};
struct EpiKVB {
    static constexpr bool PERM = true, AFTER_DRAIN = false;
    unsigned char* ws; const float* gkn;
    __device__ __forceinline__ void operator()(const f32x4 (&acc)[2][2][4][2], const Unit& u, int wr, int wc, int fr_, int fq_) const {
        (void)fr_; (void)fq_; const int ln_ = lane_id(); const int fr = ln_ & 15, fq = ln_ >> 4;
        const int row0 = u.pm * BM + wr * 64 + fr, G = 4 * u.pn + wc, head = G >> 1;
        bf16_t* const KBN = (bf16_t*)(ws + WS_KBN); bf16_t* const VB = (bf16_t*)(ws + WS_VB); const float* const ssq_ckv = (const float*)(ws + WS_SSQCKV);
        if (!(G & 1)) {
            float g0[8], g1[8];
#pragma unroll
            for (int j = 0; j < 8; ++j) { g0[j] = gkn[8 * fq + j]; g1[j] = gkn[32 + 8 * fq + j]; }
#pragma unroll
            for (int ai = 0; ai < 2; ++ai)
#pragma unroll
                for (int m = 0; m < 4; ++m) { const int row = row0 + ai * HALF + m * 16; const float eps2 = kEps * (ssq_ckv[row] * (1.0f / 256.0f) + kEps);
                    const float ss = fqsum((dot4(acc[ai][0][m][0]) + dot4(acc[ai][0][m][1])) + (dot4(acc[ai][1][m][0]) + dot4(acc[ai][1][m][1])));
                    const float r = 8.0f * __builtin_amdgcn_rsqf(ss * (1.0f / 64.0f) + eps2);
                    unsigned char* p = (unsigned char*)KBN + (unsigned)(((((row >> 12) * 8 + head) * 64 + ((row >> 6) & 63)) * 4096) + (fq >> 1) * 1024 + (row & 63) * 16 + (fq & 1) * 8);
                    *(u32x2_t*)p = pack8g_f8(acc[ai][0][m][0], acc[ai][0][m][1], g0, r); *(u32x2_t*)(p + 2048) = pack8g_f8(acc[ai][1][m][0], acc[ai][1][m][1], g1, r); }
        } else {
#pragma unroll
            for (int ai = 0; ai < 2; ++ai)
#pragma unroll
                for (int m = 0; m < 4; ++m) { const int row = row0 + ai * HALF + m * 16; const float al = __builtin_amdgcn_rsqf(ssq_ckv[row] * (1.0f / 256.0f) + kEps); bf16_t* p = VB + (unsigned)(((((row >> 12) * 8 + head) * 64 + ((row >> 6) & 63)) * 4096) + ((row >> 4) & 3) * 512 + (row & 15) * 32 + 8 * fq);
                    *(u32x4*)p = pack8s(acc[ai][0][m][0], acc[ai][0][m][1], al); *(u32x4*)(p + 4 * 512) = pack8s(acc[ai][1][m][0], acc[ai][1][m][1], al); }
        }
    }
};

__device__ __forceinline__ float clamp448(float v) { return __builtin_fminf(__builtin_fmaxf(v, -448.0f), 448.0f); }
__device__ __forceinline__ unsigned pk4_fp8(float a, float b, float c, float d) { int w = 0; w = __builtin_amdgcn_cvt_pk_fp8_f32(clamp448(a), clamp448(b), w, false); w = __builtin_amdgcn_cvt_pk_fp8_f32(clamp448(c), clamp448(d), w, true); return (unsigned)w; }
__device__ __forceinline__ unsigned pk4_fp8_nc(float a, float b, float c, float d) { int w = 0; w = __builtin_amdgcn_cvt_pk_fp8_f32(a, b, w, false); w = __builtin_amdgcn_cvt_pk_fp8_f32(c, d, w, true); return (unsigned)w; }
struct EpiSwiGLU8 {
    static constexpr bool PERM = true, AFTER_DRAIN = false;
    unsigned char* O; int ldc; float oscale;
    __device__ __forceinline__ void operator()(const f32x4 (&acc)[2][2][4][2], const Unit& u, int wr, int wc, int fr_, int fq_) const {
        (void)fr_; (void)fq_; const int ln_ = lane_id(); const int fr = ln_ & 15, fq = ln_ >> 4;
        const int row0 = u.pm * BM + wr * 64 + fr, col0 = u.pn * HALF + wc * 32 + 8 * fq;
#pragma unroll
        for (int ai = 0; ai < 2; ++ai)
#pragma unroll
            for (int m = 0; m < 4; ++m) { unsigned char* rowp = O + (unsigned)((row0 + ai * HALF + m * 16) * ldc + col0);
                const f32x4 g0 = acc[ai][0][m][0], g1 = acc[ai][0][m][1], u0 = acc[ai][1][m][0], u1 = acc[ai][1][m][1];
                typedef unsigned u32x2 __attribute__((ext_vector_type(2))); u32x2 w;
                w.x = pk4_fp8(oscale * silu_mul(g0[0], u0[0]), oscale * silu_mul(g0[1], u0[1]), oscale * silu_mul(g0[2], u0[2]), oscale * silu_mul(g0[3], u0[3]));
                w.y = pk4_fp8(oscale * silu_mul(g1[0], u1[0]), oscale * silu_mul(g1[1], u1[1]), oscale * silu_mul(g1[2], u1[2]), oscale * silu_mul(g1[3], u1[3]));
                *(u32x2*)rowp = w; }
    }
};

struct EpiRowScaleF8 {
    static constexpr bool PERM = true, AFTER_DRAIN = false;
    unsigned char* O; int ldc; const float* rowscale; float oscale;
    __device__ __forceinline__ void operator()(const f32x4 (&acc)[2][2][4][2], const Unit& u, int wr, int wc, int fr_, int fq_) const {
        (void)fr_; (void)fq_; const int ln_ = lane_id(); const int fr = ln_ & 15, fq = ln_ >> 4;
        const int row0 = u.pm * BM + wr * 64 + fr, col0 = u.pn * BM + wc * 32 + 8 * fq;
#pragma unroll
        for (int ai = 0; ai < 2; ++ai)
#pragma unroll
            for (int m = 0; m < 4; ++m) { const int row = row0 + ai * HALF + m * 16; const float sc = rowscale[row] * oscale; unsigned char* rowp = O + (unsigned)(row * ldc + col0);
#pragma unroll
                for (int bj = 0; bj < 2; ++bj) { const f32x4 v0 = acc[ai][bj][m][0] * sc, v1 = acc[ai][bj][m][1] * sc;
                    typedef unsigned u32x2 __attribute__((ext_vector_type(2))); u32x2 w; w.x = pk4_fp8(v0[0], v0[1], v0[2], v0[3]); w.y = pk4_fp8(v1[0], v1[1], v1[2], v1[3]);
                    *(u32x2*)(rowp + bj * HALF) = w; } }
    }
};

struct EpiNormBf16 {
    static constexpr bool PERM = true, AFTER_DRAIN = false;
    bf16_t* O; int ldc; const float* ssq;
    __device__ __forceinline__ void operator()(const f32x4 (&acc)[2][2][4][2], const Unit& u, int wr, int wc, int fr_, int fq_) const {
        (void)fr_; (void)fq_; const int ln_ = lane_id(); const int fr = ln_ & 15, fq = ln_ >> 4;
        const int row0 = u.pm * BM + wr * 64 + fr, col0 = u.pn * BM + wc * 32 + 8 * fq;
#pragma unroll
        for (int ai = 0; ai < 2; ++ai)
#pragma unroll
            for (int m = 0; m < 4; ++m) { const int row = row0 + ai * HALF + m * 16; const float rb = __builtin_amdgcn_rsqf(ssq[2 * row + 1] * (1.0f / 512.0f) + 1e-6f); bf16_t* rowp = O + (unsigned)(row * ldc + col0);
#pragma unroll
                for (int bj = 0; bj < 2; ++bj) *(u32x4*)(rowp + bj * HALF) = pack8s(acc[ai][bj][m][0], acc[ai][bj][m][1], rb); }
    }
};
__device__ __forceinline__ void glds_sv(const char* sbase, unsigned voff, unsigned lds_dst) { unsigned keep;
    asm volatile("s_mov_b32 %0, m0\n\ts_mov_b32 m0, %3\n\ts_nop 0\n\tglobal_load_lds_dwordx4 %1, %2\n\ts_mov_b32 m0, %0" : "=&s"(keep) : "v"(voff), "s"(sbase), "s"(lds_dst) : "memory"); }
template <class Epi, class Sched, bool ALIGN_EPI = false, bool SP2 = false, int MODE = 0, bool F8 = false>
__device__ __forceinline__ void gemm_phase(PG8_LAS unsigned char* lds, const Gemm g, const Sched& S, const Epi& E) {
    const int lane = lane_id(), wid = g.wave, tid = wid * 64 + lane,
              wr = wid >> 2, wc = wid & 3, fr = lane & 15, fq = lane >> 4;
    int K_ = g.K; asm volatile("" : "+s"(K_));
    const int K = K_, nt = K / BK;
    unsigned voffA[2], voffB[2];
#pragma unroll
    for (int i = 0; i < 2; ++i) { int R, C; if constexpr (F8) stage_rc8(tid * 16 + i * 8192, R, C); else stage_rc(tid * 16 + i * 8192, R, C); const int Rb = Epi::PERM ? ((R & ~31) + perm32(R & 31)) : R;
        voffA[i] = (unsigned)(R * K + C) * 2u; voffB[i] = (unsigned)(Rb * K + C) * 2u; }
    const size_t r64step = (size_t)64 * K * 2;
    const size_t kstep = (size_t)(BK * 2);
    const size_t hstep = (size_t)HALF * K * 2;
    const size_t tstep = 2 * hstep;
    const unsigned ldsw = (unsigned)wid * 1024u;
    const unsigned ldsbase = (unsigned)__builtin_amdgcn_readfirstlane((int)((unsigned)(uintptr_t)lds + ldsw));
    const int aoff = lds_byte(wr * 64 + fr, fq * 8), boff = lds_byte(wc * 32 + fr, fq * 8);
    const int aoff8 = lds_byte8(wr * 64 + fr, fq * 32), boff8 = lds_byte8(wc * 32 + fr, fq * 32);
#define PG8_X16(x) ({ int t_; asm volatile("v_xor_b32 %0, 16, %1" : "=v"(t_) : "v"(x)); t_; })
    typedef int v8i32 __attribute__((ext_vector_type(8))); typedef short bf16x16 __attribute__((ext_vector_type(16)));
#define PG8_SA(b, h) (((b) * 2 + (h)) * HTB)
#define PG8_SB(b, h) ((4 + (b) * 2 + (h)) * HTB)
#define PG8_STAGE(bufoff, gbase, voff) do { _Pragma("unroll") for (int _i = 0; _i < 2; ++_i) \
        glds_sv((const char*)(gbase) + (size_t)_i * r64step, (voff)[0], ldsbase + (unsigned)((bufoff) + _i * 8192)); } while (0)
#define PG8_LDA(dst, b, h) do { if constexpr (F8) { const int a1_ = PG8_X16(aoff8); _Pragma("unroll") for (int m = 0; m < 4; ++m) { dst[m][0] = *(const PG8_LAS bf16x8*)(lds + PG8_SA(b, h) + aoff8 + m * 2048); dst[m][1] = *(const PG8_LAS bf16x8*)(lds + PG8_SA(b, h) + a1_ + m * 2048); } } \
        else { _Pragma("unroll") for (int m = 0; m < 4; ++m) _Pragma("unroll") for (int k = 0; k < 2; ++k) dst[m][k] = *(const PG8_LAS bf16x8*)(lds + PG8_SA(b, h) + aoff + k * 1024 + m * 2048); } } while (0)
#define PG8_LDB(dst, b, h) do { if constexpr (F8) { const int b1_ = PG8_X16(boff8); _Pragma("unroll") for (int n = 0; n < 2; ++n) { dst[n][0] = *(const PG8_LAS bf16x8*)(lds + PG8_SB(b, h) + boff8 + n * 2048); dst[n][1] = *(const PG8_LAS bf16x8*)(lds + PG8_SB(b, h) + b1_ + n * 2048); } } \
        else { _Pragma("unroll") for (int n = 0; n < 2; ++n) _Pragma("unroll") for (int k = 0; k < 2; ++k) dst[n][k] = *(const PG8_LAS bf16x8*)(lds + PG8_SB(b, h) + boff + k * 1024 + n * 2048); } } while (0)
#define PG8_F8FRAG(x) __builtin_bit_cast(v8i32, (bf16x16){x[0][0], x[0][1], x[0][2], x[0][3], x[0][4], x[0][5], x[0][6], x[0][7], x[1][0], x[1][1], x[1][2], x[1][3], x[1][4], x[1][5], x[1][6], x[1][7]})
#define PG8_MMA(ai, bj, At, Bt) do { __builtin_amdgcn_s_setprio(1); _Pragma("unroll") for (int m = 0; m < 4; ++m) _Pragma("unroll") for (int n = 0; n < 2; ++n) { \
        if constexpr (F8) { acc[ai][bj][m][n] = __builtin_amdgcn_mfma_scale_f32_16x16x128_f8f6f4(PG8_F8FRAG(Bt[n]), PG8_F8FRAG(At[m]), acc[ai][bj][m][n], 0, 0, 0, g.sA, 0, g.sA); }     \
        else { _Pragma("unroll") for (int k = 0; k < 2; ++k) acc[ai][bj][m][n] = __builtin_amdgcn_mfma_f32_16x16x32_bf16(Bt[n][k], At[m][k], acc[ai][bj][m][n], 0, 0, 0); } } __builtin_amdgcn_s_setprio(0); } while (0)
#define PG8_WAIT_V(n) asm volatile("s_waitcnt vmcnt(" #n ")" ::: "memory")
#define PG8_WAIT_L(n) asm volatile("s_waitcnt lgkmcnt(" #n ")" ::: "memory")
#define PG8_BAR __builtin_amdgcn_s_barrier()
#define PG8_SCHED __builtin_amdgcn_sched_barrier(0)
    Unit cur, nxt; int ui = 0;
    if (!S.next(0, cur)) return;
    f32x4 acc[2][2][4][2];
#pragma unroll
    for (int a = 0; a < 2; ++a)
#pragma unroll
        for (int b = 0; b < 2; ++b)
#pragma unroll
            for (int m = 0; m < 4; ++m)
#pragma unroll
                for (int n = 0; n < 2; ++n) acc[a][b][m][n] = (f32x4){0.f, 0.f, 0.f, 0.f};
    bf16x8 At[4][2], B0[2][2], B1[2][2];
    const char* cA = (const char*)g.A + (MODE == 1 ? (size_t)0 : (size_t)cur.pm * tstep); const char* cB = (const char*)g.Bt + (size_t)cur.e * g.estride + (size_t)cur.pn * tstep;
    PG8_LAS unsigned* const gt = (PG8_LAS unsigned*)(lds + g.gtab);
#define PG8_GFILL(slot, u) do { const int t_ = wid * 64 + lane_id(); if (t_ < BM) gt[(slot) * BM + t_] = (unsigned)g.idx[(u).pm * BM + t_] * (unsigned)(K * 2); } while (0)
    if constexpr (MODE == 1) { PG8_GFILL(0, cur); __syncthreads(); }
    int gR0_, gC0_; if constexpr (F8) stage_rc8(tid * 16, gR0_, gC0_); else stage_rc(tid * 16, gR0_, gC0_); PG8_LAS unsigned* const gtl = gt + gR0_; const unsigned gcb = (unsigned)gC0_ * 2u;
#define PG8_STA(bufoff, gbase, H, NXT) do { if constexpr (MODE == 1) { const int slot_ = ((NXT) ? ui + 1 : ui) & 1; _Pragma("unroll") for (int _i = 0; _i < 2; ++_i) { \
        const unsigned vo_ = gtl[slot_ * BM + (H) * HALF + _i * 64] + gcb; glds_sv((const char*)(gbase), vo_, ldsbase + (unsigned)((bufoff) + _i * 8192)); } } \
        else { PG8_STAGE(bufoff, (gbase) + ((H) ? hstep : (size_t)0), voffA); } } while (0)
    S.a_ready(cur);
    if constexpr (SP2) {
        PG8_STAGE(PG8_SB(0, 0), cB, voffB); PG8_STAGE(PG8_SB(0, 1), cB + hstep, voffB); PG8_STA(PG8_SA(0, 0), cA, 0, false); PG8_STA(PG8_SA(0, 1), cA, 1, false);
        if (wr == 1) PG8_BAR;
        PG8_WAIT_V(2); PG8_BAR;
        PG8_STAGE(PG8_SB(1, 0), cB + kstep, voffB); PG8_STA(PG8_SA(1, 0), cA + kstep, 0, false); PG8_STAGE(PG8_SB(1, 1), cB + hstep + kstep, voffB);
        PG8_WAIT_V(6); PG8_BAR;
    } else {
        PG8_STAGE(PG8_SB(0, 0), cB, voffB); PG8_STAGE(PG8_SA(0, 0), cA, voffA); PG8_STAGE(PG8_SB(0, 1), cB + hstep, voffB); PG8_STAGE(PG8_SA(0, 1), cA + hstep, voffA);
        if (wr == 1) PG8_BAR;
        PG8_WAIT_V(4); PG8_BAR;
        PG8_STAGE(PG8_SB(1, 0), cB + kstep, voffB); PG8_STAGE(PG8_SA(1, 0), cA + kstep, voffA); PG8_STAGE(PG8_SB(1, 1), cB + hstep + kstep, voffB);
        PG8_WAIT_V(6); PG8_BAR;
    }
    for (;;) {
        const bool has_next = S.next(ui + 1, nxt);
        if constexpr (MODE == 1) { if (has_next) PG8_GFILL((ui + 1) & 1, nxt); else PG8_GFILL((ui + 1) & 1, cur); }
        const char* nA = (MODE == 1) ? cA : (has_next ? (const char*)g.A + (size_t)nxt.pm * tstep : cA); const char* nB = has_next ? (const char*)g.Bt + (size_t)nxt.e * g.estride + (size_t)nxt.pn * tstep : cB;
        for (int t = 0; t < nt; t += 2) {
            const bool last = (t == nt - 2);
            if constexpr (MODE == 2) { if (t == nt / 2) {
#pragma unroll
                for (int ai = 0; ai < 2; ++ai)
#pragma unroll
                    for (int m = 0; m < 4; ++m) { const int row = cur.pm * BM + ai * HALF + wr * 64 + m * 16 + fr; const float sa = g.ssq[2 * row], sb = g.ssq[2 * row + 1];
                        const float ratio = __builtin_amdgcn_rsqf(sa * (1.0f / 512.0f) + 1e-6f) * __builtin_amdgcn_sqrtf(sb * (1.0f / 512.0f) + 1e-6f);
#pragma unroll
                        for (int bj = 0; bj < 2; ++bj)
#pragma unroll
                            for (int n = 0; n < 2; ++n) acc[ai][bj][m][n] *= ratio; } } }
            const char* a1 = cA + (size_t)(t + 1) * kstep;
            const char* a2 = last ? nA : cA + (size_t)(t + 2) * kstep; const char* b2 = last ? nB : cB + (size_t)(t + 2) * kstep;
            const char* a3 = a2 + kstep; const char* b3 = b2 + kstep;
            if (last && has_next) S.a_ready(nxt);
            if constexpr (SP2) {
            PG8_LDB(B0, 0, 0); PG8_LDB(B1, 0, 1); PG8_SCHED; PG8_LDA(At, 0, 0); PG8_STA(PG8_SA(1, 1), a1, 1, false);
            PG8_WAIT_V(8); PG8_WAIT_L(0); PG8_BAR; PG8_MMA(0, 0, At, B0); PG8_MMA(0, 1, At, B1); PG8_BAR; PG8_SCHED;
            PG8_LDA(At, 0, 1); PG8_STAGE(PG8_SB(0, 0), b2, voffB); PG8_STAGE(PG8_SB(0, 1), b2 + hstep, voffB); PG8_STA(PG8_SA(0, 0), a2, 0, last);
            PG8_WAIT_V(8); PG8_WAIT_L(0); PG8_BAR; PG8_MMA(1, 0, At, B0); PG8_MMA(1, 1, At, B1); PG8_BAR; PG8_SCHED;
            PG8_LDB(B0, 1, 0); PG8_LDB(B1, 1, 1); PG8_SCHED; PG8_LDA(At, 1, 0); PG8_STA(PG8_SA(0, 1), a2, 1, last);
            PG8_WAIT_V(8); PG8_WAIT_L(0); PG8_BAR; PG8_MMA(0, 0, At, B0); PG8_MMA(0, 1, At, B1); PG8_BAR; PG8_SCHED;
            PG8_LDA(At, 1, 1); PG8_STAGE(PG8_SB(1, 0), b3, voffB); PG8_STAGE(PG8_SB(1, 1), b3 + hstep, voffB); PG8_STA(PG8_SA(1, 0), a3, 0, last);
            PG8_WAIT_V(8); PG8_WAIT_L(0); PG8_BAR; PG8_MMA(1, 0, At, B0); PG8_MMA(1, 1, At, B1); PG8_BAR; PG8_SCHED;
            } else {
            PG8_LDB(B0, 0, 0); PG8_SCHED; PG8_LDA(At, 0, 0); PG8_STAGE(PG8_SA(1, 1), a1 + hstep, voffA);
            PG8_WAIT_L(8); PG8_BAR; PG8_WAIT_L(0); PG8_MMA(0, 0, At, B0); PG8_BAR; PG8_SCHED;
            PG8_LDB(B1, 0, 1); PG8_STAGE(PG8_SB(0, 0), b2, voffB);
            PG8_BAR; PG8_WAIT_L(0); PG8_MMA(0, 1, At, B1); PG8_BAR;
            PG8_LDA(At, 0, 1); PG8_STAGE(PG8_SA(0, 0), a2, voffA);
            PG8_BAR; PG8_WAIT_L(0); PG8_MMA(1, 0, At, B0); PG8_BAR; PG8_SCHED;
            PG8_STAGE(PG8_SB(0, 1), b2 + hstep, voffB);
            PG8_WAIT_V(6); PG8_BAR; PG8_MMA(1, 1, At, B1); PG8_BAR;
            PG8_LDB(B0, 1, 0); PG8_SCHED; PG8_LDA(At, 1, 0); PG8_STAGE(PG8_SA(0, 1), a2 + hstep, voffA);
            PG8_WAIT_L(8); PG8_BAR; PG8_WAIT_L(0); PG8_MMA(0, 0, At, B0); PG8_BAR; PG8_SCHED;
            PG8_LDB(B1, 1, 1); PG8_STAGE(PG8_SB(1, 0), b3, voffB);
            PG8_BAR; PG8_WAIT_L(0); PG8_MMA(0, 1, At, B1); PG8_BAR;
            PG8_LDA(At, 1, 1); PG8_STAGE(PG8_SA(1, 0), a3, voffA);
            PG8_BAR; PG8_WAIT_L(0); PG8_MMA(1, 0, At, B0); PG8_BAR; PG8_SCHED;
            PG8_STAGE(PG8_SB(1, 1), b3 + hstep, voffB);
            PG8_WAIT_V(6); PG8_BAR; PG8_MMA(1, 1, At, B1); PG8_BAR;
            }
        }
        if constexpr (ALIGN_EPI) { if (wr == 0) PG8_BAR; }
        if constexpr (!Epi::AFTER_DRAIN) { E(acc, cur, wr, wc, fr, fq); S.done(cur); }
        if (!has_next) break;
#pragma unroll
        for (int a = 0; a < 2; ++a)
#pragma unroll
            for (int b = 0; b < 2; ++b)
#pragma unroll
                for (int m = 0; m < 4; ++m)
#pragma unroll
                    for (int n = 0; n < 2; ++n) acc[a][b][m][n] = (f32x4){0.f, 0.f, 0.f, 0.f};
        cur = nxt; cA = nA; cB = nB; ++ui;
        if constexpr (ALIGN_EPI) { if (wr == 1) PG8_BAR; }
    }
    PG8_WAIT_V(0);
    if constexpr (!ALIGN_EPI) { if (wr == 0) PG8_BAR; }
    PG8_BAR;
    if constexpr (Epi::AFTER_DRAIN) { E.fused(acc, cur, wr, wc, fr, fq, lds, wid, lane); S.done(cur); }
#undef PG8_SA
#undef PG8_SB
#undef PG8_STAGE
#undef PG8_LDA
#undef PG8_LDB
#undef PG8_MMA
#undef PG8_F8FRAG
#undef PG8_X16
#undef PG8_WAIT_V
#undef PG8_WAIT_L
#undef PG8_BAR
#undef PG8_SCHED
#undef PG8_STA
#undef PG8_GFILL
}
}
#define GAS __attribute__((address_space(1)))
#define LAS __attribute__((address_space(3)))
typedef unsigned short bf16;
typedef unsigned v4u __attribute__((ext_vector_type(4)));
typedef float f32x4 __attribute__((ext_vector_type(4)));
typedef short bf16x8 __attribute__((ext_vector_type(8)));
typedef GAS unsigned gu32;
typedef GAS unsigned long long gu64;
#define RLX_AGENT __ATOMIC_RELAXED, __HIP_MEMORY_SCOPE_AGENT
#define LDS_WAIT() asm volatile("s_waitcnt lgkmcnt(0)" ::: "memory")
#define VM_WAIT() asm volatile("s_waitcnt vmcnt(0)" ::: "memory")
__device__ __forceinline__ unsigned long long rt() { return __builtin_amdgcn_s_memrealtime(); }
__device__ __forceinline__ unsigned f2bf(float f) { unsigned u = __builtin_bit_cast(unsigned, f); return (u + 0x7fffu + ((u >> 16) & 1u)) >> 16; }
__device__ __forceinline__ unsigned pk2(float lo, float hi) { return f2bf(lo) | (f2bf(hi) << 16); }

#define XB_TMO      128
#define XB_XCNT(j)  (256  + 64 * (j))
#define XB_XSUB(j)  (1280 + 64 * (j))
#define XB_XGEN(j)  (2304 + 64 * (j))
#define XB_TOP      3328
#define XB_TOPGEN   3392
#define XCD_BAR_WORDS 3456
#define XB_SPIN_CAP (1u << 18)

__device__ __forceinline__ unsigned xb_ld(unsigned* p)              { return __hip_atomic_load(p, __ATOMIC_RELAXED, __HIP_MEMORY_SCOPE_AGENT); }
__device__ __forceinline__ unsigned xb_add(unsigned* p, unsigned v) { return __hip_atomic_fetch_add(p, v, __ATOMIC_RELAXED, __HIP_MEMORY_SCOPE_AGENT); }
__device__ __forceinline__ unsigned xb_xcc_id() { return (unsigned)__builtin_amdgcn_s_getreg((3 << 11) | 20) & 0xFu; }
#define XB_SPIN(cond, bar) do { unsigned _sp = 0; while (cond) { __builtin_amdgcn_s_sleep(1); \
    if ((++_sp & 255u) == 0u) { if (xb_ld(&(bar)[XB_TMO])) break; if (_sp > XB_SPIN_CAP) { atomicAdd(&(bar)[XB_TMO], 1u); break; } } } } while (0)

struct XcdBarrier {
    int wave;
    unsigned* bar; unsigned x;
    volatile LAS unsigned* st;
};

__device__ __forceinline__ XcdBarrier xcd_barrier_post(unsigned* bar, volatile LAS unsigned* st) {
    XcdBarrier b; b.wave = __builtin_amdgcn_readfirstlane((int)(threadIdx.x >> 6)); b.bar = bar; b.x = xb_xcc_id(); b.st = st;
    if (threadIdx.x == 0) (void)xb_add(&bar[XB_XCNT(b.x)], 1u);
    return b;
}
__device__ __forceinline__ void xcd_barrier_complete(unsigned* bar, unsigned x, unsigned& nloc, unsigned& nx) {
    const unsigned G = gridDim.x * gridDim.y * gridDim.z;
    unsigned sum, cnt, mine, sp = 0u;
    for (;;) {
        sum = 0u; cnt = 0u; mine = 0u;
#pragma unroll
        for (unsigned j = 0; j < 16; ++j) { const unsigned c = xb_ld(&bar[XB_XCNT(j)]); sum += c; cnt += (c > 0u) ? 1u : 0u; mine = (j == x) ? c : mine; }
        if (sum == G) break;
        __builtin_amdgcn_s_sleep(1);
        if ((++sp & 255u) == 0u) { if (xb_ld(&bar[XB_TMO])) break; if (sp > XB_SPIN_CAP) { atomicAdd(&bar[XB_TMO], 1u); break; } }
    }
    nloc = mine > 0u ? mine : 1u; nx = cnt > 0u ? cnt : 1u;
}

__device__ __forceinline__ void xcd_barrier(const XcdBarrier& b) {
    asm volatile("s_waitcnt vmcnt(0)" ::: "memory");
    __syncthreads();
    if (b.wave == 0 && lane_id() == 0) {
        unsigned* bar = b.bar;
        __builtin_amdgcn_s_waitcnt(0);
        unsigned nloc = b.st[0], nx = b.st[1];
        if (nloc == 0u) { xcd_barrier_complete(bar, b.x, nloc, nx); b.st[0] = nloc; b.st[1] = nx; }
        const unsigned old = xb_add(&bar[XB_XSUB(b.x)], 1u);
        const unsigned gen = old / nloc;
        if (old + 1u == (gen + 1u) * nloc) {
            __builtin_amdgcn_fence(__ATOMIC_RELEASE, "agent");
            asm volatile("s_waitcnt vmcnt(0)" ::: "memory");
            const unsigned og = xb_add(&bar[XB_TOP], 1u);
            const unsigned tg = og / nx;
            if (og + 1u == (tg + 1u) * nx) xb_add(&bar[XB_TOPGEN], 1u);
            else XB_SPIN(xb_ld(&bar[XB_TOPGEN]) == tg, bar);
            __builtin_amdgcn_fence(__ATOMIC_ACQUIRE, "agent");
            xb_add(&bar[XB_XGEN(b.x)], 1u);
            asm volatile("s_waitcnt vmcnt(0)" ::: "memory");
        } else {
            XB_SPIN(xb_ld(&bar[XB_XGEN(b.x)]) == gen, bar);
            __builtin_amdgcn_fence(__ATOMIC_ACQUIRE, "agent");
            asm volatile("s_waitcnt vmcnt(0)" ::: "memory");
        }
    }
    __syncthreads();
}

struct Frame {
    LAS unsigned char* lds;
    volatile LAS unsigned* MISC;
    gu32* ctl;
    int wave;
    int vcu, G;
    const float* in[23];
    float* out;
    unsigned char* ws;
};
#define WSP(T_, off) ((T_*)(F.ws + (off)))
__device__ __forceinline__ float wave_sum(float v) {
#pragma unroll
    for (int o = 1; o < 64; o <<= 1) v += __shfl_xor(v, o);
    return v;
}
__device__ __forceinline__ float grp_sum8(float v) { v += __shfl_xor(v, 1); v += __shfl_xor(v, 2); v += __shfl_xor(v, 4); return v; }
__device__ __forceinline__ float grp_sum4(float v) { v += __shfl_xor(v, 1); v += __shfl_xor(v, 2); return v; }
__device__ __forceinline__ void unpack8(const v4u w, float (&f)[8]) {
#pragma unroll
    for (int i = 0; i < 4; ++i) { f[2 * i] = __uint_as_float(w[i] << 16); f[2 * i + 1] = __uint_as_float(w[i] & 0xffff0000u); }
}
__device__ __forceinline__ v4u pack8(const float (&f)[8]) { v4u o; o.x = pk2(f[0], f[1]); o.y = pk2(f[2], f[3]); o.z = pk2(f[4], f[5]); o.w = pk2(f[6], f[7]); return o; }

__device__ __forceinline__ int t5_bucket(int rel) {
    const int base = rel > 0 ? 16 : 0; const int n = rel < 0 ? -rel : rel;
    const float nf = (float)(n > 1 ? n : 1);
    int large = 8 + (int)(logf(nf * 0.125f) / 2.772588722239781f * 8.0f + 1e-4f);
    large = large < 15 ? large : 15;
    return base + (n < 8 ? n : large);
}

template <class RowMap>
__device__ __forceinline__ void p0_transpose_item(const float* W, int K, int N, bf16* WT, const float* gain, LAS float* scr, int item, int lane, RowMap rowmap) {
    const int nblk = N / 32, kb = item / nblk, nb = item % nblk, k0 = 64 * kb, n0 = 32 * nb;
#pragma unroll 4
    for (int i = 0; i < 32; ++i) { const int kk = 2 * i + (lane >> 5); const float g = gain ? gain[k0 + kk] : 1.0f; scr[kk * 33 + (lane & 31)] = g * W[(size_t)(k0 + kk) * N + n0 + (lane & 31)]; }
    LDS_WAIT(); asm volatile("" ::: "memory");
    const int c = lane & 7;
#pragma unroll
    for (int j = 0; j < 4; ++j) { const int n = (lane >> 3) + 8 * j; const LAS float* s = scr + (8 * c) * 33 + n;
        v4u o; o.x = pk2(s[0 * 33], s[1 * 33]); o.y = pk2(s[2 * 33], s[3 * 33]); o.z = pk2(s[4 * 33], s[5 * 33]); o.w = pk2(s[6 * 33], s[7 * 33]);
        *(GAS v4u*)(WT + (size_t)rowmap(n0 + n) * K + k0 + 8 * c) = o; }
    LDS_WAIT(); asm volatile("" ::: "memory");
}
struct RowId { __device__ __forceinline__ int operator()(int n) const { return n; } };
struct RowG64 { __device__ __forceinline__ int operator()(int n) const { return (n & ~255) + 128 * ((n >> 5) & 1) + 32 * ((n >> 6) & 3) + (n & 31); } };
struct RowQB { __device__ __forceinline__ int operator()(int n) const { const int h = n / 96, dd = n % 96; return dd < 64 ? (h >> 2) * 256 + 128 * (dd >> 5) + 32 * (h & 3) + (dd & 31) : 512 + 128 * (h & 1) + 32 * (h >> 1) + (dd - 64); } };
struct RowGU { int up; __device__ __forceinline__ int operator()(int n) const { return (n >> 7) * 256 + up * 128 + (n & 127); } };

template <class RowMap>
__device__ __forceinline__ void p0_transpose_item_f8(const float* W, int K, int N, unsigned char* WT, float wscale, LAS float* scr, int item, int lane, RowMap rowmap) {
    const int nblk = N / 32, kb = item / nblk, nb = item % nblk, k0 = 64 * kb, n0 = 32 * nb;
#pragma unroll 4
    for (int i = 0; i < 32; ++i) { const int kk = 2 * i + (lane >> 5); scr[kk * 33 + (lane & 31)] = wscale * W[(size_t)(k0 + kk) * N + n0 + (lane & 31)]; }
    LDS_WAIT(); asm volatile("" ::: "memory");
    const int c = lane & 3;
#pragma unroll
    for (int j = 0; j < 2; ++j) { const int n = (lane >> 2) + 16 * j; const LAS float* s = scr + (16 * c) * 33 + n;
        v4u o; o.x = pg8::pk4_fp8(s[0 * 33], s[1 * 33], s[2 * 33], s[3 * 33]); o.y = pg8::pk4_fp8(s[4 * 33], s[5 * 33], s[6 * 33], s[7 * 33]);
        o.z = pg8::pk4_fp8(s[8 * 33], s[9 * 33], s[10 * 33], s[11 * 33]); o.w = pg8::pk4_fp8(s[12 * 33], s[13 * 33], s[14 * 33], s[15 * 33]);
        *(GAS v4u*)(WT + (size_t)rowmap(n0 + n) * K + k0 + 16 * c) = o; }
    LDS_WAIT(); asm volatile("" ::: "memory");
}
__device__ __forceinline__ void p0_prologue(Frame& F) {
    LAS float* scr = (LAS float*)(F.lds + RING_OFF + F.wave * 16384);
    const int gw = F.vcu * NWAVES + F.wave, NGW = F.G * NWAVES;
    constexpr int I_IN = (DM / 64) * (INW / 32), I_QB = (QL / 64) * (BH * QKD / 32), I_KVB = (KVL / 64) * (BH * 128 / 32), I_O = (DM / 64) * (DM / 32), I_E = (DM / 64) * (FF / 32);
    constexpr int NITEMS = I_IN + I_QB + I_KVB + I_O + NE * 3 * I_E;
    bf16* Win_t = WSP(bf16, WS_WIN); bf16* Wqb_t = WSP(bf16, WS_WQB); bf16* Wkvb_t = WSP(bf16, WS_WKVB); bf16* Wo_t = WSP(bf16, WS_WO); bf16* Wgu_t = WSP(bf16, WS_WGU); bf16* Wd_t = WSP(bf16, WS_WD);
    const int nitems = (F.G == 256) ? NITEMS - NE * 3 * I_E : NITEMS;
    for (int it = gw; it < nitems; it += NGW) {
        int r = it;
        if (r < I_IN) { p0_transpose_item(F.in[3], DM, INW, Win_t, F.in[2], scr, r, lane_id(), RowG64{}); continue; } r -= I_IN;
        if (r < I_QB) { p0_transpose_item(F.in[8], QL, BH * QKD, Wqb_t, F.in[7], scr, r, lane_id(), RowQB{}); continue; } r -= I_QB;
        if (r < I_KVB) { p0_transpose_item(F.in[10], KVL, BH * 128, Wkvb_t, F.in[9], scr, r, lane_id(), RowG64{}); continue; } r -= I_KVB;
        if (r < I_O) { const int kb = r / (DM / 32); const float* g = (kb < 8) ? F.in[15] : (F.in[16] - 512);
            p0_transpose_item(F.in[17], DM, DM, Wo_t, g, scr, r, lane_id(), RowId{}); continue; } r -= I_O;
        const int e = r / (3 * I_E), q = r % (3 * I_E), which = q / I_E, item = q % I_E;
        if (which == 0) p0_transpose_item_f8(F.in[20] + (size_t)e * DM * FF, DM, FF, (unsigned char*)Wgu_t + (size_t)e * 2 * FF * DM, 32.0f, scr, item, lane_id(), RowGU{0});
        else if (which == 1) p0_transpose_item_f8(F.in[21] + (size_t)e * DM * FF, DM, FF, (unsigned char*)Wgu_t + (size_t)e * 2 * FF * DM, 32.0f, scr, item, lane_id(), RowGU{1});
        else p0_transpose_item_f8(F.in[22] + (size_t)e * FF * DM, FF, DM, (unsigned char*)Wd_t + (size_t)e * DM * FF, 16.0f, scr, item, lane_id(), RowId{});
    }
    { const int nchunk = (NZ - INW) * DM / 8; for (int c = gw * 64 + lane_id(); c < nchunk; c += NGW * 64) { const int n = INW + c / (DM / 8), k8 = c % (DM / 8); *(GAS v4u*)(Win_t + (size_t)RowG64{}(n) * DM + (size_t)k8 * 8) = (v4u){0u, 0u, 0u, 0u}; } }
    bf16* XN = WSP(bf16, WS_XN);
    for (int m = gw; m < T; m += NGW) {
        const GAS f32x4* xr = (const GAS f32x4*)(F.in[0] + (size_t)m * DM) + lane_id();
        f32x4 v[4]; float s = 0.f;
#pragma unroll
        for (int j = 0; j < 4; ++j) { v[j] = xr[64 * j]; s += (v[j].x * v[j].x + v[j].y * v[j].y) + (v[j].z * v[j].z + v[j].w * v[j].w); }
        const float rs = 1.0f / sqrtf(wave_sum(s) * (1.f / DM) + EPS);
        GAS unsigned long long* o8 = (GAS unsigned long long*)(XN + (size_t)m * DM) + lane_id();
#pragma unroll
        for (int j = 0; j < 4; ++j) o8[64 * j] = (unsigned long long)pk2(v[j].x * rs, v[j].y * rs) | ((unsigned long long)pk2(v[j].z * rs, v[j].w * rs) << 32);
    }
    float* TAB = WSP(float, WS_TAB);
    if (blockIdx.x == 0) {
        const float* rel_bias = F.in[1];
        for (int i = (F.wave * 64 + lane_id()); i < 8 * NTAB; i += NWAVES * 64) { const int h = i / NTAB, rel = i % NTAB - 128; TAB[TAB_BIAS + i] = rel_bias[t5_bucket(rel) * A_HEADS + h] * LOG2E; }
        if (F.wave == 0) {
            const float ga = fabsf(F.in[4][lane_id()] * F.in[5][lane_id()]); float mb = 0.f; for (int i = lane_id(); i < 32 * 8; i += 64) mb = fmaxf(mb, rel_bias[i]);
            const float gb = fabsf(F.in[11][lane_id()] * F.in[13][lane_id()]); const float gqr = (lane_id() < 32) ? fabsf(F.in[12][lane_id()]) : 0.f, gkr = (lane_id() < 32) ? fabsf(F.in[14][lane_id()]) : 0.f;
            float mga = ga, mgb = gb, mqr = gqr, mkr = gkr;
#pragma unroll
            for (int o = 1; o < 64; o <<= 1) { mga = fmaxf(mga, __shfl_xor(mga, o)); mgb = fmaxf(mgb, __shfl_xor(mgb, o)); mqr = fmaxf(mqr, __shfl_xor(mqr, o)); mkr = fmaxf(mkr, __shfl_xor(mkr, o)); mb = fmaxf(mb, __shfl_xor(mb, o)); }
            if (lane_id() == 0) { TAB[TAB_CONST + 0] = (8.0f * mga + mb) * LOG2E + 1.0f; TAB[TAB_CONST + 1] = 0.10206207261596577f * (64.f * mgb + 32.f * mqr * mkr) * LOG2E + 1.0f; }
        }
    }
    for (int i = gw * 64 + lane_id(); i < SEQ * 16; i += NGW * 64) { const int s = i >> 4, k = i & 15; const float freq = powf(10000.0f, -(float)(2 * k) / 32.0f); const float ang = (float)s * freq;
        TAB[TAB_COS + i] = cosf(ang); TAB[TAB_SIN + i] = sinf(ang); }
}

__device__ __forceinline__ void p2_fixup(Frame& F) {
    const int gw = F.vcu * NWAVES + F.wave, NGW = F.G * NWAVES; const int lane = lane_id();
    const bf16* Z = WSP(bf16, WS_Z); bf16* QA = WSP(bf16, WS_QA); bf16* KA = WSP(bf16, WS_KA); bf16* VA = WSP(bf16, WS_VA); bf16* CQ = WSP(bf16, WS_CQ); bf16* CKV = WSP(bf16, WS_CKV); bf16* KR = WSP(bf16, WS_KR);
    const float* TAB = WSP(float, WS_TAB);
    const float* gq = F.in[4]; const float* gk = F.in[5]; const float* gkr = F.in[14];
    float gqv[8], gkv[8], gkrv[8];
#pragma unroll
    for (int j = 0; j < 8; ++j) { gqv[j] = gq[(8 * lane) % 64 + j]; gkv[j] = gk[(8 * lane) % 64 + j]; gkrv[j] = gkr[(8 * lane) % 32 + j]; }
    for (int m = gw; m < T; m += NGW) {
        const bf16* zr = Z + (size_t)m * NZ; const int s = m % SEQ; float f[8], o[8];
        { unpack8(*(const GAS v4u*)(zr + 8 * lane), f); float ss = 0.f;
#pragma unroll
          for (int j = 0; j < 8; ++j) ss += f[j] * f[j];
          const float r = QSC_A / sqrtf(grp_sum8(ss) * (1.f / 64.f) + EPS);
#pragma unroll
          for (int j = 0; j < 8; ++j) o[j] = f[j] * r * gqv[j];
          *(GAS v4u*)(QA + (size_t)m * 512 + 8 * lane) = pack8(o); }
        { const int l2 = lane & 31; const v4u w = *(const GAS v4u*)(zr + 512 + 8 * l2); unpack8(w, f); float ss = 0.f;
#pragma unroll
          for (int j = 0; j < 8; ++j) ss += f[j] * f[j];
          const float r = 1.0f / sqrtf(grp_sum8(ss) * (1.f / 64.f) + EPS);
#pragma unroll
          for (int j = 0; j < 8; ++j) o[j] = f[j] * r * gkv[j];
          if (lane < 16) *(GAS v4u*)(KA + (size_t)m * 128 + 8 * lane) = pack8(o);
          else if (lane < 32) *(GAS v4u*)(VA + (size_t)m * 128 + 8 * (lane - 16)) = w; }
        { const int l2 = lane < 48 ? lane : 0; unpack8(*(const GAS v4u*)(zr + 768 + 8 * l2), f); float ss = 0.f;
#pragma unroll
          for (int j = 0; j < 8; ++j) ss += f[j] * f[j];
          if (lane >= 48) ss = 0.f;
          const float r = 1.0f / sqrtf(wave_sum(ss) * (1.f / 384.f) + EPS);
#pragma unroll
          for (int j = 0; j < 8; ++j) o[j] = f[j] * r;
          if (lane < 48) *(GAS v4u*)(CQ + (size_t)m * QL + 8 * lane) = pack8(o); }
        { const int l2 = lane & 31; unpack8(*(const GAS v4u*)(zr + 1152 + 8 * l2), f); float ss = 0.f;
#pragma unroll
          for (int j = 0; j < 8; ++j) ss += f[j] * f[j];
          if (lane >= 32) ss = 0.f;
          const float r = 1.0f / sqrtf(wave_sum(ss) * (1.f / 256.f) + EPS);
#pragma unroll
          for (int j = 0; j < 8; ++j) o[j] = f[j] * r;
          if (lane < 32) *(GAS v4u*)(CKV + (size_t)m * KVL + 8 * lane) = pack8(o); }
        { const int l2 = lane & 3; unpack8(*(const GAS v4u*)(zr + 1408 + 8 * l2), f); float ss = 0.f;
#pragma unroll
          for (int j = 0; j < 8; ++j) ss += f[j] * f[j];
          const float r = 1.0f / sqrtf(grp_sum4(ss) * (1.f / 32.f) + EPS);
#pragma unroll
          for (int j = 0; j < 8; ++j) { const float y = f[j] * r * gkrv[j]; const float p = __shfl_xor(y, 2); const int i = (8 * l2 + j) & 15;
              const float c = TAB[TAB_COS + s * 16 + i], sn = TAB[TAB_SIN + s * 16 + i];
              o[j] = (l2 < 2) ? (y * c - p * sn) : (p * sn + y * c); }
          if (lane < 4) *(GAS v4u*)(KR + (size_t)m * ROPE + 8 * lane) = pack8(o); }
    }
}

__device__ __forceinline__ void p4_fixup(Frame& F) {
    const int gw = F.vcu * NWAVES + F.wave, NGW = F.G * NWAVES; const int lane = lane_id();
    bf16* QB = WSP(bf16, WS_QB); const bf16* KVR = WSP(bf16, WS_KVRAW); bf16* KBN = WSP(bf16, WS_KBN); bf16* VB = WSP(bf16, WS_VB);
    const float* TAB = WSP(float, WS_TAB);
    float gqn[8], gkn[8], gqr[8];
#pragma unroll
    for (int j = 0; j < 8; ++j) { gqn[j] = F.in[11][8 * (lane & 7) + j]; gkn[j] = F.in[13][8 * (lane & 7) + j]; gqr[j] = F.in[12][8 * (lane & 3) + j]; }
    for (int m = gw; m < T; m += NGW) {
        const int s = m % SEQ; float f[8], o[8];
        bf16* qrow = QB + (size_t)m * (BH * QKD);
        { bf16* p = qrow + QKD * (lane >> 3) + 8 * (lane & 7); unpack8(*(const GAS v4u*)p, f); float ss = 0.f;
#pragma unroll
          for (int j = 0; j < 8; ++j) ss += f[j] * f[j];
          const float r = QSC_B / sqrtf(grp_sum8(ss) * (1.f / 64.f) + EPS);
#pragma unroll
          for (int j = 0; j < 8; ++j) o[j] = f[j] * r * gqn[j];
          *(GAS v4u*)p = pack8(o); }
        { const int l2 = lane & 31; bf16* p = qrow + QKD * (l2 >> 2) + NOPE + 8 * (l2 & 3); unpack8(*(const GAS v4u*)p, f); float ss = 0.f;
#pragma unroll
          for (int j = 0; j < 8; ++j) ss += f[j] * f[j];
          const float r = 1.0f / sqrtf(grp_sum4(ss) * (1.f / 32.f) + EPS);
#pragma unroll
          for (int j = 0; j < 8; ++j) { const float y = f[j] * r * gqr[j]; const float pp = __shfl_xor(y, 2); const int i = (8 * (l2 & 3) + j) & 15;
              const float c = TAB[TAB_COS + s * 16 + i], sn = TAB[TAB_SIN + s * 16 + i];
              o[j] = QSC_B * (((l2 & 3) < 2) ? (y * c - pp * sn) : (pp * sn + y * c)); }
          if (lane < 32) *(GAS v4u*)p = pack8(o); }
        { const bf16* p = KVR + (size_t)m * 1024 + 128 * (lane >> 3) + 8 * (lane & 7); unpack8(*(const GAS v4u*)p, f); float ss = 0.f;
#pragma unroll
          for (int j = 0; j < 8; ++j) ss += f[j] * f[j];
          const float r = 1.0f / sqrtf(grp_sum8(ss) * (1.f / 64.f) + EPS);
#pragma unroll
          for (int j = 0; j < 8; ++j) o[j] = f[j] * r * gkn[j];
          *(GAS v4u*)(KBN + (size_t)m * 512 + 64 * (lane >> 3) + 8 * (lane & 7)) = pack8(o);
          *(GAS v4u*)(VB + (size_t)m * 512 + 64 * (lane >> 3) + 8 * (lane & 7)) = *(const GAS v4u*)(p + 64); }
    }
}

__device__ __forceinline__ void p6_onorm(Frame& F) {
    const int gw = F.vcu * NWAVES + F.wave, NGW = F.G * NWAVES; const int lane = lane_id();
    bf16* O = WSP(bf16, WS_O);
    for (int m = gw; m < T; m += NGW) {
#pragma unroll
        for (int hf = 0; hf < 2; ++hf) { bf16* p = O + (size_t)m * DM + 512 * hf + 8 * lane; float f[8], o[8]; unpack8(*(const GAS v4u*)p, f); float ss = 0.f;
#pragma unroll
            for (int j = 0; j < 8; ++j) ss += f[j] * f[j];
            const float r = 1.0f / sqrtf(wave_sum(ss) * (1.f / 512.f) + EPS);
#pragma unroll
            for (int j = 0; j < 8; ++j) o[j] = f[j] * r;
            *(GAS v4u*)p = pack8(o); }
    }
}

__device__ __forceinline__ float red16(float (&v)[16], int lane) {
    const bool b5 = lane & 32, b4 = lane & 16, b3 = lane & 8, b2 = lane & 4; float w8[8], w4[4], w2[2];
#pragma unroll
    for (int i = 0; i < 8; ++i) { const float mine = b5 ? v[8 + i] : v[i], oth = b5 ? v[i] : v[8 + i]; w8[i] = mine + __shfl_xor(oth, 32); }
#pragma unroll
    for (int i = 0; i < 4; ++i) { const float mine = b4 ? w8[4 + i] : w8[i], oth = b4 ? w8[i] : w8[4 + i]; w4[i] = mine + __shfl_xor(oth, 16); }
#pragma unroll
    for (int i = 0; i < 2; ++i) { const float mine = b3 ? w4[2 + i] : w4[i], oth = b3 ? w4[i] : w4[2 + i]; w2[i] = mine + __shfl_xor(oth, 8); }
    const float mine = b2 ? w2[1] : w2[0], oth = b2 ? w2[0] : w2[1]; float y = mine + __shfl_xor(oth, 4);
    y += __shfl_xor(y, 1); y += __shfl_xor(y, 2); return y;
}
__device__ __forceinline__ void p8_router(Frame& F) {
    const int gw = F.vcu * NWAVES + F.wave, NGW = F.G * NWAVES; const int lane = lane_id();
    unsigned char* H2 = WSP(unsigned char, WS_H2); float* AFF = WSP(float, WS_AFF); const bf16* ATT = WSP(bf16, WS_ATT); bf16* X1B = WSP(bf16, WS_X1B);
    const float* g2 = F.in[18]; const float* wr = F.in[19];
    LAS float* wl = (LAS float*)(F.lds + RING_OFF);
    __syncthreads();
    for (int i = (F.wave * 64 + lane_id()); i < DM * NE; i += NWAVES * 64) wl[(i & 15) * DM + (i >> 4)] = wr[i];
    __syncthreads();
    const LAS float* wlane = wl + 4 * lane;
    for (int m = gw; m < T; m += NGW) {
        f32x4 x[4]; float ss = 0.f;
#pragma unroll
        for (int k = 0; k < 4; ++k) { x[k] = *(const GAS f32x4*)(F.in[0] + (size_t)m * DM + 4 * lane + 256 * k); const unsigned long long aw = *(const GAS unsigned long long*)(ATT + (size_t)m * DM + 4 * lane + 256 * k);
            const unsigned alo = (unsigned)aw, ahi = (unsigned)(aw >> 32); x[k].x += __uint_as_float(alo << 16); x[k].y += __uint_as_float(alo & 0xffff0000u); x[k].z += __uint_as_float(ahi << 16); x[k].w += __uint_as_float(ahi & 0xffff0000u);
            ss += (x[k].x * x[k].x + x[k].y * x[k].y) + (x[k].z * x[k].z + x[k].w * x[k].w); }
        const float rs = __builtin_amdgcn_rsqf(wave_sum(ss) * (1.f / DM) + EPS);
#pragma unroll
        for (int k = 0; k < 4; ++k) { const f32x4 g = *(const GAS f32x4*)(g2 + 4 * lane + 256 * k);
            *(GAS unsigned long long*)(X1B + (size_t)m * DM + 4 * lane + 256 * k) = (unsigned long long)pk2(x[k].x, x[k].y) | ((unsigned long long)pk2(x[k].z, x[k].w) << 32);
            x[k].x *= rs * g.x; x[k].y *= rs * g.y; x[k].z *= rs * g.z; x[k].w *= rs * g.w;
            *(GAS unsigned*)(H2 + (size_t)m * DM + 4 * lane + 256 * k) = pg8::pk4_fp8(32.0f * x[k].x, 32.0f * x[k].y, 32.0f * x[k].z, 32.0f * x[k].w); }
        float lg[16];
#pragma unroll
        for (int e = 0; e < 16; ++e) { float a0 = 0.f;
#pragma unroll
            for (int k = 0; k < 4; ++k) { const f32x4 w = *(const LAS f32x4*)(wlane + e * DM + 256 * k); a0 += (x[k].x * w.x + x[k].y * w.y) + (x[k].z * w.z + x[k].w * w.w); }
            lg[e] = a0; if ((e & 3) == 3) asm volatile("" ::: "memory"); }
        const float y = red16(lg, lane); float mx = y;
#pragma unroll
        for (int o = 4; o < 64; o <<= 1) mx = fmaxf(mx, __shfl_xor(mx, o));
        const float ex = __builtin_amdgcn_exp2f((y - mx) * LOG2E); float den = ex;
#pragma unroll
        for (int o = 4; o < 64; o <<= 1) den += __shfl_xor(den, o);
        if ((lane & 3) == 0) AFF[((size_t)(m / SEQ) * NE + ((lane >> 2) & 15)) * SEQ + (m % SEQ)] = ex / den;
    }
    __syncthreads();
}

__device__ __forceinline__ int block_excl_scan(int v, LAS int* tmp, int tid, int lane, int wave, int& total) {
    int inc = v;
#pragma unroll
    for (int o = 1; o < 64; o <<= 1) { const int t = __shfl_up(inc, o); if (lane >= o) inc += t; }
    if (lane == 63) tmp[wave] = inc;
    __syncthreads();
    int base = 0, tot = 0;
#pragma unroll
    for (int w = 0; w < NWAVES; ++w) { const int t = tmp[w]; if (w < wave) base += t; tot += t; }
    __syncthreads();
    total = tot; return base + inc - v;
}
__device__ __forceinline__ void p9_topk(Frame& F) {
    LAS unsigned* keys = (LAS unsigned*)(F.lds + RING_OFF);
    LAS unsigned* hist = keys + SEQ;
    LAS int* tmp = (LAS int*)(hist + 256);
    LAS unsigned* res = (LAS unsigned*)(tmp + 16);
    const int lane = lane_id(), wave = F.wave, tid = wave * 64 + lane;
    const float* AFF = WSP(float, WS_AFF); int* IDX = WSP(int, WS_IDX); float* GATEV = WSP(float, WS_GATEV); int* SLOT = WSP(int, WS_SLOT);
    for (int item = blockIdx.x; item < BATCH * NE; item += F.G) {
        const int b = item / NE, e = item % NE; const float* a = AFF + (size_t)item * SEQ;
        __syncthreads();
#pragma unroll
        for (int i = 0; i < 8; ++i) keys[tid + 512 * i] = __float_as_uint(a[tid + 512 * i]);
        __syncthreads();
        unsigned kk[8];
#pragma unroll
        for (int i = 0; i < 8; ++i) kk[i] = keys[8 * tid + i];
        LAS int* cnt2 = tmp;
#define P9_COUNT(v, step, out) do { int c_ = 0; _Pragma("unroll") for (int i = 0; i < 8; ++i) c_ += (int)__popcll(__ballot(kk[i] >= (v))); \
            if (lane == 0) cnt2[((step) & 1) * 8 + wave] = c_; __syncthreads(); int s_ = 0; _Pragma("unroll") for (int w = 0; w < NWAVES; ++w) s_ += cnt2[((step) & 1) * 8 + w]; out = s_; } while (0)
        unsigned prefix = 0u; int step = 0;
        for (int bit = 29; bit >= 0; --bit) { const unsigned cand = prefix | (1u << bit); int c; P9_COUNT(cand, step, c); ++step; if (c >= CAP) prefix = cand; }
        int cgt; P9_COUNT(prefix + 1u, step, cgt); ++step;
        int remaining = CAP - cgt;
        __syncthreads();
#undef P9_COUNT
        int neq = 0;
#pragma unroll
        for (int i = 0; i < 8; ++i) neq += (kk[i] == prefix) ? 1 : 0;
        int toteq; int eqbase = block_excl_scan(neq, tmp, tid, lane, wave, toteq);
        int sel[8]; int nsel = 0;
#pragma unroll
        for (int i = 0; i < 8; ++i) { const bool eq = kk[i] == prefix; sel[i] = (kk[i] > prefix || (eq && eqbase < remaining)) ? 1 : 0; eqbase += eq ? 1 : 0; nsel += sel[i]; }
        int totsel; int slot = block_excl_scan(nsel, tmp, tid, lane, wave, totsel);
        const size_t rbase = (size_t)(e * BATCH + b) * CAP;
#pragma unroll
        for (int i = 0; i < 8; ++i) { const int s = 8 * tid + i;
            if (sel[i]) { if (slot < CAP) { IDX[rbase + slot] = b * SEQ + s; GATEV[rbase + slot] = __uint_as_float(kk[i]); } SLOT[(size_t)item * SEQ + s] = slot < CAP ? slot : -1; ++slot; }
            else SLOT[(size_t)item * SEQ + s] = -1; }
    }
}

__device__ __forceinline__ void p9b_gather(Frame& F) {
    const int gw = F.vcu * NWAVES + F.wave, NGW = F.G * NWAVES; const int lane = lane_id();
    const unsigned char* H2 = WSP(unsigned char, WS_H2); unsigned char* XE = WSP(unsigned char, WS_XE); const int* IDX = WSP(int, WS_IDX);
    for (int r = gw * 2; r < MX; r += NGW * 2) { const int tok0 = IDX[r], tok1 = IDX[r + 1];
        const v4u a = *((const GAS v4u*)(H2 + (size_t)tok0 * DM) + lane), b = *((const GAS v4u*)(H2 + (size_t)tok1 * DM) + lane);
        *((GAS v4u*)(XE + (size_t)r * DM) + lane) = a; *((GAS v4u*)(XE + (size_t)(r + 1) * DM) + lane) = b; }
}

__device__ __forceinline__ void p12_combine(Frame& F) {
    const int gw = F.vcu * NWAVES + F.wave, NGW = F.G * NWAVES; const int lane = lane_id();
    const unsigned char* YE = WSP(unsigned char, WS_YE); const int* SLOT = WSP(int, WS_SLOT); const bf16* X1B = WSP(bf16, WS_X1B);
    typedef float f32x2v __attribute__((ext_vector_type(2)));
    for (int m = gw; m < T; m += NGW) {
        const int b = m / SEQ, s = m % SEQ;
        const int sl = (lane < NE) ? SLOT[((size_t)b * NE + lane) * SEQ + s] : -1;
        unsigned long long mask = __ballot(sl >= 0);
        GAS f32x4* xr = (GAS f32x4*)(F.out + (size_t)m * DM) + lane; const GAS unsigned long long* x1 = (const GAS unsigned long long*)(X1B + (size_t)m * DM) + lane;
        f32x4 v[4];
#pragma unroll
        for (int j = 0; j < 4; ++j) { const unsigned long long aw = x1[64 * j]; const unsigned alo = (unsigned)aw, ahi = (unsigned)(aw >> 32);
            v[j].x = __uint_as_float(alo << 16); v[j].y = __uint_as_float(alo & 0xffff0000u); v[j].z = __uint_as_float(ahi << 16); v[j].w = __uint_as_float(ahi & 0xffff0000u); }
        f32x4 a[4];
#pragma unroll
        for (int j = 0; j < 4; ++j) a[j] = (f32x4){0.f, 0.f, 0.f, 0.f};
        while (mask) { const int e = __builtin_ctzll(mask); mask &= mask - 1; const int slot = __shfl(sl, e);
            const GAS unsigned* yr = (const GAS unsigned*)(YE + ((size_t)(e * BATCH + b) * CAP + slot) * DM) + lane;
#pragma unroll
            for (int j = 0; j < 4; ++j) { const int w = (int)yr[64 * j]; const f32x2v lo = __builtin_amdgcn_cvt_pk_f32_fp8(w, false), hi = __builtin_amdgcn_cvt_pk_f32_fp8(w, true);
                a[j].x += lo.x; a[j].y += lo.y; a[j].z += hi.x; a[j].w += hi.y; } }
#pragma unroll
        for (int j = 0; j < 4; ++j) xr[64 * j] = v[j] + a[j] * (1.0f / 64.0f);
    }
}


#ifndef MLA_UNIT
#define MLA_UNIT mla_unit2
#endif
namespace att {
using bf16x8 = __attribute__((ext_vector_type(8))) short;
using s16x4 = __attribute__((ext_vector_type(4))) short;
using f32x16 = __attribute__((ext_vector_type(16))) float;
using u32x4 = __attribute__((ext_vector_type(4))) unsigned;
constexpr int KSLOT = 12288, VSLOT = 8192, NSLOT = 3;
constexpr int LK = 0, LV = NSLOT * KSLOT, LWS = LV + NSLOT * VSLOT, LTAB = LWS + NWAVES * 256, ATT_LDS = LTAB + 4 * 512 * 4;
constexpr int CV_F32 = ATT_LDS, CV_F8 = CV_F32 + NWAVES * 2048, CV_END = CV_F8 + NWAVES * 2176;
static_assert(CV_END <= RING_BYTES, "attention LDS");
struct ConvJob { int item0; };
__device__ __forceinline__ int crow(int r, int hi) { return (r & 3) + 8 * (r >> 2) + 4 * hi; }
__device__ __forceinline__ void glds16(const void* gsrc, unsigned lds_dst) { unsigned keep;
    asm volatile("s_mov_b32 %0, m0\n\ts_mov_b32 m0, %2\n\ts_nop 0\n\tglobal_load_lds_dwordx4 %1, off\n\ts_mov_b32 m0, %0" : "=&s"(keep) : "v"(gsrc), "s"(lds_dst) : "memory"); }
__device__ __forceinline__ void glds16s(const void* sbase, unsigned voff, unsigned lds_dst) { unsigned keep;
    asm volatile("s_mov_b32 %0, m0\n\ts_mov_b32 m0, %3\n\ts_nop 0\n\tglobal_load_lds_dwordx4 %1, %2\n\ts_mov_b32 m0, %0" : "=&s"(keep) : "v"(voff), "s"(sbase), "s"(lds_dst) : "memory"); }
__device__ __forceinline__ void glds16s_nt(const void* sbase, unsigned voff, unsigned lds_dst) { unsigned keep;
    asm volatile("s_mov_b32 %0, m0\n\ts_mov_b32 m0, %3\n\ts_nop 0\n\tglobal_load_lds_dwordx4 %1, %2 nt\n\ts_mov_b32 m0, %0" : "=&s"(keep) : "v"(voff), "s"(sbase), "s"(lds_dst) : "memory"); }
__device__ __forceinline__ const bf16* sptr(const bf16* p) { const unsigned long long a = (unsigned long long)p; const unsigned lo = (unsigned)__builtin_amdgcn_readfirstlane((int)(unsigned)a), hi = (unsigned)__builtin_amdgcn_readfirstlane((int)(unsigned)(a >> 32)); return (const bf16*)(((unsigned long long)hi << 32) | lo); }
__device__ __forceinline__ unsigned rfl(unsigned v) { return (unsigned)__builtin_amdgcn_readfirstlane((int)v); }
typedef float f32x2_t __attribute__((ext_vector_type(2))); typedef __bf16 bf16x2_t __attribute__((ext_vector_type(2)));
__device__ __forceinline__ unsigned cvtpk(float lo, float hi) { f32x2_t v = {lo, hi}; bf16x2_t b = __builtin_convertvector(v, bf16x2_t); return __builtin_bit_cast(unsigned, b); }
#define ATT_SBAR() __builtin_amdgcn_sched_barrier(0)
__device__ __forceinline__ void pv(f32x16* o, int vb, bf16x8 pa0, bf16x8 pa1, bf16x8 pa2, bf16x8 pa3) {
#pragma unroll
    for (int d0 = 0; d0 < 2; ++d0) { s16x4 lo[4], hi[4];
#pragma unroll
        for (int ks = 0; ks < 4; ++ks) {
            asm volatile("ds_read_b64_tr_b16 %0,%1 offset:%c2" : "=&v"(lo[ks]) : "v"(vb), "i"(d0 * 4096 + ks * 1024) : "memory");
            asm volatile("ds_read_b64_tr_b16 %0,%1 offset:%c2" : "=&v"(hi[ks]) : "v"(vb), "i"(d0 * 4096 + ks * 1024 + 512) : "memory"); }
        asm volatile("s_waitcnt lgkmcnt(0)" ::: "memory"); ATT_SBAR();
#define ATT_PK(k) (bf16x8){lo[k][0], lo[k][1], lo[k][2], lo[k][3], hi[k][0], hi[k][1], hi[k][2], hi[k][3]}
        o[d0] = __builtin_amdgcn_mfma_f32_32x32x16_bf16(pa0, ATT_PK(0), o[d0], 0, 0, 0);
        o[d0] = __builtin_amdgcn_mfma_f32_32x32x16_bf16(pa1, ATT_PK(1), o[d0], 0, 0, 0);
        o[d0] = __builtin_amdgcn_mfma_f32_32x32x16_bf16(pa2, ATT_PK(2), o[d0], 0, 0, 0);
        o[d0] = __builtin_amdgcn_mfma_f32_32x32x16_bf16(pa3, ATT_PK(3), o[d0], 0, 0, 0);
#undef ATT_PK
    }
}
__device__ __forceinline__ void ssq_accum(const float (&part)[16], int le, float* ssq) {
    const bool b4 = le & 16, b3 = le & 8, b2 = le & 4, b1 = le & 2; float p8[8], p4[4], p2[2];
#pragma unroll
    for (int i = 0; i < 8; ++i) { const float mine = b4 ? part[8 + i] : part[i], oth = b4 ? part[i] : part[8 + i]; p8[i] = mine + __shfl_xor(oth, 16); }
#pragma unroll
    for (int i = 0; i < 4; ++i) { const float mine = b3 ? p8[4 + i] : p8[i], oth = b3 ? p8[i] : p8[4 + i]; p4[i] = mine + __shfl_xor(oth, 8); }
#pragma unroll
    for (int i = 0; i < 2; ++i) { const float mine = b2 ? p4[2 + i] : p4[i], oth = b2 ? p4[i] : p4[2 + i]; p2[i] = mine + __shfl_xor(oth, 4); }
    const float mine = b1 ? p2[1] : p2[0], oth = b1 ? p2[0] : p2[1]; float y = mine + __shfl_xor(oth, 2);
    y += __shfl_xor(y, 1);
    const int r = (b4 ? 8 : 0) + (b3 ? 4 : 0) + (b2 ? 2 : 0) + (b1 ? 1 : 0);
    if ((le & 1) == 0) atomicAdd(ssq + 2 * crow(r, le >> 5), y);
}
#define ATT_WAIT_BAR(N) asm volatile("s_waitcnt vmcnt(" #N ") lgkmcnt(0)\n\ts_barrier" ::: "memory")
__device__ __forceinline__ u32x4 pack_p(const f32x16& p, int base) { u32x4 w; w.x = cvtpk(p[base], p[base + 1]); w.y = cvtpk(p[base + 2], p[base + 3]); w.z = cvtpk(p[base + 4], p[base + 5]); w.w = cvtpk(p[base + 6], p[base + 7]); return w; }

typedef __attribute__((address_space(3))) const char* lds_cptr;
typedef short v4i16_t __attribute__((ext_vector_type(4)));
__device__ __forceinline__ s16x4 vtr(lds_cptr p) { return __builtin_bit_cast(s16x4, __builtin_amdgcn_ds_read_tr16_b64_v4i16((__attribute__((address_space(3))) v4i16_t*)p)); }
__device__ __forceinline__ void mla_unit2(LAS unsigned char* lds, int b, int h, int qb, const bf16* QB, const unsigned char* QN8, const unsigned char* KN8, const bf16* KR, const bf16* VB, bf16* O, float* SSQ, bool shift, float nb, const ConvJob cj, int wid, int lane) {
    const int r32 = lane & 31, hi = lane >> 5;
    const unsigned lds0 = (unsigned)(uintptr_t)lds;
    const size_t rowb = (size_t)b * SEQ; const int q0 = qb * 256;
    const char* ksrc = (const char*)sptr((const bf16*)((wid < 4) ? (const unsigned char*)(KR + (size_t)(b * 64) * 2048) + (wid & 3) * 1024 : KN8 + (size_t)((b * BH + h) * 64) * 4096 + (wid & 3) * 1024));
    const bf16* vsrc = sptr(VB + (size_t)((b * BH + h) * 64) * 4096 + wid * 512);
    const unsigned kl0 = lane * 16u, vl = kl0;
    constexpr int KS8 = 8192;
    const unsigned kdst = lds0 + LK + ((wid < 4 ? 4 : 0) + (wid & 3)) * 1024, vdst = lds0 + LV + wid * 1024;
#define DMA_K(t, sl) glds16s(ksrc + (size_t)(t) * 4096, kl0, rfl(kdst + (sl) * KS8))
#define DMA_V(t, sl) glds16s(vsrc + (size_t)(t) * 4096, vl, rfl(vdst + (sl) * VSLOT))
#define WAITB(N4, N8) ATT_WAIT_BAR(N8)
    constexpr int NT = SEQ / 64;
    DMA_K(0, 0); DMA_V(0, 0); DMA_K(1, 1); DMA_K(2, 2);
    typedef int v8i32 __attribute__((ext_vector_type(8))); typedef int v4i32 __attribute__((ext_vector_type(4)));
#define CAT8(a_, b_) (v8i32){a_[0], a_[1], a_[2], a_[3], b_[0], b_[1], b_[2], b_[3]}
    const int sK = 0x7c7c7c7c, sQ = 0x79797979;
    v8i32 qn8; bf16x8 qf[2];
    { const unsigned char* qp8 = QN8 + (rowb + q0 + 32 * wid + r32) * (BH * NOPE) + NOPE * h + 32 * hi; const v4i32 a_ = *(const v4i32*)qp8, b_ = *(const v4i32*)(qp8 + 16); qn8 = CAT8(a_, b_);
      const bf16* qp = QB + (rowb + q0 + 32 * wid + r32) * (BH * QKD) + QKD * h + NOPE + 8 * hi;
#pragma unroll
      for (int s = 0; s < 2; ++s) qf[s] = *(const bf16x8*)(qp + 16 * s); }
    f32x16 o[2]; o[0] = f32x16{}; o[1] = f32x16{};
    typedef float f32x4_t __attribute__((ext_vector_type(4)));
    f32x4_t ls = {0.f, 0.f, 0.f, 0.f}, ls2 = {0.f, 0.f, 0.f, 0.f};
    const short bsel1 = ((((lane >> 4) & 1) == ((lane & 15) >> 3)) ? (short)0x3F80 : (short)0);
    const bf16x8 bsel = {bsel1, bsel1, bsel1, bsel1, bsel1, bsel1, bsel1, bsel1};
#define LSUM(k) do { if ((k) & 1) ls2 = __builtin_amdgcn_mfma_f32_16x16x32_bf16(PAF(k), bsel, ls2, 0, 0, 0); else ls = __builtin_amdgcn_mfma_f32_16x16x32_bf16(PAF(k), bsel, ls, 0, 0, 0); } while (0)
    const lds_cptr kp0 = (lds_cptr)lds + LK + hi * 2048 + r32 * 16;
    const lds_cptr kr0 = (lds_cptr)lds + LK + 4096 + hi * 1024 + r32 * 16;
    const lds_cptr vp0 = (lds_cptr)lds + LV + ((lane >> 4) & 1) * 32 + (lane & 3) * 8 + (4 * hi + ((lane & 15) >> 2)) * 64;
    v8i32 kf8[2]; bf16x8 kfr[4];
#define KLD8(kp_, kh) do { const v4i32 a_ = *(const __attribute__((address_space(3))) v4i32*)((kp_) + (kh) * 512), b_ = *(const __attribute__((address_space(3))) v4i32*)((kp_) + 1024 + (kh) * 512); kf8[kh] = CAT8(a_, b_); } while (0)
#define KLDR(kp_, i) kfr[i] = *(const __attribute__((address_space(3))) bf16x8*)((kp_) + ((i) >> 1) * 2048 + ((i) & 1) * 512)
#define QKF8(kh) __builtin_amdgcn_mfma_scale_f32_32x32x64_f8f6f4(kf8[kh], qn8, f32x16{}, 0, 0, 0, sK, 0, sQ)
    WAITB(5, 3);
    KLD8(kp0, 0); KLD8(kp0, 1);
#pragma unroll
    for (int i = 0; i < 4; ++i) KLDR(kr0, i);
    f32x16 pA0, pA1, pB0, pB1;
    pA0 = QKF8(0); pA1 = QKF8(1);
#pragma unroll
    for (int s = 0; s < 2; ++s) { pA0 = __builtin_amdgcn_mfma_f32_32x32x16_bf16(kfr[2 * s], qf[s], pA0, 0, 0, 0); pA1 = __builtin_amdgcn_mfma_f32_32x32x16_bf16(kfr[2 * s + 1], qf[s], pA1, 0, 0, 0); }
    if (shift) {
#pragma unroll
        for (int r = 0; r < 16; ++r) { pA0[r] += nb; pA1[r] += nb; } }
#pragma unroll
    for (int r = 0; r < 16; ++r) { pA0[r] = __builtin_amdgcn_exp2f(pA0[r]); pA1[r] = __builtin_amdgcn_exp2f(pA1[r]); }
    WAITB(2, 1);
    DMA_K(3, 0); DMA_V(1, 1);
    KLD8(kp0 + KS8, 0); KLD8(kp0 + KS8, 1);
#pragma unroll
    for (int i = 0; i < 4; ++i) KLDR(kr0 + KS8, i);
    WAITB(3, 2);
    s16x4 vl0, vh0, vl1, vh1, vl2, vh2, vl3, vh3; u32x4 pw0, pw1, pw2, pw3;
    int i_prev = 0, i_cur = 1, i_next = 2;
#define ROT() do { const int t_ = i_prev; i_prev = i_cur; i_cur = i_next; i_next = t_; } while (0)
#define PIN(x) asm volatile("" : "+v"(x))
#define VOFF(i) (((i) >> 2) * 4096 + ((i) & 3) * 1024)
#define VRD(B, i) do { vl##B = vtr(vp_ + VOFF(i)); vh##B = vtr(vp_ + VOFF(i) + 512); } while (0)
#define VFR(B) (bf16x8){vl##B[0], vl##B[1], vl##B[2], vl##B[3], vh##B[0], vh##B[1], vh##B[2], vh##B[3]}
#define PAF(k) __builtin_bit_cast(bf16x8, pw##k)
#define EX(v) __builtin_amdgcn_exp2f(v)
#define QK0(C, kh) C = QKF8(kh)
#define QKN(C, i, s) C = __builtin_amdgcn_mfma_f32_32x32x16_bf16(kfr[i], qf[s], C, 0, 0, 0)
#define KN8(kh) do { if (GL_) { KLD8(kn_, kh); } } while (0)
#define KNR(i) do { if (GL_) { KLDR(krn_, i); } } while (0)
#define ADD4(P, B) (void)0
#define CVT2(P, B, PW, W) do { PW[W] = cvtpk(P[B], P[(B) + 1]); PW[(W) + 1] = cvtpk(P[(B) + 2], P[(B) + 3]); PIN(PW); } while (0)
#define GB(MF, RD, E0, E1, E2) do { MF; RD; E0; E1; E2; ATT_SBAR(); } while (0)
#define NOP_ (void)0
#define STEP(C0, C1, P0, P1, t, GK, GV, GL) do { ATT_SBAR(); \
    constexpr bool GL_ = GL; \
    if (GK) { DMA_K((t) + 3, i_cur); } if (GV) { DMA_V((t) + 1, i_next); } \
    const lds_cptr vp_ = vp0 + i_prev * VSLOT; const lds_cptr kn_ = kp0 + i_next * KS8, krn_ = kr0 + i_next * KS8; \
      \
    QK0(C0, 0); KN8(0); ADD4(P0, 0); CVT2(P0, 0, pw0, 0); ADD4(P0, 4); CVT2(P0, 4, pw0, 2); ATT_SBAR(); \
    QKN(C0, 0, 0); KNR(0); ADD4(P0, 8); CVT2(P0, 8, pw1, 0); ATT_SBAR(); \
    QKN(C0, 2, 1); KNR(2); ADD4(P0, 12); CVT2(P0, 12, pw1, 2); ATT_SBAR(); \
    QK0(C1, 1); KN8(1); CVT2(P1, 0, pw2, 0); CVT2(P1, 4, pw2, 2); LSUM(0); LSUM(1); ATT_SBAR(); \
    if (__builtin_expect(shift, 0)) { _Pragma("unroll") for (int r_ = 0; r_ < 16; ++r_) C0[r_] += nb; PIN(C0); } ATT_SBAR(); \
    QKN(C1, 1, 0); KNR(1); ADD4(P1, 8); CVT2(P1, 8, pw3, 0); C0[0] = EX(C0[0]); C0[1] = EX(C0[1]); VRD(0, 0); ATT_SBAR(); \
    QKN(C1, 3, 1); KNR(3); ADD4(P1, 12); CVT2(P1, 12, pw3, 2); C0[2] = EX(C0[2]); C0[3] = EX(C0[3]); VRD(1, 4); ATT_SBAR(); \
    VRD(2, 1); C0[4] = EX(C0[4]); C0[5] = EX(C0[5]); C0[6] = EX(C0[6]); C0[7] = EX(C0[7]); PIN(C0); LSUM(2); LSUM(3); ATT_SBAR(); \
    if (__builtin_expect(shift, 0)) { _Pragma("unroll") for (int r_ = 0; r_ < 16; ++r_) C1[r_] += nb; PIN(C1); } ATT_SBAR(); \
    GB(o[0] = __builtin_amdgcn_mfma_f32_32x32x16_bf16(PAF(0), VFR(0), o[0], 0, 0, 0), VRD(3, 5), C0[8] = EX(C0[8]), C0[9] = EX(C0[9]), C0[10] = EX(C0[10])); \
    GB(o[1] = __builtin_amdgcn_mfma_f32_32x32x16_bf16(PAF(0), VFR(1), o[1], 0, 0, 0), VRD(0, 2), C0[11] = EX(C0[11]), C0[12] = EX(C0[12]), C0[13] = EX(C0[13])); \
    GB(o[0] = __builtin_amdgcn_mfma_f32_32x32x16_bf16(PAF(1), VFR(2), o[0], 0, 0, 0), VRD(1, 6), C0[14] = EX(C0[14]), C0[15] = EX(C0[15]), C1[0] = EX(C1[0])); \
    GB(o[1] = __builtin_amdgcn_mfma_f32_32x32x16_bf16(PAF(1), VFR(3), o[1], 0, 0, 0), VRD(2, 3), C1[1] = EX(C1[1]), C1[2] = EX(C1[2]), C1[3] = EX(C1[3])); \
    GB(o[0] = __builtin_amdgcn_mfma_f32_32x32x16_bf16(PAF(2), VFR(0), o[0], 0, 0, 0), VRD(3, 7), C1[4] = EX(C1[4]), C1[5] = EX(C1[5]), C1[6] = EX(C1[6])); \
    GB(o[1] = __builtin_amdgcn_mfma_f32_32x32x16_bf16(PAF(2), VFR(1), o[1], 0, 0, 0), NOP_, C1[7] = EX(C1[7]), C1[8] = EX(C1[8]), C1[9] = EX(C1[9])); \
    GB(o[0] = __builtin_amdgcn_mfma_f32_32x32x16_bf16(PAF(3), VFR(2), o[0], 0, 0, 0), NOP_, C1[10] = EX(C1[10]), C1[11] = EX(C1[11]), C1[12] = EX(C1[12])); \
    GB(o[1] = __builtin_amdgcn_mfma_f32_32x32x16_bf16(PAF(3), VFR(3), o[1], 0, 0, 0), NOP_, C1[13] = EX(C1[13]), C1[14] = EX(C1[14]), C1[15] = EX(C1[15])); \
    PIN(C0); PIN(C1); \
    } while (0)
    const bool cv_on = cj.item0 >= 0;
    int cv_p = 0, cv_j = 0; const float* cv_src = nullptr; unsigned char* cv_dst = nullptr; float cv_sc = 0.f;
    LAS float* const cvf = (LAS float*)(lds + CV_F32 + wid * 2048);
    LAS unsigned* const cv8 = (LAS unsigned*)(lds + CV_F8 + wid * 2176);
    const unsigned cv_loff = (unsigned)(lane >> 3) * 4096u + (unsigned)(lane & 7) * 16u;
#define CONV() do { \
    if (cv_p == 0) { const int r_ = cj.item0 + cv_j, e_ = r_ / 1536, q_ = r_ % 1536, wh_ = q_ >> 9, it_ = q_ & 511, k0_ = (it_ >> 5) * 64, n0_ = (it_ & 31) * 32; \
        const unsigned char* ka_ = (const unsigned char*)__builtin_amdgcn_kernarg_segment_ptr();     \
        const float* w_ = *(const float* const*)(ka_ + 8 * (20 + wh_)); unsigned char* ws_ = *(unsigned char* const*)(ka_ + 8 * 24); cv_src = w_ + (size_t)e_ * 1048576 + (size_t)k0_ * 1024 + n0_; \
        if (wh_ < 2) { cv_dst = ws_ + WS_WGU + (size_t)e_ * 2097152 + (size_t)((n0_ >> 7) * 256 + wh_ * 128 + (n0_ & 127)) * 1024 + k0_; cv_sc = 32.0f; } \
        else { cv_dst = ws_ + WS_WD + (size_t)e_ * 1048576 + (size_t)n0_ * 1024 + k0_; cv_sc = 16.0f; } } \
    if (cv_p >= 1 && cv_p <= 8) { const int d_ = cv_p - 1; const LAS float* s_ = cvf + (d_ & 1) * 256 + hi * 128 + r32; \
        cv8[r32 * 17 + 2 * d_ + hi] = pg8::pk4_fp8_nc(cv_sc * s_[0], cv_sc * s_[32], cv_sc * s_[64], cv_sc * s_[96]); } \
    if (cv_p < 8) { glds16s_nt(cv_src + (size_t)(8 * cv_p) * 1024, cv_loff, rfl(lds0 + CV_F32 + wid * 2048 + (cv_p & 1) * 1024)); } \
    else { const int id_ = lane + 64 * (cv_p - 8), n2_ = id_ >> 2, c_ = id_ & 3; const LAS unsigned* q2_ = cv8 + n2_ * 17 + 4 * c_; \
        v4u w4_; w4_.x = q2_[0]; w4_.y = q2_[1]; w4_.z = q2_[2]; w4_.w = q2_[3]; *(GAS v4u*)(cv_dst + (size_t)n2_ * 1024 + 16 * c_) = w4_; } \
    if (++cv_p == 10) { cv_p = 0; ++cv_j; } } while (0)
    int t = 1;
    for (; t + 3 < NT; t += 2) {
        STEP(pB0, pB1, pA0, pA1, t, true, true, true);      WAITB(3, 2); ROT();
        if (cv_on) { CONV(); }
        STEP(pA0, pA1, pB0, pB1, t + 1, true, true, true);  if (cv_on) WAITB(4, 3); else WAITB(3, 2); ROT();
    }
#undef CONV
    STEP(pB0, pB1, pA0, pA1, NT - 3, false, true, true);   ATT_WAIT_BAR(1); ROT();
    STEP(pA0, pA1, pB0, pB1, NT - 2, false, true, true);   ATT_WAIT_BAR(1); ROT();
    STEP(pB0, pB1, pA0, pA1, NT - 1, false, false, false); ATT_WAIT_BAR(0); ROT();
    { const u32x4 w0 = pack_p(pB0, 0), w1 = pack_p(pB0, 8), w2 = pack_p(pB1, 0), w3 = pack_p(pB1, 8);
      ls = __builtin_amdgcn_mfma_f32_16x16x32_bf16(__builtin_bit_cast(bf16x8, w0), bsel, ls, 0, 0, 0); ls = __builtin_amdgcn_mfma_f32_16x16x32_bf16(__builtin_bit_cast(bf16x8, w1), bsel, ls, 0, 0, 0);
      ls = __builtin_amdgcn_mfma_f32_16x16x32_bf16(__builtin_bit_cast(bf16x8, w2), bsel, ls, 0, 0, 0); ls = __builtin_amdgcn_mfma_f32_16x16x32_bf16(__builtin_bit_cast(bf16x8, w3), bsel, ls, 0, 0, 0);
      ls += ls2;
      pv(o, (int)(lds0 + LV) + ((lane >> 4) & 1) * 32 + (lane & 3) * 8 + (4 * hi + ((lane & 15) >> 2)) * 64 + i_prev * VSLOT,
         __builtin_bit_cast(bf16x8, w0), __builtin_bit_cast(bf16x8, w1), __builtin_bit_cast(bf16x8, w2), __builtin_bit_cast(bf16x8, w3)); }
#undef STEP
#undef NOP_
#undef GB
#undef ADD4
#undef LSUM
#undef CVT2
#undef KN8
#undef KNR
#undef QK0
#undef QKN
#undef QKF8
#undef KLD8
#undef KLDR
#undef CAT8
#undef EX
#undef PAF
#undef VFR
#undef VRD
#undef VOFF
#undef PIN
#undef ROT
#undef WAITB
#undef DMA_K
#undef DMA_V
    const int le = lane_id();
    const int r32e = le & 31, hie = le >> 5;
    LAS float* wsf = (LAS float*)(lds + LWS) + wid * 64;
    if ((le & 7) == 0) { LAS float* wq = wsf + ((le & 8) ? 16 : 0) + 4 * (le >> 4); wq[0] = ls[0]; wq[1] = ls[1]; wq[2] = ls[2]; wq[3] = ls[3]; }
    asm volatile("s_waitcnt lgkmcnt(0)" ::: "memory");
    bf16* Ow = (bf16*)sptr(O + (rowb + q0 + 32 * wid) * DM + 512 + VD * h);
    float part[16];
#pragma unroll
    for (int r = 0; r < 16; ++r) { const int q = crow(r, hie); const float il = __builtin_amdgcn_rcpf(wsf[q]); const unsigned off = (unsigned)(q * DM + r32e); const float v0 = o[0][r] * il, v1 = o[1][r] * il;
        part[r] = v0 * v0 + v1 * v1; Ow[off] = (bf16)f2bf(v0); Ow[off + 32] = (bf16)f2bf(v1); }
    ssq_accum(part, le, SSQ + 2 * (rowb + q0 + 32 * wid) + 1);
    asm volatile("s_waitcnt lgkmcnt(0)\n\ts_barrier" ::: "memory");
}

__device__ __forceinline__ void swa_fill_table(LAS unsigned char* lds, int g, const float* TAB, int tid) {
    const float bnd = TAB[TAB_CONST + 0]; LAS float* tb = (LAS float*)(lds + LTAB);
    for (int i = tid; i < 4 * 512; i += NWAVES * 64) { const int hh = i >> 9, idx = (i & 511) - 63; tb[i] = (idx >= 0 && idx <= 2 * WINDOW) ? TAB[TAB_BIAS + (4 * g + hh) * NTAB + idx] - bnd : -1e30f; }
}
__device__ __forceinline__ void swa_unit(LAS unsigned char* lds, int b, int nh, int g, const bf16* QA, const bf16* KA, const bf16* VA, bf16* O, float* SSQ, const float* TAB, const float* sink, int wid, int lane, int tid) {
    const int r32 = lane & 31, hi = lane >> 5, hr = wid >> 1, rh = wid & 1, h = 4 * g + hr;
    const unsigned lds0 = (unsigned)(uintptr_t)lds;
    const size_t rowb = (size_t)b * SEQ;
    const int kt0 = (nh - 2 < 0) ? 0 : nh - 2, kt1 = (nh + 3 > SEQ / 64) ? SEQ / 64 : nh + 3, NT = kt1 - kt0;
    const bf16* ksrc = sptr(KA + (rowb + (size_t)kt0 * 64) * 128 + 64 * g + 8 * wid);
    const bf16* vsrc = sptr(VA + (rowb + (size_t)kt0 * 64 + 16 * (wid & 3)) * 128 + 64 * g + (wid >> 2) * 32);
    const unsigned kl = lane * 256u, vl = (lane >> 2) * 256u + (lane & 3) * 16u;
    constexpr int SK = 0, SV = 73728, SSLOT = 8192;
    const unsigned kdst = lds0 + SK + wid * 1024, vdst = lds0 + SV + wid * 1024;
#define SWA_DMA(t, sl) do { glds16s(ksrc + (size_t)(t) * 64 * 128, kl, rfl(kdst + (sl) * SSLOT)); glds16s(vsrc + (size_t)(t) * 64 * 128, vl, rfl(vdst + (sl) * SSLOT)); } while (0)
    for (int t_ = 0; t_ < NT; ++t_) SWA_DMA(t_, t_);
    const float bnd = TAB[TAB_CONST + 0];
    bf16x8 qf[4];
    { const bf16* qp = QA + (rowb + 64 * nh + 32 * rh + r32) * 512 + HD * h + 8 * hi;
#pragma unroll
      for (int s = 0; s < 4; ++s) qf[s] = *(const bf16x8*)(qp + 16 * s); }
    f32x16 o[2]; o[0] = f32x16{}; o[1] = f32x16{};
    float l = 0.f;
    const LAS unsigned char* kbase = lds + SK + hi * 1024 + r32 * 16;
    const int vb0 = (int)(lds0 + SV) + ((lane >> 4) & 1) * 32 + (lane & 3) * 8 + (4 * hi + ((lane & 15) >> 2)) * 64;
    const LAS float* tbl = (const LAS float*)(lds + LTAB) + hr * 512 + 63 + 4 * hi - 32 * rh - r32 + 64 * (kt0 - (nh - 2));
    for (int t = 0; t < NT; ++t) {
        { const int rem = NT - 1 - t;
          if (rem == 4) ATT_WAIT_BAR(8); else if (rem == 3) ATT_WAIT_BAR(6); else if (rem == 2) ATT_WAIT_BAR(4); else if (rem == 1) ATT_WAIT_BAR(2); else ATT_WAIT_BAR(0); }
        const int sl = t;
        const LAS unsigned char* kp = kbase + sl * SSLOT;
        const LAS float* tt = tbl + 64 * t;
        f32x16 p0, p1;
#pragma unroll
        for (int r = 0; r < 16; ++r) { const int off = (r & 3) + 8 * (r >> 2); p0[r] = tt[off]; p1[r] = tt[off + 32]; }
#pragma unroll
        for (int s = 0; s < 4; ++s) { const bf16x8 a0 = *(const LAS bf16x8*)(kp + s * 2048), a1 = *(const LAS bf16x8*)(kp + s * 2048 + 512);
            p0 = __builtin_amdgcn_mfma_f32_32x32x16_bf16(a0, qf[s], p0, 0, 0, 0); p1 = __builtin_amdgcn_mfma_f32_32x32x16_bf16(a1, qf[s], p1, 0, 0, 0); }
        float sa = 0.f, sb = 0.f;
#pragma unroll
        for (int r = 0; r < 16; ++r) { p0[r] = __builtin_amdgcn_exp2f(p0[r]); p1[r] = __builtin_amdgcn_exp2f(p1[r]); sa += p0[r]; sb += p1[r]; }
        l += sa + sb;
        const u32x4 w0 = pack_p(p0, 0), w1 = pack_p(p0, 8), w2 = pack_p(p1, 0), w3 = pack_p(p1, 8);
        pv(o, vb0 + sl * SSLOT, __builtin_bit_cast(bf16x8, w0), __builtin_bit_cast(bf16x8, w1), __builtin_bit_cast(bf16x8, w2), __builtin_bit_cast(bf16x8, w3));
    }
#undef SWA_DMA
    l += __shfl_xor(l, 32); l += __builtin_amdgcn_exp2f(sink[h] * LOG2E - bnd);
    const int le = lane_id();
    const int r32e = le & 31, hie = le >> 5;
    LAS float* wsf = (LAS float*)(lds + LWS) + wid * 64;
    if (hie == 0) wsf[r32e] = l;
    asm volatile("s_waitcnt lgkmcnt(0)" ::: "memory");
    bf16* Ow = (bf16*)sptr(O + (rowb + 64 * nh + 32 * rh) * DM + HD * h);
    float part[16];
#pragma unroll
    for (int r = 0; r < 16; ++r) { const int q = crow(r, hie); const float il = __builtin_amdgcn_rcpf(wsf[q]); const unsigned off = (unsigned)(q * DM + r32e); const float v0 = o[0][r] * il, v1 = o[1][r] * il;
        part[r] = v0 * v0 + v1 * v1; Ow[off] = (bf16)f2bf(v0); Ow[off + 32] = (bf16)f2bf(v1); }
    ssq_accum(part, le, SSQ + 2 * (rowb + 64 * nh + 32 * rh));
    asm volatile("s_waitcnt lgkmcnt(0)\n\ts_barrier" ::: "memory");
}
__device__ __forceinline__ void swa_unit3(LAS unsigned char* lds, int b, int n128, int g, const bf16* QA, const bf16* KA, const bf16* VA, bf16* O, float* SSQ, const float* TAB, const float* sink, int wid, int lane) {
    const int r32 = lane & 31, hi = lane >> 5, hr = wid >> 1, rh = wid & 1, h = 4 * g + hr;
    const unsigned lds0 = (unsigned)(uintptr_t)lds;
    const size_t rowb = (size_t)b * SEQ;
    const int kta = (2 * n128 - 2 < 0) ? 0 : 2 * n128 - 2, ktb = (2 * n128 + 4 > SEQ / 64) ? SEQ / 64 : 2 * n128 + 4, NTA = ktb - kta;
    const bf16* ksrc = sptr(KA + (rowb + (size_t)kta * 64) * 128 + 64 * g + 8 * wid);
    const bf16* vsrc = sptr(VA + (rowb + (size_t)kta * 64 + 16 * (wid & 3)) * 128 + 64 * g + (wid >> 2) * 32);
    const unsigned kl = lane * 256u, vl = (lane >> 2) * 256u + (lane & 3) * 16u;
    constexpr int SK = 0, SV = 73728, SSLOT = 8192;
    const unsigned kdst = lds0 + SK + wid * 1024, vdst = lds0 + SV + wid * 1024;
#define DMA_K(t, sl) glds16s(ksrc + (size_t)(t) * 64 * 128, kl, rfl(kdst + (sl) * SSLOT))
#define DMA_V(t, sl) glds16s(vsrc + (size_t)(t) * 64 * 128, vl, rfl(vdst + (sl) * SSLOT))
    for (int t_ = 0; t_ < NTA; ++t_) DMA_K(t_, t_);
    for (int t_ = 0; t_ < NTA; ++t_) DMA_V(t_, t_);
    const float bnd = TAB[TAB_CONST + 0];
    for (int sub = 0; sub < 2; ++sub) {
    const int nh = 2 * n128 + sub; const int kt0 = (nh - 2 < 0) ? 0 : nh - 2, kt1 = (nh + 3 > SEQ / 64) ? SEQ / 64 : nh + 3, NT = kt1 - kt0, s0 = kt0 - kta;
    bf16x8 qf[4];
    { const bf16* qp = QA + (rowb + 64 * nh + 32 * rh + r32) * 512 + HD * h + 8 * hi;
#pragma unroll
      for (int s = 0; s < 4; ++s) qf[s] = *(const bf16x8*)(qp + 16 * s); }
    f32x16 o[2]; o[0] = f32x16{}; o[1] = f32x16{};
    float l_reg = 0.f;
    const lds_cptr kp0 = (lds_cptr)lds + SK + s0 * SSLOT + hi * 1024 + r32 * 16;
    const lds_cptr vp0 = (lds_cptr)lds + SV + s0 * SSLOT + ((lane >> 4) & 1) * 32 + (lane & 3) * 8 + (4 * hi + ((lane & 15) >> 2)) * 64;
    const LAS float* tbl = (const LAS float*)(lds + LTAB) + hr * 512 + 63 + 4 * hi - 32 * rh - r32 + 64 * (kt0 - (nh - 2));
    bf16x8 kf[8];
#define KLD(kp, i) kf[i] = *(const __attribute__((address_space(3))) bf16x8*)((kp) + ((i) >> 1) * 2048 + ((i) & 1) * 512)
#define BIAS(C0, C1, tt_) do { _Pragma("unroll") for (int r_ = 0; r_ < 16; ++r_) { C0[r_] = (tt_)[(r_ & 3) + 8 * (r_ >> 2)]; C1[r_] = (tt_)[(r_ & 3) + 8 * (r_ >> 2) + 32]; } } while (0)
    if (sub == 0) { if (NTA == 6) ATT_WAIT_BAR(11); else ATT_WAIT_BAR(7); }
#pragma unroll
    for (int i = 0; i < 8; ++i) KLD(kp0, i);
    f32x16 pA0, pA1, pB0, pB1;
    BIAS(pA0, pA1, tbl);
#pragma unroll
    for (int s = 0; s < 4; ++s) { pA0 = __builtin_amdgcn_mfma_f32_32x32x16_bf16(kf[2 * s], qf[s], pA0, 0, 0, 0); pA1 = __builtin_amdgcn_mfma_f32_32x32x16_bf16(kf[2 * s + 1], qf[s], pA1, 0, 0, 0); }
#pragma unroll
    for (int r = 0; r < 16; ++r) { pA0[r] = __builtin_amdgcn_exp2f(pA0[r]); pA1[r] = __builtin_amdgcn_exp2f(pA1[r]); }
    BIAS(pB0, pB1, tbl + 64);
    if (sub == 0) ATT_WAIT_BAR(0);
#pragma unroll
    for (int i = 0; i < 8; ++i) KLD(kp0 + SSLOT, i);
    s16x4 vl0, vh0, vl1, vh1, vl2, vh2, vl3, vh3; u32x4 pw0, pw1, pw2, pw3;
#define ROT() do { } while (0)
#define PIN(x) asm volatile("" : "+v"(x))
#define VOFF(i) (((i) >> 2) * 4096 + ((i) & 3) * 1024)
#define VRD(B, i) do { vl##B = vtr(vp_ + VOFF(i)); vh##B = vtr(vp_ + VOFF(i) + 512); } while (0)
#define VFR(B) (bf16x8){vl##B[0], vl##B[1], vl##B[2], vl##B[3], vh##B[0], vh##B[1], vh##B[2], vh##B[3]}
#define PAF(k) __builtin_bit_cast(bf16x8, pw##k)
#define EX(v) __builtin_amdgcn_exp2f(v)
#define QKN(C, i, s) C = __builtin_amdgcn_mfma_f32_32x32x16_bf16(kf[i], qf[s], C, 0, 0, 0)
#define KN(i) do { if (gl_) { KLD(kn_, i); } } while (0)
#define GA(MF, KI, P, B, PW, W, X0, X1) do { MF; KN(KI); sacc += P[B]; sacc += P[B + 1]; sacc += P[B + 2]; sacc += P[B + 3]; PIN(sacc); PW[W] = cvtpk(P[B], P[B + 1]); PW[W + 1] = cvtpk(P[B + 2], P[B + 3]); PIN(PW); X0; X1; ATT_SBAR(); } while (0)
#define GB(MF, RD, E0, E1, E2, E3, NB) do { MF; RD; E0; E1; E2; E3; NB; ATT_SBAR(); } while (0)
#define NOP_ (void)0
#define NBIAS(P0, P1, q) do { if (gl_) { P0[2 * (q)] = tn_[((2 * (q)) & 3) + 8 * ((2 * (q)) >> 2)]; P0[2 * (q) + 1] = tn_[((2 * (q) + 1) & 3) + 8 * ((2 * (q) + 1) >> 2)]; \
        P1[2 * (q)] = tn_[((2 * (q)) & 3) + 8 * ((2 * (q)) >> 2) + 32]; P1[2 * (q) + 1] = tn_[((2 * (q) + 1) & 3) + 8 * ((2 * (q) + 1) >> 2) + 32]; } } while (0)
#define STEP(C0, C1, P0, P1, t) do { ATT_SBAR(); \
    const bool gl_ = (t) + 1 < NT; \
    const lds_cptr vp_ = vp0 + ((t) - 1) * SSLOT; const lds_cptr kn_ = kp0 + ((t) + 1) * SSLOT; const LAS float* tn_ = tbl + 64 * ((t) + 1); \
    float sacc = 0.f; \
    GA(QKN(C0, 0, 0), 0, P0, 0, pw0, 0, NOP_, NOP_); \
    GA(QKN(C0, 2, 1), 2, P0, 4, pw0, 2, NOP_, NOP_); \
    GA(QKN(C0, 4, 2), 4, P0, 8, pw1, 0, NOP_, NOP_); \
    GA(QKN(C0, 6, 3), 6, P0, 12, pw1, 2, NOP_, NOP_); \
    GA(QKN(C1, 1, 0), 1, P1, 0, pw2, 0, NOP_, NOP_); \
    GA(QKN(C1, 3, 1), 3, P1, 4, pw2, 2, NOP_, VRD(0, 0)); \
    GA(QKN(C1, 5, 2), 5, P1, 8, pw3, 0, C0[0] = EX(C0[0]), VRD(1, 4)); \
    GA(QKN(C1, 7, 3), 7, P1, 12, pw3, 2, C0[1] = EX(C0[1]), VRD(2, 1)); \
    l_reg += sacc; C0[2] = EX(C0[2]); C0[3] = EX(C0[3]); PIN(C0); ATT_SBAR(); \
    GB(o[0] = __builtin_amdgcn_mfma_f32_32x32x16_bf16(PAF(0), VFR(0), o[0], 0, 0, 0), VRD(3, 5), C0[4] = EX(C0[4]), C0[5] = EX(C0[5]), C0[6] = EX(C0[6]), C0[7] = EX(C0[7]), NBIAS(P0, P1, 0)); \
    GB(o[1] = __builtin_amdgcn_mfma_f32_32x32x16_bf16(PAF(0), VFR(1), o[1], 0, 0, 0), VRD(0, 2), C0[8] = EX(C0[8]), C0[9] = EX(C0[9]), C0[10] = EX(C0[10]), C0[11] = EX(C0[11]), NBIAS(P0, P1, 1)); \
    GB(o[0] = __builtin_amdgcn_mfma_f32_32x32x16_bf16(PAF(1), VFR(2), o[0], 0, 0, 0), VRD(1, 6), C0[12] = EX(C0[12]), C0[13] = EX(C0[13]), C0[14] = EX(C0[14]), C0[15] = EX(C0[15]), NBIAS(P0, P1, 2)); \
    GB(o[1] = __builtin_amdgcn_mfma_f32_32x32x16_bf16(PAF(1), VFR(3), o[1], 0, 0, 0), VRD(2, 3), C1[0] = EX(C1[0]), C1[1] = EX(C1[1]), C1[2] = EX(C1[2]), C1[3] = EX(C1[3]), NBIAS(P0, P1, 3)); \
    GB(o[0] = __builtin_amdgcn_mfma_f32_32x32x16_bf16(PAF(2), VFR(0), o[0], 0, 0, 0), VRD(3, 7), C1[4] = EX(C1[4]), C1[5] = EX(C1[5]), C1[6] = EX(C1[6]), C1[7] = EX(C1[7]), NBIAS(P0, P1, 4)); \
    GB(o[1] = __builtin_amdgcn_mfma_f32_32x32x16_bf16(PAF(2), VFR(1), o[1], 0, 0, 0), NOP_, C1[8] = EX(C1[8]), C1[9] = EX(C1[9]), C1[10] = EX(C1[10]), C1[11] = EX(C1[11]), NBIAS(P0, P1, 5)); \
    GB(o[0] = __builtin_amdgcn_mfma_f32_32x32x16_bf16(PAF(3), VFR(2), o[0], 0, 0, 0), NOP_, C1[12] = EX(C1[12]), C1[13] = EX(C1[13]), NOP_, NOP_, NBIAS(P0, P1, 6)); \
    GB(o[1] = __builtin_amdgcn_mfma_f32_32x32x16_bf16(PAF(3), VFR(3), o[1], 0, 0, 0), NOP_, C1[14] = EX(C1[14]), C1[15] = EX(C1[15]), NOP_, NOP_, NBIAS(P0, P1, 7)); \
    PIN(C0); PIN(C1); \
    } while (0)
#define DRAIN(P0, P1) do { float sacc = 0.f; _Pragma("unroll") for (int r_ = 0; r_ < 16; ++r_) sacc += P0[r_] + P1[r_]; l_reg += sacc; \
      const u32x4 w0 = pack_p(P0, 0), w1 = pack_p(P0, 8), w2 = pack_p(P1, 0), w3 = pack_p(P1, 8); \
      pv(o, (int)(lds0 + SV) + ((lane >> 4) & 1) * 32 + (lane & 3) * 8 + (4 * hi + ((lane & 15) >> 2)) * 64 + (s0 + NT - 1) * SSLOT, \
         __builtin_bit_cast(bf16x8, w0), __builtin_bit_cast(bf16x8, w1), __builtin_bit_cast(bf16x8, w2), __builtin_bit_cast(bf16x8, w3)); } while (0)
    STEP(pB0, pB1, pA0, pA1, 1);
    STEP(pA0, pA1, pB0, pB1, 2);
    if (NT > 3) { STEP(pB0, pB1, pA0, pA1, 3);
        if (NT > 4) { STEP(pA0, pA1, pB0, pB1, 4); DRAIN(pA0, pA1); } else { DRAIN(pB0, pB1); } }
    else { DRAIN(pA0, pA1); }
#undef DRAIN
#undef STEP
#undef NBIAS
#undef NOP_
#undef GB
#undef GA
#undef KN
#undef QKN
#undef EX
#undef PAF
#undef VFR
#undef VRD
#undef VOFF
#undef PIN
#undef ROT
#undef BIAS
#undef KLD
#undef DMA_K
#undef DMA_V
    float l = l_reg; l += __shfl_xor(l, 32); l += __builtin_amdgcn_exp2f(sink[h] * LOG2E - bnd);
    const int le = lane_id();
    const int r32e = le & 31, hie = le >> 5;
    LAS float* wsf = (LAS float*)(lds + LWS) + wid * 64;
    if (hie == 0) wsf[r32e] = l;
    asm volatile("s_waitcnt lgkmcnt(0)" ::: "memory");
    bf16* Ow = (bf16*)sptr(O + (rowb + 64 * nh + 32 * rh) * DM + HD * h);
    float part[16];
#pragma unroll
    for (int r = 0; r < 16; ++r) { const int q = crow(r, hie); const float il = __builtin_amdgcn_rcpf(wsf[q]); const unsigned off = (unsigned)(q * DM + r32e); const float v0 = o[0][r] * il, v1 = o[1][r] * il;
        part[r] = v0 * v0 + v1 * v1; Ow[off] = (bf16)f2bf(v0); Ow[off + 32] = (bf16)f2bf(v1); }
    ssq_accum(part, le, SSQ + 2 * (rowb + 64 * nh + 32 * rh));
    }
    asm volatile("s_waitcnt lgkmcnt(0)\n\ts_barrier" ::: "memory");
}

#undef ATT_SBAR
#undef ATT_WAIT_BAR
}

__device__ __forceinline__ void p5_attention(Frame& F, bool probe_dup = false) {
    const int lane_ = lane_id();
    const bf16* QB = WSP(bf16, WS_QB); const unsigned char* KN8 = WSP(unsigned char, WS_KBN); const unsigned char* QN8 = WSP(unsigned char, WS_QN8); const bf16* KR = WSP(bf16, WS_KR); const bf16* VB = WSP(bf16, WS_VB);
    const bf16* QA = WSP(bf16, WS_QA); const bf16* KA = WSP(bf16, WS_KA); const bf16* VA = WSP(bf16, WS_VA); bf16* O = WSP(bf16, WS_O);
    const float* TAB = WSP(float, WS_TAB); float* SSQ = probe_dup ? WSP(float, WS_KVRAW) : WSP(float, WS_SSQ);
    constexpr int NU_B = BATCH * BH * (SEQ / 256), NU_A = BATCH * (SEQ / 64) * A_KV;
#ifndef NO_MLA
    { const float bndB = __uint_as_float((unsigned)__builtin_amdgcn_readfirstlane((int)__float_as_uint(TAB[TAB_CONST + 1])));
      const bool shift = bndB > 64.0f; const float nb = shift ? -bndB : 0.f;
      for (int i = 0; i < (NU_B + F.G - 1) / F.G; ++i) {
        const int u = (F.G == 256) ? (F.vcu >> 2) * 16 + (F.vcu & 3) * 4 + i : i * F.G + F.vcu;
        if (u >= NU_B) break;
        const att::ConvJob cj{(F.G == 256 && !probe_dup) ? ((F.vcu * 4 + i) * NWAVES + F.wave) * 3 : -1};
        att::mla_unit2(F.lds + RING_OFF, (u >> 4) / BH, (u >> 4) % BH, u & 15, QB, QN8, KN8, KR, VB, O, SSQ, shift, nb, cj, F.wave, lane_);
      } }
#endif
#ifndef NO_SWA
    { const int lane2 = lane_id();
      int gcur = -1;
      for (int u = F.vcu; u < NU_A / 2; u += F.G) { if ((u & 1) != gcur) { gcur = u & 1; asm volatile("s_waitcnt lgkmcnt(0)\n\ts_barrier" ::: "memory"); att::swa_fill_table(F.lds + RING_OFF, gcur, TAB, F.wave * 64 + lane2); }
        att::swa_unit3(F.lds + RING_OFF, u >> 6, (u >> 1) & 31, u & 1, QA, KA, VA, O, SSQ, TAB, F.in[6], F.wave, lane2); } }
#endif
}

struct Args { const float* in[23]; float* out; unsigned char* ws; int ph_lo, ph_hi, li, pad; };
constexpr int N_PHASES = 13;
__global__ void __launch_bounds__(NWAVES * 64, 2) skel_fwd(Args args) {
    extern __shared__ __attribute__((aligned(16))) unsigned char lds[];
    Frame F;
    F.lds = (LAS unsigned char*)lds;
    F.MISC = (volatile LAS unsigned*)(F.lds + MISC_OFF);
    F.wave = __builtin_amdgcn_readfirstlane((int)(threadIdx.x >> 6));
    F.G = gridDim.x; { const int bx = blockIdx.x; F.vcu = (F.G % 8 == 0) ? (bx % 8) * (F.G / 8) + bx / 8 : bx; }
    F.ws = args.ws; F.out = args.out;
#pragma unroll
    for (int i = 0; i < 23; ++i) F.in[i] = args.in[i];
    F.ctl = (gu32*)(F.ws + WS_CTL);
    for (int u = threadIdx.x; u < (LDS_BYTES - LDSCTL_OFF) / 4; u += NWAVES * 64) ((LAS unsigned*)(F.lds + LDSCTL_OFF))[u] = 0u;
    __syncthreads();
    XcdBarrier bar = xcd_barrier_post((unsigned*)(F.ctl + CW_BAR) + args.li * XCD_BAR_WORDS, F.MISC + 8);
    const int lo = args.ph_lo, hi = args.ph_hi;
#define IN(k) (lo <= (k) && (k) < hi)
#define SEAM(k) do { if (IN(k) && IN((k) + 1)) xcd_barrier(bar); } while (0)

#define PH(k, ...) do { if (IN(k)) { __VA_ARGS__; if ((PROBE_MASK >> (k)) & 1) { xcd_barrier(bar); __VA_ARGS__; } } SEAM(k); } while (0)
    PH(0, p0_prologue(F));
    PH(1, {
        pg8::Gemm g{WSP(bf16, WS_XN), WSP(bf16, WS_WIN), T, NZ, DM, 0, nullptr, nullptr, 0, 0, 0, F.wave}; pg8::StaticOrder S; S.init(T, NZ, F.G, (int)blockIdx.x);
        pg8::EpiInProj E{F.ws, F.in[4], F.in[5], F.in[14]};
        pg8::gemm_phase<pg8::EpiInProj, pg8::StaticOrder, true, true>(F.lds + RING_OFF, g, S, E); });
    PH(3, {
        { pg8::Gemm g{WSP(bf16, WS_CQ), WSP(bf16, WS_WQB), T, BH * QKD, QL, 0, nullptr, nullptr, 0, 0, 0, F.wave}; pg8::StaticOrder S; S.init(T, BH * QKD, F.G, (int)blockIdx.x);
          pg8::EpiQB E{F.ws, F.in[11], F.in[12]};
          pg8::gemm_phase<pg8::EpiQB, pg8::StaticOrder, true, true>(F.lds + RING_OFF, g, S, E); }
        __syncthreads();
        { pg8::Gemm g{WSP(bf16, WS_CKV), WSP(bf16, WS_WKVB), T, BH * 128, KVL, 0, nullptr, nullptr, 0, 0, 0, F.wave}; pg8::StaticOrder S; S.init(T, BH * 128, F.G, (int)(F.G - 1 - blockIdx.x));
          pg8::EpiKVB E{F.ws, F.in[13]};
          pg8::gemm_phase<pg8::EpiKVB, pg8::StaticOrder, true, true>(F.lds + RING_OFF, g, S, E); } });
#if !NAIVE_ATTN
    PH(5, p5_attention(F));
#if PROBE_ATT
    xcd_barrier(bar); p5_attention(F, true); xcd_barrier(bar);
#endif
#endif
    PH(7, {
        pg8::Gemm g{WSP(bf16, WS_O), WSP(bf16, WS_WO), T, DM, DM, 0, nullptr, WSP(float, WS_SSQ), 0, 0, 0, F.wave}; pg8::StaticOrder S; S.init(T, DM, F.G, (int)blockIdx.x);
        pg8::EpiNormBf16 E{WSP(bf16, WS_ATT), DM, WSP(float, WS_SSQ)};
        pg8::gemm_phase<pg8::EpiNormBf16, pg8::StaticOrder, true, true, 2>(F.lds + RING_OFF, g, S, E); });
    PH(8, p8_router(F));
    PH(9, p9_topk(F));
    PH(11, {
        pg8::Gemm g{WSP(bf16, WS_H2), WSP(bf16, WS_WGU), MX, 2 * FF, DM / 2, (size_t)2 * FF * DM, WSP(int, WS_IDX), nullptr, 0x7a7a7a7a, 0x7a7a7a7a, (unsigned)(LDSCTL_OFF + 1024 - RING_OFF), F.wave}; pg8::StaticOrder S; S.init(MX, 2 * FF, F.G, (int)blockIdx.x, 16);
        pg8::EpiSwiGLU8 E{WSP(unsigned char, WS_ACT), FF, 16.0f};
        pg8::gemm_phase<pg8::EpiSwiGLU8, pg8::StaticOrder, true, true, 1, true>(F.lds + RING_OFF, g, S, E); });
    PH(12, {
        pg8::Gemm g{WSP(bf16, WS_ACT), WSP(bf16, WS_WD), MX, DM, FF / 2, (size_t)DM * FF, nullptr, nullptr, 0x7b7b7b7b, 0x7b7b7b7b, 0, F.wave}; pg8::StaticOrder S; S.init(MX, DM, F.G, (int)blockIdx.x, 16);
        pg8::EpiRowScaleF8 E{WSP(unsigned char, WS_YE), DM, WSP(float, WS_GATEV), 64.0f};
        pg8::gemm_phase<pg8::EpiRowScaleF8, pg8::StaticOrder, true, true, 0, true>(F.lds + RING_OFF, g, S, E); });
    PH(13, p12_combine(F));
#undef PH
#undef IN
#undef SEAM
}

#if NAIVE_ATTN
__device__ __forceinline__ float bf2f(bf16 v) { return __uint_as_float((unsigned)v << 16); }
__global__ void __launch_bounds__(256) naive_attn_a(const bf16* __restrict__ QA, const bf16* __restrict__ KA, const bf16* __restrict__ VA, const float* __restrict__ TAB, const float* __restrict__ sink, bf16* __restrict__ O) {
    const int s = (blockIdx.x % (SEQ / 256)) * 256 + threadIdx.x, bh = blockIdx.x / (SEQ / 256), h = bh % A_HEADS, b = bh / A_HEADS, g = h / (A_HEADS / A_KV);
    const size_t m = (size_t)b * SEQ + s;
    float q[HD], o[HD];
#pragma unroll
    for (int d = 0; d < HD; ++d) { q[d] = bf2f(QA[m * 512 + h * HD + d]); o[d] = 0.f; }
    const float bnd = TAB[TAB_CONST + 0];
    float l = exp2f(sink[h] * LOG2E - bnd);
    for (int rel = -WINDOW; rel <= WINDOW; ++rel) { const int j = s + rel; if (j < 0 || j >= SEQ) continue;
        const bf16* kr = KA + ((size_t)b * SEQ + j) * 128 + g * HD; const bf16* vr = VA + ((size_t)b * SEQ + j) * 128 + g * HD;
        float sc = 0.f;
#pragma unroll
        for (int d = 0; d < HD; ++d) sc += q[d] * bf2f(kr[d]);
        const float p = exp2f(sc + TAB[TAB_BIAS + h * NTAB + rel + 128] - bnd); l += p;
#pragma unroll
        for (int d = 0; d < HD; ++d) o[d] += p * bf2f(vr[d]); }
    const float il = 1.0f / l;
#pragma unroll
    for (int d = 0; d < HD; ++d) O[m * DM + h * HD + d] = (bf16)f2bf(o[d] * il);
}
__global__ void __launch_bounds__(256) naive_attn_b(const bf16* __restrict__ QB, const bf16* __restrict__ KBN, const bf16* __restrict__ KR, const bf16* __restrict__ VB, const float* __restrict__ TAB, bf16* __restrict__ O) {
    const int s = (blockIdx.x % (SEQ / 256)) * 256 + threadIdx.x, bh = blockIdx.x / (SEQ / 256), h = bh % BH, b = bh / BH;
    const size_t m = (size_t)b * SEQ + s;
    float q[QKD], o[VD];
#pragma unroll
    for (int d = 0; d < QKD; ++d) q[d] = bf2f(QB[m * (BH * QKD) + h * QKD + d]);
#pragma unroll
    for (int d = 0; d < VD; ++d) o[d] = 0.f;
    const float bnd = TAB[TAB_CONST + 1];
    float l = 0.f;
    for (int j = 0; j < SEQ; ++j) { const size_t mj = (size_t)b * SEQ + j;
        const bf16* kn = KBN + mj * 512 + h * NOPE; const bf16* kr = KR + mj * ROPE; const bf16* vr = VB + mj * 512 + h * VD;
        float sc = 0.f;
#pragma unroll
        for (int d = 0; d < NOPE; ++d) sc += q[d] * bf2f(kn[d]);
#pragma unroll
        for (int d = 0; d < ROPE; ++d) sc += q[NOPE + d] * bf2f(kr[d]);
        const float p = exp2f(sc - bnd); l += p;
#pragma unroll
        for (int d = 0; d < VD; ++d) o[d] += p * bf2f(vr[d]); }
    const float il = 1.0f / l;
#pragma unroll
    for (int d = 0; d < VD; ++d) O[m * DM + 512 + h * VD + d] = (bf16)f2bf(o[d] * il);
}

#endif
extern "C" void kernel_launch(void* const* d_in, const int* in_sizes, int n_in, void* d_out, int out_size, void* d_ws, size_t ws_size, hipStream_t stream) {
    static int grid = 0;
    if (grid == 0) {
        if (n_in != 23 || in_sizes[0] != T * DM || out_size != T * DM || ws_size < WS_END) { fprintf(stderr, "kernel_launch: unexpected shapes (n_in %d, in0 %d, out %d, ws %zu)\n", n_in, n_in > 0 ? in_sizes[0] : -1, out_size, ws_size); grid = -1; return; }
        int dev = 0, cus = 0, per_cu = 0;
        if (hipGetDevice(&dev) != hipSuccess || hipDeviceGetAttribute(&cus, hipDeviceAttributeMultiprocessorCount, dev) != hipSuccess) { grid = -1; return; }
        if (hipFuncSetAttribute((const void*)skel_fwd, hipFuncAttributeMaxDynamicSharedMemorySize, LDS_BYTES) != hipSuccess) { fprintf(stderr, "kernel_launch: hipFuncSetAttribute failed\n"); grid = -1; return; }
        if (hipOccupancyMaxActiveBlocksPerMultiprocessor(&per_cu, (const void*)skel_fwd, NWAVES * 64, LDS_BYTES) != hipSuccess || per_cu < 1) fprintf(stderr, "kernel_launch: occupancy query says %d\n", per_cu);
        (void)hipGetLastError();
        grid = cus;
    }
    if (grid < 0) return;
    if (hipMemsetAsync((char*)d_ws + WS_CTL, 0, CTL_ZERO_BYTES, stream) != hipSuccess) return;
    Args a{};
    for (int i = 0; i < 23; ++i) a.in[i] = (const float*)d_in[i];
    a.out = (float*)d_out; a.ws = (unsigned char*)d_ws;
    unsigned char* ws = (unsigned char*)d_ws;
#if NAIVE_ATTN
    a.ph_lo = 0; a.ph_hi = 5; a.li = 0;
    hipLaunchKernelGGL(skel_fwd, dim3(grid), dim3(NWAVES * 64), LDS_BYTES, stream, a);
    hipLaunchKernelGGL(naive_attn_a, dim3(BATCH * A_HEADS * (SEQ / 256)), dim3(256), 0, stream, (const bf16*)(ws + WS_QA), (const bf16*)(ws + WS_KA), (const bf16*)(ws + WS_VA), (const float*)(ws + WS_TAB), (const float*)d_in[6], (bf16*)(ws + WS_O));
    hipLaunchKernelGGL(naive_attn_b, dim3(BATCH * BH * (SEQ / 256)), dim3(256), 0, stream, (const bf16*)(ws + WS_QB), (const bf16*)(ws + WS_KBN), (const bf16*)(ws + WS_KR), (const bf16*)(ws + WS_VB), (const float*)(ws + WS_TAB), (bf16*)(ws + WS_O));
    a.ph_lo = 6; a.ph_hi = 14; a.li = 1;
    hipLaunchKernelGGL(skel_fwd, dim3(grid), dim3(NWAVES * 64), LDS_BYTES, stream, a);
#else
    a.ph_lo = 0; a.ph_hi = 14; a.li = 0;
    hipLaunchKernelGGL(skel_fwd, dim3(grid), dim3(NWAVES * 64), LDS_BYTES, stream, a);
#endif
}
```

```cpp
#include <hip/hip_runtime.h>
#include <hip/hip_bf16.h>
#include <cstdio>
#include <cstdint>
#ifndef PROBE_ATT
#define PROBE_ATT 0
#endif
#ifndef PROBE_MASK
#define PROBE_MASK 0
#endif
#ifndef NAIVE_ATTN
#define NAIVE_ATTN 0
#endif
__device__ __forceinline__ int lane_id() { int l; asm volatile("v_mbcnt_lo_u32_b32 %0, -1, 0\n\tv_mbcnt_hi_u32_b32 %0, -1, %0" : "=v"(l)); return l; }

constexpr int NWAVES = 8;
constexpr int BATCH = 8, SEQ = 4096, DM = 1024, T = BATCH * SEQ;
constexpr int INW = 1440, NZ = 1536;
constexpr int A_HEADS = 8, A_KV = 2, HD = 64, WINDOW = 128;
constexpr int BH = 8, QL = 384, KVL = 256, NOPE = 64, ROPE = 32, VD = 64, QKD = NOPE + ROPE;
constexpr int NE = 16, FF = 1024, CAP = 512, MX = NE * BATCH * CAP;
constexpr float EPS = 1e-6f, LOG2E = 1.4426950408889634f;
constexpr float QSC_A = 0.125f * LOG2E;
constexpr float QSC_B = 0.10206207261596577f * LOG2E;
constexpr int NTAB = 257;

constexpr size_t MiB = 1u << 20;
constexpr size_t WS_CTL = 0, CTL_ZERO_BYTES = 1 * MiB;
constexpr size_t WS_SSQ = 512 * 1024;
constexpr size_t WS_SSQCQ = 768 * 1024, WS_SSQCKV = 896 * 1024;
constexpr size_t WS_TAB = 1 * MiB;
constexpr size_t WS_WIN = 4 * MiB, WS_WQB = 7 * MiB, WS_WKVB = 8 * MiB, WS_WO = 9 * MiB, WS_WGU = 12 * MiB, WS_WD = 76 * MiB;
constexpr size_t WS_AFF = 108 * MiB, WS_IDX = 110 * MiB, WS_GATEV = WS_IDX + 512 * 1024, WS_SLOT = 111 * MiB;
constexpr size_t WS_XN = 114 * MiB;
constexpr size_t WS_Z = 178 * MiB;
constexpr size_t WS_QA = 274 * MiB, WS_KA = 306 * MiB, WS_VA = 314 * MiB, WS_CQ = 322 * MiB, WS_CKV = 346 * MiB, WS_KR = 362 * MiB;
constexpr size_t WS_KVRAW = 364 * MiB, WS_KBN = 428 * MiB, WS_VB = 460 * MiB, WS_END = 492 * MiB;
constexpr size_t WS_ATT = 242 * MiB;
constexpr size_t WS_QN8 = 242 * MiB;
constexpr size_t WS_X1B = 370 * MiB;
constexpr size_t WS_QB = WS_Z, WS_O = WS_XN, WS_H2 = WS_XN, WS_XE = WS_Z, WS_ACT = 306 * MiB, WS_YE = WS_Z;
constexpr int TAB_BIAS = 0, TAB_CONST = 8 * NTAB + 8, TAB_COS = TAB_CONST + 16, TAB_SIN = TAB_COS + SEQ * 16;
constexpr int CW_TMO = 0, CW_BAR = 4096;

constexpr int RING_OFF = 0, RING_BYTES = 131072;
constexpr int LDSCTL_OFF = RING_BYTES, MISC_OFF = LDSCTL_OFF + 320;
constexpr int LDS_BYTES = 147456;
namespace pg8 {
#define PG8_LAS __attribute__((address_space(3)))
typedef unsigned short bf16_t;
typedef short bf16x8 __attribute__((ext_vector_type(8)));
typedef float f32x4 __attribute__((ext_vector_type(4)));
typedef unsigned u32x4 __attribute__((ext_vector_type(4)));
constexpr int BM = 256, BK = 64, HALF = 128, HTB = HALF * BK * 2  , STAGE_BYTES = 8 * HTB, NXCD = 8, WGM = 8;

__host__ __device__ __forceinline__ int lds_byte(int r, int c) { const int st = (r >> 4) * 2 + (c >> 5), rr = r & 15, cc = c & 31, ob = rr * 64 + cc * 2; return st * 1024 + (ob ^ (((ob >> 9) & 1) << 5)); }
__host__ __device__ __forceinline__ void stage_rc(int b, int& R, int& C) { const int st = b / 1024, sb = b % 1024, swz = sb ^ (((sb >> 9) & 1) << 5); R = (st >> 1) * 16 + swz / 64; C = (st & 1) * 32 + (swz % 64) / 2; }
__host__ __device__ __forceinline__ int gray4(int q) { return q ^ (q >> 1); }
__host__ __device__ __forceinline__ int lds_byte8(int r, int cbyte) { const int st = (r >> 4) * 2 + (cbyte >> 6), rr = r & 15; return st * 1024 + rr * 64 + ((((cbyte >> 4) & 3) ^ gray4((rr >> 2) & 3)) << 4) + (cbyte & 15); }
__host__ __device__ __forceinline__ void stage_rc8(int b, int& R, int& C) { const int st = b / 1024, sb = b % 1024, rr = sb / 64, ch = ((sb % 64) / 16) ^ gray4((rr >> 2) & 3); R = (st >> 1) * 16 + rr; C = (st & 1) * 32 + ch * 8; }
__host__ __device__ __forceinline__ int perm32(int rho) { const int n = rho >> 4, i = rho & 15; return 8 * (i >> 2) + 4 * n + (i & 3); }

struct Unit { int pm, pn, e; };
struct Gemm { const bf16_t* A; const bf16_t* Bt; int M, N, K; size_t estride; const int* idx; const float* ssq; int sA, sB; unsigned gtab; int wave; };

struct StaticOrder {
    int nM, nN, nwg, G, c, epan;
    __host__ __device__ void init(int M, int N, int G_, int c_, int epan_ = 0) { nM = M / BM; nN = N / BM; nwg = nM * nN; G = G_; c = c_; epan = epan_; }
    __host__ __device__ bool next(int i, Unit& u) const {
        const long L = (long)i * G + c; if (L >= nwg) return false;
        int wgid = (int)L; { const int q = nwg / NXCD, r = nwg % NXCD, xcd = wgid % NXCD, off = wgid / NXCD; wgid = (xcd < r ? xcd * (q + 1) : r * (q + 1) + (xcd - r) * q) + off; }
        const int nig = WGM * nN, gid = wgid / nig, fm = gid * WGM, gsz = (nM - fm) < WGM ? (nM - fm) : WGM;
        u.pm = fm + ((wgid % nig) % gsz); u.pn = (wgid % nig) / gsz; u.e = epan ? u.pm / epan : 0; return true;
    }
    __device__ __forceinline__ void a_ready(const Unit&) const {}
    __device__ __forceinline__ void done(const Unit&) const {}
};

__device__ __forceinline__ unsigned cvt_pk_bf16(float lo, float hi) { unsigned r; asm volatile("v_cvt_pk_bf16_f32 %0, %1, %2" : "=v"(r) : "v"(lo), "v"(hi)); return r; }
typedef float f32x2 __attribute__((ext_vector_type(2)));
__device__ __forceinline__ f32x2 gelu_pk(f32x2 v) {
    const f32x2 av = __builtin_elementwise_abs(v), d = av * 0.2316418882f + 1.0f;
    f32x2 t; t.x = __builtin_amdgcn_rcpf(d.x); t.y = __builtin_amdgcn_rcpf(d.y);
    f32x2 q = t * 0.5307027145f + (-0.7265760135f); q = q * t + 0.7107068705f; q = q * t + (-0.142248368f); q = q * t + 0.127414796f; q = q * t;
    const f32x2 s = (v * v) * (-0.72134752044f);
    f32x2 e; e.x = __builtin_amdgcn_exp2f(s.x); e.y = __builtin_amdgcn_exp2f(s.y);
    const f32x2 m = v * (q * e), r = v - m;
    f32x2 o; o.x = v.x < 0.f ? m.x : r.x; o.y = v.y < 0.f ? m.y : r.y; return o;
}

template <int ACT  > struct EpiBf16 {
    static constexpr bool PERM = true, AFTER_DRAIN = false; static_assert(ACT == 0 || ACT == 1, "EpiBf16: ACT is 0 (none) or 1 (gelu_pk)");
    bf16_t* O; int ldc; const float* bias; int split_cols; size_t split_stride; float scale0;
    __device__ __forceinline__ void operator()(const f32x4 (&acc)[2][2][4][2], const Unit& u, int wr, int wc, int fr, int fq) const {
        const int row0 = u.pm * BM + wr * 64 + fr; int colt = u.pn * BM; bf16_t* base = O;
        float sc = 1.f; if (split_cols) { const int t = colt / split_cols; base += (size_t)t * split_stride; colt -= t * split_cols; if (t == 0) sc = scale0; }
        const int col0 = colt + wc * 32 + 8 * fq, bcol0 = u.pn * BM + wc * 32 + 8 * fq;
        f32x4 bv[2][2];
#pragma unroll
        for (int bj = 0; bj < 2; ++bj)
#pragma unroll
            for (int n = 0; n < 2; ++n) bv[bj][n] = bias ? *(const f32x4*)(bias + bcol0 + bj * HALF + 4 * n) : (f32x4){0.f, 0.f, 0.f, 0.f};
#pragma unroll
        for (int ai = 0; ai < 2; ++ai)
#pragma unroll
            for (int m = 0; m < 4; ++m) { bf16_t* rowp = base + (size_t)(row0 + ai * HALF + m * 16) * ldc + col0;
#pragma unroll
                for (int bj = 0; bj < 2; ++bj) { f32x4 v0 = acc[ai][bj][m][0] + bv[bj][0], v1 = acc[ai][bj][m][1] + bv[bj][1];
                    if (ACT == 1) { f32x2 a = gelu_pk((f32x2){v0[0], v0[1]}), b = gelu_pk((f32x2){v0[2], v0[3]}), c = gelu_pk((f32x2){v1[0], v1[1]}), d = gelu_pk((f32x2){v1[2], v1[3]});
                        v0 = (f32x4){a.x, a.y, b.x, b.y}; v1 = (f32x4){c.x, c.y, d.x, d.y}; }
                    v0 = v0 * sc; v1 = v1 * sc; u32x4 w; w.x = cvt_pk_bf16(v0[0], v0[1]); w.y = cvt_pk_bf16(v0[2], v0[3]); w.z = cvt_pk_bf16(v1[0], v1[1]); w.w = cvt_pk_bf16(v1[2], v1[3]);
                    *(u32x4*)(rowp + bj * HALF) = w; } }
    }
};

struct EpiResF32 {
    static constexpr bool PERM = true, AFTER_DRAIN = false;
    const float* base; float* out; int ldc; const float* ssq;
    __device__ __forceinline__ void operator()(const f32x4 (&acc)[2][2][4][2], const Unit& u, int wr, int wc, int fr_, int fq_) const {
        (void)fr_; (void)fq_; const int ln_ = lane_id(); const int fr = ln_ & 15, fq = ln_ >> 4;
        const int col0 = u.pn * BM + wc * 32 + 8 * fq;
#pragma unroll
        for (int ai = 0; ai < 2; ++ai)
#pragma unroll
            for (int m = 0; m < 4; ++m) { const int r = ai * HALF + wr * 64 + m * 16 + fr; const unsigned off = (unsigned)((u.pm * BM + r) * ldc + col0);
                const float rb = ssq ? __builtin_amdgcn_rsqf(ssq[2 * (u.pm * BM + r) + 1] * (1.0f / 512.0f) + 1e-6f) : 1.0f;
#pragma unroll
                for (int bj = 0; bj < 2; ++bj)
#pragma unroll
                    for (int n = 0; n < 2; ++n) { const f32x4 bs = *(const f32x4*)(base + off + bj * HALF + n * 4); *(f32x4*)(out + off + bj * HALF + n * 4) = bs + acc[ai][bj][m][n] * rb; } }
    }
};
__device__ __forceinline__ float silu_mul(float g, float u) { return g * u * __builtin_amdgcn_rcpf(1.0f + __builtin_amdgcn_exp2f(-1.4426950408889634f * g)); }
struct EpiSwiGLU {
    static constexpr bool PERM = true, AFTER_DRAIN = false;
    bf16_t* O; int ldc;
    __device__ __forceinline__ void operator()(const f32x4 (&acc)[2][2][4][2], const Unit& u, int wr, int wc, int fr_, int fq_) const {
        (void)fr_; (void)fq_; const int ln_ = lane_id(); const int fr = ln_ & 15, fq = ln_ >> 4;
        const int row0 = u.pm * BM + wr * 64 + fr, col0 = u.pn * HALF + wc * 32 + 8 * fq;
#pragma unroll
        for (int ai = 0; ai < 2; ++ai)
#pragma unroll
            for (int m = 0; m < 4; ++m) { bf16_t* rowp = O + (unsigned)((row0 + ai * HALF + m * 16) * ldc + col0);
                const f32x4 g0 = acc[ai][0][m][0], g1 = acc[ai][0][m][1], u0 = acc[ai][1][m][0], u1 = acc[ai][1][m][1];
                u32x4 w; w.x = cvt_pk_bf16(silu_mul(g0[0], u0[0]), silu_mul(g0[1], u0[1])); w.y = cvt_pk_bf16(silu_mul(g0[2], u0[2]), silu_mul(g0[3], u0[3]));
                w.z = cvt_pk_bf16(silu_mul(g1[0], u1[0]), silu_mul(g1[1], u1[1])); w.w = cvt_pk_bf16(silu_mul(g1[2], u1[2]), silu_mul(g1[3], u1[3]));
                *(u32x4*)rowp = w; }
    }
};
struct EpiRowScaleBf16 {
    static constexpr bool PERM = true, AFTER_DRAIN = false;
    bf16_t* O; int ldc; const float* rowscale;
    __device__ __forceinline__ void operator()(const f32x4 (&acc)[2][2][4][2], const Unit& u, int wr, int wc, int fr_, int fq_) const {
        (void)fr_; (void)fq_; const int ln_ = lane_id(); const int fr = ln_ & 15, fq = ln_ >> 4;
        const int row0 = u.pm * BM + wr * 64 + fr, col0 = u.pn * BM + wc * 32 + 8 * fq;
#pragma unroll
        for (int ai = 0; ai < 2; ++ai)
#pragma unroll
            for (int m = 0; m < 4; ++m) { const int row = row0 + ai * HALF + m * 16; const float sc = rowscale[row]; bf16_t* rowp = O + (unsigned)(row * ldc + col0);
#pragma unroll
                for (int bj = 0; bj < 2; ++bj) { const f32x4 v0 = acc[ai][bj][m][0] * sc, v1 = acc[ai][bj][m][1] * sc;
                    u32x4 w; w.x = cvt_pk_bf16(v0[0], v0[1]); w.y = cvt_pk_bf16(v0[2], v0[3]); w.z = cvt_pk_bf16(v1[0], v1[1]); w.w = cvt_pk_bf16(v1[2], v1[3]);
                    *(u32x4*)(rowp + bj * HALF) = w; } }
    }
};
__device__ __forceinline__ float fqsum(float v) { v += __shfl_xor(v, 16); v += __shfl_xor(v, 32); return v; }
__device__ __forceinline__ float dot4(const f32x4 a) { return (a[0] * a[0] + a[1] * a[1]) + (a[2] * a[2] + a[3] * a[3]); }
__device__ __forceinline__ u32x4 pack8g(const f32x4 a, const f32x4 b, const float (&g)[8], float r) {
    u32x4 w; w.x = cvt_pk_bf16(a[0] * r * g[0], a[1] * r * g[1]); w.y = cvt_pk_bf16(a[2] * r * g[2], a[3] * r * g[3]); w.z = cvt_pk_bf16(b[0] * r * g[4], b[1] * r * g[5]); w.w = cvt_pk_bf16(b[2] * r * g[6], b[3] * r * g[7]); return w; }
typedef unsigned u32x2_t __attribute__((ext_vector_type(2)));
__device__ __forceinline__ float clampf8(float v) { return __builtin_amdgcn_fmed3f(v, -448.0f, 448.0f); }
__device__ __forceinline__ u32x2_t pack8g_f8(const f32x4 a, const f32x4 b, const float (&g)[8], float r) {
    int w0 = 0, w1 = 0;
    w0 = __builtin_amdgcn_cvt_pk_fp8_f32(clampf8(a[0] * r * g[0]), clampf8(a[1] * r * g[1]), w0, false); w0 = __builtin_amdgcn_cvt_pk_fp8_f32(clampf8(a[2] * r * g[2]), clampf8(a[3] * r * g[3]), w0, true);
    w1 = __builtin_amdgcn_cvt_pk_fp8_f32(clampf8(b[0] * r * g[4]), clampf8(b[1] * r * g[5]), w1, false); w1 = __builtin_amdgcn_cvt_pk_fp8_f32(clampf8(b[2] * r * g[6]), clampf8(b[3] * r * g[7]), w1, true);
    return (u32x2_t){(unsigned)w0, (unsigned)w1}; }
__device__ __forceinline__ u32x4 pack8s(const f32x4 a, const f32x4 b, float r) {
    u32x4 w; w.x = cvt_pk_bf16(a[0] * r, a[1] * r); w.y = cvt_pk_bf16(a[2] * r, a[3] * r); w.z = cvt_pk_bf16(b[0] * r, b[1] * r); w.w = cvt_pk_bf16(b[2] * r, b[3] * r); return w; }
constexpr float kEps = 1e-6f;
struct EpiInProj {
    static constexpr bool PERM = true, AFTER_DRAIN = false;
    unsigned char* ws; const float *gq, *gk, *gkr;
    __device__ __forceinline__ void operator()(const f32x4 (&acc)[2][2][4][2], const Unit& u, int wr, int wc, int fr_, int fq_) const {
        (void)fr_; (void)fq_; const int ln_ = lane_id(); const int fr = ln_ & 15, fq = ln_ >> 4;
        const int G = 4 * u.pn + wc;
        if (G >= 23) return;
        const int row0 = u.pm * BM + wr * 64 + fr;
        bf16_t* const QA = (bf16_t*)(ws + WS_QA); bf16_t* const KA = (bf16_t*)(ws + WS_KA); bf16_t* const VA = (bf16_t*)(ws + WS_VA); bf16_t* const CQ = (bf16_t*)(ws + WS_CQ); bf16_t* const CKV = (bf16_t*)(ws + WS_CKV); bf16_t* const KR = (bf16_t*)(ws + WS_KR);
        float* const ssq_cq = (float*)(ws + WS_SSQCQ); float* const ssq_ckv = (float*)(ws + WS_SSQCKV); const float* const cosT = (const float*)(ws + WS_TAB) + TAB_COS; const float* const sinT = (const float*)(ws + WS_TAB) + TAB_SIN;
        constexpr float qscale = QSC_A; constexpr int seq = SEQ;
        if (G < 10) {
            const float* gg = (G < 8) ? gq : gk; const float sc = (G < 8) ? qscale : 1.0f; bf16_t* dst = (G < 8) ? QA + 64 * G : KA + 64 * (G - 8); const int ld = (G < 8) ? 512 : 128;
            float g0[8], g1[8];
#pragma unroll
            for (int j = 0; j < 8; ++j) { g0[j] = gg[8 * fq + j]; g1[j] = gg[32 + 8 * fq + j]; }
#pragma unroll
            for (int ai = 0; ai < 2; ++ai)
#pragma unroll
                for (int m = 0; m < 4; ++m) { const int row = row0 + ai * HALF + m * 16;
                    const float ss = fqsum((dot4(acc[ai][0][m][0]) + dot4(acc[ai][0][m][1])) + (dot4(acc[ai][1][m][0]) + dot4(acc[ai][1][m][1])));
                    const float r = sc * __builtin_amdgcn_rsqf(ss * (1.0f / 64.0f) + kEps); bf16_t* p = dst + (unsigned)(row * ld + 8 * fq);
                    *(u32x4*)p = pack8g(acc[ai][0][m][0], acc[ai][0][m][1], g0, r); *(u32x4*)(p + 32) = pack8g(acc[ai][1][m][0], acc[ai][1][m][1], g1, r); }
        } else if (G < 22) {
            bf16_t* dst; int ld; float* sq;
            if (G < 12) { dst = VA + 64 * (G - 10); ld = 128; sq = nullptr; } else if (G < 18) { dst = CQ + 64 * (G - 12); ld = 384; sq = ssq_cq; } else { dst = CKV + 64 * (G - 18); ld = 256; sq = ssq_ckv; }
#pragma unroll
            for (int ai = 0; ai < 2; ++ai)
#pragma unroll
                for (int m = 0; m < 4; ++m) { const int row = row0 + ai * HALF + m * 16; bf16_t* p = dst + (unsigned)(row * ld + 8 * fq);
                    if (sq) { const float ss = fqsum((dot4(acc[ai][0][m][0]) + dot4(acc[ai][0][m][1])) + (dot4(acc[ai][1][m][0]) + dot4(acc[ai][1][m][1]))); if (fq == 0) atomicAdd(sq + row, ss); }
                    *(u32x4*)p = pack8s(acc[ai][0][m][0], acc[ai][0][m][1], 1.0f); *(u32x4*)(p + 32) = pack8s(acc[ai][1][m][0], acc[ai][1][m][1], 1.0f); }
        } else {
            float g0[8];
#pragma unroll
            for (int j = 0; j < 8; ++j) g0[j] = gkr[8 * fq + j];
#pragma unroll
            for (int ai = 0; ai < 2; ++ai)
#pragma unroll
                for (int m = 0; m < 4; ++m) { const int row = row0 + ai * HALF + m * 16; const int s = row % seq;
                    const float ss = fqsum(dot4(acc[ai][0][m][0]) + dot4(acc[ai][0][m][1])); const float r = __builtin_amdgcn_rsqf(ss * (1.0f / 32.0f) + kEps);
                    float o[8];
#pragma unroll
                    for (int j = 0; j < 8; ++j) { const float y = ((j < 4) ? acc[ai][0][m][0][j & 3] : acc[ai][0][m][1][j & 3]) * r * g0[j]; const float pp = __shfl_xor(y, 32);
                        const int i16 = 8 * (fq & 1) + j; const float c = cosT[s * 16 + i16], sn = sinT[s * 16 + i16]; o[j] = (fq < 2) ? (y * c - pp * sn) : (pp * sn + y * c); }
                    u32x4 w; w.x = cvt_pk_bf16(o[0], o[1]); w.y = cvt_pk_bf16(o[2], o[3]); w.z = cvt_pk_bf16(o[4], o[5]); w.w = cvt_pk_bf16(o[6], o[7]);
                    *(u32x4*)(KR + (unsigned)((((row >> 12) * 64 + ((row >> 6) & 63)) * 2048) + fq * 512 + (row & 63) * 8)) = w; }
        }
    }
};
struct EpiQB {
    static constexpr bool PERM = true, AFTER_DRAIN = false;
    unsigned char* ws; const float *gqn, *gqr;
    __device__ __forceinline__ void operator()(const f32x4 (&acc)[2][2][4][2], const Unit& u, int wr, int wc, int fr_, int fq_) const {
        (void)fr_; (void)fq_; const int ln_ = lane_id(); const int fr = ln_ & 15, fq = ln_ >> 4;
        const int row0 = u.pm * BM + wr * 64 + fr;
        bf16_t* const QB = (bf16_t*)(ws + WS_QB); const float* const ssq_cq = (const float*)(ws + WS_SSQCQ); const float* const cosT = (const float*)(ws + WS_TAB) + TAB_COS; const float* const sinT = (const float*)(ws + WS_TAB) + TAB_SIN;
        constexpr float qscale = QSC_B; constexpr int seq = SEQ;
        if (u.pn < 2) {
            const int head = 4 * u.pn + wc; float g0[8], g1[8];
#pragma unroll
            for (int j = 0; j < 8; ++j) { g0[j] = gqn[8 * fq + j]; g1[j] = gqn[32 + 8 * fq + j]; }
#pragma unroll
            for (int ai = 0; ai < 2; ++ai)
#pragma unroll
                for (int m = 0; m < 4; ++m) { const int row = row0 + ai * HALF + m * 16; const float eps2 = kEps * (ssq_cq[row] * (1.0f / 384.0f) + kEps);
                    const float ss = fqsum((dot4(acc[ai][0][m][0]) + dot4(acc[ai][0][m][1])) + (dot4(acc[ai][1][m][0]) + dot4(acc[ai][1][m][1])));
                    const float r = (64.0f * qscale) * __builtin_amdgcn_rsqf(ss * (1.0f / 64.0f) + eps2); unsigned char* p = ws + WS_QN8 + (unsigned)(row * 512 + 64 * head + 8 * fq);
                    *(u32x2_t*)p = pack8g_f8(acc[ai][0][m][0], acc[ai][0][m][1], g0, r); *(u32x2_t*)(p + 32) = pack8g_f8(acc[ai][1][m][0], acc[ai][1][m][1], g1, r); }
        } else {
            float g0[8];
#pragma unroll
            for (int j = 0; j < 8; ++j) g0[j] = gqr[8 * fq + j];
#pragma unroll
            for (int ai = 0; ai < 2; ++ai)
#pragma unroll
                for (int m = 0; m < 4; ++m) { const int row = row0 + ai * HALF + m * 16; const int s = row % seq; const float eps2 = kEps * (ssq_cq[row] * (1.0f / 384.0f) + kEps);
#pragma unroll
                    for (int bj = 0; bj < 2; ++bj) { const int head = 2 * wc + bj;
                        const float ss = fqsum(dot4(acc[ai][bj][m][0]) + dot4(acc[ai][bj][m][1])); const float r = __builtin_amdgcn_rsqf(ss * (1.0f / 32.0f) + eps2);
                        float o[8];
#pragma unroll
                        for (int j = 0; j < 8; ++j) { const float y = ((j < 4) ? acc[ai][bj][m][0][j & 3] : acc[ai][bj][m][1][j & 3]) * r * g0[j]; const float pp = __shfl_xor(y, 32);
                            const int i16 = 8 * (fq & 1) + j; const float c = cosT[s * 16 + i16], sn = sinT[s * 16 + i16]; o[j] = qscale * ((fq < 2) ? (y * c - pp * sn) : (pp * sn + y * c)); }
                        u32x4 w; w.x = cvt_pk_bf16(o[0], o[1]); w.y = cvt_pk_bf16(o[2], o[3]); w.z = cvt_pk_bf16(o[4], o[5]); w.w = cvt_pk_bf16(o[6], o[7]);
                        *(u32x4*)(QB + (unsigned)(row * 768 + 96 * head + 64 + 8 * fq)) = w; } }
        }
    }
};
struct EpiKVB {
    static constexpr bool PERM = true, AFTER_DRAIN = false;
    unsigned char* ws; const float* gkn;
    __device__ __forceinline__ void operator()(const f32x4 (&acc)[2][2][4][2], const Unit& u, int wr, int wc, int fr_, int fq_) const {
        (void)fr_; (void)fq_; const int ln_ = lane_id(); const int fr = ln_ & 15, fq = ln_ >> 4;
        const int row0 = u.pm * BM + wr * 64 + fr, G = 4 * u.pn + wc, head = G >> 1;
        bf16_t* const KBN = (bf16_t*)(ws + WS_KBN); bf16_t* const VB = (bf16_t*)(ws + WS_VB); const float* const ssq_ckv = (const float*)(ws + WS_SSQCKV);
        if (!(G & 1)) {
            float g0[8], g1[8];
#pragma unroll
            for (int j = 0; j < 8; ++j) { g0[j] = gkn[8 * fq + j]; g1[j] = gkn[32 + 8 * fq + j]; }
#pragma unroll
            for (int ai = 0; ai < 2; ++ai)
#pragma unroll
                for (int m = 0; m < 4; ++m) { const int row = row0 + ai * HALF + m * 16; const float eps2 = kEps * (ssq_ckv[row] * (1.0f / 256.0f) + kEps);
                    const float ss = fqsum((dot4(acc[ai][0][m][0]) + dot4(acc[ai][0][m][1])) + (dot4(acc[ai][1][m][0]) + dot4(acc[ai][1][m][1])));
                    const float r = 8.0f * __builtin_amdgcn_rsqf(ss * (1.0f / 64.0f) + eps2);
                    unsigned char* p = (unsigned char*)KBN + (unsigned)(((((row >> 12) * 8 + head) * 64 + ((row >> 6) & 63)) * 4096) + (fq >> 1) * 1024 + (row & 63) * 16 + (fq & 1) * 8);
                    *(u32x2_t*)p = pack8g_f8(acc[ai][0][m][0], acc[ai][0][m][1], g0, r); *(u32x2_t*)(p + 2048) = pack8g_f8(acc[ai][1][m][0], acc[ai][1][m][1], g1, r); }
        } else {
#pragma unroll
            for (int ai = 0; ai < 2; ++ai)
#pragma unroll
                for (int m = 0; m < 4; ++m) { const int row = row0 + ai * HALF + m * 16; const float al = __builtin_amdgcn_rsqf(ssq_ckv[row] * (1.0f / 256.0f) + kEps); bf16_t* p = VB + (unsigned)(((((row >> 12) * 8 + head) * 64 + ((row >> 6) & 63)) * 4096) + ((row >> 4) & 3) * 512 + (row & 15) * 32 + 8 * fq);
                    *(u32x4*)p = pack8s(acc[ai][0][m][0], acc[ai][0][m][1], al); *(u32x4*)(p + 4 * 512) = pack8s(acc[ai][1][m][0], acc[ai][1][m][1], al); }
        }
    }
};

__device__ __forceinline__ float clamp448(float v) { return __builtin_fminf(__builtin_fmaxf(v, -448.0f), 448.0f); }
__device__ __forceinline__ unsigned pk4_fp8(float a, float b, float c, float d) { int w = 0; w = __builtin_amdgcn_cvt_pk_fp8_f32(clamp448(a), clamp448(b), w, false); w = __builtin_amdgcn_cvt_pk_fp8_f32(clamp448(c), clamp448(d), w, true); return (unsigned)w; }
__device__ __forceinline__ unsigned pk4_fp8_nc(float a, float b, float c, float d) { int w = 0; w = __builtin_amdgcn_cvt_pk_fp8_f32(a, b, w, false); w = __builtin_amdgcn_cvt_pk_fp8_f32(c, d, w, true); return (unsigned)w; }
struct EpiSwiGLU8 {
    static constexpr bool PERM = true, AFTER_DRAIN = false;
    unsigned char* O; int ldc; float oscale;
    __device__ __forceinline__ void operator()(const f32x4 (&acc)[2][2][4][2], const Unit& u, int wr, int wc, int fr_, int fq_) const {
        (void)fr_; (void)fq_; const int ln_ = lane_id(); const int fr = ln_ & 15, fq = ln_ >> 4;
        const int row0 = u.pm * BM + wr * 64 + fr, col0 = u.pn * HALF + wc * 32 + 8 * fq;
#pragma unroll
        for (int ai = 0; ai < 2; ++ai)
#pragma unroll
            for (int m = 0; m < 4; ++m) { unsigned char* rowp = O + (unsigned)((row0 + ai * HALF + m * 16) * ldc + col0);
                const f32x4 g0 = acc[ai][0][m][0], g1 = acc[ai][0][m][1], u0 = acc[ai][1][m][0], u1 = acc[ai][1][m][1];
                typedef unsigned u32x2 __attribute__((ext_vector_type(2))); u32x2 w;
                w.x = pk4_fp8(oscale * silu_mul(g0[0], u0[0]), oscale * silu_mul(g0[1], u0[1]), oscale * silu_mul(g0[2], u0[2]), oscale * silu_mul(g0[3], u0[3]));
                w.y = pk4_fp8(oscale * silu_mul(g1[0], u1[0]), oscale * silu_mul(g1[1], u1[1]), oscale * silu_mul(g1[2], u1[2]), oscale * silu_mul(g1[3], u1[3]));
                *(u32x2*)rowp = w; }
    }
};

struct EpiRowScaleF8 {
    static constexpr bool PERM = true, AFTER_DRAIN = false;
    unsigned char* O; int ldc; const float* rowscale; float oscale;
    __device__ __forceinline__ void operator()(const f32x4 (&acc)[2][2][4][2], const Unit& u, int wr, int wc, int fr_, int fq_) const {
        (void)fr_; (void)fq_; const int ln_ = lane_id(); const int fr = ln_ & 15, fq = ln_ >> 4;
        const int row0 = u.pm * BM + wr * 64 + fr, col0 = u.pn * BM + wc * 32 + 8 * fq;
#pragma unroll
        for (int ai = 0; ai < 2; ++ai)
#pragma unroll
            for (int m = 0; m < 4; ++m) { const int row = row0 + ai * HALF + m * 16; const float sc = rowscale[row] * oscale; unsigned char* rowp = O + (unsigned)(row * ldc + col0);
#pragma unroll
                for (int bj = 0; bj < 2; ++bj) { const f32x4 v0 = acc[ai][bj][m][0] * sc, v1 = acc[ai][bj][m][1] * sc;
                    typedef unsigned u32x2 __attribute__((ext_vector_type(2))); u32x2 w; w.x = pk4_fp8(v0[0], v0[1], v0[2], v0[3]); w.y = pk4_fp8(v1[0], v1[1], v1[2], v1[3]);
                    *(u32x2*)(rowp + bj * HALF) = w; } }
    }
};

struct EpiNormBf16 {
    static constexpr bool PERM = true, AFTER_DRAIN = false;
    bf16_t* O; int ldc; const float* ssq;
    __device__ __forceinline__ void operator()(const f32x4 (&acc)[2][2][4][2], const Unit& u, int wr, int wc, int fr_, int fq_) const {
        (void)fr_; (void)fq_; const int ln_ = lane_id(); const int fr = ln_ & 15, fq = ln_ >> 4;
        const int row0 = u.pm * BM + wr * 64 + fr, col0 = u.pn * BM + wc * 32 + 8 * fq;
#pragma unroll
        for (int ai = 0; ai < 2; ++ai)
#pragma unroll
            for (int m = 0; m < 4; ++m) { const int row = row0 + ai * HALF + m * 16; const float rb = __builtin_amdgcn_rsqf(ssq[2 * row + 1] * (1.0f / 512.0f) + 1e-6f); bf16_t* rowp = O + (unsigned)(row * ldc + col0);
#pragma unroll
                for (int bj = 0; bj < 2; ++bj) *(u32x4*)(rowp + bj * HALF) = pack8s(acc[ai][bj][m][0], acc[ai][bj][m][1], rb); }
    }
};
__device__ __forceinline__ void glds_sv(const char* sbase, unsigned voff, unsigned lds_dst) { unsigned keep;
    asm volatile("s_mov_b32 %0, m0\n\ts_mov_b32 m0, %3\n\ts_nop 0\n\tglobal_load_lds_dwordx4 %1, %2\n\ts_mov_b32 m0, %0" : "=&s"(keep) : "v"(voff), "s"(sbase), "s"(lds_dst) : "memory"); }
template <class Epi, class Sched, bool ALIGN_EPI = false, bool SP2 = false, int MODE = 0, bool F8 = false>
__device__ __forceinline__ void gemm_phase(PG8_LAS unsigned char* lds, const Gemm g, const Sched& S, const Epi& E) {
    const int lane = lane_id(), wid = g.wave, tid = wid * 64 + lane,
              wr = wid >> 2, wc = wid & 3, fr = lane & 15, fq = lane >> 4;
    int K_ = g.K; asm volatile("" : "+s"(K_));
    const int K = K_, nt = K / BK;
    unsigned voffA[2], voffB[2];
#pragma unroll
    for (int i = 0; i < 2; ++i) { int R, C; if constexpr (F8) stage_rc8(tid * 16 + i * 8192, R, C); else stage_rc(tid * 16 + i * 8192, R, C); const int Rb = Epi::PERM ? ((R & ~31) + perm32(R & 31)) : R;
        voffA[i] = (unsigned)(R * K + C) * 2u; voffB[i] = (unsigned)(Rb * K + C) * 2u; }
    const size_t r64step = (size_t)64 * K * 2;
    const size_t kstep = (size_t)(BK * 2);
    const size_t hstep = (size_t)HALF * K * 2;
    const size_t tstep = 2 * hstep;
    const unsigned ldsw = (unsigned)wid * 1024u;
    const unsigned ldsbase = (unsigned)__builtin_amdgcn_readfirstlane((int)((unsigned)(uintptr_t)lds + ldsw));
    const int aoff = lds_byte(wr * 64 + fr, fq * 8), boff = lds_byte(wc * 32 + fr, fq * 8);
    const int aoff8 = lds_byte8(wr * 64 + fr, fq * 32), boff8 = lds_byte8(wc * 32 + fr, fq * 32);
#define PG8_X16(x) ({ int t_; asm volatile("v_xor_b32 %0, 16, %1" : "=v"(t_) : "v"(x)); t_; })
    typedef int v8i32 __attribute__((ext_vector_type(8))); typedef short bf16x16 __attribute__((ext_vector_type(16)));
#define PG8_SA(b, h) (((b) * 2 + (h)) * HTB)
#define PG8_SB(b, h) ((4 + (b) * 2 + (h)) * HTB)
#define PG8_STAGE(bufoff, gbase, voff) do { _Pragma("unroll") for (int _i = 0; _i < 2; ++_i) \
        glds_sv((const char*)(gbase) + (size_t)_i * r64step, (voff)[0], ldsbase + (unsigned)((bufoff) + _i * 8192)); } while (0)
#define PG8_LDA(dst, b, h) do { if constexpr (F8) { const int a1_ = PG8_X16(aoff8); _Pragma("unroll") for (int m = 0; m < 4; ++m) { dst[m][0] = *(const PG8_LAS bf16x8*)(lds + PG8_SA(b, h) + aoff8 + m * 2048); dst[m][1] = *(const PG8_LAS bf16x8*)(lds + PG8_SA(b, h) + a1_ + m * 2048); } } \
        else { _Pragma("unroll") for (int m = 0; m < 4; ++m) _Pragma("unroll") for (int k = 0; k < 2; ++k) dst[m][k] = *(const PG8_LAS bf16x8*)(lds + PG8_SA(b, h) + aoff + k * 1024 + m * 2048); } } while (0)
#define PG8_LDB(dst, b, h) do { if constexpr (F8) { const int b1_ = PG8_X16(boff8); _Pragma("unroll") for (int n = 0; n < 2; ++n) { dst[n][0] = *(const PG8_LAS bf16x8*)(lds + PG8_SB(b, h) + boff8 + n * 2048); dst[n][1] = *(const PG8_LAS bf16x8*)(lds + PG8_SB(b, h) + b1_ + n * 2048); } } \
        else { _Pragma("unroll") for (int n = 0; n < 2; ++n) _Pragma("unroll") for (int k = 0; k < 2; ++k) dst[n][k] = *(const PG8_LAS bf16x8*)(lds + PG8_SB(b, h) + boff + k * 1024 + n * 2048); } } while (0)
#define PG8_F8FRAG(x) __builtin_bit_cast(v8i32, (bf16x16){x[0][0], x[0][1], x[0][2], x[0][3], x[0][4], x[0][5], x[0][6], x[0][7], x[1][0], x[1][1], x[1][2], x[1][3], x[1][4], x[1][5], x[1][6], x[1][7]})
#define PG8_MMA(ai, bj, At, Bt) do { __builtin_amdgcn_s_setprio(1); _Pragma("unroll") for (int m = 0; m < 4; ++m) _Pragma("unroll") for (int n = 0; n < 2; ++n) { \
        if constexpr (F8) { acc[ai][bj][m][n] = __builtin_amdgcn_mfma_scale_f32_16x16x128_f8f6f4(PG8_F8FRAG(Bt[n]), PG8_F8FRAG(At[m]), acc[ai][bj][m][n], 0, 0, 0, g.sA, 0, g.sA); }     \
        else { _Pragma("unroll") for (int k = 0; k < 2; ++k) acc[ai][bj][m][n] = __builtin_amdgcn_mfma_f32_16x16x32_bf16(Bt[n][k], At[m][k], acc[ai][bj][m][n], 0, 0, 0); } } __builtin_amdgcn_s_setprio(0); } while (0)
#define PG8_WAIT_V(n) asm volatile("s_waitcnt vmcnt(" #n ")" ::: "memory")
#define PG8_WAIT_L(n) asm volatile("s_waitcnt lgkmcnt(" #n ")" ::: "memory")
#define PG8_BAR __builtin_amdgcn_s_barrier()
#define PG8_SCHED __builtin_amdgcn_sched_barrier(0)
    Unit cur, nxt; int ui = 0;
    if (!S.next(0, cur)) return;
    f32x4 acc[2][2][4][2];
#pragma unroll
    for (int a = 0; a < 2; ++a)
#pragma unroll
        for (int b = 0; b < 2; ++b)
#pragma unroll
            for (int m = 0; m < 4; ++m)
#pragma unroll
                for (int n = 0; n < 2; ++n) acc[a][b][m][n] = (f32x4){0.f, 0.f, 0.f, 0.f};
    bf16x8 At[4][2], B0[2][2], B1[2][2];
    const char* cA = (const char*)g.A + (MODE == 1 ? (size_t)0 : (size_t)cur.pm * tstep); const char* cB = (const char*)g.Bt + (size_t)cur.e * g.estride + (size_t)cur.pn * tstep;
    PG8_LAS unsigned* const gt = (PG8_LAS unsigned*)(lds + g.gtab);
#define PG8_GFILL(slot, u) do { const int t_ = wid * 64 + lane_id(); if (t_ < BM) gt[(slot) * BM + t_] = (unsigned)g.idx[(u).pm * BM + t_] * (unsigned)(K * 2); } while (0)
    if constexpr (MODE == 1) { PG8_GFILL(0, cur); __syncthreads(); }
    int gR0_, gC0_; if constexpr (F8) stage_rc8(tid * 16, gR0_, gC0_); else stage_rc(tid * 16, gR0_, gC0_); PG8_LAS unsigned* const gtl = gt + gR0_; const unsigned gcb = (unsigned)gC0_ * 2u;
#define PG8_STA(bufoff, gbase, H, NXT) do { if constexpr (MODE == 1) { const int slot_ = ((NXT) ? ui + 1 : ui) & 1; _Pragma("unroll") for (int _i = 0; _i < 2; ++_i) { \
        const unsigned vo_ = gtl[slot_ * BM + (H) * HALF + _i * 64] + gcb; glds_sv((const char*)(gbase), vo_, ldsbase + (unsigned)((bufoff) + _i * 8192)); } } \
        else { PG8_STAGE(bufoff, (gbase) + ((H) ? hstep : (size_t)0), voffA); } } while (0)
    S.a_ready(cur);
    if constexpr (SP2) {
        PG8_STAGE(PG8_SB(0, 0), cB, voffB); PG8_STAGE(PG8_SB(0, 1), cB + hstep, voffB); PG8_STA(PG8_SA(0, 0), cA, 0, false); PG8_STA(PG8_SA(0, 1), cA, 1, false);
        if (wr == 1) PG8_BAR;
        PG8_WAIT_V(2); PG8_BAR;
        PG8_STAGE(PG8_SB(1, 0), cB + kstep, voffB); PG8_STA(PG8_SA(1, 0), cA + kstep, 0, false); PG8_STAGE(PG8_SB(1, 1), cB + hstep + kstep, voffB);
        PG8_WAIT_V(6); PG8_BAR;
    } else {
        PG8_STAGE(PG8_SB(0, 0), cB, voffB); PG8_STAGE(PG8_SA(0, 0), cA, voffA); PG8_STAGE(PG8_SB(0, 1), cB + hstep, voffB); PG8_STAGE(PG8_SA(0, 1), cA + hstep, voffA);
        if (wr == 1) PG8_BAR;
        PG8_WAIT_V(4); PG8_BAR;
        PG8_STAGE(PG8_SB(1, 0), cB + kstep, voffB); PG8_STAGE(PG8_SA(1, 0), cA + kstep, voffA); PG8_STAGE(PG8_SB(1, 1), cB + hstep + kstep, voffB);
        PG8_WAIT_V(6); PG8_BAR;
    }
    for (;;) {
        const bool has_next = S.next(ui + 1, nxt);
        if constexpr (MODE == 1) { if (has_next) PG8_GFILL((ui + 1) & 1, nxt); else PG8_GFILL((ui + 1) & 1, cur); }
        const char* nA = (MODE == 1) ? cA : (has_next ? (const char*)g.A + (size_t)nxt.pm * tstep : cA); const char* nB = has_next ? (const char*)g.Bt + (size_t)nxt.e * g.estride + (size_t)nxt.pn * tstep : cB;
        for (int t = 0; t < nt; t += 2) {
            const bool last = (t == nt - 2);
            if constexpr (MODE == 2) { if (t == nt / 2) {
#pragma unroll
                for (int ai = 0; ai < 2; ++ai)
#pragma unroll
                    for (int m = 0; m < 4; ++m) { const int row = cur.pm * BM + ai * HALF + wr * 64 + m * 16 + fr; const float sa = g.ssq[2 * row], sb = g.ssq[2 * row + 1];
                        const float ratio = __builtin_amdgcn_rsqf(sa * (1.0f / 512.0f) + 1e-6f) * __builtin_amdgcn_sqrtf(sb * (1.0f / 512.0f) + 1e-6f);
#pragma unroll
                        for (int bj = 0; bj < 2; ++bj)
#pragma unroll
                            for (int n = 0; n < 2; ++n) acc[ai][bj][m][n] *= ratio; } } }
            const char* a1 = cA + (size_t)(t + 1) * kstep;
            const char* a2 = last ? nA : cA + (size_t)(t + 2) * kstep; const char* b2 = last ? nB : cB + (size_t)(t + 2) * kstep;
            const char* a3 = a2 + kstep; const char* b3 = b2 + kstep;
            if (last && has_next) S.a_ready(nxt);
            if constexpr (SP2) {
            PG8_LDB(B0, 0, 0); PG8_LDB(B1, 0, 1); PG8_SCHED; PG8_LDA(At, 0, 0); PG8_STA(PG8_SA(1, 1), a1, 1, false);
            PG8_WAIT_V(8); PG8_WAIT_L(0); PG8_BAR; PG8_MMA(0, 0, At, B0); PG8_MMA(0, 1, At, B1); PG8_BAR; PG8_SCHED;
            PG8_LDA(At, 0, 1); PG8_STAGE(PG8_SB(0, 0), b2, voffB); PG8_STAGE(PG8_SB(0, 1), b2 + hstep, voffB); PG8_STA(PG8_SA(0, 0), a2, 0, last);
            PG8_WAIT_V(8); PG8_WAIT_L(0); PG8_BAR; PG8_MMA(1, 0, At, B0); PG8_MMA(1, 1, At, B1); PG8_BAR; PG8_SCHED;
            PG8_LDB(B0, 1, 0); PG8_LDB(B1, 1, 1); PG8_SCHED; PG8_LDA(At, 1, 0); PG8_STA(PG8_SA(0, 1), a2, 1, last);
            PG8_WAIT_V(8); PG8_WAIT_L(0); PG8_BAR; PG8_MMA(0, 0, At, B0); PG8_MMA(0, 1, At, B1); PG8_BAR; PG8_SCHED;
            PG8_LDA(At, 1, 1); PG8_STAGE(PG8_SB(1, 0), b3, voffB); PG8_STAGE(PG8_SB(1, 1), b3 + hstep, voffB); PG8_STA(PG8_SA(1, 0), a3, 0, last);
            PG8_WAIT_V(8); PG8_WAIT_L(0); PG8_BAR; PG8_MMA(1, 0, At, B0); PG8_MMA(1, 1, At, B1); PG8_BAR; PG8_SCHED;
            } else {
            PG8_LDB(B0, 0, 0); PG8_SCHED; PG8_LDA(At, 0, 0); PG8_STAGE(PG8_SA(1, 1), a1 + hstep, voffA);
            PG8_WAIT_L(8); PG8_BAR; PG8_WAIT_L(0); PG8_MMA(0, 0, At, B0); PG8_BAR; PG8_SCHED;
            PG8_LDB(B1, 0, 1); PG8_STAGE(PG8_SB(0, 0), b2, voffB);
            PG8_BAR; PG8_WAIT_L(0); PG8_MMA(0, 1, At, B1); PG8_BAR;
            PG8_LDA(At, 0, 1); PG8_STAGE(PG8_SA(0, 0), a2, voffA);
            PG8_BAR; PG8_WAIT_L(0); PG8_MMA(1, 0, At, B0); PG8_BAR; PG8_SCHED;
            PG8_STAGE(PG8_SB(0, 1), b2 + hstep, voffB);
            PG8_WAIT_V(6); PG8_BAR; PG8_MMA(1, 1, At, B1); PG8_BAR;
            PG8_LDB(B0, 1, 0); PG8_SCHED; PG8_LDA(At, 1, 0); PG8_STAGE(PG8_SA(0, 1), a2 + hstep, voffA);
            PG8_WAIT_L(8); PG8_BAR; PG8_WAIT_L(0); PG8_MMA(0, 0, At, B0); PG8_BAR; PG8_SCHED;
            PG8_LDB(B1, 1, 1); PG8_STAGE(PG8_SB(1, 0), b3, voffB);
            PG8_BAR; PG8_WAIT_L(0); PG8_MMA(0, 1, At, B1); PG8_BAR;
            PG8_LDA(At, 1, 1); PG8_STAGE(PG8_SA(1, 0), a3, voffA);
            PG8_BAR; PG8_WAIT_L(0); PG8_MMA(1, 0, At, B0); PG8_BAR; PG8_SCHED;
            PG8_STAGE(PG8_SB(1, 1), b3 + hstep, voffB);
            PG8_WAIT_V(6); PG8_BAR; PG8_MMA(1, 1, At, B1); PG8_BAR;
            }
        }
        if constexpr (ALIGN_EPI) { if (wr == 0) PG8_BAR; }
        if constexpr (!Epi::AFTER_DRAIN) { E(acc, cur, wr, wc, fr, fq); S.done(cur); }
        if (!has_next) break;
#pragma unroll
        for (int a = 0; a < 2; ++a)
#pragma unroll
            for (int b = 0; b < 2; ++b)
#pragma unroll
                for (int m = 0; m < 4; ++m)
#pragma unroll
                    for (int n = 0; n < 2; ++n) acc[a][b][m][n] = (f32x4){0.f, 0.f, 0.f, 0.f};
        cur = nxt; cA = nA; cB = nB; ++ui;
        if constexpr (ALIGN_EPI) { if (wr == 1) PG8_BAR; }
    }
    PG8_WAIT_V(0);
    if constexpr (!ALIGN_EPI) { if (wr == 0) PG8_BAR; }
    PG8_BAR;
    if constexpr (Epi::AFTER_DRAIN) { E.fused(acc, cur, wr, wc, fr, fq, lds, wid, lane); S.done(cur); }
#undef PG8_SA
#undef PG8_SB
#undef PG8_STAGE
#undef PG8_LDA
#undef PG8_LDB
#undef PG8_MMA
#undef PG8_F8FRAG
#undef PG8_X16
#undef PG8_WAIT_V
#undef PG8_WAIT_L
#undef PG8_BAR
#undef PG8_SCHED
#undef PG8_STA
#undef PG8_GFILL
}
}
#define GAS __attribute__((address_space(1)))
#define LAS __attribute__((address_space(3)))
typedef unsigned short bf16;
typedef unsigned v4u __attribute__((ext_vector_type(4)));
typedef float f32x4 __attribute__((ext_vector_type(4)));
typedef short bf16x8 __attribute__((ext_vector_type(8)));
typedef GAS unsigned gu32;
typedef GAS unsigned long long gu64;
#define RLX_AGENT __ATOMIC_RELAXED, __HIP_MEMORY_SCOPE_AGENT
#define LDS_WAIT() asm volatile("s_waitcnt lgkmcnt(0)" ::: "memory")
#define VM_WAIT() asm volatile("s_waitcnt vmcnt(0)" ::: "memory")
__device__ __forceinline__ unsigned long long rt() { return __builtin_amdgcn_s_memrealtime(); }
__device__ __forceinline__ unsigned f2bf(float f) { unsigned u = __builtin_bit_cast(unsigned, f); return (u + 0x7fffu + ((u >> 16) & 1u)) >> 16; }
__device__ __forceinline__ unsigned pk2(float lo, float hi) { return f2bf(lo) | (f2bf(hi) << 16); }

#define XB_TMO      128
#define XB_XCNT(j)  (256  + 64 * (j))
#define XB_XSUB(j)  (1280 + 64 * (j))
#define XB_XGEN(j)  (2304 + 64 * (j))
#define XB_TOP      3328
#define XB_TOPGEN   3392
#define XCD_BAR_WORDS 3456
#define XB_SPIN_CAP (1u << 18)

__device__ __forceinline__ unsigned xb_ld(unsigned* p)              { return __hip_atomic_load(p, __ATOMIC_RELAXED, __HIP_MEMORY_SCOPE_AGENT); }
__device__ __forceinline__ unsigned xb_add(unsigned* p, unsigned v) { return __hip_atomic_fetch_add(p, v, __ATOMIC_RELAXED, __HIP_MEMORY_SCOPE_AGENT); }
__device__ __forceinline__ unsigned xb_xcc_id() { return (unsigned)__builtin_amdgcn_s_getreg((3 << 11) | 20) & 0xFu; }
#define XB_SPIN(cond, bar) do { unsigned _sp = 0; while (cond) { __builtin_amdgcn_s_sleep(1); \
    if ((++_sp & 255u) == 0u) { if (xb_ld(&(bar)[XB_TMO])) break; if (_sp > XB_SPIN_CAP) { atomicAdd(&(bar)[XB_TMO], 1u); break; } } } } while (0)

struct XcdBarrier {
    int wave;
    unsigned* bar; unsigned x;
    volatile LAS unsigned* st;
};

__device__ __forceinline__ XcdBarrier xcd_barrier_post(unsigned* bar, volatile LAS unsigned* st) {
    XcdBarrier b; b.wave = __builtin_amdgcn_readfirstlane((int)(threadIdx.x >> 6)); b.bar = bar; b.x = xb_xcc_id(); b.st = st;
    if (threadIdx.x == 0) (void)xb_add(&bar[XB_XCNT(b.x)], 1u);
    return b;
}
__device__ __forceinline__ void xcd_barrier_complete(unsigned* bar, unsigned x, unsigned& nloc, unsigned& nx) {
    const unsigned G = gridDim.x * gridDim.y * gridDim.z;
    unsigned sum, cnt, mine, sp = 0u;
    for (;;) {
        sum = 0u; cnt = 0u; mine = 0u;
#pragma unroll
        for (unsigned j = 0; j < 16; ++j) { const unsigned c = xb_ld(&bar[XB_XCNT(j)]); sum += c; cnt += (c > 0u) ? 1u : 0u; mine = (j == x) ? c : mine; }
        if (sum == G) break;
        __builtin_amdgcn_s_sleep(1);
        if ((++sp & 255u) == 0u) { if (xb_ld(&bar[XB_TMO])) break; if (sp > XB_SPIN_CAP) { atomicAdd(&bar[XB_TMO], 1u); break; } }
    }
    nloc = mine > 0u ? mine : 1u; nx = cnt > 0u ? cnt : 1u;
}

__device__ __forceinline__ void xcd_barrier(const XcdBarrier& b) {
    asm volatile("s_waitcnt vmcnt(0)" ::: "memory");
    __syncthreads();
    if (b.wave == 0 && lane_id() == 0) {
        unsigned* bar = b.bar;
        __builtin_amdgcn_s_waitcnt(0);
        unsigned nloc = b.st[0], nx = b.st[1];
        if (nloc == 0u) { xcd_barrier_complete(bar, b.x, nloc, nx); b.st[0] = nloc; b.st[1] = nx; }
        const unsigned old = xb_add(&bar[XB_XSUB(b.x)], 1u);
        const unsigned gen = old / nloc;
        if (old + 1u == (gen + 1u) * nloc) {
            __builtin_amdgcn_fence(__ATOMIC_RELEASE, "agent");
            asm volatile("s_waitcnt vmcnt(0)" ::: "memory");
            const unsigned og = xb_add(&bar[XB_TOP], 1u);
            const unsigned tg = og / nx;
            if (og + 1u == (tg + 1u) * nx) xb_add(&bar[XB_TOPGEN], 1u);
            else XB_SPIN(xb_ld(&bar[XB_TOPGEN]) == tg, bar);
            __builtin_amdgcn_fence(__ATOMIC_ACQUIRE, "agent");
            xb_add(&bar[XB_XGEN(b.x)], 1u);
            asm volatile("s_waitcnt vmcnt(0)" ::: "memory");
        } else {
            XB_SPIN(xb_ld(&bar[XB_XGEN(b.x)]) == gen, bar);
            __builtin_amdgcn_fence(__ATOMIC_ACQUIRE, "agent");
            asm volatile("s_waitcnt vmcnt(0)" ::: "memory");
        }
    }
    __syncthreads();
}

struct Frame {
    LAS unsigned char* lds;
    volatile LAS unsigned* MISC;
    gu32* ctl;
    int wave;
    int vcu, G;
    const float* in[23];
    float* out;
    unsigned char* ws;
};
#define WSP(T_, off) ((T_*)(F.ws + (off)))
__device__ __forceinline__ float wave_sum(float v) {
#pragma unroll
    for (int o = 1; o < 64; o <<= 1) v += __shfl_xor(v, o);
    return v;
}
__device__ __forceinline__ float grp_sum8(float v) { v += __shfl_xor(v, 1); v += __shfl_xor(v, 2); v += __shfl_xor(v, 4); return v; }
__device__ __forceinline__ float grp_sum4(float v) { v += __shfl_xor(v, 1); v += __shfl_xor(v, 2); return v; }
__device__ __forceinline__ void unpack8(const v4u w, float (&f)[8]) {
#pragma unroll
    for (int i = 0; i < 4; ++i) { f[2 * i] = __uint_as_float(w[i] << 16); f[2 * i + 1] = __uint_as_float(w[i] & 0xffff0000u); }
}
__device__ __forceinline__ v4u pack8(const float (&f)[8]) { v4u o; o.x = pk2(f[0], f[1]); o.y = pk2(f[2], f[3]); o.z = pk2(f[4], f[5]); o.w = pk2(f[6], f[7]); return o; }

__device__ __forceinline__ int t5_bucket(int rel) {
    const int base = rel > 0 ? 16 : 0; const int n = rel < 0 ? -rel : rel;
    const float nf = (float)(n > 1 ? n : 1);
    int large = 8 + (int)(logf(nf * 0.125f) / 2.772588722239781f * 8.0f + 1e-4f);
    large = large < 15 ? large : 15;
    return base + (n < 8 ? n : large);
}

template <class RowMap>
__device__ __forceinline__ void p0_transpose_item(const float* W, int K, int N, bf16* WT, const float* gain, LAS float* scr, int item, int lane, RowMap rowmap) {
    const int nblk = N / 32, kb = item / nblk, nb = item % nblk, k0 = 64 * kb, n0 = 32 * nb;
#pragma unroll 4
    for (int i = 0; i < 32; ++i) { const int kk = 2 * i + (lane >> 5); const float g = gain ? gain[k0 + kk] : 1.0f; scr[kk * 33 + (lane & 31)] = g * W[(size_t)(k0 + kk) * N + n0 + (lane & 31)]; }
    LDS_WAIT(); asm volatile("" ::: "memory");
    const int c = lane & 7;
#pragma unroll
    for (int j = 0; j < 4; ++j) { const int n = (lane >> 3) + 8 * j; const LAS float* s = scr + (8 * c) * 33 + n;
        v4u o; o.x = pk2(s[0 * 33], s[1 * 33]); o.y = pk2(s[2 * 33], s[3 * 33]); o.z = pk2(s[4 * 33], s[5 * 33]); o.w = pk2(s[6 * 33], s[7 * 33]);
        *(GAS v4u*)(WT + (size_t)rowmap(n0 + n) * K + k0 + 8 * c) = o; }
    LDS_WAIT(); asm volatile("" ::: "memory");
}
struct RowId { __device__ __forceinline__ int operator()(int n) const { return n; } };
struct RowG64 { __device__ __forceinline__ int operator()(int n) const { return (n & ~255) + 128 * ((n >> 5) & 1) + 32 * ((n >> 6) & 3) + (n & 31); } };
struct RowQB { __device__ __forceinline__ int operator()(int n) const { const int h = n / 96, dd = n % 96; return dd < 64 ? (h >> 2) * 256 + 128 * (dd >> 5) + 32 * (h & 3) + (dd & 31) : 512 + 128 * (h & 1) + 32 * (h >> 1) + (dd - 64); } };
struct RowGU { int up; __device__ __forceinline__ int operator()(int n) const { return (n >> 7) * 256 + up * 128 + (n & 127); } };

template <class RowMap>
__device__ __forceinline__ void p0_transpose_item_f8(const float* W, int K, int N, unsigned char* WT, float wscale, LAS float* scr, int item, int lane, RowMap rowmap) {
    const int nblk = N / 32, kb = item / nblk, nb = item % nblk, k0 = 64 * kb, n0 = 32 * nb;
#pragma unroll 4
    for (int i = 0; i < 32; ++i) { const int kk = 2 * i + (lane >> 5); scr[kk * 33 + (lane & 31)] = wscale * W[(size_t)(k0 + kk) * N + n0 + (lane & 31)]; }
    LDS_WAIT(); asm volatile("" ::: "memory");
    const int c = lane & 3;
#pragma unroll
    for (int j = 0; j < 2; ++j) { const int n = (lane >> 2) + 16 * j; const LAS float* s = scr + (16 * c) * 33 + n;
        v4u o; o.x = pg8::pk4_fp8(s[0 * 33], s[1 * 33], s[2 * 33], s[3 * 33]); o.y = pg8::pk4_fp8(s[4 * 33], s[5 * 33], s[6 * 33], s[7 * 33]);
        o.z = pg8::pk4_fp8(s[8 * 33], s[9 * 33], s[10 * 33], s[11 * 33]); o.w = pg8::pk4_fp8(s[12 * 33], s[13 * 33], s[14 * 33], s[15 * 33]);
        *(GAS v4u*)(WT + (size_t)rowmap(n0 + n) * K + k0 + 16 * c) = o; }
    LDS_WAIT(); asm volatile("" ::: "memory");
}
__device__ __forceinline__ void p0_prologue(Frame& F) {
    LAS float* scr = (LAS float*)(F.lds + RING_OFF + F.wave * 16384);
    const int gw = F.vcu * NWAVES + F.wave, NGW = F.G * NWAVES;
    constexpr int I_IN = (DM / 64) * (INW / 32), I_QB = (QL / 64) * (BH * QKD / 32), I_KVB = (KVL / 64) * (BH * 128 / 32), I_O = (DM / 64) * (DM / 32), I_E = (DM / 64) * (FF / 32);
    constexpr int NITEMS = I_IN + I_QB + I_KVB + I_O + NE * 3 * I_E;
    bf16* Win_t = WSP(bf16, WS_WIN); bf16* Wqb_t = WSP(bf16, WS_WQB); bf16* Wkvb_t = WSP(bf16, WS_WKVB); bf16* Wo_t = WSP(bf16, WS_WO); bf16* Wgu_t = WSP(bf16, WS_WGU); bf16* Wd_t = WSP(bf16, WS_WD);
    const int nitems = (F.G == 256) ? NITEMS - NE * 3 * I_E : NITEMS;
    for (int it = gw; it < nitems; it += NGW) {
        int r = it;
        if (r < I_IN) { p0_transpose_item(F.in[3], DM, INW, Win_t, F.in[2], scr, r, lane_id(), RowG64{}); continue; } r -= I_IN;
        if (r < I_QB) { p0_transpose_item(F.in[8], QL, BH * QKD, Wqb_t, F.in[7], scr, r, lane_id(), RowQB{}); continue; } r -= I_QB;
        if (r < I_KVB) { p0_transpose_item(F.in[10], KVL, BH * 128, Wkvb_t, F.in[9], scr, r, lane_id(), RowG64{}); continue; } r -= I_KVB;
        if (r < I_O) { const int kb = r / (DM / 32); const float* g = (kb < 8) ? F.in[15] : (F.in[16] - 512);
            p0_transpose_item(F.in[17], DM, DM, Wo_t, g, scr, r, lane_id(), RowId{}); continue; } r -= I_O;
        const int e = r / (3 * I_E), q = r % (3 * I_E), which = q / I_E, item = q % I_E;
        if (which == 0) p0_transpose_item_f8(F.in[20] + (size_t)e * DM * FF, DM, FF, (unsigned char*)Wgu_t + (size_t)e * 2 * FF * DM, 32.0f, scr, item, lane_id(), RowGU{0});
        else if (which == 1) p0_transpose_item_f8(F.in[21] + (size_t)e * DM * FF, DM, FF, (unsigned char*)Wgu_t + (size_t)e * 2 * FF * DM, 32.0f, scr, item, lane_id(), RowGU{1});
        else p0_transpose_item_f8(F.in[22] + (size_t)e * FF * DM, FF, DM, (unsigned char*)Wd_t + (size_t)e * DM * FF, 16.0f, scr, item, lane_id(), RowId{});
    }
    { const int nchunk = (NZ - INW) * DM / 8; for (int c = gw * 64 + lane_id(); c < nchunk; c += NGW * 64) { const int n = INW + c / (DM / 8), k8 = c % (DM / 8); *(GAS v4u*)(Win_t + (size_t)RowG64{}(n) * DM + (size_t)k8 * 8) = (v4u){0u, 0u, 0u, 0u}; } }
    bf16* XN = WSP(bf16, WS_XN);
    for (int m = gw; m < T; m += NGW) {
        const GAS f32x4* xr = (const GAS f32x4*)(F.in[0] + (size_t)m * DM) + lane_id();
        f32x4 v[4]; float s = 0.f;
#pragma unroll
        for (int j = 0; j < 4; ++j) { v[j] = xr[64 * j]; s += (v[j].x * v[j].x + v[j].y * v[j].y) + (v[j].z * v[j].z + v[j].w * v[j].w); }
        const float rs = 1.0f / sqrtf(wave_sum(s) * (1.f / DM) + EPS);
        GAS unsigned long long* o8 = (GAS unsigned long long*)(XN + (size_t)m * DM) + lane_id();
#pragma unroll
        for (int j = 0; j < 4; ++j) o8[64 * j] = (unsigned long long)pk2(v[j].x * rs, v[j].y * rs) | ((unsigned long long)pk2(v[j].z * rs, v[j].w * rs) << 32);
    }
    float* TAB = WSP(float, WS_TAB);
    if (blockIdx.x == 0) {
        const float* rel_bias = F.in[1];
        for (int i = (F.wave * 64 + lane_id()); i < 8 * NTAB; i += NWAVES * 64) { const int h = i / NTAB, rel = i % NTAB - 128; TAB[TAB_BIAS + i] = rel_bias[t5_bucket(rel) * A_HEADS + h] * LOG2E; }
        if (F.wave == 0) {
            const float ga = fabsf(F.in[4][lane_id()] * F.in[5][lane_id()]); float mb = 0.f; for (int i = lane_id(); i < 32 * 8; i += 64) mb = fmaxf(mb, rel_bias[i]);
            const float gb = fabsf(F.in[11][lane_id()] * F.in[13][lane_id()]); const float gqr = (lane_id() < 32) ? fabsf(F.in[12][lane_id()]) : 0.f, gkr = (lane_id() < 32) ? fabsf(F.in[14][lane_id()]) : 0.f;
            float mga = ga, mgb = gb, mqr = gqr, mkr = gkr;
#pragma unroll
            for (int o = 1; o < 64; o <<= 1) { mga = fmaxf(mga, __shfl_xor(mga, o)); mgb = fmaxf(mgb, __shfl_xor(mgb, o)); mqr = fmaxf(mqr, __shfl_xor(mqr, o)); mkr = fmaxf(mkr, __shfl_xor(mkr, o)); mb = fmaxf(mb, __shfl_xor(mb, o)); }
            if (lane_id() == 0) { TAB[TAB_CONST + 0] = (8.0f * mga + mb) * LOG2E + 1.0f; TAB[TAB_CONST + 1] = 0.10206207261596577f * (64.f * mgb + 32.f * mqr * mkr) * LOG2E + 1.0f; }
        }
    }
    for (int i = gw * 64 + lane_id(); i < SEQ * 16; i += NGW * 64) { const int s = i >> 4, k = i & 15; const float freq = powf(10000.0f, -(float)(2 * k) / 32.0f); const float ang = (float)s * freq;
        TAB[TAB_COS + i] = cosf(ang); TAB[TAB_SIN + i] = sinf(ang); }
}

__device__ __forceinline__ void p2_fixup(Frame& F) {
    const int gw = F.vcu * NWAVES + F.wave, NGW = F.G * NWAVES; const int lane = lane_id();
    const bf16* Z = WSP(bf16, WS_Z); bf16* QA = WSP(bf16, WS_QA); bf16* KA = WSP(bf16, WS_KA); bf16* VA = WSP(bf16, WS_VA); bf16* CQ = WSP(bf16, WS_CQ); bf16* CKV = WSP(bf16, WS_CKV); bf16* KR = WSP(bf16, WS_KR);
    const float* TAB = WSP(float, WS_TAB);
    const float* gq = F.in[4]; const float* gk = F.in[5]; const float* gkr = F.in[14];
    float gqv[8], gkv[8], gkrv[8];
#pragma unroll
    for (int j = 0; j < 8; ++j) { gqv[j] = gq[(8 * lane) % 64 + j]; gkv[j] = gk[(8 * lane) % 64 + j]; gkrv[j] = gkr[(8 * lane) % 32 + j]; }
    for (int m = gw; m < T; m += NGW) {
        const bf16* zr = Z + (size_t)m * NZ; const int s = m % SEQ; float f[8], o[8];
        { unpack8(*(const GAS v4u*)(zr + 8 * lane), f); float ss = 0.f;
#pragma unroll
          for (int j = 0; j < 8; ++j) ss += f[j] * f[j];
          const float r = QSC_A / sqrtf(grp_sum8(ss) * (1.f / 64.f) + EPS);
#pragma unroll
          for (int j = 0; j < 8; ++j) o[j] = f[j] * r * gqv[j];
          *(GAS v4u*)(QA + (size_t)m * 512 + 8 * lane) = pack8(o); }
        { const int l2 = lane & 31; const v4u w = *(const GAS v4u*)(zr + 512 + 8 * l2); unpack8(w, f); float ss = 0.f;
#pragma unroll
          for (int j = 0; j < 8; ++j) ss += f[j] * f[j];
          const float r = 1.0f / sqrtf(grp_sum8(ss) * (1.f / 64.f) + EPS);
#pragma unroll
          for (int j = 0; j < 8; ++j) o[j] = f[j] * r * gkv[j];
          if (lane < 16) *(GAS v4u*)(KA + (size_t)m * 128 + 8 * lane) = pack8(o);
          else if (lane < 32) *(GAS v4u*)(VA + (size_t)m * 128 + 8 * (lane - 16)) = w; }
        { const int l2 = lane < 48 ? lane : 0; unpack8(*(const GAS v4u*)(zr + 768 + 8 * l2), f); float ss = 0.f;
#pragma unroll
          for (int j = 0; j < 8; ++j) ss += f[j] * f[j];
          if (lane >= 48) ss = 0.f;
          const float r = 1.0f / sqrtf(wave_sum(ss) * (1.f / 384.f) + EPS);
#pragma unroll
          for (int j = 0; j < 8; ++j) o[j] = f[j] * r;
          if (lane < 48) *(GAS v4u*)(CQ + (size_t)m * QL + 8 * lane) = pack8(o); }
        { const int l2 = lane & 31; unpack8(*(const GAS v4u*)(zr + 1152 + 8 * l2), f); float ss = 0.f;
#pragma unroll
          for (int j = 0; j < 8; ++j) ss += f[j] * f[j];
          if (lane >= 32) ss = 0.f;
          const float r = 1.0f / sqrtf(wave_sum(ss) * (1.f / 256.f) + EPS);
#pragma unroll
          for (int j = 0; j < 8; ++j) o[j] = f[j] * r;
          if (lane < 32) *(GAS v4u*)(CKV + (size_t)m * KVL + 8 * lane) = pack8(o); }
        { const int l2 = lane & 3; unpack8(*(const GAS v4u*)(zr + 1408 + 8 * l2), f); float ss = 0.f;
#pragma unroll
          for (int j = 0; j < 8; ++j) ss += f[j] * f[j];
          const float r = 1.0f / sqrtf(grp_sum4(ss) * (1.f / 32.f) + EPS);
#pragma unroll
          for (int j = 0; j < 8; ++j) { const float y = f[j] * r * gkrv[j]; const float p = __shfl_xor(y, 2); const int i = (8 * l2 + j) & 15;
              const float c = TAB[TAB_COS + s * 16 + i], sn = TAB[TAB_SIN + s * 16 + i];
              o[j] = (l2 < 2) ? (y * c - p * sn) : (p * sn + y * c); }
          if (lane < 4) *(GAS v4u*)(KR + (size_t)m * ROPE + 8 * lane) = pack8(o); }
    }
}

__device__ __forceinline__ void p4_fixup(Frame& F) {
    const int gw = F.vcu * NWAVES + F.wave, NGW = F.G * NWAVES; const int lane = lane_id();
    bf16* QB = WSP(bf16, WS_QB); const bf16* KVR = WSP(bf16, WS_KVRAW); bf16* KBN = WSP(bf16, WS_KBN); bf16* VB = WSP(bf16, WS_VB);
    const float* TAB = WSP(float, WS_TAB);
    float gqn[8], gkn[8], gqr[8];
#pragma unroll
    for (int j = 0; j < 8; ++j) { gqn[j] = F.in[11][8 * (lane & 7) + j]; gkn[j] = F.in[13][8 * (lane & 7) + j]; gqr[j] = F.in[12][8 * (lane & 3) + j]; }
    for (int m = gw; m < T; m += NGW) {
        const int s = m % SEQ; float f[8], o[8];
        bf16* qrow = QB + (size_t)m * (BH * QKD);
        { bf16* p = qrow + QKD * (lane >> 3) + 8 * (lane & 7); unpack8(*(const GAS v4u*)p, f); float ss = 0.f;
#pragma unroll
          for (int j = 0; j < 8; ++j) ss += f[j] * f[j];
          const float r = QSC_B / sqrtf(grp_sum8(ss) * (1.f / 64.f) + EPS);
#pragma unroll
          for (int j = 0; j < 8; ++j) o[j] = f[j] * r * gqn[j];
          *(GAS v4u*)p = pack8(o); }
        { const int l2 = lane & 31; bf16* p = qrow + QKD * (l2 >> 2) + NOPE + 8 * (l2 & 3); unpack8(*(const GAS v4u*)p, f); float ss = 0.f;
#pragma unroll
          for (int j = 0; j < 8; ++j) ss += f[j] * f[j];
          const float r = 1.0f / sqrtf(grp_sum4(ss) * (1.f / 32.f) + EPS);
#pragma unroll
          for (int j = 0; j < 8; ++j) { const float y = f[j] * r * gqr[j]; const float pp = __shfl_xor(y, 2); const int i = (8 * (l2 & 3) + j) & 15;
              const float c = TAB[TAB_COS + s * 16 + i], sn = TAB[TAB_SIN + s * 16 + i];
              o[j] = QSC_B * (((l2 & 3) < 2) ? (y * c - pp * sn) : (pp * sn + y * c)); }
          if (lane < 32) *(GAS v4u*)p = pack8(o); }
        { const bf16* p = KVR + (size_t)m * 1024 + 128 * (lane >> 3) + 8 * (lane & 7); unpack8(*(const GAS v4u*)p, f); float ss = 0.f;
#pragma unroll
          for (int j = 0; j < 8; ++j) ss += f[j] * f[j];
          const float r = 1.0f / sqrtf(grp_sum8(ss) * (1.f / 64.f) + EPS);
#pragma unroll
          for (int j = 0; j < 8; ++j) o[j] = f[j] * r * gkn[j];
          *(GAS v4u*)(KBN + (size_t)m * 512 + 64 * (lane >> 3) + 8 * (lane & 7)) = pack8(o);
          *(GAS v4u*)(VB + (size_t)m * 512 + 64 * (lane >> 3) + 8 * (lane & 7)) = *(const GAS v4u*)(p + 64); }
    }
}

__device__ __forceinline__ void p6_onorm(Frame& F) {
    const int gw = F.vcu * NWAVES + F.wave, NGW = F.G * NWAVES; const int lane = lane_id();
    bf16* O = WSP(bf16, WS_O);
    for (int m = gw; m < T; m += NGW) {
#pragma unroll
        for (int hf = 0; hf < 2; ++hf) { bf16* p = O + (size_t)m * DM + 512 * hf + 8 * lane; float f[8], o[8]; unpack8(*(const GAS v4u*)p, f); float ss = 0.f;
#pragma unroll
            for (int j = 0; j < 8; ++j) ss += f[j] * f[j];
            const float r = 1.0f / sqrtf(wave_sum(ss) * (1.f / 512.f) + EPS);
#pragma unroll
            for (int j = 0; j < 8; ++j) o[j] = f[j] * r;
            *(GAS v4u*)p = pack8(o); }
    }
}

__device__ __forceinline__ float red16(float (&v)[16], int lane) {
    const bool b5 = lane & 32, b4 = lane & 16, b3 = lane & 8, b2 = lane & 4; float w8[8], w4[4], w2[2];
#pragma unroll
    for (int i = 0; i < 8; ++i) { const float mine = b5 ? v[8 + i] : v[i], oth = b5 ? v[i] : v[8 + i]; w8[i] = mine + __shfl_xor(oth, 32); }
#pragma unroll
    for (int i = 0; i < 4; ++i) { const float mine = b4 ? w8[4 + i] : w8[i], oth = b4 ? w8[i] : w8[4 + i]; w4[i] = mine + __shfl_xor(oth, 16); }
#pragma unroll
    for (int i = 0; i < 2; ++i) { const float mine = b3 ? w4[2 + i] : w4[i], oth = b3 ? w4[i] : w4[2 + i]; w2[i] = mine + __shfl_xor(oth, 8); }
    const float mine = b2 ? w2[1] : w2[0], oth = b2 ? w2[0] : w2[1]; float y = mine + __shfl_xor(oth, 4);
    y += __shfl_xor(y, 1); y += __shfl_xor(y, 2); return y;
}
__device__ __forceinline__ void p8_router(Frame& F) {
    const int gw = F.vcu * NWAVES + F.wave, NGW = F.G * NWAVES; const int lane = lane_id();
    unsigned char* H2 = WSP(unsigned char, WS_H2); float* AFF = WSP(float, WS_AFF); const bf16* ATT = WSP(bf16, WS_ATT); bf16* X1B = WSP(bf16, WS_X1B);
    const float* g2 = F.in[18]; const float* wr = F.in[19];
    LAS float* wl = (LAS float*)(F.lds + RING_OFF);
    __syncthreads();
    for (int i = (F.wave * 64 + lane_id()); i < DM * NE; i += NWAVES * 64) wl[(i & 15) * DM + (i >> 4)] = wr[i];
    for (int i = (F.wave * 64 + lane_id()); i < DM; i += NWAVES * 64) wl[NE * DM + i] = g2[i];
    __syncthreads();
    const LAS float* wlane = wl + 4 * lane;
    f32x4 xn[4], xn2[4]; unsigned long long an[4], an2[4];
#pragma unroll
    for (int k = 0; k < 4; ++k) { xn[k] = *(const GAS f32x4*)(F.in[0] + (size_t)gw * DM + 4 * lane + 256 * k); an[k] = *(const GAS unsigned long long*)(ATT + (size_t)gw * DM + 4 * lane + 256 * k); }
    { const int m1 = (gw + NGW < T) ? gw + NGW : gw;
#pragma unroll
      for (int k = 0; k < 4; ++k) { xn2[k] = *(const GAS f32x4*)(F.in[0] + (size_t)m1 * DM + 4 * lane + 256 * k); an2[k] = *(const GAS unsigned long long*)(ATT + (size_t)m1 * DM + 4 * lane + 256 * k); } }
    for (int m = gw; m < T; m += NGW) {
        f32x4 x[4]; unsigned long long ac[4]; float ss = 0.f;
#pragma unroll
        for (int k = 0; k < 4; ++k) { x[k] = xn[k]; ac[k] = an[k]; xn[k] = xn2[k]; an[k] = an2[k]; }
        { const int mn = (m + 2 * NGW < T) ? m + 2 * NGW : m;
#pragma unroll
          for (int k = 0; k < 4; ++k) { xn2[k] = *(const GAS f32x4*)(F.in[0] + (size_t)mn * DM + 4 * lane + 256 * k); an2[k] = *(const GAS unsigned long long*)(ATT + (size_t)mn * DM + 4 * lane + 256 * k); } }
        asm volatile("" ::: "memory");
#pragma unroll
        for (int k = 0; k < 4; ++k) { const unsigned long long aw = ac[k];
            const unsigned alo = (unsigned)aw, ahi = (unsigned)(aw >> 32); x[k].x += __uint_as_float(alo << 16); x[k].y += __uint_as_float(alo & 0xffff0000u); x[k].z += __uint_as_float(ahi << 16); x[k].w += __uint_as_float(ahi & 0xffff0000u);
            ss += (x[k].x * x[k].x + x[k].y * x[k].y) + (x[k].z * x[k].z + x[k].w * x[k].w); }
        const float rs = __builtin_amdgcn_rsqf(wave_sum(ss) * (1.f / DM) + EPS);
#pragma unroll
        for (int k = 0; k < 4; ++k) { const f32x4 g = *(const LAS f32x4*)(wlane + NE * DM + 256 * k);
            *(GAS unsigned long long*)(X1B + (size_t)m * DM + 4 * lane + 256 * k) = (unsigned long long)pk2(x[k].x, x[k].y) | ((unsigned long long)pk2(x[k].z, x[k].w) << 32);
            x[k].x *= rs * g.x; x[k].y *= rs * g.y; x[k].z *= rs * g.z; x[k].w *= rs * g.w;
            *(GAS unsigned*)(H2 + (size_t)m * DM + 4 * lane + 256 * k) = pg8::pk4_fp8(32.0f * x[k].x, 32.0f * x[k].y, 32.0f * x[k].z, 32.0f * x[k].w); }
        float lg[16];
#pragma unroll
        for (int e = 0; e < 16; ++e) { float a0 = 0.f;
#pragma unroll
            for (int k = 0; k < 4; ++k) { const f32x4 w = *(const LAS f32x4*)(wlane + e * DM + 256 * k); a0 += (x[k].x * w.x + x[k].y * w.y) + (x[k].z * w.z + x[k].w * w.w); }
            lg[e] = a0; if ((e & 3) == 3) asm volatile("" ::: "memory"); }
        const float y = red16(lg, lane); float mx = y;
#pragma unroll
        for (int o = 4; o < 64; o <<= 1) mx = fmaxf(mx, __shfl_xor(mx, o));
        const float ex = __builtin_amdgcn_exp2f((y - mx) * LOG2E); float den = ex;
#pragma unroll
        for (int o = 4; o < 64; o <<= 1) den += __shfl_xor(den, o);
        if ((lane & 3) == 0) AFF[((size_t)(m / SEQ) * NE + ((lane >> 2) & 15)) * SEQ + (m % SEQ)] = ex / den;
    }
    __syncthreads();
}

__device__ __forceinline__ int block_excl_scan(int v, LAS int* tmp, int tid, int lane, int wave, int& total) {
    int inc = v;
#pragma unroll
    for (int o = 1; o < 64; o <<= 1) { const int t = __shfl_up(inc, o); if (lane >= o) inc += t; }
    if (lane == 63) tmp[wave] = inc;
    __syncthreads();
    int base = 0, tot = 0;
#pragma unroll
    for (int w = 0; w < NWAVES; ++w) { const int t = tmp[w]; if (w < wave) base += t; tot += t; }
    __syncthreads();
    total = tot; return base + inc - v;
}
__device__ __forceinline__ void p9_topk(Frame& F) {
    LAS unsigned* keys = (LAS unsigned*)(F.lds + RING_OFF);
    LAS unsigned* hist = keys + SEQ;
    LAS int* tmp = (LAS int*)(hist + 256);
    LAS unsigned* res = (LAS unsigned*)(tmp + 16);
    const int lane = lane_id(), wave = F.wave, tid = wave * 64 + lane;
    const float* AFF = WSP(float, WS_AFF); int* IDX = WSP(int, WS_IDX); float* GATEV = WSP(float, WS_GATEV); int* SLOT = WSP(int, WS_SLOT);
    for (int item = blockIdx.x; item < BATCH * NE; item += F.G) {
        const int b = item / NE, e = item % NE; const float* a = AFF + (size_t)item * SEQ;
        __syncthreads();
#pragma unroll
        for (int i = 0; i < 8; ++i) keys[tid + 512 * i] = __float_as_uint(a[tid + 512 * i]);
        __syncthreads();
        unsigned kk[8];
#pragma unroll
        for (int i = 0; i < 8; ++i) kk[i] = keys[8 * tid + i];
        LAS int* cnt2 = tmp;
#define P9_COUNT(v, step, out) do { int c_ = 0; _Pragma("unroll") for (int i = 0; i < 8; ++i) c_ += (int)__popcll(__ballot(kk[i] >= (v))); \
            if (lane == 0) cnt2[((step) & 1) * 8 + wave] = c_; __syncthreads(); int s_ = 0; _Pragma("unroll") for (int w = 0; w < NWAVES; ++w) s_ += cnt2[((step) & 1) * 8 + w]; out = s_; } while (0)
        unsigned prefix = 0u; int step = 0;
        for (int bit = 29; bit >= 0; --bit) { const unsigned cand = prefix | (1u << bit); int c; P9_COUNT(cand, step, c); ++step; if (c >= CAP) prefix = cand; }
        int cgt; P9_COUNT(prefix + 1u, step, cgt); ++step;
        int remaining = CAP - cgt;
        __syncthreads();
#undef P9_COUNT
        int neq = 0;
#pragma unroll
        for (int i = 0; i < 8; ++i) neq += (kk[i] == prefix) ? 1 : 0;
        int toteq; int eqbase = block_excl_scan(neq, tmp, tid, lane, wave, toteq);
        int sel[8]; int nsel = 0;
#pragma unroll
        for (int i = 0; i < 8; ++i) { const bool eq = kk[i] == prefix; sel[i] = (kk[i] > prefix || (eq && eqbase < remaining)) ? 1 : 0; eqbase += eq ? 1 : 0; nsel += sel[i]; }
        int totsel; int slot = block_excl_scan(nsel, tmp, tid, lane, wave, totsel);
        const size_t rbase = (size_t)(e * BATCH + b) * CAP;
#pragma unroll
        for (int i = 0; i < 8; ++i) { const int s = 8 * tid + i;
            if (sel[i]) { if (slot < CAP) { IDX[rbase + slot] = b * SEQ + s; GATEV[rbase + slot] = __uint_as_float(kk[i]); } SLOT[(size_t)item * SEQ + s] = slot < CAP ? slot : -1; ++slot; }
            else SLOT[(size_t)item * SEQ + s] = -1; }
    }
}

__device__ __forceinline__ void p9b_gather(Frame& F) {
    const int gw = F.vcu * NWAVES + F.wave, NGW = F.G * NWAVES; const int lane = lane_id();
    const unsigned char* H2 = WSP(unsigned char, WS_H2); unsigned char* XE = WSP(unsigned char, WS_XE); const int* IDX = WSP(int, WS_IDX);
    for (int r = gw * 2; r < MX; r += NGW * 2) { const int tok0 = IDX[r], tok1 = IDX[r + 1];
        const v4u a = *((const GAS v4u*)(H2 + (size_t)tok0 * DM) + lane), b = *((const GAS v4u*)(H2 + (size_t)tok1 * DM) + lane);
        *((GAS v4u*)(XE + (size_t)r * DM) + lane) = a; *((GAS v4u*)(XE + (size_t)(r + 1) * DM) + lane) = b; }
}

__device__ __forceinline__ void p12_combine(Frame& F) {
    const int gw = F.vcu * NWAVES + F.wave, NGW = F.G * NWAVES; const int lane = lane_id();
    const unsigned char* YE = WSP(unsigned char, WS_YE); const int* SLOT = WSP(int, WS_SLOT); const bf16* X1B = WSP(bf16, WS_X1B);
    typedef float f32x2v __attribute__((ext_vector_type(2)));
    for (int m = gw; m < T; m += NGW) {
        const int b = m / SEQ, s = m % SEQ;
        const int sl = (lane < NE) ? SLOT[((size_t)b * NE + lane) * SEQ + s] : -1;
        unsigned long long mask = __ballot(sl >= 0);
        GAS f32x4* xr = (GAS f32x4*)(F.out + (size_t)m * DM) + lane; const GAS unsigned long long* x1 = (const GAS unsigned long long*)(X1B + (size_t)m * DM) + lane;
        f32x4 v[4];
#pragma unroll
        for (int j = 0; j < 4; ++j) { const unsigned long long aw = x1[64 * j]; const unsigned alo = (unsigned)aw, ahi = (unsigned)(aw >> 32);
            v[j].x = __uint_as_float(alo << 16); v[j].y = __uint_as_float(alo & 0xffff0000u); v[j].z = __uint_as_float(ahi << 16); v[j].w = __uint_as_float(ahi & 0xffff0000u); }
        f32x4 a[4];
#pragma unroll
        for (int j = 0; j < 4; ++j) a[j] = (f32x4){0.f, 0.f, 0.f, 0.f};
        while (mask) { const int e = __builtin_ctzll(mask); mask &= mask - 1; const int slot = __shfl(sl, e);
            const GAS unsigned* yr = (const GAS unsigned*)(YE + ((size_t)(e * BATCH + b) * CAP + slot) * DM) + lane;
#pragma unroll
            for (int j = 0; j < 4; ++j) { const int w = (int)yr[64 * j]; const f32x2v lo = __builtin_amdgcn_cvt_pk_f32_fp8(w, false), hi = __builtin_amdgcn_cvt_pk_f32_fp8(w, true);
                a[j].x += lo.x; a[j].y += lo.y; a[j].z += hi.x; a[j].w += hi.y; } }
#pragma unroll
        for (int j = 0; j < 4; ++j) xr[64 * j] = v[j] + a[j] * (1.0f / 64.0f);
    }
}


#ifndef MLA_UNIT
#define MLA_UNIT mla_unit2
#endif
namespace att {
using bf16x8 = __attribute__((ext_vector_type(8))) short;
using s16x4 = __attribute__((ext_vector_type(4))) short;
using f32x16 = __attribute__((ext_vector_type(16))) float;
using u32x4 = __attribute__((ext_vector_type(4))) unsigned;
constexpr int KSLOT = 12288, VSLOT = 8192, NSLOT = 3;
constexpr int LK = 0, LV = NSLOT * KSLOT, LWS = LV + NSLOT * VSLOT, LTAB = LWS + NWAVES * 256, ATT_LDS = LTAB + 4 * 512 * 4;
constexpr int CV_F32 = ATT_LDS, CV_F8 = CV_F32 + NWAVES * 2048, CV_END = CV_F8 + NWAVES * 2176;
static_assert(CV_END <= RING_BYTES, "attention LDS");
struct ConvJob { int item0; };
__device__ __forceinline__ int crow(int r, int hi) { return (r & 3) + 8 * (r >> 2) + 4 * hi; }
__device__ __forceinline__ void glds16(const void* gsrc, unsigned lds_dst) { unsigned keep;
    asm volatile("s_mov_b32 %0, m0\n\ts_mov_b32 m0, %2\n\ts_nop 0\n\tglobal_load_lds_dwordx4 %1, off\n\ts_mov_b32 m0, %0" : "=&s"(keep) : "v"(gsrc), "s"(lds_dst) : "memory"); }
__device__ __forceinline__ void glds16s(const void* sbase, unsigned voff, unsigned lds_dst) { unsigned keep;
    asm volatile("s_mov_b32 %0, m0\n\ts_mov_b32 m0, %3\n\ts_nop 0\n\tglobal_load_lds_dwordx4 %1, %2\n\ts_mov_b32 m0, %0" : "=&s"(keep) : "v"(voff), "s"(sbase), "s"(lds_dst) : "memory"); }
__device__ __forceinline__ void glds16s_nt(const void* sbase, unsigned voff, unsigned lds_dst) { unsigned keep;
    asm volatile("s_mov_b32 %0, m0\n\ts_mov_b32 m0, %3\n\ts_nop 0\n\tglobal_load_lds_dwordx4 %1, %2 nt\n\ts_mov_b32 m0, %0" : "=&s"(keep) : "v"(voff), "s"(sbase), "s"(lds_dst) : "memory"); }
__device__ __forceinline__ const bf16* sptr(const bf16* p) { const unsigned long long a = (unsigned long long)p; const unsigned lo = (unsigned)__builtin_amdgcn_readfirstlane((int)(unsigned)a), hi = (unsigned)__builtin_amdgcn_readfirstlane((int)(unsigned)(a >> 32)); return (const bf16*)(((unsigned long long)hi << 32) | lo); }
__device__ __forceinline__ unsigned rfl(unsigned v) { return (unsigned)__builtin_amdgcn_readfirstlane((int)v); }
typedef float f32x2_t __attribute__((ext_vector_type(2))); typedef __bf16 bf16x2_t __attribute__((ext_vector_type(2)));
__device__ __forceinline__ unsigned cvtpk(float lo, float hi) { f32x2_t v = {lo, hi}; bf16x2_t b = __builtin_convertvector(v, bf16x2_t); return __builtin_bit_cast(unsigned, b); }
#define ATT_SBAR() __builtin_amdgcn_sched_barrier(0)
__device__ __forceinline__ void pv(f32x16* o, int vb, bf16x8 pa0, bf16x8 pa1, bf16x8 pa2, bf16x8 pa3) {
#pragma unroll
    for (int d0 = 0; d0 < 2; ++d0) { s16x4 lo[4], hi[4];
#pragma unroll
        for (int ks = 0; ks < 4; ++ks) {
            asm volatile("ds_read_b64_tr_b16 %0,%1 offset:%c2" : "=&v"(lo[ks]) : "v"(vb), "i"(d0 * 4096 + ks * 1024) : "memory");
            asm volatile("ds_read_b64_tr_b16 %0,%1 offset:%c2" : "=&v"(hi[ks]) : "v"(vb), "i"(d0 * 4096 + ks * 1024 + 512) : "memory"); }
        asm volatile("s_waitcnt lgkmcnt(0)" ::: "memory"); ATT_SBAR();
#define ATT_PK(k) (bf16x8){lo[k][0], lo[k][1], lo[k][2], lo[k][3], hi[k][0], hi[k][1], hi[k][2], hi[k][3]}
        o[d0] = __builtin_amdgcn_mfma_f32_32x32x16_bf16(pa0, ATT_PK(0), o[d0], 0, 0, 0);
        o[d0] = __builtin_amdgcn_mfma_f32_32x32x16_bf16(pa1, ATT_PK(1), o[d0], 0, 0, 0);
        o[d0] = __builtin_amdgcn_mfma_f32_32x32x16_bf16(pa2, ATT_PK(2), o[d0], 0, 0, 0);
        o[d0] = __builtin_amdgcn_mfma_f32_32x32x16_bf16(pa3, ATT_PK(3), o[d0], 0, 0, 0);
#undef ATT_PK
    }
}
__device__ __forceinline__ void ssq_accum(const float (&part)[16], int le, float* ssq) {
    const bool b4 = le & 16, b3 = le & 8, b2 = le & 4, b1 = le & 2; float p8[8], p4[4], p2[2];
#pragma unroll
    for (int i = 0; i < 8; ++i) { const float mine = b4 ? part[8 + i] : part[i], oth = b4 ? part[i] : part[8 + i]; p8[i] = mine + __shfl_xor(oth, 16); }
#pragma unroll
    for (int i = 0; i < 4; ++i) { const float mine = b3 ? p8[4 + i] : p8[i], oth = b3 ? p8[i] : p8[4 + i]; p4[i] = mine + __shfl_xor(oth, 8); }
#pragma unroll
    for (int i = 0; i < 2; ++i) { const float mine = b2 ? p4[2 + i] : p4[i], oth = b2 ? p4[i] : p4[2 + i]; p2[i] = mine + __shfl_xor(oth, 4); }
    const float mine = b1 ? p2[1] : p2[0], oth = b1 ? p2[0] : p2[1]; float y = mine + __shfl_xor(oth, 2);
    y += __shfl_xor(y, 1);
    const int r = (b4 ? 8 : 0) + (b3 ? 4 : 0) + (b2 ? 2 : 0) + (b1 ? 1 : 0);
    if ((le & 1) == 0) atomicAdd(ssq + 2 * crow(r, le >> 5), y);
}
#define ATT_WAIT_BAR(N) asm volatile("s_waitcnt vmcnt(" #N ") lgkmcnt(0)\n\ts_barrier" ::: "memory")
__device__ __forceinline__ u32x4 pack_p(const f32x16& p, int base) { u32x4 w; w.x = cvtpk(p[base], p[base + 1]); w.y = cvtpk(p[base + 2], p[base + 3]); w.z = cvtpk(p[base + 4], p[base + 5]); w.w = cvtpk(p[base + 6], p[base + 7]); return w; }

typedef __attribute__((address_space(3))) const char* lds_cptr;
typedef short v4i16_t __attribute__((ext_vector_type(4)));
__device__ __forceinline__ s16x4 vtr(lds_cptr p) { return __builtin_bit_cast(s16x4, __builtin_amdgcn_ds_read_tr16_b64_v4i16((__attribute__((address_space(3))) v4i16_t*)p)); }
__device__ __forceinline__ void mla_unit2(LAS unsigned char* lds, int b, int h, int qb, const bf16* QB, const unsigned char* QN8, const unsigned char* KN8, const bf16* KR, const bf16* VB, bf16* O, float* SSQ, bool shift, float nb, const ConvJob cj, int wid, int lane) {
    const int r32 = lane & 31, hi = lane >> 5;
    const unsigned lds0 = (unsigned)(uintptr_t)lds;
    const size_t rowb = (size_t)b * SEQ; const int q0 = qb * 256;
    const char* ksrc = (const char*)sptr((const bf16*)((wid < 4) ? (const unsigned char*)(KR + (size_t)(b * 64) * 2048) + (wid & 3) * 1024 : KN8 + (size_t)((b * BH + h) * 64) * 4096 + (wid & 3) * 1024));
    const bf16* vsrc = sptr(VB + (size_t)((b * BH + h) * 64) * 4096 + wid * 512);
    const unsigned kl0 = lane * 16u, vl = kl0;
    constexpr int KS8 = 8192;
    const unsigned kdst = lds0 + LK + ((wid < 4 ? 4 : 0) + (wid & 3)) * 1024, vdst = lds0 + LV + wid * 1024;
#define DMA_K(t, sl) glds16s(ksrc + (size_t)(t) * 4096, kl0, rfl(kdst + (sl) * KS8))
#define DMA_V(t, sl) glds16s(vsrc + (size_t)(t) * 4096, vl, rfl(vdst + (sl) * VSLOT))
#define WAITB(N4, N8) ATT_WAIT_BAR(N8)
    constexpr int NT = SEQ / 64;
    DMA_K(0, 0); DMA_V(0, 0); DMA_K(1, 1); DMA_K(2, 2);
    typedef int v8i32 __attribute__((ext_vector_type(8))); typedef int v4i32 __attribute__((ext_vector_type(4)));
#define CAT8(a_, b_) (v8i32){a_[0], a_[1], a_[2], a_[3], b_[0], b_[1], b_[2], b_[3]}
    const int sK = 0x7c7c7c7c, sQ = 0x79797979;
    v8i32 qn8; bf16x8 qf[2];
    { const unsigned char* qp8 = QN8 + (rowb + q0 + 32 * wid + r32) * (BH * NOPE) + NOPE * h + 32 * hi; const v4i32 a_ = *(const v4i32*)qp8, b_ = *(const v4i32*)(qp8 + 16); qn8 = CAT8(a_, b_);
      const bf16* qp = QB + (rowb + q0 + 32 * wid + r32) * (BH * QKD) + QKD * h + NOPE + 8 * hi;
#pragma unroll
      for (int s = 0; s < 2; ++s) qf[s] = *(const bf16x8*)(qp + 16 * s); }
    f32x16 o[2]; o[0] = f32x16{}; o[1] = f32x16{};
    typedef float f32x4_t __attribute__((ext_vector_type(4)));
    f32x4_t ls = {0.f, 0.f, 0.f, 0.f}, ls2 = {0.f, 0.f, 0.f, 0.f};
    const short bsel1 = ((((lane >> 4) & 1) == ((lane & 15) >> 3)) ? (short)0x3F80 : (short)0);
    const bf16x8 bsel = {bsel1, bsel1, bsel1, bsel1, bsel1, bsel1, bsel1, bsel1};
#define LSUM(k) do { if ((k) & 1) ls2 = __builtin_amdgcn_mfma_f32_16x16x32_bf16(PAF(k), bsel, ls2, 0, 0, 0); else ls = __builtin_amdgcn_mfma_f32_16x16x32_bf16(PAF(k), bsel, ls, 0, 0, 0); } while (0)
    const lds_cptr kp0 = (lds_cptr)lds + LK + hi * 2048 + r32 * 16;
    const lds_cptr kr0 = (lds_cptr)lds + LK + 4096 + hi * 1024 + r32 * 16;
    const lds_cptr vp0 = (lds_cptr)lds + LV + ((lane >> 4) & 1) * 32 + (lane & 3) * 8 + (4 * hi + ((lane & 15) >> 2)) * 64;
    v8i32 kf8[2]; bf16x8 kfr[4];
#define KLD8(kp_, kh) do { const v4i32 a_ = *(const __attribute__((address_space(3))) v4i32*)((kp_) + (kh) * 512), b_ = *(const __attribute__((address_space(3))) v4i32*)((kp_) + 1024 + (kh) * 512); kf8[kh] = CAT8(a_, b_); } while (0)
#define KLDR(kp_, i) kfr[i] = *(const __attribute__((address_space(3))) bf16x8*)((kp_) + ((i) >> 1) * 2048 + ((i) & 1) * 512)
#define QKF8(kh) __builtin_amdgcn_mfma_scale_f32_32x32x64_f8f6f4(kf8[kh], qn8, f32x16{}, 0, 0, 0, sK, 0, sQ)
    WAITB(5, 3);
    KLD8(kp0, 0); KLD8(kp0, 1);
#pragma unroll
    for (int i = 0; i < 4; ++i) KLDR(kr0, i);
    f32x16 pA0, pA1, pB0, pB1;
    pA0 = QKF8(0); pA1 = QKF8(1);
#pragma unroll
    for (int s = 0; s < 2; ++s) { pA0 = __builtin_amdgcn_mfma_f32_32x32x16_bf16(kfr[2 * s], qf[s], pA0, 0, 0, 0); pA1 = __builtin_amdgcn_mfma_f32_32x32x16_bf16(kfr[2 * s + 1], qf[s], pA1, 0, 0, 0); }
    if (shift) {
#pragma unroll
        for (int r = 0; r < 16; ++r) { pA0[r] += nb; pA1[r] += nb; } }
#pragma unroll
    for (int r = 0; r < 16; ++r) { pA0[r] = __builtin_amdgcn_exp2f(pA0[r]); pA1[r] = __builtin_amdgcn_exp2f(pA1[r]); }
    WAITB(2, 1);
    DMA_K(3, 0); DMA_V(1, 1);
    KLD8(kp0 + KS8, 0); KLD8(kp0 + KS8, 1);
#pragma unroll
    for (int i = 0; i < 4; ++i) KLDR(kr0 + KS8, i);
    WAITB(3, 2);
    s16x4 vl0, vh0, vl1, vh1, vl2, vh2, vl3, vh3; u32x4 pw0, pw1, pw2, pw3;
    int i_prev = 0, i_cur = 1, i_next = 2;
#define ROT() do { const int t_ = i_prev; i_prev = i_cur; i_cur = i_next; i_next = t_; } while (0)
#define PIN(x) asm volatile("" : "+v"(x))
#define VOFF(i) (((i) >> 2) * 4096 + ((i) & 3) * 1024)
#define VRD(B, i) do { vl##B = vtr(vp_ + VOFF(i)); vh##B = vtr(vp_ + VOFF(i) + 512); } while (0)
#define VFR(B) (bf16x8){vl##B[0], vl##B[1], vl##B[2], vl##B[3], vh##B[0], vh##B[1], vh##B[2], vh##B[3]}
#define PAF(k) __builtin_bit_cast(bf16x8, pw##k)
#define EX(v) __builtin_amdgcn_exp2f(v)
#define QK0(C, kh) C = QKF8(kh)
#define QKN(C, i, s) C = __builtin_amdgcn_mfma_f32_32x32x16_bf16(kfr[i], qf[s], C, 0, 0, 0)
#define KN8(kh) do { if (GL_) { KLD8(kn_, kh); } } while (0)
#define KNR(i) do { if (GL_) { KLDR(krn_, i); } } while (0)
#define ADD4(P, B) (void)0
#define CVT2(P, B, PW, W) do { PW[W] = cvtpk(P[B], P[(B) + 1]); PW[(W) + 1] = cvtpk(P[(B) + 2], P[(B) + 3]); PIN(PW); } while (0)
#define GB(MF, RD, E0, E1, E2) do { MF; RD; E0; E1; E2; ATT_SBAR(); } while (0)
#define NOP_ (void)0
#define STEP(C0, C1, P0, P1, t, GK, GV, GL) do { ATT_SBAR(); \
    constexpr bool GL_ = GL; \
    if (GK) { DMA_K((t) + 3, i_cur); } if (GV) { DMA_V((t) + 1, i_next); } \
    const lds_cptr vp_ = vp0 + i_prev * VSLOT; const lds_cptr kn_ = kp0 + i_next * KS8, krn_ = kr0 + i_next * KS8; \
      \
    QK0(C0, 0); KN8(0); ADD4(P0, 0); CVT2(P0, 0, pw0, 0); ADD4(P0, 4); CVT2(P0, 4, pw0, 2); ATT_SBAR(); \
    QKN(C0, 0, 0); KNR(0); ADD4(P0, 8); CVT2(P0, 8, pw1, 0); ATT_SBAR(); \
    QKN(C0, 2, 1); KNR(2); ADD4(P0, 12); CVT2(P0, 12, pw1, 2); ATT_SBAR(); \
    QK0(C1, 1); KN8(1); CVT2(P1, 0, pw2, 0); CVT2(P1, 4, pw2, 2); LSUM(0); LSUM(1); ATT_SBAR(); \
    if (__builtin_expect(shift, 0)) { _Pragma("unroll") for (int r_ = 0; r_ < 16; ++r_) C0[r_] += nb; PIN(C0); } ATT_SBAR(); \
    QKN(C1, 1, 0); KNR(1); ADD4(P1, 8); CVT2(P1, 8, pw3, 0); C0[0] = EX(C0[0]); C0[1] = EX(C0[1]); VRD(0, 0); ATT_SBAR(); \
    QKN(C1, 3, 1); KNR(3); ADD4(P1, 12); CVT2(P1, 12, pw3, 2); C0[2] = EX(C0[2]); C0[3] = EX(C0[3]); VRD(1, 4); ATT_SBAR(); \
    VRD(2, 1); C0[4] = EX(C0[4]); C0[5] = EX(C0[5]); C0[6] = EX(C0[6]); C0[7] = EX(C0[7]); PIN(C0); LSUM(2); LSUM(3); ATT_SBAR(); \
    if (__builtin_expect(shift, 0)) { _Pragma("unroll") for (int r_ = 0; r_ < 16; ++r_) C1[r_] += nb; PIN(C1); } ATT_SBAR(); \
    GB(o[0] = __builtin_amdgcn_mfma_f32_32x32x16_bf16(PAF(0), VFR(0), o[0], 0, 0, 0), VRD(3, 5), C0[8] = EX(C0[8]), C0[9] = EX(C0[9]), C0[10] = EX(C0[10])); \
    GB(o[1] = __builtin_amdgcn_mfma_f32_32x32x16_bf16(PAF(0), VFR(1), o[1], 0, 0, 0), VRD(0, 2), C0[11] = EX(C0[11]), C0[12] = EX(C0[12]), C0[13] = EX(C0[13])); \
    GB(o[0] = __builtin_amdgcn_mfma_f32_32x32x16_bf16(PAF(1), VFR(2), o[0], 0, 0, 0), VRD(1, 6), C0[14] = EX(C0[14]), C0[15] = EX(C0[15]), C1[0] = EX(C1[0])); \
    GB(o[1] = __builtin_amdgcn_mfma_f32_32x32x16_bf16(PAF(1), VFR(3), o[1], 0, 0, 0), VRD(2, 3), C1[1] = EX(C1[1]), C1[2] = EX(C1[2]), C1[3] = EX(C1[3])); \
    GB(o[0] = __builtin_amdgcn_mfma_f32_32x32x16_bf16(PAF(2), VFR(0), o[0], 0, 0, 0), VRD(3, 7), C1[4] = EX(C1[4]), C1[5] = EX(C1[5]), C1[6] = EX(C1[6])); \
    GB(o[1] = __builtin_amdgcn_mfma_f32_32x32x16_bf16(PAF(2), VFR(1), o[1], 0, 0, 0), NOP_, C1[7] = EX(C1[7]), C1[8] = EX(C1[8]), C1[9] = EX(C1[9])); \
    GB(o[0] = __builtin_amdgcn_mfma_f32_32x32x16_bf16(PAF(3), VFR(2), o[0], 0, 0, 0), NOP_, C1[10] = EX(C1[10]), C1[11] = EX(C1[11]), C1[12] = EX(C1[12])); \
    GB(o[1] = __builtin_amdgcn_mfma_f32_32x32x16_bf16(PAF(3), VFR(3), o[1], 0, 0, 0), NOP_, C1[13] = EX(C1[13]), C1[14] = EX(C1[14]), C1[15] = EX(C1[15])); \
    PIN(C0); PIN(C1); \
    } while (0)
    const bool cv_on = cj.item0 >= 0;
    int cv_p = 0, cv_j = 0; const float* cv_src = nullptr; unsigned char* cv_dst = nullptr; float cv_sc = 0.f;
    LAS float* const cvf = (LAS float*)(lds + CV_F32 + wid * 2048);
    LAS unsigned* const cv8 = (LAS unsigned*)(lds + CV_F8 + wid * 2176);
    const unsigned cv_loff = (unsigned)(lane >> 3) * 4096u + (unsigned)(lane & 7) * 16u;
#define CONV() do { \
    if (cv_p == 0) { const int r_ = cj.item0 + cv_j, e_ = r_ / 1536, q_ = r_ % 1536, wh_ = q_ >> 9, it_ = q_ & 511, k0_ = (it_ >> 5) * 64, n0_ = (it_ & 31) * 32; \
        const unsigned char* ka_ = (const unsigned char*)__builtin_amdgcn_kernarg_segment_ptr();     \
        const float* w_ = *(const float* const*)(ka_ + 8 * (20 + wh_)); unsigned char* ws_ = *(unsigned char* const*)(ka_ + 8 * 24); cv_src = w_ + (size_t)e_ * 1048576 + (size_t)k0_ * 1024 + n0_; \
        if (wh_ < 2) { cv_dst = ws_ + WS_WGU + (size_t)e_ * 2097152 + (size_t)((n0_ >> 7) * 256 + wh_ * 128 + (n0_ & 127)) * 1024 + k0_; cv_sc = 32.0f; } \
        else { cv_dst = ws_ + WS_WD + (size_t)e_ * 1048576 + (size_t)n0_ * 1024 + k0_; cv_sc = 16.0f; } } \
    if (cv_p >= 1 && cv_p <= 8) { const int d_ = cv_p - 1; const LAS float* s_ = cvf + (d_ & 1) * 256 + hi * 128 + r32; \
        cv8[r32 * 17 + 2 * d_ + hi] = pg8::pk4_fp8_nc(cv_sc * s_[0], cv_sc * s_[32], cv_sc * s_[64], cv_sc * s_[96]); } \
    if (cv_p < 8) { glds16s_nt(cv_src + (size_t)(8 * cv_p) * 1024, cv_loff, rfl(lds0 + CV_F32 + wid * 2048 + (cv_p & 1) * 1024)); } \
    else { const int id_ = lane + 64 * (cv_p - 8), n2_ = id_ >> 2, c_ = id_ & 3; const LAS unsigned* q2_ = cv8 + n2_ * 17 + 4 * c_; \
        v4u w4_; w4_.x = q2_[0]; w4_.y = q2_[1]; w4_.z = q2_[2]; w4_.w = q2_[3]; *(GAS v4u*)(cv_dst + (size_t)n2_ * 1024 + 16 * c_) = w4_; } \
    if (++cv_p == 10) { cv_p = 0; ++cv_j; } } while (0)
    int t = 1;
    for (; t + 3 < NT; t += 2) {
        STEP(pB0, pB1, pA0, pA1, t, true, true, true);      WAITB(3, 2); ROT();
        if (cv_on) { CONV(); }
        STEP(pA0, pA1, pB0, pB1, t + 1, true, true, true);  if (cv_on) WAITB(4, 3); else WAITB(3, 2); ROT();
    }
#undef CONV
    STEP(pB0, pB1, pA0, pA1, NT - 3, false, true, true);   ATT_WAIT_BAR(1); ROT();
    STEP(pA0, pA1, pB0, pB1, NT - 2, false, true, true);   ATT_WAIT_BAR(1); ROT();
    STEP(pB0, pB1, pA0, pA1, NT - 1, false, false, false); ATT_WAIT_BAR(0); ROT();
    { const u32x4 w0 = pack_p(pB0, 0), w1 = pack_p(pB0, 8), w2 = pack_p(pB1, 0), w3 = pack_p(pB1, 8);
      ls = __builtin_amdgcn_mfma_f32_16x16x32_bf16(__builtin_bit_cast(bf16x8, w0), bsel, ls, 0, 0, 0); ls = __builtin_amdgcn_mfma_f32_16x16x32_bf16(__builtin_bit_cast(bf16x8, w1), bsel, ls, 0, 0, 0);
      ls = __builtin_amdgcn_mfma_f32_16x16x32_bf16(__builtin_bit_cast(bf16x8, w2), bsel, ls, 0, 0, 0); ls = __builtin_amdgcn_mfma_f32_16x16x32_bf16(__builtin_bit_cast(bf16x8, w3), bsel, ls, 0, 0, 0);
      ls += ls2;
      pv(o, (int)(lds0 + LV) + ((lane >> 4) & 1) * 32 + (lane & 3) * 8 + (4 * hi + ((lane & 15) >> 2)) * 64 + i_prev * VSLOT,
         __builtin_bit_cast(bf16x8, w0), __builtin_bit_cast(bf16x8, w1), __builtin_bit_cast(bf16x8, w2), __builtin_bit_cast(bf16x8, w3)); }
#undef STEP
#undef NOP_
#undef GB
#undef ADD4
#undef LSUM
#undef CVT2
#undef KN8
#undef KNR
#undef QK0
#undef QKN
#undef QKF8
#undef KLD8
#undef KLDR
#undef CAT8
#undef EX
#undef PAF
#undef VFR
#undef VRD
#undef VOFF
#undef PIN
#undef ROT
#undef WAITB
#undef DMA_K
#undef DMA_V
    const int le = lane_id();
    const int r32e = le & 31, hie = le >> 5;
    LAS float* wsf = (LAS float*)(lds + LWS) + wid * 64;
    if ((le & 7) == 0) { LAS float* wq = wsf + ((le & 8) ? 16 : 0) + 4 * (le >> 4); wq[0] = ls[0]; wq[1] = ls[1]; wq[2] = ls[2]; wq[3] = ls[3]; }
    asm volatile("s_waitcnt lgkmcnt(0)" ::: "memory");
    bf16* Ow = (bf16*)sptr(O + (rowb + q0 + 32 * wid) * DM + 512 + VD * h);
    float part[16];
#pragma unroll
    for (int r = 0; r < 16; ++r) { const int q = crow(r, hie); const float il = __builtin_amdgcn_rcpf(wsf[q]); const unsigned off = (unsigned)(q * DM + r32e); const float v0 = o[0][r] * il, v1 = o[1][r] * il;
        part[r] = v0 * v0 + v1 * v1; Ow[off] = (bf16)f2bf(v0); Ow[off + 32] = (bf16)f2bf(v1); }
    ssq_accum(part, le, SSQ + 2 * (rowb + q0 + 32 * wid) + 1);
    asm volatile("s_waitcnt lgkmcnt(0)\n\ts_barrier" ::: "memory");
}

__device__ __forceinline__ void swa_fill_table(LAS unsigned char* lds, int g, const float* TAB, int tid) {
    const float bnd = TAB[TAB_CONST + 0]; LAS float* tb = (LAS float*)(lds + LTAB);
    for (int i = tid; i < 4 * 512; i += NWAVES * 64) { const int hh = i >> 9, idx = (i & 511) - 63; tb[i] = (idx >= 0 && idx <= 2 * WINDOW) ? TAB[TAB_BIAS + (4 * g + hh) * NTAB + idx] - bnd : -1e30f; }
}
__device__ __forceinline__ void swa_unit(LAS unsigned char* lds, int b, int nh, int g, const bf16* QA, const bf16* KA, const bf16* VA, bf16* O, float* SSQ, const float* TAB, const float* sink, int wid, int lane, int tid) {
    const int r32 = lane & 31, hi = lane >> 5, hr = wid >> 1, rh = wid & 1, h = 4 * g + hr;
    const unsigned lds0 = (unsigned)(uintptr_t)lds;
    const size_t rowb = (size_t)b * SEQ;
    const int kt0 = (nh - 2 < 0) ? 0 : nh - 2, kt1 = (nh + 3 > SEQ / 64) ? SEQ / 64 : nh + 3, NT = kt1 - kt0;
    const bf16* ksrc = sptr(KA + (rowb + (size_t)kt0 * 64) * 128 + 64 * g + 8 * wid);
    const bf16* vsrc = sptr(VA + (rowb + (size_t)kt0 * 64 + 16 * (wid & 3)) * 128 + 64 * g + (wid >> 2) * 32);
    const unsigned kl = lane * 256u, vl = (lane >> 2) * 256u + (lane & 3) * 16u;
    constexpr int SK = 0, SV = 73728, SSLOT = 8192;
    const unsigned kdst = lds0 + SK + wid * 1024, vdst = lds0 + SV + wid * 1024;
#define SWA_DMA(t, sl) do { glds16s(ksrc + (size_t)(t) * 64 * 128, kl, rfl(kdst + (sl) * SSLOT)); glds16s(vsrc + (size_t)(t) * 64 * 128, vl, rfl(vdst + (sl) * SSLOT)); } while (0)
    for (int t_ = 0; t_ < NT; ++t_) SWA_DMA(t_, t_);
    const float bnd = TAB[TAB_CONST + 0];
    bf16x8 qf[4];
    { const bf16* qp = QA + (rowb + 64 * nh + 32 * rh + r32) * 512 + HD * h + 8 * hi;
#pragma unroll
      for (int s = 0; s < 4; ++s) qf[s] = *(const bf16x8*)(qp + 16 * s); }
    f32x16 o[2]; o[0] = f32x16{}; o[1] = f32x16{};
    float l = 0.f;
    const LAS unsigned char* kbase = lds + SK + hi * 1024 + r32 * 16;
    const int vb0 = (int)(lds0 + SV) + ((lane >> 4) & 1) * 32 + (lane & 3) * 8 + (4 * hi + ((lane & 15) >> 2)) * 64;
    const LAS float* tbl = (const LAS float*)(lds + LTAB) + hr * 512 + 63 + 4 * hi - 32 * rh - r32 + 64 * (kt0 - (nh - 2));
    for (int t = 0; t < NT; ++t) {
        { const int rem = NT - 1 - t;
          if (rem == 4) ATT_WAIT_BAR(8); else if (rem == 3) ATT_WAIT_BAR(6); else if (rem == 2) ATT_WAIT_BAR(4); else if (rem == 1) ATT_WAIT_BAR(2); else ATT_WAIT_BAR(0); }
        const int sl = t;
        const LAS unsigned char* kp = kbase + sl * SSLOT;
        const LAS float* tt = tbl + 64 * t;
        f32x16 p0, p1;
#pragma unroll
        for (int r = 0; r < 16; ++r) { const int off = (r & 3) + 8 * (r >> 2); p0[r] = tt[off]; p1[r] = tt[off + 32]; }
#pragma unroll
        for (int s = 0; s < 4; ++s) { const bf16x8 a0 = *(const LAS bf16x8*)(kp + s * 2048), a1 = *(const LAS bf16x8*)(kp + s * 2048 + 512);
            p0 = __builtin_amdgcn_mfma_f32_32x32x16_bf16(a0, qf[s], p0, 0, 0, 0); p1 = __builtin_amdgcn_mfma_f32_32x32x16_bf16(a1, qf[s], p1, 0, 0, 0); }
        float sa = 0.f, sb = 0.f;
#pragma unroll
        for (int r = 0; r < 16; ++r) { p0[r] = __builtin_amdgcn_exp2f(p0[r]); p1[r] = __builtin_amdgcn_exp2f(p1[r]); sa += p0[r]; sb += p1[r]; }
        l += sa + sb;
        const u32x4 w0 = pack_p(p0, 0), w1 = pack_p(p0, 8), w2 = pack_p(p1, 0), w3 = pack_p(p1, 8);
        pv(o, vb0 + sl * SSLOT, __builtin_bit_cast(bf16x8, w0), __builtin_bit_cast(bf16x8, w1), __builtin_bit_cast(bf16x8, w2), __builtin_bit_cast(bf16x8, w3));
    }
#undef SWA_DMA
    l += __shfl_xor(l, 32); l += __builtin_amdgcn_exp2f(sink[h] * LOG2E - bnd);
    const int le = lane_id();
    const int r32e = le & 31, hie = le >> 5;
    LAS float* wsf = (LAS float*)(lds + LWS) + wid * 64;
    if (hie == 0) wsf[r32e] = l;
    asm volatile("s_waitcnt lgkmcnt(0)" ::: "memory");
    bf16* Ow = (bf16*)sptr(O + (rowb + 64 * nh + 32 * rh) * DM + HD * h);
    float part[16];
#pragma unroll
    for (int r = 0; r < 16; ++r) { const int q = crow(r, hie); const float il = __builtin_amdgcn_rcpf(wsf[q]); const unsigned off = (unsigned)(q * DM + r32e); const float v0 = o[0][r] * il, v1 = o[1][r] * il;
        part[r] = v0 * v0 + v1 * v1; Ow[off] = (bf16)f2bf(v0); Ow[off + 32] = (bf16)f2bf(v1); }
    ssq_accum(part, le, SSQ + 2 * (rowb + 64 * nh + 32 * rh));
    asm volatile("s_waitcnt lgkmcnt(0)\n\ts_barrier" ::: "memory");
}
__device__ __forceinline__ void swa_unit3(LAS unsigned char* lds, int b, int n128, int g, const bf16* QA, const bf16* KA, const bf16* VA, bf16* O, float* SSQ, const float* TAB, const float* sink, int wid, int lane) {
    const int r32 = lane & 31, hi = lane >> 5, hr = wid >> 1, rh = wid & 1, h = 4 * g + hr;
    const unsigned lds0 = (unsigned)(uintptr_t)lds;
    const size_t rowb = (size_t)b * SEQ;
    const int kta = (2 * n128 - 2 < 0) ? 0 : 2 * n128 - 2, ktb = (2 * n128 + 4 > SEQ / 64) ? SEQ / 64 : 2 * n128 + 4, NTA = ktb - kta;
    const bf16* ksrc = sptr(KA + (rowb + (size_t)kta * 64) * 128 + 64 * g + 8 * wid);
    const bf16* vsrc = sptr(VA + (rowb + (size_t)kta * 64 + 16 * (wid & 3)) * 128 + 64 * g + (wid >> 2) * 32);
    const unsigned kl = lane * 256u, vl = (lane >> 2) * 256u + (lane & 3) * 16u;
    constexpr int SK = 0, SV = 73728, SSLOT = 8192;
    const unsigned kdst = lds0 + SK + wid * 1024, vdst = lds0 + SV + wid * 1024;
#define DMA_K(t, sl) glds16s(ksrc + (size_t)(t) * 64 * 128, kl, rfl(kdst + (sl) * SSLOT))
#define DMA_V(t, sl) glds16s(vsrc + (size_t)(t) * 64 * 128, vl, rfl(vdst + (sl) * SSLOT))
    for (int t_ = 0; t_ < NTA; ++t_) DMA_K(t_, t_);
    for (int t_ = 0; t_ < NTA; ++t_) DMA_V(t_, t_);
    const float bnd = TAB[TAB_CONST + 0];
    for (int sub = 0; sub < 2; ++sub) {
    const int nh = 2 * n128 + sub; const int kt0 = (nh - 2 < 0) ? 0 : nh - 2, kt1 = (nh + 3 > SEQ / 64) ? SEQ / 64 : nh + 3, NT = kt1 - kt0, s0 = kt0 - kta;
    bf16x8 qf[4];
    { const bf16* qp = QA + (rowb + 64 * nh + 32 * rh + r32) * 512 + HD * h + 8 * hi;
#pragma unroll
      for (int s = 0; s < 4; ++s) qf[s] = *(const bf16x8*)(qp + 16 * s); }
    f32x16 o[2]; o[0] = f32x16{}; o[1] = f32x16{};
    float l_reg = 0.f;
    const lds_cptr kp0 = (lds_cptr)lds + SK + s0 * SSLOT + hi * 1024 + r32 * 16;
    const lds_cptr vp0 = (lds_cptr)lds + SV + s0 * SSLOT + ((lane >> 4) & 1) * 32 + (lane & 3) * 8 + (4 * hi + ((lane & 15) >> 2)) * 64;
    const LAS float* tbl = (const LAS float*)(lds + LTAB) + hr * 512 + 63 + 4 * hi - 32 * rh - r32 + 64 * (kt0 - (nh - 2));
    bf16x8 kf[8];
#define KLD(kp, i) kf[i] = *(const __attribute__((address_space(3))) bf16x8*)((kp) + ((i) >> 1) * 2048 + ((i) & 1) * 512)
#define BIAS(C0, C1, tt_) do { _Pragma("unroll") for (int r_ = 0; r_ < 16; ++r_) { C0[r_] = (tt_)[(r_ & 3) + 8 * (r_ >> 2)]; C1[r_] = (tt_)[(r_ & 3) + 8 * (r_ >> 2) + 32]; } } while (0)
    if (sub == 0) { if (NTA == 6) ATT_WAIT_BAR(11); else ATT_WAIT_BAR(7); }
#pragma unroll
    for (int i = 0; i < 8; ++i) KLD(kp0, i);
    f32x16 pA0, pA1, pB0, pB1;
    BIAS(pA0, pA1, tbl);
#pragma unroll
    for (int s = 0; s < 4; ++s) { pA0 = __builtin_amdgcn_mfma_f32_32x32x16_bf16(kf[2 * s], qf[s], pA0, 0, 0, 0); pA1 = __builtin_amdgcn_mfma_f32_32x32x16_bf16(kf[2 * s + 1], qf[s], pA1, 0, 0, 0); }
#pragma unroll
    for (int r = 0; r < 16; ++r) { pA0[r] = __builtin_amdgcn_exp2f(pA0[r]); pA1[r] = __builtin_amdgcn_exp2f(pA1[r]); }
    BIAS(pB0, pB1, tbl + 64);
    if (sub == 0) ATT_WAIT_BAR(0);
#pragma unroll
    for (int i = 0; i < 8; ++i) KLD(kp0 + SSLOT, i);
    s16x4 vl0, vh0, vl1, vh1, vl2, vh2, vl3, vh3; u32x4 pw0, pw1, pw2, pw3;
#define ROT() do { } while (0)
#define PIN(x) asm volatile("" : "+v"(x))
#define VOFF(i) (((i) >> 2) * 4096 + ((i) & 3) * 1024)
#define VRD(B, i) do { vl##B = vtr(vp_ + VOFF(i)); vh##B = vtr(vp_ + VOFF(i) + 512); } while (0)
#define VFR(B) (bf16x8){vl##B[0], vl##B[1], vl##B[2], vl##B[3], vh##B[0], vh##B[1], vh##B[2], vh##B[3]}
#define PAF(k) __builtin_bit_cast(bf16x8, pw##k)
#define EX(v) __builtin_amdgcn_exp2f(v)
#define QKN(C, i, s) C = __builtin_amdgcn_mfma_f32_32x32x16_bf16(kf[i], qf[s], C, 0, 0, 0)
#define KN(i) do { if (gl_) { KLD(kn_, i); } } while (0)
#define GA(MF, KI, P, B, PW, W, X0, X1) do { MF; KN(KI); sacc += P[B]; sacc += P[B + 1]; sacc += P[B + 2]; sacc += P[B + 3]; PIN(sacc); PW[W] = cvtpk(P[B], P[B + 1]); PW[W + 1] = cvtpk(P[B + 2], P[B + 3]); PIN(PW); X0; X1; ATT_SBAR(); } while (0)
#define GB(MF, RD, E0, E1, E2, E3, NB) do { MF; RD; E0; E1; E2; E3; NB; ATT_SBAR(); } while (0)
#define NOP_ (void)0
#define NBIAS(P0, P1, q) do { if (gl_) { P0[2 * (q)] = tn_[((2 * (q)) & 3) + 8 * ((2 * (q)) >> 2)]; P0[2 * (q) + 1] = tn_[((2 * (q) + 1) & 3) + 8 * ((2 * (q) + 1) >> 2)]; \
        P1[2 * (q)] = tn_[((2 * (q)) & 3) + 8 * ((2 * (q)) >> 2) + 32]; P1[2 * (q) + 1] = tn_[((2 * (q) + 1) & 3) + 8 * ((2 * (q) + 1) >> 2) + 32]; } } while (0)
#define STEP(C0, C1, P0, P1, t) do { ATT_SBAR(); \
    const bool gl_ = (t) + 1 < NT; \
    const lds_cptr vp_ = vp0 + ((t) - 1) * SSLOT; const lds_cptr kn_ = kp0 + ((t) + 1) * SSLOT; const LAS float* tn_ = tbl + 64 * ((t) + 1); \
    float sacc = 0.f; \
    GA(QKN(C0, 0, 0), 0, P0, 0, pw0, 0, NOP_, NOP_); \
    GA(QKN(C0, 2, 1), 2, P0, 4, pw0, 2, NOP_, NOP_); \
    GA(QKN(C0, 4, 2), 4, P0, 8, pw1, 0, NOP_, NOP_); \
    GA(QKN(C0, 6, 3), 6, P0, 12, pw1, 2, NOP_, NOP_); \
    GA(QKN(C1, 1, 0), 1, P1, 0, pw2, 0, NOP_, NOP_); \
    GA(QKN(C1, 3, 1), 3, P1, 4, pw2, 2, NOP_, VRD(0, 0)); \
    GA(QKN(C1, 5, 2), 5, P1, 8, pw3, 0, C0[0] = EX(C0[0]), VRD(1, 4)); \
    GA(QKN(C1, 7, 3), 7, P1, 12, pw3, 2, C0[1] = EX(C0[1]), VRD(2, 1)); \
    l_reg += sacc; C0[2] = EX(C0[2]); C0[3] = EX(C0[3]); PIN(C0); ATT_SBAR(); \
    GB(o[0] = __builtin_amdgcn_mfma_f32_32x32x16_bf16(PAF(0), VFR(0), o[0], 0, 0, 0), VRD(3, 5), C0[4] = EX(C0[4]), C0[5] = EX(C0[5]), C0[6] = EX(C0[6]), C0[7] = EX(C0[7]), NBIAS(P0, P1, 0)); \
    GB(o[1] = __builtin_amdgcn_mfma_f32_32x32x16_bf16(PAF(0), VFR(1), o[1], 0, 0, 0), VRD(0, 2), C0[8] = EX(C0[8]), C0[9] = EX(C0[9]), C0[10] = EX(C0[10]), C0[11] = EX(C0[11]), NBIAS(P0, P1, 1)); \
    GB(o[0] = __builtin_amdgcn_mfma_f32_32x32x16_bf16(PAF(1), VFR(2), o[0], 0, 0, 0), VRD(1, 6), C0[12] = EX(C0[12]), C0[13] = EX(C0[13]), C0[14] = EX(C0[14]), C0[15] = EX(C0[15]), NBIAS(P0, P1, 2)); \
    GB(o[1] = __builtin_amdgcn_mfma_f32_32x32x16_bf16(PAF(1), VFR(3), o[1], 0, 0, 0), VRD(2, 3), C1[0] = EX(C1[0]), C1[1] = EX(C1[1]), C1[2] = EX(C1[2]), C1[3] = EX(C1[3]), NBIAS(P0, P1, 3)); \
    GB(o[0] = __builtin_amdgcn_mfma_f32_32x32x16_bf16(PAF(2), VFR(0), o[0], 0, 0, 0), VRD(3, 7), C1[4] = EX(C1[4]), C1[5] = EX(C1[5]), C1[6] = EX(C1[6]), C1[7] = EX(C1[7]), NBIAS(P0, P1, 4)); \
    GB(o[1] = __builtin_amdgcn_mfma_f32_32x32x16_bf16(PAF(2), VFR(1), o[1], 0, 0, 0), NOP_, C1[8] = EX(C1[8]), C1[9] = EX(C1[9]), C1[10] = EX(C1[10]), C1[11] = EX(C1[11]), NBIAS(P0, P1, 5)); \
    GB(o[0] = __builtin_amdgcn_mfma_f32_32x32x16_bf16(PAF(3), VFR(2), o[0], 0, 0, 0), NOP_, C1[12] = EX(C1[12]), C1[13] = EX(C1[13]), NOP_, NOP_, NBIAS(P0, P1, 6)); \
    GB(o[1] = __builtin_amdgcn_mfma_f32_32x32x16_bf16(PAF(3), VFR(3), o[1], 0, 0, 0), NOP_, C1[14] = EX(C1[14]), C1[15] = EX(C1[15]), NOP_, NOP_, NBIAS(P0, P1, 7)); \
    PIN(C0); PIN(C1); \
    } while (0)
#define DRAIN(P0, P1) do { float sacc = 0.f; _Pragma("unroll") for (int r_ = 0; r_ < 16; ++r_) sacc += P0[r_] + P1[r_]; l_reg += sacc; \
      const u32x4 w0 = pack_p(P0, 0), w1 = pack_p(P0, 8), w2 = pack_p(P1, 0), w3 = pack_p(P1, 8); \
      pv(o, (int)(lds0 + SV) + ((lane >> 4) & 1) * 32 + (lane & 3) * 8 + (4 * hi + ((lane & 15) >> 2)) * 64 + (s0 + NT - 1) * SSLOT, \
         __builtin_bit_cast(bf16x8, w0), __builtin_bit_cast(bf16x8, w1), __builtin_bit_cast(bf16x8, w2), __builtin_bit_cast(bf16x8, w3)); } while (0)
    STEP(pB0, pB1, pA0, pA1, 1);
    STEP(pA0, pA1, pB0, pB1, 2);
    if (NT > 3) { STEP(pB0, pB1, pA0, pA1, 3);
        if (NT > 4) { STEP(pA0, pA1, pB0, pB1, 4); DRAIN(pA0, pA1); } else { DRAIN(pB0, pB1); } }
    else { DRAIN(pA0, pA1); }
#undef DRAIN
#undef STEP
#undef NBIAS
#undef NOP_
#undef GB
#undef GA
#undef KN
#undef QKN
#undef EX
#undef PAF
#undef VFR
#undef VRD
#undef VOFF
#undef PIN
#undef ROT
#undef BIAS
#undef KLD
#undef DMA_K
#undef DMA_V
    float l = l_reg; l += __shfl_xor(l, 32); l += __builtin_amdgcn_exp2f(sink[h] * LOG2E - bnd);
    const int le = lane_id();
    const int r32e = le & 31, hie = le >> 5;
    LAS float* wsf = (LAS float*)(lds + LWS) + wid * 64;
    if (hie == 0) wsf[r32e] = l;
    asm volatile("s_waitcnt lgkmcnt(0)" ::: "memory");
    bf16* Ow = (bf16*)sptr(O + (rowb + 64 * nh + 32 * rh) * DM + HD * h);
    float part[16];
#pragma unroll
    for (int r = 0; r < 16; ++r) { const int q = crow(r, hie); const float il = __builtin_amdgcn_rcpf(wsf[q]); const unsigned off = (unsigned)(q * DM + r32e); const float v0 = o[0][r] * il, v1 = o[1][r] * il;
        part[r] = v0 * v0 + v1 * v1; Ow[off] = (bf16)f2bf(v0); Ow[off + 32] = (bf16)f2bf(v1); }
    ssq_accum(part, le, SSQ + 2 * (rowb + 64 * nh + 32 * rh));
    }
    asm volatile("s_waitcnt lgkmcnt(0)\n\ts_barrier" ::: "memory");
}

#undef ATT_SBAR
#undef ATT_WAIT_BAR
}

__device__ __forceinline__ void p5_attention(Frame& F, bool probe_dup = false) {
    const int lane_ = lane_id();
    const bf16* QB = WSP(bf16, WS_QB); const unsigned char* KN8 = WSP(unsigned char, WS_KBN); const unsigned char* QN8 = WSP(unsigned char, WS_QN8); const bf16* KR = WSP(bf16, WS_KR); const bf16* VB = WSP(bf16, WS_VB);
    const bf16* QA = WSP(bf16, WS_QA); const bf16* KA = WSP(bf16, WS_KA); const bf16* VA = WSP(bf16, WS_VA); bf16* O = WSP(bf16, WS_O);
    const float* TAB = WSP(float, WS_TAB); float* SSQ = probe_dup ? WSP(float, WS_KVRAW) : WSP(float, WS_SSQ);
    constexpr int NU_B = BATCH * BH * (SEQ / 256), NU_A = BATCH * (SEQ / 64) * A_KV;
#ifndef NO_MLA
    { const float bndB = __uint_as_float((unsigned)__builtin_amdgcn_readfirstlane((int)__float_as_uint(TAB[TAB_CONST + 1])));
      const bool shift = bndB > 64.0f; const float nb = shift ? -bndB : 0.f;
      for (int i = 0; i < (NU_B + F.G - 1) / F.G; ++i) {
        const int u = (F.G == 256) ? (F.vcu >> 2) * 16 + (F.vcu & 3) * 4 + i : i * F.G + F.vcu;
        if (u >= NU_B) break;
        const att::ConvJob cj{(F.G == 256 && !probe_dup) ? ((F.vcu * 4 + i) * NWAVES + F.wave) * 3 : -1};
        att::mla_unit2(F.lds + RING_OFF, (u >> 4) / BH, (u >> 4) % BH, u & 15, QB, QN8, KN8, KR, VB, O, SSQ, shift, nb, cj, F.wave, lane_);
      } }
#endif
#ifndef NO_SWA
    { const int lane2 = lane_id();
      int gcur = -1;
      for (int u = F.vcu; u < NU_A / 2; u += F.G) { if ((u & 1) != gcur) { gcur = u & 1; asm volatile("s_waitcnt lgkmcnt(0)\n\ts_barrier" ::: "memory"); att::swa_fill_table(F.lds + RING_OFF, gcur, TAB, F.wave * 64 + lane2); }
        att::swa_unit3(F.lds + RING_OFF, u >> 6, (u >> 1) & 31, u & 1, QA, KA, VA, O, SSQ, TAB, F.in[6], F.wave, lane2); } }
#endif
}

struct Args { const float* in[23]; float* out; unsigned char* ws; int ph_lo, ph_hi, li, pad; };
constexpr int N_PHASES = 13;
__global__ void __launch_bounds__(NWAVES * 64, 2) skel_fwd(Args args) {
    extern __shared__ __attribute__((aligned(16))) unsigned char lds[];
    Frame F;
    F.lds = (LAS unsigned char*)lds;
    F.MISC = (volatile LAS unsigned*)(F.lds + MISC_OFF);
    F.wave = __builtin_amdgcn_readfirstlane((int)(threadIdx.x >> 6));
    F.G = gridDim.x; { const int bx = blockIdx.x; F.vcu = (F.G % 8 == 0) ? (bx % 8) * (F.G / 8) + bx / 8 : bx; }
    F.ws = args.ws; F.out = args.out;
#pragma unroll
    for (int i = 0; i < 23; ++i) F.in[i] = args.in[i];
    F.ctl = (gu32*)(F.ws + WS_CTL);
    for (int u = threadIdx.x; u < (LDS_BYTES - LDSCTL_OFF) / 4; u += NWAVES * 64) ((LAS unsigned*)(F.lds + LDSCTL_OFF))[u] = 0u;
    __syncthreads();
    XcdBarrier bar = xcd_barrier_post((unsigned*)(F.ctl + CW_BAR) + args.li * XCD_BAR_WORDS, F.MISC + 8);
    const int lo = args.ph_lo, hi = args.ph_hi;
#define IN(k) (lo <= (k) && (k) < hi)
#define SEAM(k) do { if (IN(k) && IN((k) + 1)) xcd_barrier(bar); } while (0)

#define PH(k, ...) do { if (IN(k)) { __VA_ARGS__; if ((PROBE_MASK >> (k)) & 1) { xcd_barrier(bar); __VA_ARGS__; } } SEAM(k); } while (0)
    PH(0, p0_prologue(F));
    PH(1, {
        pg8::Gemm g{WSP(bf16, WS_XN), WSP(bf16, WS_WIN), T, NZ, DM, 0, nullptr, nullptr, 0, 0, 0, F.wave}; pg8::StaticOrder S; S.init(T, NZ, F.G, (int)blockIdx.x);
        pg8::EpiInProj E{F.ws, F.in[4], F.in[5], F.in[14]};
        pg8::gemm_phase<pg8::EpiInProj, pg8::StaticOrder, true, true>(F.lds + RING_OFF, g, S, E); });
    PH(3, {
        { pg8::Gemm g{WSP(bf16, WS_CQ), WSP(bf16, WS_WQB), T, BH * QKD, QL, 0, nullptr, nullptr, 0, 0, 0, F.wave}; pg8::StaticOrder S; S.init(T, BH * QKD, F.G, (int)blockIdx.x);
          pg8::EpiQB E{F.ws, F.in[11], F.in[12]};
          pg8::gemm_phase<pg8::EpiQB, pg8::StaticOrder, true, true>(F.lds + RING_OFF, g, S, E); }
        __syncthreads();
        { pg8::Gemm g{WSP(bf16, WS_CKV), WSP(bf16, WS_WKVB), T, BH * 128, KVL, 0, nullptr, nullptr, 0, 0, 0, F.wave}; pg8::StaticOrder S; S.init(T, BH * 128, F.G, (int)(F.G - 1 - blockIdx.x));
          pg8::EpiKVB E{F.ws, F.in[13]};
          pg8::gemm_phase<pg8::EpiKVB, pg8::StaticOrder, true, true>(F.lds + RING_OFF, g, S, E); } });
#if !NAIVE_ATTN
    PH(5, p5_attention(F));
#if PROBE_ATT
    xcd_barrier(bar); p5_attention(F, true); xcd_barrier(bar);
#endif
#endif
    PH(7, {
        pg8::Gemm g{WSP(bf16, WS_O), WSP(bf16, WS_WO), T, DM, DM, 0, nullptr, WSP(float, WS_SSQ), 0, 0, 0, F.wave}; pg8::StaticOrder S; S.init(T, DM, F.G, (int)blockIdx.x);
        pg8::EpiNormBf16 E{WSP(bf16, WS_ATT), DM, WSP(float, WS_SSQ)};
        pg8::gemm_phase<pg8::EpiNormBf16, pg8::StaticOrder, true, true, 2>(F.lds + RING_OFF, g, S, E); });
    PH(8, p8_router(F));
    PH(9, p9_topk(F));
    PH(11, {
        pg8::Gemm g{WSP(bf16, WS_H2), WSP(bf16, WS_WGU), MX, 2 * FF, DM / 2, (size_t)2 * FF * DM, WSP(int, WS_IDX), nullptr, 0x7a7a7a7a, 0x7a7a7a7a, (unsigned)(LDSCTL_OFF + 1024 - RING_OFF), F.wave}; pg8::StaticOrder S; S.init(MX, 2 * FF, F.G, (int)blockIdx.x, 16);
        pg8::EpiSwiGLU8 E{WSP(unsigned char, WS_ACT), FF, 16.0f};
        pg8::gemm_phase<pg8::EpiSwiGLU8, pg8::StaticOrder, true, true, 1, true>(F.lds + RING_OFF, g, S, E); });
    PH(12, {
        pg8::Gemm g{WSP(bf16, WS_ACT), WSP(bf16, WS_WD), MX, DM, FF / 2, (size_t)DM * FF, nullptr, nullptr, 0x7b7b7b7b, 0x7b7b7b7b, 0, F.wave}; pg8::StaticOrder S; S.init(MX, DM, F.G, (int)blockIdx.x, 16);
        pg8::EpiRowScaleF8 E{WSP(unsigned char, WS_YE), DM, WSP(float, WS_GATEV), 64.0f};
        pg8::gemm_phase<pg8::EpiRowScaleF8, pg8::StaticOrder, true, true, 0, true>(F.lds + RING_OFF, g, S, E); });
    PH(13, p12_combine(F));
#undef PH
#undef IN
#undef SEAM
}

#if NAIVE_ATTN
__device__ __forceinline__ float bf2f(bf16 v) { return __uint_as_float((unsigned)v << 16); }
__global__ void __launch_bounds__(256) naive_attn_a(const bf16* __restrict__ QA, const bf16* __restrict__ KA, const bf16* __restrict__ VA, const float* __restrict__ TAB, const float* __restrict__ sink, bf16* __restrict__ O) {
    const int s = (blockIdx.x % (SEQ / 256)) * 256 + threadIdx.x, bh = blockIdx.x / (SEQ / 256), h = bh % A_HEADS, b = bh / A_HEADS, g = h / (A_HEADS / A_KV);
    const size_t m = (size_t)b * SEQ + s;
    float q[HD], o[HD];
#pragma unroll
    for (int d = 0; d < HD; ++d) { q[d] = bf2f(QA[m * 512 + h * HD + d]); o[d] = 0.f; }
    const float bnd = TAB[TAB_CONST + 0];
    float l = exp2f(sink[h] * LOG2E - bnd);
    for (int rel = -WINDOW; rel <= WINDOW; ++rel) { const int j = s + rel; if (j < 0 || j >= SEQ) continue;
        const bf16* kr = KA + ((size_t)b * SEQ + j) * 128 + g * HD; const bf16* vr = VA + ((size_t)b * SEQ + j) * 128 + g * HD;
        float sc = 0.f;
#pragma unroll
        for (int d = 0; d < HD; ++d) sc += q[d] * bf2f(kr[d]);
        const float p = exp2f(sc + TAB[TAB_BIAS + h * NTAB + rel + 128] - bnd); l += p;
#pragma unroll
        for (int d = 0; d < HD; ++d) o[d] += p * bf2f(vr[d]); }
    const float il = 1.0f / l;
#pragma unroll
    for (int d = 0; d < HD; ++d) O[m * DM + h * HD + d] = (bf16)f2bf(o[d] * il);
}
__global__ void __launch_bounds__(256) naive_attn_b(const bf16* __restrict__ QB, const bf16* __restrict__ KBN, const bf16* __restrict__ KR, const bf16* __restrict__ VB, const float* __restrict__ TAB, bf16* __restrict__ O) {
    const int s = (blockIdx.x % (SEQ / 256)) * 256 + threadIdx.x, bh = blockIdx.x / (SEQ / 256), h = bh % BH, b = bh / BH;
    const size_t m = (size_t)b * SEQ + s;
    float q[QKD], o[VD];
#pragma unroll
    for (int d = 0; d < QKD; ++d) q[d] = bf2f(QB[m * (BH * QKD) + h * QKD + d]);
#pragma unroll
    for (int d = 0; d < VD; ++d) o[d] = 0.f;
    const float bnd = TAB[TAB_CONST + 1];
    float l = 0.f;
    for (int j = 0; j < SEQ; ++j) { const size_t mj = (size_t)b * SEQ + j;
        const bf16* kn = KBN + mj * 512 + h * NOPE; const bf16* kr = KR + mj * ROPE; const bf16* vr = VB + mj * 512 + h * VD;
        float sc = 0.f;
#pragma unroll
        for (int d = 0; d < NOPE; ++d) sc += q[d] * bf2f(kn[d]);
#pragma unroll
        for (int d = 0; d < ROPE; ++d) sc += q[NOPE + d] * bf2f(kr[d]);
        const float p = exp2f(sc - bnd); l += p;
#pragma unroll
        for (int d = 0; d < VD; ++d) o[d] += p * bf2f(vr[d]); }
    const float il = 1.0f / l;
#pragma unroll
    for (int d = 0; d < VD; ++d) O[m * DM + 512 + h * VD + d] = (bf16)f2bf(o[d] * il);
}

#endif
extern "C" void kernel_launch(void* const* d_in, const int* in_sizes, int n_in, void* d_out, int out_size, void* d_ws, size_t ws_size, hipStream_t stream) {
    static int grid = 0;
    if (grid == 0) {
        if (n_in != 23 || in_sizes[0] != T * DM || out_size != T * DM || ws_size < WS_END) { fprintf(stderr, "kernel_launch: unexpected shapes (n_in %d, in0 %d, out %d, ws %zu)\n", n_in, n_in > 0 ? in_sizes[0] : -1, out_size, ws_size); grid = -1; return; }
        int dev = 0, cus = 0, per_cu = 0;
        if (hipGetDevice(&dev) != hipSuccess || hipDeviceGetAttribute(&cus, hipDeviceAttributeMultiprocessorCount, dev) != hipSuccess) { grid = -1; return; }
        if (hipFuncSetAttribute((const void*)skel_fwd, hipFuncAttributeMaxDynamicSharedMemorySize, LDS_BYTES) != hipSuccess) { fprintf(stderr, "kernel_launch: hipFuncSetAttribute failed\n"); grid = -1; return; }
        if (hipOccupancyMaxActiveBlocksPerMultiprocessor(&per_cu, (const void*)skel_fwd, NWAVES * 64, LDS_BYTES) != hipSuccess || per_cu < 1) fprintf(stderr, "kernel_launch: occupancy query says %d\n", per_cu);
        (void)hipGetLastError();
        grid = cus;
    }
    if (grid < 0) return;
    if (hipMemsetAsync((char*)d_ws + WS_CTL, 0, CTL_ZERO_BYTES, stream) != hipSuccess) return;
    Args a{};
    for (int i = 0; i < 23; ++i) a.in[i] = (const float*)d_in[i];
    a.out = (float*)d_out; a.ws = (unsigned char*)d_ws;
    unsigned char* ws = (unsigned char*)d_ws;
#if NAIVE_ATTN
    a.ph_lo = 0; a.ph_hi = 5; a.li = 0;
    hipLaunchKernelGGL(skel_fwd, dim3(grid), dim3(NWAVES * 64), LDS_BYTES, stream, a);
    hipLaunchKernelGGL(naive_attn_a, dim3(BATCH * A_HEADS * (SEQ / 256)), dim3(256), 0, stream, (const bf16*)(ws + WS_QA), (const bf16*)(ws + WS_KA), (const bf16*)(ws + WS_VA), (const float*)(ws + WS_TAB), (const float*)d_in[6], (bf16*)(ws + WS_O));
    hipLaunchKernelGGL(naive_attn_b, dim3(BATCH * BH * (SEQ / 256)), dim3(256), 0, stream, (const bf16*)(ws + WS_QB), (const bf16*)(ws + WS_KBN), (const bf16*)(ws + WS_KR), (const bf16*)(ws + WS_VB), (const float*)(ws + WS_TAB), (bf16*)(ws + WS_O));
    a.ph_lo = 6; a.ph_hi = 14; a.li = 1;
    hipLaunchKernelGGL(skel_fwd, dim3(grid), dim3(NWAVES * 64), LDS_BYTES, stream, a);
#else
    a.ph_lo = 0; a.ph_hi = 14; a.li = 0;
    hipLaunchKernelGGL(skel_fwd, dim3(grid), dim3(NWAVES * 64), LDS_BYTES, stream, a);
#endif
}
```

```cpp
#include <hip/hip_runtime.h>
#include <hip/hip_bf16.h>
#include <cstdio>
#include <cstdint>
#ifndef PROBE_ATT
#define PROBE_ATT 0
#endif
#ifndef PROBE_MASK
#define PROBE_MASK 0
#endif
#ifndef NAIVE_ATTN
#define NAIVE_ATTN 0
#endif
__device__ __forceinline__ int lane_id() { int l; asm volatile("v_mbcnt_lo_u32_b32 %0, -1, 0\n\tv_mbcnt_hi_u32_b32 %0, -1, %0" : "=v"(l)); return l; }

constexpr int NWAVES = 8;
constexpr int BATCH = 8, SEQ = 4096, DM = 1024, T = BATCH * SEQ;
constexpr int INW = 1440, NZ = 1536;
constexpr int A_HEADS = 8, A_KV = 2, HD = 64, WINDOW = 128;
constexpr int BH = 8, QL = 384, KVL = 256, NOPE = 64, ROPE = 32, VD = 64, QKD = NOPE + ROPE;
constexpr int NE = 16, FF = 1024, CAP = 512, MX = NE * BATCH * CAP;
constexpr float EPS = 1e-6f, LOG2E = 1.4426950408889634f;
constexpr float QSC_A = 0.125f * LOG2E;
constexpr float QSC_B = 0.10206207261596577f * LOG2E;
constexpr int NTAB = 257;

constexpr size_t MiB = 1u << 20;
constexpr size_t WS_CTL = 0, CTL_ZERO_BYTES = 1 * MiB;
constexpr size_t WS_SSQ = 512 * 1024;
constexpr size_t WS_SSQCQ = 768 * 1024, WS_SSQCKV = 896 * 1024;
constexpr size_t WS_TAB = 1 * MiB;
constexpr size_t WS_WIN = 4 * MiB, WS_WQB = 7 * MiB, WS_WKVB = 8 * MiB, WS_WO = 9 * MiB, WS_WGU = 12 * MiB, WS_WD = 76 * MiB;
constexpr size_t WS_AFF = 108 * MiB, WS_IDX = 110 * MiB, WS_GATEV = WS_IDX + 512 * 1024, WS_SLOT = 111 * MiB;
constexpr size_t WS_XN = 114 * MiB;
constexpr size_t WS_Z = 178 * MiB;
constexpr size_t WS_QA = 274 * MiB, WS_KA = 306 * MiB, WS_VA = 314 * MiB, WS_CQ = 322 * MiB, WS_CKV = 346 * MiB, WS_KR = 362 * MiB;
constexpr size_t WS_KVRAW = 364 * MiB, WS_KBN = 428 * MiB, WS_VB = 460 * MiB, WS_END = 492 * MiB;
constexpr size_t WS_ATT = 242 * MiB;
constexpr size_t WS_QN8 = 242 * MiB;
constexpr size_t WS_X1B = 370 * MiB;
constexpr size_t WS_QB = WS_Z, WS_O = WS_XN, WS_H2 = WS_XN, WS_XE = WS_Z, WS_ACT = 306 * MiB, WS_YE = WS_Z;
constexpr int TAB_BIAS = 0, TAB_CONST = 8 * NTAB + 8, TAB_COS = TAB_CONST + 16, TAB_SIN = TAB_COS + SEQ * 16;
constexpr int CW_TMO = 0, CW_BAR = 4096;

constexpr int RING_OFF = 0, RING_BYTES = 131072;
constexpr int LDSCTL_OFF = RING_BYTES, MISC_OFF = LDSCTL_OFF + 320;
constexpr int LDS_BYTES = 147456;
namespace pg8 {
#define PG8_LAS __attribute__((address_space(3)))
typedef unsigned short bf16_t;
typedef short bf16x8 __attribute__((ext_vector_type(8)));
typedef float f32x4 __attribute__((ext_vector_type(4)));
typedef unsigned u32x4 __attribute__((ext_vector_type(4)));
constexpr int BM = 256, BK = 64, HALF = 128, HTB = HALF * BK * 2  , STAGE_BYTES = 8 * HTB, NXCD = 8, WGM = 8;

__host__ __device__ __forceinline__ int lds_byte(int r, int c) { const int st = (r >> 4) * 2 + (c >> 5), rr = r & 15, cc = c & 31, ob = rr * 64 + cc * 2; return st * 1024 + (ob ^ (((ob >> 9) & 1) << 5)); }
__host__ __device__ __forceinline__ void stage_rc(int b, int& R, int& C) { const int st = b / 1024, sb = b % 1024, swz = sb ^ (((sb >> 9) & 1) << 5); R = (st >> 1) * 16 + swz / 64; C = (st & 1) * 32 + (swz % 64) / 2; }
__host__ __device__ __forceinline__ int gray4(int q) { return q ^ (q >> 1); }
__host__ __device__ __forceinline__ int lds_byte8(int r, int cbyte) { const int st = (r >> 4) * 2 + (cbyte >> 6), rr = r & 15; return st * 1024 + rr * 64 + ((((cbyte >> 4) & 3) ^ gray4((rr >> 2) & 3)) << 4) + (cbyte & 15); }
__host__ __device__ __forceinline__ void stage_rc8(int b, int& R, int& C) { const int st = b / 1024, sb = b % 1024, rr = sb / 64, ch = ((sb % 64) / 16) ^ gray4((rr >> 2) & 3); R = (st >> 1) * 16 + rr; C = (st & 1) * 32 + ch * 8; }
__host__ __device__ __forceinline__ int perm32(int rho) { const int n = rho >> 4, i = rho & 15; return 8 * (i >> 2) + 4 * n + (i & 3); }

struct Unit { int pm, pn, e; };
struct Gemm { const bf16_t* A; const bf16_t* Bt; int M, N, K; size_t estride; const int* idx; const float* ssq; int sA, sB; unsigned gtab; int wave; };

struct StaticOrder {
    int nM, nN, nwg, G, c, epan;
    __host__ __device__ void init(int M, int N, int G_, int c_, int epan_ = 0) { nM = M / BM; nN = N / BM; nwg = nM * nN; G = G_; c = c_; epan = epan_; }
    __host__ __device__ bool next(int i, Unit& u) const {
        const long L = (long)i * G + c; if (L >= nwg) return false;
        int wgid = (int)L; { const int q = nwg / NXCD, r = nwg % NXCD, xcd = wgid % NXCD, off = wgid / NXCD; wgid = (xcd < r ? xcd * (q + 1) : r * (q + 1) + (xcd - r) * q) + off; }
        const int nig = WGM * nN, gid = wgid / nig, fm = gid * WGM, gsz = (nM - fm) < WGM ? (nM - fm) : WGM;
        u.pm = fm + ((wgid % nig) % gsz); u.pn = (wgid % nig) / gsz; u.e = epan ? u.pm / epan : 0; return true;
    }
    __device__ __forceinline__ void a_ready(const Unit&) const {}
    __device__ __forceinline__ void done(const Unit&) const {}
};

__device__ __forceinline__ unsigned cvt_pk_bf16(float lo, float hi) { unsigned r; asm volatile("v_cvt_pk_bf16_f32 %0, %1, %2" : "=v"(r) : "v"(lo), "v"(hi)); return r; }
typedef float f32x2 __attribute__((ext_vector_type(2)));
__device__ __forceinline__ f32x2 gelu_pk(f32x2 v) {
    const f32x2 av = __builtin_elementwise_abs(v), d = av * 0.2316418882f + 1.0f;
    f32x2 t; t.x = __builtin_amdgcn_rcpf(d.x); t.y = __builtin_amdgcn_rcpf(d.y);
    f32x2 q = t * 0.5307027145f + (-0.7265760135f); q = q * t + 0.7107068705f; q = q * t + (-0.142248368f); q = q * t + 0.127414796f; q = q * t;
    const f32x2 s = (v * v) * (-0.72134752044f);
    f32x2 e; e.x = __builtin_amdgcn_exp2f(s.x); e.y = __builtin_amdgcn_exp2f(s.y);
    const f32x2 m = v * (q * e), r = v - m;
    f32x2 o; o.x = v.x < 0.f ? m.x : r.x; o.y = v.y < 0.f ? m.y : r.y; return o;
}

template <int ACT  > struct EpiBf16 {
    static constexpr bool PERM = true, AFTER_DRAIN = false; static_assert(ACT == 0 || ACT == 1, "EpiBf16: ACT is 0 (none) or 1 (gelu_pk)");
    bf16_t* O; int ldc; const float* bias; int split_cols; size_t split_stride; float scale0;
    __device__ __forceinline__ void operator()(const f32x4 (&acc)[2][2][4][2], const Unit& u, int wr, int wc, int fr, int fq) const {
        const int row0 = u.pm * BM + wr * 64 + fr; int colt = u.pn * BM; bf16_t* base = O;
        float sc = 1.f; if (split_cols) { const int t = colt / split_cols; base += (size_t)t * split_stride; colt -= t * split_cols; if (t == 0) sc = scale0; }
        const int col0 = colt + wc * 32 + 8 * fq, bcol0 = u.pn * BM + wc * 32 + 8 * fq;
        f32x4 bv[2][2];
#pragma unroll
        for (int bj = 0; bj < 2; ++bj)
#pragma unroll
            for (int n = 0; n < 2; ++n) bv[bj][n] = bias ? *(const f32x4*)(bias + bcol0 + bj * HALF + 4 * n) : (f32x4){0.f, 0.f, 0.f, 0.f};
#pragma unroll
        for (int ai = 0; ai < 2; ++ai)
#pragma unroll
            for (int m = 0; m < 4; ++m) { bf16_t* rowp = base + (size_t)(row0 + ai * HALF + m * 16) * ldc + col0;
#pragma unroll
                for (int bj = 0; bj < 2; ++bj) { f32x4 v0 = acc[ai][bj][m][0] + bv[bj][0], v1 = acc[ai][bj][m][1] + bv[bj][1];
                    if (ACT == 1) { f32x2 a = gelu_pk((f32x2){v0[0], v0[1]}), b = gelu_pk((f32x2){v0[2], v0[3]}), c = gelu_pk((f32x2){v1[0], v1[1]}), d = gelu_pk((f32x2){v1[2], v1[3]});
                        v0 = (f32x4){a.x, a.y, b.x, b.y}; v1 = (f32x4){c.x, c.y, d.x, d.y}; }
                    v0 = v0 * sc; v1 = v1 * sc; u32x4 w; w.x = cvt_pk_bf16(v0[0], v0[1]); w.y = cvt_pk_bf16(v0[2], v0[3]); w.z = cvt_pk_bf16(v1[0], v1[1]); w.w = cvt_pk_bf16(v1[2], v1[3]);
                    *(u32x4*)(rowp + bj * HALF) = w; } }
    }
};

struct EpiResF32 {
    static constexpr bool PERM = true, AFTER_DRAIN = false;
    const float* base; float* out; int ldc; const float* ssq;
    __device__ __forceinline__ void operator()(const f32x4 (&acc)[2][2][4][2], const Unit& u, int wr, int wc, int fr_, int fq_) const {
        (void)fr_; (void)fq_; const int ln_ = lane_id(); const int fr = ln_ & 15, fq = ln_ >> 4;
        const int col0 = u.pn * BM + wc * 32 + 8 * fq;
#pragma unroll
        for (int ai = 0; ai < 2; ++ai)
#pragma unroll
            for (int m = 0; m < 4; ++m) { const int r = ai * HALF + wr * 64 + m * 16 + fr; const unsigned off = (unsigned)((u.pm * BM + r) * ldc + col0);
                const float rb = ssq ? __builtin_amdgcn_rsqf(ssq[2 * (u.pm * BM + r) + 1] * (1.0f / 512.0f) + 1e-6f) : 1.0f;
#pragma unroll
                for (int bj = 0; bj < 2; ++bj)
#pragma unroll
                    for (int n = 0; n < 2; ++n) { const f32x4 bs = *(const f32x4*)(base + off + bj * HALF + n * 4); *(f32x4*)(out + off + bj * HALF + n * 4) = bs + acc[ai][bj][m][n] * rb; } }
    }
};
__device__ __forceinline__ float silu_mul(float g, float u) { return g * u * __builtin_amdgcn_rcpf(1.0f + __builtin_amdgcn_exp2f(-1.4426950408889634f * g)); }
struct EpiSwiGLU {
    static constexpr bool PERM = true, AFTER_DRAIN = false;
    bf16_t* O; int ldc;
    __device__ __forceinline__ void operator()(const f32x4 (&acc)[2][2][4][2], const Unit& u, int wr, int wc, int fr_, int fq_) const {
        (void)fr_; (void)fq_; const int ln_ = lane_id(); const int fr = ln_ & 15, fq = ln_ >> 4;
        const int row0 = u.pm * BM + wr * 64 + fr, col0 = u.pn * HALF + wc * 32 + 8 * fq;
#pragma unroll
        for (int ai = 0; ai < 2; ++ai)
#pragma unroll
            for (int m = 0; m < 4; ++m) { bf16_t* rowp = O + (unsigned)((row0 + ai * HALF + m * 16) * ldc + col0);
                const f32x4 g0 = acc[ai][0][m][0], g1 = acc[ai][0][m][1], u0 = acc[ai][1][m][0], u1 = acc[ai][1][m][1];
                u32x4 w; w.x = cvt_pk_bf16(silu_mul(g0[0], u0[0]), silu_mul(g0[1], u0[1])); w.y = cvt_pk_bf16(silu_mul(g0[2], u0[2]), silu_mul(g0[3], u0[3]));
                w.z = cvt_pk_bf16(silu_mul(g1[0], u1[0]), silu_mul(g1[1], u1[1])); w.w = cvt_pk_bf16(silu_mul(g1[2], u1[2]), silu_mul(g1[3], u1[3]));
                *(u32x4*)rowp = w; }
    }
};
struct EpiRowScaleBf16 {
    static constexpr bool PERM = true, AFTER_DRAIN = false;
    bf16_t* O; int ldc; const float* rowscale;
    __device__ __forceinline__ void operator()(const f32x4 (&acc)[2][2][4][2], const Unit& u, int wr, int wc, int fr_, int fq_) const {
        (void)fr_; (void)fq_; const int ln_ = lane_id(); const int fr = ln_ & 15, fq = ln_ >> 4;
        const int row0 = u.pm * BM + wr * 64 + fr, col0 = u.pn * BM + wc * 32 + 8 * fq;
#pragma unroll
        for (int ai = 0; ai < 2; ++ai)
#pragma unroll
            for (int m = 0; m < 4; ++m) { const int row = row0 + ai * HALF + m * 16; const float sc = rowscale[row]; bf16_t* rowp = O + (unsigned)(row * ldc + col0);
#pragma unroll
                for (int bj = 0; bj < 2; ++bj) { const f32x4 v0 = acc[ai][bj][m][0] * sc, v1 = acc[ai][bj][m][1] * sc;
                    u32x4 w; w.x = cvt_pk_bf16(v0[0], v0[1]); w.y = cvt_pk_bf16(v0[2], v0[3]); w.z = cvt_pk_bf16(v1[0], v1[1]); w.w = cvt_pk_bf16(v1[2], v1[3]);
                    *(u32x4*)(rowp + bj * HALF) = w; } }
    }
};
__device__ __forceinline__ float fqsum(float v) { v += __shfl_xor(v, 16); v += __shfl_xor(v, 32); return v; }
__device__ __forceinline__ float dot4(const f32x4 a) { return (a[0] * a[0] + a[1] * a[1]) + (a[2] * a[2] + a[3] * a[3]); }
__device__ __forceinline__ u32x4 pack8g(const f32x4 a, const f32x4 b, const float (&g)[8], float r) {
    u32x4 w; w.x = cvt_pk_bf16(a[0] * r * g[0], a[1] * r * g[1]); w.y = cvt_pk_bf16(a[2] * r * g[2], a[3] * r * g[3]); w.z = cvt_pk_bf16(b[0] * r * g[4], b[1] * r * g[5]); w.w = cvt_pk_bf16(b[2] * r * g[6], b[3] * r * g[7]); return w; }
typedef unsigned u32x2_t __attribute__((ext_vector_type(2)));
__device__ __forceinline__ float clampf8(float v) { return __builtin_amdgcn_fmed3f(v, -448.0f, 448.0f); }
__device__ __forceinline__ u32x2_t pack8g_f8(const f32x4 a, const f32x4 b, const float (&g)[8], float r) {
    int w0 = 0, w1 = 0;
    w0 = __builtin_amdgcn_cvt_pk_fp8_f32(clampf8(a[0] * r * g[0]), clampf8(a[1] * r * g[1]), w0, false); w0 = __builtin_amdgcn_cvt_pk_fp8_f32(clampf8(a[2] * r * g[2]), clampf8(a[3] * r * g[3]), w0, true);
    w1 = __builtin_amdgcn_cvt_pk_fp8_f32(clampf8(b[0] * r * g[4]), clampf8(b[1] * r * g[5]), w1, false); w1 = __builtin_amdgcn_cvt_pk_fp8_f32(clampf8(b[2] * r * g[6]), clampf8(b[3] * r * g[7]), w1, true);
    return (u32x2_t){(unsigned)w0, (unsigned)w1}; }
__device__ __forceinline__ u32x4 pack8s(const f32x4 a, const f32x4 b, float r) {
    u32x4 w; w.x = cvt_pk_bf16(a[0] * r, a[1] * r); w.y = cvt_pk_bf16(a[2] * r, a[3] * r); w.z = cvt_pk_bf16(b[0] * r, b[1] * r); w.w = cvt_pk_bf16(b[2] * r, b[3] * r); return w; }
constexpr float kEps = 1e-6f;
struct EpiInProj {
    static constexpr bool PERM = true, AFTER_DRAIN = false;
    unsigned char* ws; const float *gq, *gk, *gkr;
    __device__ __forceinline__ void operator()(const f32x4 (&acc)[2][2][4][2], const Unit& u, int wr, int wc, int fr_, int fq_) const {
        (void)fr_; (void)fq_; const int ln_ = lane_id(); const int fr = ln_ & 15, fq = ln_ >> 4;
        const int G = 4 * u.pn + wc;
        if (G >= 23) return;
        const int row0 = u.pm * BM + wr * 64 + fr;
        bf16_t* const QA = (bf16_t*)(ws + WS_QA); bf16_t* const KA = (bf16_t*)(ws + WS_KA); bf16_t* const VA = (bf16_t*)(ws + WS_VA); bf16_t* const CQ = (bf16_t*)(ws + WS_CQ); bf16_t* const CKV = (bf16_t*)(ws + WS_CKV); bf16_t* const KR = (bf16_t*)(ws + WS_KR);
        float* const ssq_cq = (float*)(ws + WS_SSQCQ); float* const ssq_ckv = (float*)(ws + WS_SSQCKV); const float* const cosT = (const float*)(ws + WS_TAB) + TAB_COS; const float* const sinT = (const float*)(ws + WS_TAB) + TAB_SIN;
        constexpr float qscale = QSC_A; constexpr int seq = SEQ;
        if (G < 10) {
            const float* gg = (G < 8) ? gq : gk; const float sc = (G < 8) ? qscale : 1.0f; bf16_t* dst = (G < 8) ? QA + 64 * G : KA + 64 * (G - 8); const int ld = (G < 8) ? 512 : 128;
            float g0[8], g1[8];
#pragma unroll
            for (int j = 0; j < 8; ++j) { g0[j] = gg[8 * fq + j]; g1[j] = gg[32 + 8 * fq + j]; }
#pragma unroll
            for (int ai = 0; ai < 2; ++ai)
#pragma unroll
                for (int m = 0; m < 4; ++m) { const int row = row0 + ai * HALF + m * 16;
                    const float ss = fqsum((dot4(acc[ai][0][m][0]) + dot4(acc[ai][0][m][1])) + (dot4(acc[ai][1][m][0]) + dot4(acc[ai][1][m][1])));
                    const float r = sc * __builtin_amdgcn_rsqf(ss * (1.0f / 64.0f) + kEps); bf16_t* p = dst + (unsigned)(row * ld + 8 * fq);
                    *(u32x4*)p = pack8g(acc[ai][0][m][0], acc[ai][0][m][1], g0, r); *(u32x4*)(p + 32) = pack8g(acc[ai][1][m][0], acc[ai][1][m][1], g1, r); }
        } else if (G < 22) {
            bf16_t* dst; int ld; float* sq;
            if (G < 12) { dst = VA + 64 * (G - 10); ld = 128; sq = nullptr; } else if (G < 18) { dst = CQ + 64 * (G - 12); ld = 384; sq = ssq_cq; } else { dst = CKV + 64 * (G - 18); ld = 256; sq = ssq_ckv; }
#pragma unroll
            for (int ai = 0; ai < 2; ++ai)
#pragma unroll
                for (int m = 0; m < 4; ++m) { const int row = row0 + ai * HALF + m * 16; bf16_t* p = dst + (unsigned)(row * ld + 8 * fq);
                    if (sq) { const float ss = fqsum((dot4(acc[ai][0][m][0]) + dot4(acc[ai][0][m][1])) + (dot4(acc[ai][1][m][0]) + dot4(acc[ai][1][m][1]))); if (fq == 0) atomicAdd(sq + row, ss); }
                    *(u32x4*)p = pack8s(acc[ai][0][m][0], acc[ai][0][m][1], 1.0f); *(u32x4*)(p + 32) = pack8s(acc[ai][1][m][0], acc[ai][1][m][1], 1.0f); }
        } else {
            float g0[8];
#pragma unroll
            for (int j = 0; j < 8; ++j) g0[j] = gkr[8 * fq + j];
#pragma unroll
            for (int ai = 0; ai < 2; ++ai)
#pragma unroll
                for (int m = 0; m < 4; ++m) { const int row = row0 + ai * HALF + m * 16; const int s = row % seq;
                    const float ss = fqsum(dot4(acc[ai][0][m][0]) + dot4(acc[ai][0][m][1])); const float r = __builtin_amdgcn_rsqf(ss * (1.0f / 32.0f) + kEps);
                    float o[8];
#pragma unroll
                    for (int j = 0; j < 8; ++j) { const float y = ((j < 4) ? acc[ai][0][m][0][j & 3] : acc[ai][0][m][1][j & 3]) * r * g0[j]; const float pp = __shfl_xor(y, 32);
                        const int i16 = 8 * (fq & 1) + j; const float c = cosT[s * 16 + i16], sn = sinT[s * 16 + i16]; o[j] = (fq < 2) ? (y * c - pp * sn) : (pp * sn + y * c); }
                    u32x4 w; w.x = cvt_pk_bf16(o[0], o[1]); w.y = cvt_pk_bf16(o[2], o[3]); w.z = cvt_pk_bf16(o[4], o[5]); w.w = cvt_pk_bf16(o[6], o[7]);
                    *(u32x4*)(KR + (unsigned)((((row >> 12) * 64 + ((row >> 6) & 63)) * 2048) + fq * 512 + (row & 63) * 8)) = w; }
        }
    }
};
struct EpiQB {
    static constexpr bool PERM = true, AFTER_DRAIN = false;
    unsigned char* ws; const float *gqn, *gqr;
    __device__ __forceinline__ void operator()(const f32x4 (&acc)[2][2][4][2], const Unit& u, int wr, int wc, int fr_, int fq_) const {
        (void)fr_; (void)fq_; const int ln_ = lane_id(); const int fr = ln_ & 15, fq = ln_ >> 4;
        const int row0 = u.pm * BM + wr * 64 + fr;
        bf16_t* const QB = (bf16_t*)(ws + WS_QB); const float* const ssq_cq = (const float*)(ws + WS_SSQCQ); const float* const cosT = (const float*)(ws + WS_TAB) + TAB_COS; const float* const sinT = (const float*)(ws + WS_TAB) + TAB_SIN;
        constexpr float qscale = QSC_B; constexpr int seq = SEQ;
        if (u.pn < 2) {
            const int head = 4 * u.pn + wc; float g0[8], g1[8];
#pragma unroll
            for (int j = 0; j < 8; ++j) { g0[j] = gqn[8 * fq + j]; g1[j] = gqn[32 + 8 * fq + j]; }
#pragma unroll
            for (int ai = 0; ai < 2; ++ai)
#pragma unroll
                for (int m = 0; m < 4; ++m) { const int row = row0 + ai * HALF + m * 16; const float eps2 = kEps * (ssq_cq[row] * (1.0f / 384.0f) + kEps);
                    const float ss = fqsum((dot4(acc[ai][0][m][0]) + dot4(acc[ai][0][m][1])) + (dot4(acc[ai][1][m][0]) + dot4(acc[ai][1][m][1])));
                    const float r = (64.0f * qscale) * __builtin_amdgcn_rsqf(ss * (1.0f / 64.0f) + eps2); unsigned char* p = ws + WS_QN8 + (unsigned)(row * 512 + 64 * head + 8 * fq);
                    *(u32x2_t*)p = pack8g_f8(acc[ai][0][m][0], acc[ai][0][m][1], g0, r); *(u32x2_t*)(p + 32) = pack8g_f8(acc[ai][1][m][0], acc[ai][1][m][1], g1, r); }
        } else {
            float g0[8];
#pragma unroll
            for (int j = 0; j < 8; ++j) g0[j] = gqr[8 * fq + j];
#pragma unroll
            for (int ai = 0; ai < 2; ++ai)
#pragma unroll
                for (int m = 0; m < 4; ++m) { const int row = row0 + ai * HALF + m * 16; const int s = row % seq; const float eps2 = kEps * (ssq_cq[row] * (1.0f / 384.0f) + kEps);
#pragma unroll
                    for (int bj = 0; bj < 2; ++bj) { const int head = 2 * wc + bj;
                        const float ss = fqsum(dot4(acc[ai][bj][m][0]) + dot4(acc[ai][bj][m][1])); const float r = __builtin_amdgcn_rsqf(ss * (1.0f / 32.0f) + eps2);
                        float o[8];
#pragma unroll
                        for (int j = 0; j < 8; ++j) { const float y = ((j < 4) ? acc[ai][bj][m][0][j & 3] : acc[ai][bj][m][1][j & 3]) * r * g0[j]; const float pp = __shfl_xor(y, 32);
                            const int i16 = 8 * (fq & 1) + j; const float c = cosT[s * 16 + i16], sn = sinT[s * 16 + i16]; o[j] = qscale * ((fq < 2) ? (y * c - pp * sn) : (pp * sn + y * c)); }
                        u32x4 w; w.x = cvt_pk_bf16(o[0], o[1]); w.y = cvt_pk_bf16(o[2], o[3]); w.z = cvt_pk_bf16(o[4], o[5]); w.w = cvt_pk_bf16(o[6], o[7]);
                        *(u32x4*)(QB + (unsigned)(row * 768 + 96 * head + 64 + 8 * fq)) = w; } }
        }
    }
};
struct EpiKVB {
    static constexpr bool PERM = true, AFTER_DRAIN = false;
    unsigned char* ws; const float* gkn;
    __device__ __forceinline__ void operator()(const f32x4 (&acc)[2][2][4][2], const Unit& u, int wr, int wc, int fr_, int fq_) const {
        (void)fr_; (void)fq_; const int ln_ = lane_id(); const int fr = ln_ & 15, fq = ln_ >> 4;
        const int row0 = u.pm * BM + wr * 64 + fr, G = 4 * u.pn + wc, head = G >> 1;
        bf16_t* const KBN = (bf16_t*)(ws + WS_KBN); bf16_t* const VB = (bf16_t*)(ws + WS_VB); const float* const ssq_ckv = (const float*)(ws + WS_SSQCKV);
        if (!(G & 1)) {
            float g0[8], g1[8];
#pragma unroll
            for (int j = 0; j < 8; ++j) { g0[j] = gkn[8 * fq + j]; g1[j] = gkn[32 + 8 * fq + j]; }
#pragma unroll
            for (int ai = 0; ai < 2; ++ai)
#pragma unroll
                for (int m = 0; m < 4; ++m) { const int row = row0 + ai * HALF + m * 16; const float eps2 = kEps * (ssq_ckv[row] * (1.0f / 256.0f) + kEps);
                    const float ss = fqsum((dot4(acc[ai][0][m][0]) + dot4(acc[ai][0][m][1])) + (dot4(acc[ai][1][m][0]) + dot4(acc[ai][1][m][1])));
                    const float r = 8.0f * __builtin_amdgcn_rsqf(ss * (1.0f / 64.0f) + eps2);
                    unsigned char* p = (unsigned char*)KBN + (unsigned)(((((row >> 12) * 8 + head) * 64 + ((row >> 6) & 63)) * 4096) + (fq >> 1) * 1024 + (row & 63) * 16 + (fq & 1) * 8);
                    *(u32x2_t*)p = pack8g_f8(acc[ai][0][m][0], acc[ai][0][m][1], g0, r); *(u32x2_t*)(p + 2048) = pack8g_f8(acc[ai][1][m][0], acc[ai][1][m][1], g1, r); }
        } else {
#pragma unroll
            for (int ai = 0; ai < 2; ++ai)
#pragma unroll
                for (int m = 0; m < 4; ++m) { const int row = row0 + ai * HALF + m * 16; const float al = __builtin_amdgcn_rsqf(ssq_ckv[row] * (1.0f / 256.0f) + kEps); bf16_t* p = VB + (unsigned)(((((row >> 12) * 8 + head) * 64 + ((row >> 6) & 63)) * 4096) + ((row >> 4) & 3) * 512 + (row & 15) * 32 + 8 * fq);
                    *(u32x4*)p = pack8s(acc[ai][0][m][0], acc[ai][0][m][1], al); *(u32x4*)(p + 4 * 512) = pack8s(acc[ai][1][m][0], acc[ai][1][m][1], al); }
        }
    }
};

__device__ __forceinline__ float clamp448(float v) { return __builtin_fminf(__builtin_fmaxf(v, -448.0f), 448.0f); }
__device__ __forceinline__ unsigned pk4_fp8(float a, float b, float c, float d) { int w = 0; w = __builtin_amdgcn_cvt_pk_fp8_f32(clamp448(a), clamp448(b), w, false); w = __builtin_amdgcn_cvt_pk_fp8_f32(clamp448(c), clamp448(d), w, true); return (unsigned)w; }
__device__ __forceinline__ unsigned pk4_fp8_nc(float a, float b, float c, float d) { int w = 0; w = __builtin_amdgcn_cvt_pk_fp8_f32(a, b, w, false); w = __builtin_amdgcn_cvt_pk_fp8_f32(c, d, w, true); return (unsigned)w; }
struct EpiSwiGLU8 {
    static constexpr bool PERM = true, AFTER_DRAIN = false;
    unsigned char* O; int ldc; float oscale;
    __device__ __forceinline__ void operator()(const f32x4 (&acc)[2][2][4][2], const Unit& u, int wr, int wc, int fr_, int fq_) const {
        (void)fr_; (void)fq_; const int ln_ = lane_id(); const int fr = ln_ & 15, fq = ln_ >> 4;
        const int row0 = u.pm * BM + wr * 64 + fr, col0 = u.pn * HALF + wc * 32 + 8 * fq;
#pragma unroll
        for (int ai = 0; ai < 2; ++ai)
#pragma unroll
            for (int m = 0; m < 4; ++m) { unsigned char* rowp = O + (unsigned)((row0 + ai * HALF + m * 16) * ldc + col0);
                const f32x4 g0 = acc[ai][0][m][0], g1 = acc[ai][0][m][1], u0 = acc[ai][1][m][0], u1 = acc[ai][1][m][1];
                typedef unsigned u32x2 __attribute__((ext_vector_type(2))); u32x2 w;
                w.x = pk4_fp8(oscale * silu_mul(g0[0], u0[0]), oscale * silu_mul(g0[1], u0[1]), oscale * silu_mul(g0[2], u0[2]), oscale * silu_mul(g0[3], u0[3]));
                w.y = pk4_fp8(oscale * silu_mul(g1[0], u1[0]), oscale * silu_mul(g1[1], u1[1]), oscale * silu_mul(g1[2], u1[2]), oscale * silu_mul(g1[3], u1[3]));
                *(u32x2*)rowp = w; }
    }
};

struct EpiRowScaleF8 {
    static constexpr bool PERM = true, AFTER_DRAIN = false;
    unsigned char* O; int ldc; const float* rowscale; float oscale;
    __device__ __forceinline__ void operator()(const f32x4 (&acc)[2][2][4][2], const Unit& u, int wr, int wc, int fr_, int fq_) const {
        (void)fr_; (void)fq_; const int ln_ = lane_id(); const int fr = ln_ & 15, fq = ln_ >> 4;
        const int row0 = u.pm * BM + wr * 64 + fr, col0 = u.pn * BM + wc * 32 + 8 * fq;
#pragma unroll
        for (int ai = 0; ai < 2; ++ai)
#pragma unroll
            for (int m = 0; m < 4; ++m) { const int row = row0 + ai * HALF + m * 16; const float sc = rowscale[row] * oscale; unsigned char* rowp = O + (unsigned)(row * ldc + col0);
#pragma unroll
                for (int bj = 0; bj < 2; ++bj) { const f32x4 v0 = acc[ai][bj][m][0] * sc, v1 = acc[ai][bj][m][1] * sc;
                    typedef unsigned u32x2 __attribute__((ext_vector_type(2))); u32x2 w; w.x = pk4_fp8(v0[0], v0[1], v0[2], v0[3]); w.y = pk4_fp8(v1[0], v1[1], v1[2], v1[3]);
                    *(u32x2*)(rowp + bj * HALF) = w; } }
    }
};

struct EpiNormBf16 {
    static constexpr bool PERM = true, AFTER_DRAIN = false;
    bf16_t* O; int ldc; const float* ssq;
    __device__ __forceinline__ void operator()(const f32x4 (&acc)[2][2][4][2], const Unit& u, int wr, int wc, int fr_, int fq_) const {
        (void)fr_; (void)fq_; const int ln_ = lane_id(); const int fr = ln_ & 15, fq = ln_ >> 4;
        const int row0 = u.pm * BM + wr * 64 + fr, col0 = u.pn * BM + wc * 32 + 8 * fq;
#pragma unroll
        for (int ai = 0; ai < 2; ++ai)
#pragma unroll
            for (int m = 0; m < 4; ++m) { const int row = row0 + ai * HALF + m * 16; const float rb = __builtin_amdgcn_rsqf(ssq[2 * row + 1] * (1.0f / 512.0f) + 1e-6f); bf16_t* rowp = O + (unsigned)(row * ldc + col0);
#pragma unroll
                for (int bj = 0; bj < 2; ++bj) *(u32x4*)(rowp + bj * HALF) = pack8s(acc[ai][bj][m][0], acc[ai][bj][m][1], rb); }
    }
};
__device__ __forceinline__ void glds_sv(const char* sbase, unsigned voff, unsigned lds_dst) { unsigned keep;
    asm volatile("s_mov_b32 %0, m0\n\ts_mov_b32 m0, %3\n\ts_nop 0\n\tglobal_load_lds_dwordx4 %1, %2\n\ts_mov_b32 m0, %0" : "=&s"(keep) : "v"(voff), "s"(sbase), "s"(lds_dst) : "memory"); }
template <class Epi, class Sched, bool ALIGN_EPI = false, bool SP2 = false, int MODE = 0, bool F8 = false>
__device__ __forceinline__ void gemm_phase(PG8_LAS unsigned char* lds, const Gemm g, const Sched& S, const Epi& E) {
    const int lane = lane_id(), wid = g.wave, tid = wid * 64 + lane,
              wr = wid >> 2, wc = wid & 3, fr = lane & 15, fq = lane >> 4;
    int K_ = g.K; asm volatile("" : "+s"(K_));
    const int K = K_, nt = K / BK;
    unsigned voffA[2], voffB[2];
#pragma unroll
    for (int i = 0; i < 2; ++i) { int R, C; if constexpr (F8) stage_rc8(tid * 16 + i * 8192, R, C); else stage_rc(tid * 16 + i * 8192, R, C); const int Rb = Epi::PERM ? ((R & ~31) + perm32(R & 31)) : R;
        voffA[i] = (unsigned)(R * K + C) * 2u; voffB[i] = (unsigned)(Rb * K + C) * 2u; }
    const size_t r64step = (size_t)64 * K * 2;
    const size_t kstep = (size_t)(BK * 2);
    const size_t hstep = (size_t)HALF * K * 2;
    const size_t tstep = 2 * hstep;
    const unsigned ldsw = (unsigned)wid * 1024u;
    const unsigned ldsbase = (unsigned)__builtin_amdgcn_readfirstlane((int)((unsigned)(uintptr_t)lds + ldsw));
    const int aoff = lds_byte(wr * 64 + fr, fq * 8), boff = lds_byte(wc * 32 + fr, fq * 8);
    const int aoff8 = lds_byte8(wr * 64 + fr, fq * 32), boff8 = lds_byte8(wc * 32 + fr, fq * 32);
#define PG8_X16(x) ({ int t_; asm volatile("v_xor_b32 %0, 16, %1" : "=v"(t_) : "v"(x)); t_; })
    typedef int v8i32 __attribute__((ext_vector_type(8))); typedef short bf16x16 __attribute__((ext_vector_type(16)));
#define PG8_SA(b, h) (((b) * 2 + (h)) * HTB)
#define PG8_SB(b, h) ((4 + (b) * 2 + (h)) * HTB)
#define PG8_STAGE(bufoff, gbase, voff) do { _Pragma("unroll") for (int _i = 0; _i < 2; ++_i) \
        glds_sv((const char*)(gbase) + (size_t)_i * r64step, (voff)[0], ldsbase + (unsigned)((bufoff) + _i * 8192)); } while (0)
#define PG8_LDA(dst, b, h) do { if constexpr (F8) { const int a1_ = PG8_X16(aoff8); _Pragma("unroll") for (int m = 0; m < 4; ++m) { dst[m][0] = *(const PG8_LAS bf16x8*)(lds + PG8_SA(b, h) + aoff8 + m * 2048); dst[m][1] = *(const PG8_LAS bf16x8*)(lds + PG8_SA(b, h) + a1_ + m * 2048); } } \
        else { _Pragma("unroll") for (int m = 0; m < 4; ++m) _Pragma("unroll") for (int k = 0; k < 2; ++k) dst[m][k] = *(const PG8_LAS bf16x8*)(lds + PG8_SA(b, h) + aoff + k * 1024 + m * 2048); } } while (0)
#define PG8_LDB(dst, b, h) do { if constexpr (F8) { const int b1_ = PG8_X16(boff8); _Pragma("unroll") for (int n = 0; n < 2; ++n) { dst[n][0] = *(const PG8_LAS bf16x8*)(lds + PG8_SB(b, h) + boff8 + n * 2048); dst[n][1] = *(const PG8_LAS bf16x8*)(lds + PG8_SB(b, h) + b1_ + n * 2048); } } \
        else { _Pragma("unroll") for (int n = 0; n < 2; ++n) _Pragma("unroll") for (int k = 0; k < 2; ++k) dst[n][k] = *(const PG8_LAS bf16x8*)(lds + PG8_SB(b, h) + boff + k * 1024 + n * 2048); } } while (0)
#define PG8_F8FRAG(x) __builtin_bit_cast(v8i32, (bf16x16){x[0][0], x[0][1], x[0][2], x[0][3], x[0][4], x[0][5], x[0][6], x[0][7], x[1][0], x[1][1], x[1][2], x[1][3], x[1][4], x[1][5], x[1][6], x[1][7]})
#define PG8_MMA(ai, bj, At, Bt) do { __builtin_amdgcn_s_setprio(1); _Pragma("unroll") for (int m = 0; m < 4; ++m) _Pragma("unroll") for (int n = 0; n < 2; ++n) { \
        if constexpr (F8) { acc[ai][bj][m][n] = __builtin_amdgcn_mfma_scale_f32_16x16x128_f8f6f4(PG8_F8FRAG(Bt[n]), PG8_F8FRAG(At[m]), acc[ai][bj][m][n], 0, 0, 0, g.sA, 0, g.sA); }     \
        else { _Pragma("unroll") for (int k = 0; k < 2; ++k) acc[ai][bj][m][n] = __builtin_amdgcn_mfma_f32_16x16x32_bf16(Bt[n][k], At[m][k], acc[ai][bj][m][n], 0, 0, 0); } } __builtin_amdgcn_s_setprio(0); } while (0)
#define PG8_WAIT_V(n) asm volatile("s_waitcnt vmcnt(" #n ")" ::: "memory")
#define PG8_WAIT_L(n) asm volatile("s_waitcnt lgkmcnt(" #n ")" ::: "memory")
#define PG8_BAR __builtin_amdgcn_s_barrier()
#define PG8_SCHED __builtin_amdgcn_sched_barrier(0)
    Unit cur, nxt; int ui = 0;
    if (!S.next(0, cur)) return;
    f32x4 acc[2][2][4][2];
    bf16x8 At[4][2], B0[2][2], B1[2][2];
    const char* cA = (const char*)g.A + (MODE == 1 ? (size_t)0 : (size_t)cur.pm * tstep); const char* cB = (const char*)g.Bt + (size_t)cur.e * g.estride + (size_t)cur.pn * tstep;
    PG8_LAS unsigned* const gt = (PG8_LAS unsigned*)(lds + g.gtab);
#define PG8_GFILL(slot, u) do { const int t_ = wid * 64 + lane_id(); if (t_ < BM) gt[(slot) * BM + t_] = (unsigned)g.idx[(u).pm * BM + t_] * (unsigned)(K * 2); } while (0)
    if constexpr (MODE == 1) { PG8_GFILL(0, cur); __syncthreads(); }
    int gR0_, gC0_; if constexpr (F8) stage_rc8(tid * 16, gR0_, gC0_); else stage_rc(tid * 16, gR0_, gC0_); PG8_LAS unsigned* const gtl = gt + gR0_; const unsigned gcb = (unsigned)gC0_ * 2u;
#define PG8_STA(bufoff, gbase, H, NXT) do { if constexpr (MODE == 1) { const int slot_ = ((NXT) ? ui + 1 : ui) & 1; _Pragma("unroll") for (int _i = 0; _i < 2; ++_i) { \
        const unsigned vo_ = gtl[slot_ * BM + (H) * HALF + _i * 64] + gcb; glds_sv((const char*)(gbase), vo_, ldsbase + (unsigned)((bufoff) + _i * 8192)); } } \
        else { PG8_STAGE(bufoff, (gbase) + ((H) ? hstep : (size_t)0), voffA); } } while (0)
    S.a_ready(cur);
    if constexpr (SP2) {
        PG8_STAGE(PG8_SB(0, 0), cB, voffB); PG8_STAGE(PG8_SB(0, 1), cB + hstep, voffB); PG8_STA(PG8_SA(0, 0), cA, 0, false); PG8_STA(PG8_SA(0, 1), cA, 1, false);
        if (wr == 1) PG8_BAR;
        PG8_WAIT_V(2); PG8_BAR;
        PG8_STAGE(PG8_SB(1, 0), cB + kstep, voffB); PG8_STA(PG8_SA(1, 0), cA + kstep, 0, false); PG8_STAGE(PG8_SB(1, 1), cB + hstep + kstep, voffB);
        PG8_WAIT_V(6); PG8_BAR;
    } else {
        PG8_STAGE(PG8_SB(0, 0), cB, voffB); PG8_STAGE(PG8_SA(0, 0), cA, voffA); PG8_STAGE(PG8_SB(0, 1), cB + hstep, voffB); PG8_STAGE(PG8_SA(0, 1), cA + hstep, voffA);
        if (wr == 1) PG8_BAR;
        PG8_WAIT_V(4); PG8_BAR;
        PG8_STAGE(PG8_SB(1, 0), cB + kstep, voffB); PG8_STAGE(PG8_SA(1, 0), cA + kstep, voffA); PG8_STAGE(PG8_SB(1, 1), cB + hstep + kstep, voffB);
        PG8_WAIT_V(6); PG8_BAR;
    }
    for (;;) {
        const bool has_next = S.next(ui + 1, nxt);
#pragma unroll
        for (int a = 0; a < 2; ++a)
#pragma unroll
            for (int b = 0; b < 2; ++b)
#pragma unroll
                for (int m = 0; m < 4; ++m)
#pragma unroll
                    for (int n = 0; n < 2; ++n) acc[a][b][m][n] = (f32x4){0.f, 0.f, 0.f, 0.f};
        if constexpr (MODE == 1) { if (has_next) PG8_GFILL((ui + 1) & 1, nxt); else PG8_GFILL((ui + 1) & 1, cur); }
        const char* nA = (MODE == 1) ? cA : (has_next ? (const char*)g.A + (size_t)nxt.pm * tstep : cA); const char* nB = has_next ? (const char*)g.Bt + (size_t)nxt.e * g.estride + (size_t)nxt.pn * tstep : cB;
        int t = 0; do {
            const bool last = (t == nt - 2);
            if constexpr (MODE == 2) { if (t == nt / 2) {
#pragma unroll
                for (int ai = 0; ai < 2; ++ai)
#pragma unroll
                    for (int m = 0; m < 4; ++m) { const int row = cur.pm * BM + ai * HALF + wr * 64 + m * 16 + fr; const float sa = g.ssq[2 * row], sb = g.ssq[2 * row + 1];
                        const float ratio = __builtin_amdgcn_rsqf(sa * (1.0f / 512.0f) + 1e-6f) * __builtin_amdgcn_sqrtf(sb * (1.0f / 512.0f) + 1e-6f);
#pragma unroll
                        for (int bj = 0; bj < 2; ++bj)
#pragma unroll
                            for (int n = 0; n < 2; ++n) acc[ai][bj][m][n] *= ratio; } } }
            const char* a1 = cA + (size_t)(t + 1) * kstep;
            const char* a2 = last ? nA : cA + (size_t)(t + 2) * kstep; const char* b2 = last ? nB : cB + (size_t)(t + 2) * kstep;
            const char* a3 = a2 + kstep; const char* b3 = b2 + kstep;
            if (last && has_next) S.a_ready(nxt);
            if constexpr (SP2) {
            PG8_LDB(B0, 0, 0); PG8_LDB(B1, 0, 1); PG8_SCHED; PG8_LDA(At, 0, 0); PG8_STA(PG8_SA(1, 1), a1, 1, false);
            PG8_WAIT_V(8); PG8_WAIT_L(0); PG8_BAR; PG8_MMA(0, 0, At, B0); PG8_MMA(0, 1, At, B1); PG8_BAR; PG8_SCHED;
            PG8_LDA(At, 0, 1); PG8_STAGE(PG8_SB(0, 0), b2, voffB); PG8_STAGE(PG8_SB(0, 1), b2 + hstep, voffB); PG8_STA(PG8_SA(0, 0), a2, 0, last);
            PG8_WAIT_V(8); PG8_WAIT_L(0); PG8_BAR; PG8_MMA(1, 0, At, B0); PG8_MMA(1, 1, At, B1); PG8_BAR; PG8_SCHED;
            PG8_LDB(B0, 1, 0); PG8_LDB(B1, 1, 1); PG8_SCHED; PG8_LDA(At, 1, 0); PG8_STA(PG8_SA(0, 1), a2, 1, last);
            PG8_WAIT_V(8); PG8_WAIT_L(0); PG8_BAR; PG8_MMA(0, 0, At, B0); PG8_MMA(0, 1, At, B1); PG8_BAR; PG8_SCHED;
            PG8_LDA(At, 1, 1); PG8_STAGE(PG8_SB(1, 0), b3, voffB); PG8_STAGE(PG8_SB(1, 1), b3 + hstep, voffB); PG8_STA(PG8_SA(1, 0), a3, 0, last);
            PG8_WAIT_V(8); PG8_WAIT_L(0); PG8_BAR; PG8_MMA(1, 0, At, B0); PG8_MMA(1, 1, At, B1); PG8_BAR; PG8_SCHED;
            } else {
            PG8_LDB(B0, 0, 0); PG8_SCHED; PG8_LDA(At, 0, 0); PG8_STAGE(PG8_SA(1, 1), a1 + hstep, voffA);
            PG8_WAIT_L(8); PG8_BAR; PG8_WAIT_L(0); PG8_MMA(0, 0, At, B0); PG8_BAR; PG8_SCHED;
            PG8_LDB(B1, 0, 1); PG8_STAGE(PG8_SB(0, 0), b2, voffB);
            PG8_BAR; PG8_WAIT_L(0); PG8_MMA(0, 1, At, B1); PG8_BAR;
            PG8_LDA(At, 0, 1); PG8_STAGE(PG8_SA(0, 0), a2, voffA);
            PG8_BAR; PG8_WAIT_L(0); PG8_MMA(1, 0, At, B0); PG8_BAR; PG8_SCHED;
            PG8_STAGE(PG8_SB(0, 1), b2 + hstep, voffB);
            PG8_WAIT_V(6); PG8_BAR; PG8_MMA(1, 1, At, B1); PG8_BAR;
            PG8_LDB(B0, 1, 0); PG8_SCHED; PG8_LDA(At, 1, 0); PG8_STAGE(PG8_SA(0, 1), a2 + hstep, voffA);
            PG8_WAIT_L(8); PG8_BAR; PG8_WAIT_L(0); PG8_MMA(0, 0, At, B0); PG8_BAR; PG8_SCHED;
            PG8_LDB(B1, 1, 1); PG8_STAGE(PG8_SB(1, 0), b3, voffB);
            PG8_BAR; PG8_WAIT_L(0); PG8_MMA(0, 1, At, B1); PG8_BAR;
            PG8_LDA(At, 1, 1); PG8_STAGE(PG8_SA(1, 0), a3, voffA);
            PG8_BAR; PG8_WAIT_L(0); PG8_MMA(1, 0, At, B0); PG8_BAR; PG8_SCHED;
            PG8_STAGE(PG8_SB(1, 1), b3 + hstep, voffB);
            PG8_WAIT_V(6); PG8_BAR; PG8_MMA(1, 1, At, B1); PG8_BAR;
            }
        t += 2; } while (t < nt);
        if constexpr (ALIGN_EPI) { if (wr == 0) PG8_BAR; }
        if constexpr (!Epi::AFTER_DRAIN) { E(acc, cur, wr, wc, fr, fq); S.done(cur); }
        if (!has_next) break;
        cur = nxt; cA = nA; cB = nB; ++ui;
        if constexpr (ALIGN_EPI) { if (wr == 1) PG8_BAR; }
    }
    PG8_WAIT_V(0);
    if constexpr (!ALIGN_EPI) { if (wr == 0) PG8_BAR; }
    PG8_BAR;
    if constexpr (Epi::AFTER_DRAIN) { E.fused(acc, cur, wr, wc, fr, fq, lds, wid, lane); S.done(cur); }
#undef PG8_SA
#undef PG8_SB
#undef PG8_STAGE
#undef PG8_LDA
#undef PG8_LDB
#undef PG8_MMA
#undef PG8_F8FRAG
#undef PG8_X16
#undef PG8_WAIT_V
#undef PG8_WAIT_L
#undef PG8_BAR
#undef PG8_SCHED
#undef PG8_STA
#undef PG8_GFILL
}
}
#define GAS __attribute__((address_space(1)))
#define LAS __attribute__((address_space(3)))
typedef unsigned short bf16;
typedef unsigned v4u __attribute__((ext_vector_type(4)));
typedef float f32x4 __attribute__((ext_vector_type(4)));
typedef short bf16x8 __attribute__((ext_vector_type(8)));
typedef GAS unsigned gu32;
typedef GAS unsigned long long gu64;
#define RLX_AGENT __ATOMIC_RELAXED, __HIP_MEMORY_SCOPE_AGENT
#define LDS_WAIT() asm volatile("s_waitcnt lgkmcnt(0)" ::: "memory")
#define VM_WAIT() asm volatile("s_waitcnt vmcnt(0)" ::: "memory")
__device__ __forceinline__ unsigned long long rt() { return __builtin_amdgcn_s_memrealtime(); }
__device__ __forceinline__ unsigned f2bf(float f) { unsigned u = __builtin_bit_cast(unsigned, f); return (u + 0x7fffu + ((u >> 16) & 1u)) >> 16; }
__device__ __forceinline__ unsigned pk2(float lo, float hi) { return f2bf(lo) | (f2bf(hi) << 16); }

#define XB_TMO      128
#define XB_XCNT(j)  (256  + 64 * (j))
#define XB_XSUB(j)  (1280 + 64 * (j))
#define XB_XGEN(j)  (2304 + 64 * (j))
#define XB_TOP      3328
#define XB_TOPGEN   3392
#define XCD_BAR_WORDS 3456
#define XB_SPIN_CAP (1u << 18)

__device__ __forceinline__ unsigned xb_ld(unsigned* p)              { return __hip_atomic_load(p, __ATOMIC_RELAXED, __HIP_MEMORY_SCOPE_AGENT); }
__device__ __forceinline__ unsigned xb_add(unsigned* p, unsigned v) { return __hip_atomic_fetch_add(p, v, __ATOMIC_RELAXED, __HIP_MEMORY_SCOPE_AGENT); }
__device__ __forceinline__ unsigned xb_xcc_id() { return (unsigned)__builtin_amdgcn_s_getreg((3 << 11) | 20) & 0xFu; }
#define XB_SPIN(cond, bar) do { unsigned _sp = 0; while (cond) { __builtin_amdgcn_s_sleep(1); \
    if ((++_sp & 255u) == 0u) { if (xb_ld(&(bar)[XB_TMO])) break; if (_sp > XB_SPIN_CAP) { atomicAdd(&(bar)[XB_TMO], 1u); break; } } } } while (0)

struct XcdBarrier {
    int wave;
    unsigned* bar; unsigned x;
    volatile LAS unsigned* st;
};

__device__ __forceinline__ XcdBarrier xcd_barrier_post(unsigned* bar, volatile LAS unsigned* st) {
    XcdBarrier b; b.wave = __builtin_amdgcn_readfirstlane((int)(threadIdx.x >> 6)); b.bar = bar; b.x = xb_xcc_id(); b.st = st;
    if (threadIdx.x == 0) (void)xb_add(&bar[XB_XCNT(b.x)], 1u);
    return b;
}
__device__ __forceinline__ void xcd_barrier_complete(unsigned* bar, unsigned x, unsigned& nloc, unsigned& nx) {
    const unsigned G = gridDim.x * gridDim.y * gridDim.z;
    unsigned sum, cnt, mine, sp = 0u;
    for (;;) {
        sum = 0u; cnt = 0u; mine = 0u;
#pragma unroll
        for (unsigned j = 0; j < 16; ++j) { const unsigned c = xb_ld(&bar[XB_XCNT(j)]); sum += c; cnt += (c > 0u) ? 1u : 0u; mine = (j == x) ? c : mine; }
        if (sum == G) break;
        __builtin_amdgcn_s_sleep(1);
        if ((++sp & 255u) == 0u) { if (xb_ld(&bar[XB_TMO])) break; if (sp > XB_SPIN_CAP) { atomicAdd(&bar[XB_TMO], 1u); break; } }
    }
    nloc = mine > 0u ? mine : 1u; nx = cnt > 0u ? cnt : 1u;
}

__device__ __forceinline__ void xcd_barrier(const XcdBarrier& b) {
    asm volatile("s_waitcnt vmcnt(0)" ::: "memory");
    __syncthreads();
    if (b.wave == 0 && lane_id() == 0) {
        unsigned* bar = b.bar;
        __builtin_amdgcn_s_waitcnt(0);
        unsigned nloc = b.st[0], nx = b.st[1];
        if (nloc == 0u) { xcd_barrier_complete(bar, b.x, nloc, nx); b.st[0] = nloc; b.st[1] = nx; }
        const unsigned old = xb_add(&bar[XB_XSUB(b.x)], 1u);
        const unsigned gen = old / nloc;
        if (old + 1u == (gen + 1u) * nloc) {
            __builtin_amdgcn_fence(__ATOMIC_RELEASE, "agent");
            asm volatile("s_waitcnt vmcnt(0)" ::: "memory");
            const unsigned og = xb_add(&bar[XB_TOP], 1u);
            const unsigned tg = og / nx;
            if (og + 1u == (tg + 1u) * nx) xb_add(&bar[XB_TOPGEN], 1u);
            else XB_SPIN(xb_ld(&bar[XB_TOPGEN]) == tg, bar);
            __builtin_amdgcn_fence(__ATOMIC_ACQUIRE, "agent");
            xb_add(&bar[XB_XGEN(b.x)], 1u);
            asm volatile("s_waitcnt vmcnt(0)" ::: "memory");
        } else {
            XB_SPIN(xb_ld(&bar[XB_XGEN(b.x)]) == gen, bar);
            __builtin_amdgcn_fence(__ATOMIC_ACQUIRE, "agent");
            asm volatile("s_waitcnt vmcnt(0)" ::: "memory");
        }
    }
    __syncthreads();
}

struct Frame {
    LAS unsigned char* lds;
    volatile LAS unsigned* MISC;
    gu32* ctl;
    int wave;
    int vcu, G;
    const float* in[23];
    float* out;
    unsigned char* ws;
};
#define WSP(T_, off) ((T_*)(F.ws + (off)))
__device__ __forceinline__ float wave_sum(float v) {
#pragma unroll
    for (int o = 1; o < 64; o <<= 1) v += __shfl_xor(v, o);
    return v;
}
__device__ __forceinline__ float grp_sum8(float v) { v += __shfl_xor(v, 1); v += __shfl_xor(v, 2); v += __shfl_xor(v, 4); return v; }
__device__ __forceinline__ float grp_sum4(float v) { v += __shfl_xor(v, 1); v += __shfl_xor(v, 2); return v; }
__device__ __forceinline__ void unpack8(const v4u w, float (&f)[8]) {
#pragma unroll
    for (int i = 0; i < 4; ++i) { f[2 * i] = __uint_as_float(w[i] << 16); f[2 * i + 1] = __uint_as_float(w[i] & 0xffff0000u); }
}
__device__ __forceinline__ v4u pack8(const float (&f)[8]) { v4u o; o.x = pk2(f[0], f[1]); o.y = pk2(f[2], f[3]); o.z = pk2(f[4], f[5]); o.w = pk2(f[6], f[7]); return o; }

__device__ __forceinline__ int t5_bucket(int rel) {
    const int base = rel > 0 ? 16 : 0; const int n = rel < 0 ? -rel : rel;
    const float nf = (float)(n > 1 ? n : 1);
    int large = 8 + (int)(logf(nf * 0.125f) / 2.772588722239781f * 8.0f + 1e-4f);
    large = large < 15 ? large : 15;
    return base + (n < 8 ? n : large);
}

template <class RowMap>
__device__ __forceinline__ void p0_transpose_item(const float* W, int K, int N, bf16* WT, const float* gain, LAS float* scr, int item, int lane, RowMap rowmap) {
    const int nblk = N / 32, kb = item / nblk, nb = item % nblk, k0 = 64 * kb, n0 = 32 * nb;
#pragma unroll 4
    for (int i = 0; i < 32; ++i) { const int kk = 2 * i + (lane >> 5); const float g = gain ? gain[k0 + kk] : 1.0f; scr[kk * 33 + (lane & 31)] = g * W[(size_t)(k0 + kk) * N + n0 + (lane & 31)]; }
    LDS_WAIT(); asm volatile("" ::: "memory");
    const int c = lane & 7;
#pragma unroll
    for (int j = 0; j < 4; ++j) { const int n = (lane >> 3) + 8 * j; const LAS float* s = scr + (8 * c) * 33 + n;
        v4u o; o.x = pk2(s[0 * 33], s[1 * 33]); o.y = pk2(s[2 * 33], s[3 * 33]); o.z = pk2(s[4 * 33], s[5 * 33]); o.w = pk2(s[6 * 33], s[7 * 33]);
        *(GAS v4u*)(WT + (size_t)rowmap(n0 + n) * K + k0 + 8 * c) = o; }
    LDS_WAIT(); asm volatile("" ::: "memory");
}
struct RowId { __device__ __forceinline__ int operator()(int n) const { return n; } };
struct RowG64 { __device__ __forceinline__ int operator()(int n) const { return (n & ~255) + 128 * ((n >> 5) & 1) + 32 * ((n >> 6) & 3) + (n & 31); } };
struct RowQB { __device__ __forceinline__ int operator()(int n) const { const int h = n / 96, dd = n % 96; return dd < 64 ? (h >> 2) * 256 + 128 * (dd >> 5) + 32 * (h & 3) + (dd & 31) : 512 + 128 * (h & 1) + 32 * (h >> 1) + (dd - 64); } };
struct RowGU { int up; __device__ __forceinline__ int operator()(int n) const { return (n >> 7) * 256 + up * 128 + (n & 127); } };

template <class RowMap>
__device__ __forceinline__ void p0_transpose_item_f8(const float* W, int K, int N, unsigned char* WT, float wscale, LAS float* scr, int item, int lane, RowMap rowmap) {
    const int nblk = N / 32, kb = item / nblk, nb = item % nblk, k0 = 64 * kb, n0 = 32 * nb;
#pragma unroll 4
    for (int i = 0; i < 32; ++i) { const int kk = 2 * i + (lane >> 5); scr[kk * 33 + (lane & 31)] = wscale * W[(size_t)(k0 + kk) * N + n0 + (lane & 31)]; }
    LDS_WAIT(); asm volatile("" ::: "memory");
    const int c = lane & 3;
#pragma unroll
    for (int j = 0; j < 2; ++j) { const int n = (lane >> 2) + 16 * j; const LAS float* s = scr + (16 * c) * 33 + n;
        v4u o; o.x = pg8::pk4_fp8(s[0 * 33], s[1 * 33], s[2 * 33], s[3 * 33]); o.y = pg8::pk4_fp8(s[4 * 33], s[5 * 33], s[6 * 33], s[7 * 33]);
        o.z = pg8::pk4_fp8(s[8 * 33], s[9 * 33], s[10 * 33], s[11 * 33]); o.w = pg8::pk4_fp8(s[12 * 33], s[13 * 33], s[14 * 33], s[15 * 33]);
        *(GAS v4u*)(WT + (size_t)rowmap(n0 + n) * K + k0 + 16 * c) = o; }
    LDS_WAIT(); asm volatile("" ::: "memory");
}
__device__ __forceinline__ void p0_prologue(Frame& F) {
    LAS float* scr = (LAS float*)(F.lds + RING_OFF + F.wave * 16384);
    const int gw = F.vcu * NWAVES + F.wave, NGW = F.G * NWAVES;
    constexpr int I_IN = (DM / 64) * (INW / 32), I_QB = (QL / 64) * (BH * QKD / 32), I_KVB = (KVL / 64) * (BH * 128 / 32), I_O = (DM / 64) * (DM / 32), I_E = (DM / 64) * (FF / 32);
    constexpr int NITEMS = I_IN + I_QB + I_KVB + I_O + NE * 3 * I_E;
    bf16* Win_t = WSP(bf16, WS_WIN); bf16* Wqb_t = WSP(bf16, WS_WQB); bf16* Wkvb_t = WSP(bf16, WS_WKVB); bf16* Wo_t = WSP(bf16, WS_WO); bf16* Wgu_t = WSP(bf16, WS_WGU); bf16* Wd_t = WSP(bf16, WS_WD);
    const int nitems = (F.G == 256) ? NITEMS - NE * 3 * I_E : NITEMS;
    for (int it = gw; it < nitems; it += NGW) {
        int r = it;
        if (r < I_IN) { p0_transpose_item(F.in[3], DM, INW, Win_t, F.in[2], scr, r, lane_id(), RowG64{}); continue; } r -= I_IN;
        if (r < I_QB) { p0_transpose_item(F.in[8], QL, BH * QKD, Wqb_t, F.in[7], scr, r, lane_id(), RowQB{}); continue; } r -= I_QB;
        if (r < I_KVB) { p0_transpose_item(F.in[10], KVL, BH * 128, Wkvb_t, F.in[9], scr, r, lane_id(), RowG64{}); continue; } r -= I_KVB;
        if (r < I_O) { const int kb = r / (DM / 32); const float* g = (kb < 8) ? F.in[15] : (F.in[16] - 512);
            p0_transpose_item(F.in[17], DM, DM, Wo_t, g, scr, r, lane_id(), RowId{}); continue; } r -= I_O;
        const int e = r / (3 * I_E), q = r % (3 * I_E), which = q / I_E, item = q % I_E;
        if (which == 0) p0_transpose_item_f8(F.in[20] + (size_t)e * DM * FF, DM, FF, (unsigned char*)Wgu_t + (size_t)e * 2 * FF * DM, 32.0f, scr, item, lane_id(), RowGU{0});
        else if (which == 1) p0_transpose_item_f8(F.in[21] + (size_t)e * DM * FF, DM, FF, (unsigned char*)Wgu_t + (size_t)e * 2 * FF * DM, 32.0f, scr, item, lane_id(), RowGU{1});
        else p0_transpose_item_f8(F.in[22] + (size_t)e * FF * DM, FF, DM, (unsigned char*)Wd_t + (size_t)e * DM * FF, 16.0f, scr, item, lane_id(), RowId{});
    }
    { const int nchunk = (NZ - INW) * DM / 8; for (int c = gw * 64 + lane_id(); c < nchunk; c += NGW * 64) { const int n = INW + c / (DM / 8), k8 = c % (DM / 8); *(GAS v4u*)(Win_t + (size_t)RowG64{}(n) * DM + (size_t)k8 * 8) = (v4u){0u, 0u, 0u, 0u}; } }
    bf16* XN = WSP(bf16, WS_XN);
    for (int m = gw; m < T; m += NGW) {
        const GAS f32x4* xr = (const GAS f32x4*)(F.in[0] + (size_t)m * DM) + lane_id();
        f32x4 v[4]; float s = 0.f;
#pragma unroll
        for (int j = 0; j < 4; ++j) { v[j] = xr[64 * j]; s += (v[j].x * v[j].x + v[j].y * v[j].y) + (v[j].z * v[j].z + v[j].w * v[j].w); }
        const float rs = 1.0f / sqrtf(wave_sum(s) * (1.f / DM) + EPS);
        GAS unsigned long long* o8 = (GAS unsigned long long*)(XN + (size_t)m * DM) + lane_id();
#pragma unroll
        for (int j = 0; j < 4; ++j) o8[64 * j] = (unsigned long long)pk2(v[j].x * rs, v[j].y * rs) | ((unsigned long long)pk2(v[j].z * rs, v[j].w * rs) << 32);
    }
    float* TAB = WSP(float, WS_TAB);
    if (blockIdx.x == 0) {
        const float* rel_bias = F.in[1];
        for (int i = (F.wave * 64 + lane_id()); i < 8 * NTAB; i += NWAVES * 64) { const int h = i / NTAB, rel = i % NTAB - 128; TAB[TAB_BIAS + i] = rel_bias[t5_bucket(rel) * A_HEADS + h] * LOG2E; }
        if (F.wave == 0) {
            const float ga = fabsf(F.in[4][lane_id()] * F.in[5][lane_id()]); float mb = 0.f; for (int i = lane_id(); i < 32 * 8; i += 64) mb = fmaxf(mb, rel_bias[i]);
            const float gb = fabsf(F.in[11][lane_id()] * F.in[13][lane_id()]); const float gqr = (lane_id() < 32) ? fabsf(F.in[12][lane_id()]) : 0.f, gkr = (lane_id() < 32) ? fabsf(F.in[14][lane_id()]) : 0.f;
            float mga = ga, mgb = gb, mqr = gqr, mkr = gkr;
#pragma unroll
            for (int o = 1; o < 64; o <<= 1) { mga = fmaxf(mga, __shfl_xor(mga, o)); mgb = fmaxf(mgb, __shfl_xor(mgb, o)); mqr = fmaxf(mqr, __shfl_xor(mqr, o)); mkr = fmaxf(mkr, __shfl_xor(mkr, o)); mb = fmaxf(mb, __shfl_xor(mb, o)); }
            if (lane_id() == 0) { TAB[TAB_CONST + 0] = (8.0f * mga + mb) * LOG2E + 1.0f; TAB[TAB_CONST + 1] = 0.10206207261596577f * (64.f * mgb + 32.f * mqr * mkr) * LOG2E + 1.0f; }
        }
    }
    for (int i = gw * 64 + lane_id(); i < SEQ * 16; i += NGW * 64) { const int s = i >> 4, k = i & 15; const float freq = powf(10000.0f, -(float)(2 * k) / 32.0f); const float ang = (float)s * freq;
        TAB[TAB_COS + i] = cosf(ang); TAB[TAB_SIN + i] = sinf(ang); }
}

__device__ __forceinline__ void p2_fixup(Frame& F) {
    const int gw = F.vcu * NWAVES + F.wave, NGW = F.G * NWAVES; const int lane = lane_id();
    const bf16* Z = WSP(bf16, WS_Z); bf16* QA = WSP(bf16, WS_QA); bf16* KA = WSP(bf16, WS_KA); bf16* VA = WSP(bf16, WS_VA); bf16* CQ = WSP(bf16, WS_CQ); bf16* CKV = WSP(bf16, WS_CKV); bf16* KR = WSP(bf16, WS_KR);
    const float* TAB = WSP(float, WS_TAB);
    const float* gq = F.in[4]; const float* gk = F.in[5]; const float* gkr = F.in[14];
    float gqv[8], gkv[8], gkrv[8];
#pragma unroll
    for (int j = 0; j < 8; ++j) { gqv[j] = gq[(8 * lane) % 64 + j]; gkv[j] = gk[(8 * lane) % 64 + j]; gkrv[j] = gkr[(8 * lane) % 32 + j]; }
    for (int m = gw; m < T; m += NGW) {
        const bf16* zr = Z + (size_t)m * NZ; const int s = m % SEQ; float f[8], o[8];
        { unpack8(*(const GAS v4u*)(zr + 8 * lane), f); float ss = 0.f;
#pragma unroll
          for (int j = 0; j < 8; ++j) ss += f[j] * f[j];
          const float r = QSC_A / sqrtf(grp_sum8(ss) * (1.f / 64.f) + EPS);
#pragma unroll
          for (int j = 0; j < 8; ++j) o[j] = f[j] * r * gqv[j];
          *(GAS v4u*)(QA + (size_t)m * 512 + 8 * lane) = pack8(o); }
        { const int l2 = lane & 31; const v4u w = *(const GAS v4u*)(zr + 512 + 8 * l2); unpack8(w, f); float ss = 0.f;
#pragma unroll
          for (int j = 0; j < 8; ++j) ss += f[j] * f[j];
          const float r = 1.0f / sqrtf(grp_sum8(ss) * (1.f / 64.f) + EPS);
#pragma unroll
          for (int j = 0; j < 8; ++j) o[j] = f[j] * r * gkv[j];
          if (lane < 16) *(GAS v4u*)(KA + (size_t)m * 128 + 8 * lane) = pack8(o);
          else if (lane < 32) *(GAS v4u*)(VA + (size_t)m * 128 + 8 * (lane - 16)) = w; }
        { const int l2 = lane < 48 ? lane : 0; unpack8(*(const GAS v4u*)(zr + 768 + 8 * l2), f); float ss = 0.f;
#pragma unroll
          for (int j = 0; j < 8; ++j) ss += f[j] * f[j];
          if (lane >= 48) ss = 0.f;
          const float r = 1.0f / sqrtf(wave_sum(ss) * (1.f / 384.f) + EPS);
#pragma unroll
          for (int j = 0; j < 8; ++j) o[j] = f[j] * r;
          if (lane < 48) *(GAS v4u*)(CQ + (size_t)m * QL + 8 * lane) = pack8(o); }
        { const int l2 = lane & 31; unpack8(*(const GAS v4u*)(zr + 1152 + 8 * l2), f); float ss = 0.f;
#pragma unroll
          for (int j = 0; j < 8; ++j) ss += f[j] * f[j];
          if (lane >= 32) ss = 0.f;
          const float r = 1.0f / sqrtf(wave_sum(ss) * (1.f / 256.f) + EPS);
#pragma unroll
          for (int j = 0; j < 8; ++j) o[j] = f[j] * r;
          if (lane < 32) *(GAS v4u*)(CKV + (size_t)m * KVL + 8 * lane) = pack8(o); }
        { const int l2 = lane & 3; unpack8(*(const GAS v4u*)(zr + 1408 + 8 * l2), f); float ss = 0.f;
#pragma unroll
          for (int j = 0; j < 8; ++j) ss += f[j] * f[j];
          const float r = 1.0f / sqrtf(grp_sum4(ss) * (1.f / 32.f) + EPS);
#pragma unroll
          for (int j = 0; j < 8; ++j) { const float y = f[j] * r * gkrv[j]; const float p = __shfl_xor(y, 2); const int i = (8 * l2 + j) & 15;
              const float c = TAB[TAB_COS + s * 16 + i], sn = TAB[TAB_SIN + s * 16 + i];
              o[j] = (l2 < 2) ? (y * c - p * sn) : (p * sn + y * c); }
          if (lane < 4) *(GAS v4u*)(KR + (size_t)m * ROPE + 8 * lane) = pack8(o); }
    }
}

__device__ __forceinline__ void p4_fixup(Frame& F) {
    const int gw = F.vcu * NWAVES + F.wave, NGW = F.G * NWAVES; const int lane = lane_id();
    bf16* QB = WSP(bf16, WS_QB); const bf16* KVR = WSP(bf16, WS_KVRAW); bf16* KBN = WSP(bf16, WS_KBN); bf16* VB = WSP(bf16, WS_VB);
    const float* TAB = WSP(float, WS_TAB);
    float gqn[8], gkn[8], gqr[8];
#pragma unroll
    for (int j = 0; j < 8; ++j) { gqn[j] = F.in[11][8 * (lane & 7) + j]; gkn[j] = F.in[13][8 * (lane & 7) + j]; gqr[j] = F.in[12][8 * (lane & 3) + j]; }
    for (int m = gw; m < T; m += NGW) {
        const int s = m % SEQ; float f[8], o[8];
        bf16* qrow = QB + (size_t)m * (BH * QKD);
        { bf16* p = qrow + QKD * (lane >> 3) + 8 * (lane & 7); unpack8(*(const GAS v4u*)p, f); float ss = 0.f;
#pragma unroll
          for (int j = 0; j < 8; ++j) ss += f[j] * f[j];
          const float r = QSC_B / sqrtf(grp_sum8(ss) * (1.f / 64.f) + EPS);
#pragma unroll
          for (int j = 0; j < 8; ++j) o[j] = f[j] * r * gqn[j];
          *(GAS v4u*)p = pack8(o); }
        { const int l2 = lane & 31; bf16* p = qrow + QKD * (l2 >> 2) + NOPE + 8 * (l2 & 3); unpack8(*(const GAS v4u*)p, f); float ss = 0.f;
#pragma unroll
          for (int j = 0; j < 8; ++j) ss += f[j] * f[j];
          const float r = 1.0f / sqrtf(grp_sum4(ss) * (1.f / 32.f) + EPS);
#pragma unroll
          for (int j = 0; j < 8; ++j) { const float y = f[j] * r * gqr[j]; const float pp = __shfl_xor(y, 2); const int i = (8 * (l2 & 3) + j) & 15;
              const float c = TAB[TAB_COS + s * 16 + i], sn = TAB[TAB_SIN + s * 16 + i];
              o[j] = QSC_B * (((l2 & 3) < 2) ? (y * c - pp * sn) : (pp * sn + y * c)); }
          if (lane < 32) *(GAS v4u*)p = pack8(o); }
        { const bf16* p = KVR + (size_t)m * 1024 + 128 * (lane >> 3) + 8 * (lane & 7); unpack8(*(const GAS v4u*)p, f); float ss = 0.f;
#pragma unroll
          for (int j = 0; j < 8; ++j) ss += f[j] * f[j];
          const float r = 1.0f / sqrtf(grp_sum8(ss) * (1.f / 64.f) + EPS);
#pragma unroll
          for (int j = 0; j < 8; ++j) o[j] = f[j] * r * gkn[j];
          *(GAS v4u*)(KBN + (size_t)m * 512 + 64 * (lane >> 3) + 8 * (lane & 7)) = pack8(o);
          *(GAS v4u*)(VB + (size_t)m * 512 + 64 * (lane >> 3) + 8 * (lane & 7)) = *(const GAS v4u*)(p + 64); }
    }
}

__device__ __forceinline__ void p6_onorm(Frame& F) {
    const int gw = F.vcu * NWAVES + F.wave, NGW = F.G * NWAVES; const int lane = lane_id();
    bf16* O = WSP(bf16, WS_O);
    for (int m = gw; m < T; m += NGW) {
#pragma unroll
        for (int hf = 0; hf < 2; ++hf) { bf16* p = O + (size_t)m * DM + 512 * hf + 8 * lane; float f[8], o[8]; unpack8(*(const GAS v4u*)p, f); float ss = 0.f;
#pragma unroll
            for (int j = 0; j < 8; ++j) ss += f[j] * f[j];
            const float r = 1.0f / sqrtf(wave_sum(ss) * (1.f / 512.f) + EPS);
#pragma unroll
            for (int j = 0; j < 8; ++j) o[j] = f[j] * r;
            *(GAS v4u*)p = pack8(o); }
    }
}

__device__ __forceinline__ float red16(float (&v)[16], int lane) {
    const bool b5 = lane & 32, b4 = lane & 16, b3 = lane & 8, b2 = lane & 4; float w8[8], w4[4], w2[2];
#pragma unroll
    for (int i = 0; i < 8; ++i) { const float mine = b5 ? v[8 + i] : v[i], oth = b5 ? v[i] : v[8 + i]; w8[i] = mine + __shfl_xor(oth, 32); }
#pragma unroll
    for (int i = 0; i < 4; ++i) { const float mine = b4 ? w8[4 + i] : w8[i], oth = b4 ? w8[i] : w8[4 + i]; w4[i] = mine + __shfl_xor(oth, 16); }
#pragma unroll
    for (int i = 0; i < 2; ++i) { const float mine = b3 ? w4[2 + i] : w4[i], oth = b3 ? w4[i] : w4[2 + i]; w2[i] = mine + __shfl_xor(oth, 8); }
    const float mine = b2 ? w2[1] : w2[0], oth = b2 ? w2[0] : w2[1]; float y = mine + __shfl_xor(oth, 4);
    y += __shfl_xor(y, 1); y += __shfl_xor(y, 2); return y;
}
__device__ __forceinline__ void p8_router(Frame& F) {
    const int gw = F.vcu * NWAVES + F.wave, NGW = F.G * NWAVES; const int lane = lane_id();
    unsigned char* H2 = WSP(unsigned char, WS_H2); float* AFF = WSP(float, WS_AFF); const bf16* ATT = WSP(bf16, WS_ATT); bf16* X1B = WSP(bf16, WS_X1B);
    const float* g2 = F.in[18]; const float* wr = F.in[19];
    LAS float* wl = (LAS float*)(F.lds + RING_OFF);
    __syncthreads();
    for (int i = (F.wave * 64 + lane_id()); i < DM * NE; i += NWAVES * 64) wl[(i & 15) * DM + (i >> 4)] = wr[i];
    for (int i = (F.wave * 64 + lane_id()); i < DM; i += NWAVES * 64) wl[NE * DM + i] = g2[i];
    __syncthreads();
    const LAS float* wlane = wl + 4 * lane;
    f32x4 xn[4], xn2[4]; unsigned long long an[4], an2[4];
#pragma unroll
    for (int k = 0; k < 4; ++k) { xn[k] = *(const GAS f32x4*)(F.in[0] + (size_t)gw * DM + 4 * lane + 256 * k); an[k] = *(const GAS unsigned long long*)(ATT + (size_t)gw * DM + 4 * lane + 256 * k); }
    { const int m1 = (gw + NGW < T) ? gw + NGW : gw;
#pragma unroll
      for (int k = 0; k < 4; ++k) { xn2[k] = *(const GAS f32x4*)(F.in[0] + (size_t)m1 * DM + 4 * lane + 256 * k); an2[k] = *(const GAS unsigned long long*)(ATT + (size_t)m1 * DM + 4 * lane + 256 * k); } }
    for (int m = gw; m < T; m += NGW) {
        f32x4 x[4]; unsigned long long ac[4]; float ss = 0.f;
#pragma unroll
        for (int k = 0; k < 4; ++k) { x[k] = xn[k]; ac[k] = an[k]; xn[k] = xn2[k]; an[k] = an2[k]; }
        { const int mn = (m + 2 * NGW < T) ? m + 2 * NGW : m;
#pragma unroll
          for (int k = 0; k < 4; ++k) { xn2[k] = *(const GAS f32x4*)(F.in[0] + (size_t)mn * DM + 4 * lane + 256 * k); an2[k] = *(const GAS unsigned long long*)(ATT + (size_t)mn * DM + 4 * lane + 256 * k); } }
        asm volatile("" ::: "memory");
#pragma unroll
        for (int k = 0; k < 4; ++k) { const unsigned long long aw = ac[k];
            const unsigned alo = (unsigned)aw, ahi = (unsigned)(aw >> 32); x[k].x += __uint_as_float(alo << 16); x[k].y += __uint_as_float(alo & 0xffff0000u); x[k].z += __uint_as_float(ahi << 16); x[k].w += __uint_as_float(ahi & 0xffff0000u);
            ss += (x[k].x * x[k].x + x[k].y * x[k].y) + (x[k].z * x[k].z + x[k].w * x[k].w); }
        const float rs = __builtin_amdgcn_rsqf(wave_sum(ss) * (1.f / DM) + EPS);
#pragma unroll
        for (int k = 0; k < 4; ++k) { const f32x4 g = *(const LAS f32x4*)(wlane + NE * DM + 256 * k);
            *(GAS unsigned long long*)(X1B + (size_t)m * DM + 4 * lane + 256 * k) = (unsigned long long)pk2(x[k].x, x[k].y) | ((unsigned long long)pk2(x[k].z, x[k].w) << 32);
            x[k].x *= rs * g.x; x[k].y *= rs * g.y; x[k].z *= rs * g.z; x[k].w *= rs * g.w;
            *(GAS unsigned*)(H2 + (size_t)m * DM + 4 * lane + 256 * k) = pg8::pk4_fp8(32.0f * x[k].x, 32.0f * x[k].y, 32.0f * x[k].z, 32.0f * x[k].w); }
        float lg[16];
#pragma unroll
        for (int e = 0; e < 16; ++e) { float a0 = 0.f;
#pragma unroll
            for (int k = 0; k < 4; ++k) { const f32x4 w = *(const LAS f32x4*)(wlane + e * DM + 256 * k); a0 += (x[k].x * w.x + x[k].y * w.y) + (x[k].z * w.z + x[k].w * w.w); }
            lg[e] = a0; if ((e & 3) == 3) asm volatile("" ::: "memory"); }
        const float y = red16(lg, lane); float mx = y;
#pragma unroll
        for (int o = 4; o < 64; o <<= 1) mx = fmaxf(mx, __shfl_xor(mx, o));
        const float ex = __builtin_amdgcn_exp2f((y - mx) * LOG2E); float den = ex;
#pragma unroll
        for (int o = 4; o < 64; o <<= 1) den += __shfl_xor(den, o);
        if ((lane & 3) == 0) AFF[((size_t)(m / SEQ) * NE + ((lane >> 2) & 15)) * SEQ + (m % SEQ)] = ex / den;
    }
    __syncthreads();
}

__device__ __forceinline__ int block_excl_scan(int v, LAS int* tmp, int tid, int lane, int wave, int& total) {
    int inc = v;
#pragma unroll
    for (int o = 1; o < 64; o <<= 1) { const int t = __shfl_up(inc, o); if (lane >= o) inc += t; }
    if (lane == 63) tmp[wave] = inc;
    __syncthreads();
    int base = 0, tot = 0;
#pragma unroll
    for (int w = 0; w < NWAVES; ++w) { const int t = tmp[w]; if (w < wave) base += t; tot += t; }
    __syncthreads();
    total = tot; return base + inc - v;
}
__device__ __forceinline__ void p9_topk(Frame& F) {
    LAS unsigned* keys = (LAS unsigned*)(F.lds + RING_OFF);
    LAS unsigned* hist = keys + SEQ;
    LAS int* tmp = (LAS int*)(hist + 256);
    LAS unsigned* res = (LAS unsigned*)(tmp + 16);
    const int lane = lane_id(), wave = F.wave, tid = wave * 64 + lane;
    const float* AFF = WSP(float, WS_AFF); int* IDX = WSP(int, WS_IDX); float* GATEV = WSP(float, WS_GATEV); int* SLOT = WSP(int, WS_SLOT);
    for (int item = blockIdx.x; item < BATCH * NE; item += F.G) {
        const int b = item / NE, e = item % NE; const float* a = AFF + (size_t)item * SEQ;
        __syncthreads();
#pragma unroll
        for (int i = 0; i < 8; ++i) keys[tid + 512 * i] = __float_as_uint(a[tid + 512 * i]);
        __syncthreads();
        unsigned kk[8];
#pragma unroll
        for (int i = 0; i < 8; ++i) kk[i] = keys[8 * tid + i];
        LAS int* cnt2 = tmp;
#define P9_COUNT(v, step, out) do { int c_ = 0; _Pragma("unroll") for (int i = 0; i < 8; ++i) c_ += (int)__popcll(__ballot(kk[i] >= (v))); \
            if (lane == 0) cnt2[((step) & 1) * 8 + wave] = c_; __syncthreads(); int s_ = 0; _Pragma("unroll") for (int w = 0; w < NWAVES; ++w) s_ += cnt2[((step) & 1) * 8 + w]; out = s_; } while (0)
        unsigned prefix = 0u; int step = 0;
        for (int bit = 29; bit >= 0; --bit) { const unsigned cand = prefix | (1u << bit); int c; P9_COUNT(cand, step, c); ++step; if (c >= CAP) prefix = cand; }
        int cgt; P9_COUNT(prefix + 1u, step, cgt); ++step;
        int remaining = CAP - cgt;
        __syncthreads();
#undef P9_COUNT
        int neq = 0;
#pragma unroll
        for (int i = 0; i < 8; ++i) neq += (kk[i] == prefix) ? 1 : 0;
        int toteq; int eqbase = block_excl_scan(neq, tmp, tid, lane, wave, toteq);
        int sel[8]; int nsel = 0;
#pragma unroll
        for (int i = 0; i < 8; ++i) { const bool eq = kk[i] == prefix; sel[i] = (kk[i] > prefix || (eq && eqbase < remaining)) ? 1 : 0; eqbase += eq ? 1 : 0; nsel += sel[i]; }
        int totsel; int slot = block_excl_scan(nsel, tmp, tid, lane, wave, totsel);
        const size_t rbase = (size_t)(e * BATCH + b) * CAP;
#pragma unroll
        for (int i = 0; i < 8; ++i) { const int s = 8 * tid + i;
            if (sel[i]) { if (slot < CAP) { IDX[rbase + slot] = b * SEQ + s; GATEV[rbase + slot] = __uint_as_float(kk[i]); } SLOT[(size_t)item * SEQ + s] = slot < CAP ? slot : -1; ++slot; }
            else SLOT[(size_t)item * SEQ + s] = -1; }
    }
}

__device__ __forceinline__ void p9b_gather(Frame& F) {
    const int gw = F.vcu * NWAVES + F.wave, NGW = F.G * NWAVES; const int lane = lane_id();
    const unsigned char* H2 = WSP(unsigned char, WS_H2); unsigned char* XE = WSP(unsigned char, WS_XE); const int* IDX = WSP(int, WS_IDX);
    for (int r = gw * 2; r < MX; r += NGW * 2) { const int tok0 = IDX[r], tok1 = IDX[r + 1];
        const v4u a = *((const GAS v4u*)(H2 + (size_t)tok0 * DM) + lane), b = *((const GAS v4u*)(H2 + (size_t)tok1 * DM) + lane);
        *((GAS v4u*)(XE + (size_t)r * DM) + lane) = a; *((GAS v4u*)(XE + (size_t)(r + 1) * DM) + lane) = b; }
}

__device__ __forceinline__ void p12_combine(Frame& F) {
    const int gw = F.vcu * NWAVES + F.wave, NGW = F.G * NWAVES; const int lane = lane_id();
    const unsigned char* YE = WSP(unsigned char, WS_YE); const int* SLOT = WSP(int, WS_SLOT); const bf16* X1B = WSP(bf16, WS_X1B);
    typedef float f32x2v __attribute__((ext_vector_type(2)));
    for (int m = gw; m < T; m += NGW) {
        const int b = m / SEQ, s = m % SEQ;
        const int sl = (lane < NE) ? SLOT[((size_t)b * NE + lane) * SEQ + s] : -1;
        unsigned long long mask = __ballot(sl >= 0);
        GAS f32x4* xr = (GAS f32x4*)(F.out + (size_t)m * DM) + lane; const GAS unsigned long long* x1 = (const GAS unsigned long long*)(X1B + (size_t)m * DM) + lane;
        f32x4 v[4];
#pragma unroll
        for (int j = 0; j < 4; ++j) { const unsigned long long aw = x1[64 * j]; const unsigned alo = (unsigned)aw, ahi = (unsigned)(aw >> 32);
            v[j].x = __uint_as_float(alo << 16); v[j].y = __uint_as_float(alo & 0xffff0000u); v[j].z = __uint_as_float(ahi << 16); v[j].w = __uint_as_float(ahi & 0xffff0000u); }
        f32x4 a[4];
#pragma unroll
        for (int j = 0; j < 4; ++j) a[j] = (f32x4){0.f, 0.f, 0.f, 0.f};
        while (mask) { const int e = __builtin_ctzll(mask); mask &= mask - 1; const int slot = __shfl(sl, e);
            const GAS unsigned* yr = (const GAS unsigned*)(YE + ((size_t)(e * BATCH + b) * CAP + slot) * DM) + lane;
#pragma unroll
            for (int j = 0; j < 4; ++j) { const int w = (int)yr[64 * j]; const f32x2v lo = __builtin_amdgcn_cvt_pk_f32_fp8(w, false), hi = __builtin_amdgcn_cvt_pk_f32_fp8(w, true);
                a[j].x += lo.x; a[j].y += lo.y; a[j].z += hi.x; a[j].w += hi.y; } }
#pragma unroll
        for (int j = 0; j < 4; ++j) xr[64 * j] = v[j] + a[j] * (1.0f / 64.0f);
    }
}


#ifndef MLA_UNIT
#define MLA_UNIT mla_unit2
#endif
namespace att {
using bf16x8 = __attribute__((ext_vector_type(8))) short;
using s16x4 = __attribute__((ext_vector_type(4))) short;
using f32x16 = __attribute__((ext_vector_type(16))) float;
using u32x4 = __attribute__((ext_vector_type(4))) unsigned;
constexpr int KSLOT = 12288, VSLOT = 8192, NSLOT = 3;
constexpr int LK = 0, LV = NSLOT * KSLOT, LWS = LV + NSLOT * VSLOT, LTAB = LWS + NWAVES * 256, ATT_LDS = LTAB + 4 * 512 * 4;
constexpr int CV_F32 = ATT_LDS, CV_F8 = CV_F32 + NWAVES * 2048, CV_END = CV_F8 + NWAVES * 2176;
static_assert(CV_END <= RING_BYTES, "attention LDS");
struct ConvJob { int item0; };
__device__ __forceinline__ int crow(int r, int hi) { return (r & 3) + 8 * (r >> 2) + 4 * hi; }
__device__ __forceinline__ void glds16(const void* gsrc, unsigned lds_dst) { unsigned keep;
    asm volatile("s_mov_b32 %0, m0\n\ts_mov_b32 m0, %2\n\ts_nop 0\n\tglobal_load_lds_dwordx4 %1, off\n\ts_mov_b32 m0, %0" : "=&s"(keep) : "v"(gsrc), "s"(lds_dst) : "memory"); }
__device__ __forceinline__ void glds16s(const void* sbase, unsigned voff, unsigned lds_dst) { unsigned keep;
    asm volatile("s_mov_b32 %0, m0\n\ts_mov_b32 m0, %3\n\ts_nop 0\n\tglobal_load_lds_dwordx4 %1, %2\n\ts_mov_b32 m0, %0" : "=&s"(keep) : "v"(voff), "s"(sbase), "s"(lds_dst) : "memory"); }
__device__ __forceinline__ void glds16s_nt(const void* sbase, unsigned voff, unsigned lds_dst) { unsigned keep;
    asm volatile("s_mov_b32 %0, m0\n\ts_mov_b32 m0, %3\n\ts_nop 0\n\tglobal_load_lds_dwordx4 %1, %2 nt\n\ts_mov_b32 m0, %0" : "=&s"(keep) : "v"(voff), "s"(sbase), "s"(lds_dst) : "memory"); }
__device__ __forceinline__ const bf16* sptr(const bf16* p) { const unsigned long long a = (unsigned long long)p; const unsigned lo = (unsigned)__builtin_amdgcn_readfirstlane((int)(unsigned)a), hi = (unsigned)__builtin_amdgcn_readfirstlane((int)(unsigned)(a >> 32)); return (const bf16*)(((unsigned long long)hi << 32) | lo); }
__device__ __forceinline__ unsigned rfl(unsigned v) { return (unsigned)__builtin_amdgcn_readfirstlane((int)v); }
typedef float f32x2_t __attribute__((ext_vector_type(2))); typedef __bf16 bf16x2_t __attribute__((ext_vector_type(2)));
__device__ __forceinline__ unsigned cvtpk(float lo, float hi) { f32x2_t v = {lo, hi}; bf16x2_t b = __builtin_convertvector(v, bf16x2_t); return __builtin_bit_cast(unsigned, b); }
#define ATT_SBAR() __builtin_amdgcn_sched_barrier(0)
__device__ __forceinline__ void pv(f32x16* o, int vb, bf16x8 pa0, bf16x8 pa1, bf16x8 pa2, bf16x8 pa3) {
#pragma unroll
    for (int d0 = 0; d0 < 2; ++d0) { s16x4 lo[4], hi[4];
#pragma unroll
        for (int ks = 0; ks < 4; ++ks) {
            asm volatile("ds_read_b64_tr_b16 %0,%1 offset:%c2" : "=&v"(lo[ks]) : "v"(vb), "i"(d0 * 4096 + ks * 1024) : "memory");
            asm volatile("ds_read_b64_tr_b16 %0,%1 offset:%c2" : "=&v"(hi[ks]) : "v"(vb), "i"(d0 * 4096 + ks * 1024 + 512) : "memory"); }
        asm volatile("s_waitcnt lgkmcnt(0)" ::: "memory"); ATT_SBAR();
#define ATT_PK(k) (bf16x8){lo[k][0], lo[k][1], lo[k][2], lo[k][3], hi[k][0], hi[k][1], hi[k][2], hi[k][3]}
        o[d0] = __builtin_amdgcn_mfma_f32_32x32x16_bf16(pa0, ATT_PK(0), o[d0], 0, 0, 0);
        o[d0] = __builtin_amdgcn_mfma_f32_32x32x16_bf16(pa1, ATT_PK(1), o[d0], 0, 0, 0);
        o[d0] = __builtin_amdgcn_mfma_f32_32x32x16_bf16(pa2, ATT_PK(2), o[d0], 0, 0, 0);
        o[d0] = __builtin_amdgcn_mfma_f32_32x32x16_bf16(pa3, ATT_PK(3), o[d0], 0, 0, 0);
#undef ATT_PK
    }
}
__device__ __forceinline__ void ssq_accum(const float (&part)[16], int le, float* ssq) {
    const bool b4 = le & 16, b3 = le & 8, b2 = le & 4, b1 = le & 2; float p8[8], p4[4], p2[2];
#pragma unroll
    for (int i = 0; i < 8; ++i) { const float mine = b4 ? part[8 + i] : part[i], oth = b4 ? part[i] : part[8 + i]; p8[i] = mine + __shfl_xor(oth, 16); }
#pragma unroll
    for (int i = 0; i < 4; ++i) { const float mine = b3 ? p8[4 + i] : p8[i], oth = b3 ? p8[i] : p8[4 + i]; p4[i] = mine + __shfl_xor(oth, 8); }
#pragma unroll
    for (int i = 0; i < 2; ++i) { const float mine = b2 ? p4[2 + i] : p4[i], oth = b2 ? p4[i] : p4[2 + i]; p2[i] = mine + __shfl_xor(oth, 4); }
    const float mine = b1 ? p2[1] : p2[0], oth = b1 ? p2[0] : p2[1]; float y = mine + __shfl_xor(oth, 2);
    y += __shfl_xor(y, 1);
    const int r = (b4 ? 8 : 0) + (b3 ? 4 : 0) + (b2 ? 2 : 0) + (b1 ? 1 : 0);
    if ((le & 1) == 0) atomicAdd(ssq + 2 * crow(r, le >> 5), y);
}
#define ATT_WAIT_BAR(N) asm volatile("s_waitcnt vmcnt(" #N ") lgkmcnt(0)\n\ts_barrier" ::: "memory")
__device__ __forceinline__ u32x4 pack_p(const f32x16& p, int base) { u32x4 w; w.x = cvtpk(p[base], p[base + 1]); w.y = cvtpk(p[base + 2], p[base + 3]); w.z = cvtpk(p[base + 4], p[base + 5]); w.w = cvtpk(p[base + 6], p[base + 7]); return w; }

typedef __attribute__((address_space(3))) const char* lds_cptr;
typedef short v4i16_t __attribute__((ext_vector_type(4)));
__device__ __forceinline__ s16x4 vtr(lds_cptr p) { return __builtin_bit_cast(s16x4, __builtin_amdgcn_ds_read_tr16_b64_v4i16((__attribute__((address_space(3))) v4i16_t*)p)); }
__device__ __forceinline__ void mla_unit2(LAS unsigned char* lds, int b, int h, int qb, const bf16* QB, const unsigned char* QN8, const unsigned char* KN8, const bf16* KR, const bf16* VB, bf16* O, float* SSQ, bool shift, float nb, const ConvJob cj, int wid, int lane) {
    const int r32 = lane & 31, hi = lane >> 5;
    const unsigned lds0 = (unsigned)(uintptr_t)lds;
    const size_t rowb = (size_t)b * SEQ; const int q0 = qb * 256;
    const char* ksrc = (const char*)sptr((const bf16*)((wid < 4) ? (const unsigned char*)(KR + (size_t)(b * 64) * 2048) + (wid & 3) * 1024 : KN8 + (size_t)((b * BH + h) * 64) * 4096 + (wid & 3) * 1024));
    const bf16* vsrc = sptr(VB + (size_t)((b * BH + h) * 64) * 4096 + wid * 512);
    const unsigned kl0 = lane * 16u, vl = kl0;
    constexpr int KS8 = 8192;
    const unsigned kdst = lds0 + LK + ((wid < 4 ? 4 : 0) + (wid & 3)) * 1024, vdst = lds0 + LV + wid * 1024;
#define DMA_K(t, sl) glds16s(ksrc + (size_t)(t) * 4096, kl0, rfl(kdst + (sl) * KS8))
#define DMA_V(t, sl) glds16s(vsrc + (size_t)(t) * 4096, vl, rfl(vdst + (sl) * VSLOT))
#define WAITB(N4, N8) ATT_WAIT_BAR(N8)
    constexpr int NT = SEQ / 64;
    DMA_K(0, 0); DMA_V(0, 0); DMA_K(1, 1); DMA_K(2, 2);
    typedef int v8i32 __attribute__((ext_vector_type(8))); typedef int v4i32 __attribute__((ext_vector_type(4)));
#define CAT8(a_, b_) (v8i32){a_[0], a_[1], a_[2], a_[3], b_[0], b_[1], b_[2], b_[3]}
    const int sK = 0x7c7c7c7c, sQ = 0x79797979;
    v8i32 qn8; bf16x8 qf[2];
    { const unsigned char* qp8 = QN8 + (rowb + q0 + 32 * wid + r32) * (BH * NOPE) + NOPE * h + 32 * hi; const v4i32 a_ = *(const v4i32*)qp8, b_ = *(const v4i32*)(qp8 + 16); qn8 = CAT8(a_, b_);
      const bf16* qp = QB + (rowb + q0 + 32 * wid + r32) * (BH * QKD) + QKD * h + NOPE + 8 * hi;
#pragma unroll
      for (int s = 0; s < 2; ++s) qf[s] = *(const bf16x8*)(qp + 16 * s); }
    f32x16 o[2]; o[0] = f32x16{}; o[1] = f32x16{};
    typedef float f32x4_t __attribute__((ext_vector_type(4)));
    f32x4_t ls = {0.f, 0.f, 0.f, 0.f}, ls2 = {0.f, 0.f, 0.f, 0.f};
    const short bsel1 = ((((lane >> 4) & 1) == ((lane & 15) >> 3)) ? (short)0x3F80 : (short)0);
    const bf16x8 bsel = {bsel1, bsel1, bsel1, bsel1, bsel1, bsel1, bsel1, bsel1};
#define LSUM(k) do { if ((k) & 1) ls2 = __builtin_amdgcn_mfma_f32_16x16x32_bf16(PAF(k), bsel, ls2, 0, 0, 0); else ls = __builtin_amdgcn_mfma_f32_16x16x32_bf16(PAF(k), bsel, ls, 0, 0, 0); } while (0)
    const lds_cptr kp0 = (lds_cptr)lds + LK + hi * 2048 + r32 * 16;
    const lds_cptr kr0 = (lds_cptr)lds + LK + 4096 + hi * 1024 + r32 * 16;
    const lds_cptr vp0 = (lds_cptr)lds + LV + ((lane >> 4) & 1) * 32 + (lane & 3) * 8 + (4 * hi + ((lane & 15) >> 2)) * 64;
    v8i32 kf8[2]; bf16x8 kfr[4];
#define KLD8(kp_, kh) do { const v4i32 a_ = *(const __attribute__((address_space(3))) v4i32*)((kp_) + (kh) * 512), b_ = *(const __attribute__((address_space(3))) v4i32*)((kp_) + 1024 + (kh) * 512); kf8[kh] = CAT8(a_, b_); } while (0)
#define KLDR(kp_, i) kfr[i] = *(const __attribute__((address_space(3))) bf16x8*)((kp_) + ((i) >> 1) * 2048 + ((i) & 1) * 512)
#define QKF8(kh) __builtin_amdgcn_mfma_scale_f32_32x32x64_f8f6f4(kf8[kh], qn8, f32x16{}, 0, 0, 0, sK, 0, sQ)
    WAITB(5, 3);
    KLD8(kp0, 0); KLD8(kp0, 1);
#pragma unroll
    for (int i = 0; i < 4; ++i) KLDR(kr0, i);
    f32x16 pA0, pA1, pB0, pB1;
    pA0 = QKF8(0); pA1 = QKF8(1);
#pragma unroll
    for (int s = 0; s < 2; ++s) { pA0 = __builtin_amdgcn_mfma_f32_32x32x16_bf16(kfr[2 * s], qf[s], pA0, 0, 0, 0); pA1 = __builtin_amdgcn_mfma_f32_32x32x16_bf16(kfr[2 * s + 1], qf[s], pA1, 0, 0, 0); }
    if (shift) {
#pragma unroll
        for (int r = 0; r < 16; ++r) { pA0[r] += nb; pA1[r] += nb; } }
#pragma unroll
    for (int r = 0; r < 16; ++r) { pA0[r] = __builtin_amdgcn_exp2f(pA0[r]); pA1[r] = __builtin_amdgcn_exp2f(pA1[r]); }
    WAITB(2, 1);
    DMA_K(3, 0); DMA_V(1, 1);
    KLD8(kp0 + KS8, 0); KLD8(kp0 + KS8, 1);
#pragma unroll
    for (int i = 0; i < 4; ++i) KLDR(kr0 + KS8, i);
    WAITB(3, 2);
    s16x4 vl0, vh0, vl1, vh1, vl2, vh2, vl3, vh3; u32x4 pw0, pw1, pw2, pw3;
    int i_prev = 0, i_cur = 1, i_next = 2;
#define ROT() do { const int t_ = i_prev; i_prev = i_cur; i_cur = i_next; i_next = t_; } while (0)
#define PIN(x) asm volatile("" : "+v"(x))
#define VOFF(i) (((i) >> 2) * 4096 + ((i) & 3) * 1024)
#define VRD(B, i) do { vl##B = vtr(vp_ + VOFF(i)); vh##B = vtr(vp_ + VOFF(i) + 512); } while (0)
#define VFR(B) (bf16x8){vl##B[0], vl##B[1], vl##B[2], vl##B[3], vh##B[0], vh##B[1], vh##B[2], vh##B[3]}
#define PAF(k) __builtin_bit_cast(bf16x8, pw##k)
#define EX(v) __builtin_amdgcn_exp2f(v)
#define QK0(C, kh) C = QKF8(kh)
#define QKN(C, i, s) C = __builtin_amdgcn_mfma_f32_32x32x16_bf16(kfr[i], qf[s], C, 0, 0, 0)
#define KN8(kh) do { if (GL_) { KLD8(kn_, kh); } } while (0)
#define KNR(i) do { if (GL_) { KLDR(krn_, i); } } while (0)
#define ADD4(P, B) (void)0
#define CVT2(P, B, PW, W) do { PW[W] = cvtpk(P[B], P[(B) + 1]); PW[(W) + 1] = cvtpk(P[(B) + 2], P[(B) + 3]); PIN(PW); } while (0)
#define GB(MF, RD, E0, E1, E2) do { MF; RD; E0; E1; E2; ATT_SBAR(); } while (0)
#define NOP_ (void)0
#define STEP(C0, C1, P0, P1, t, GK, GV, GL) do { ATT_SBAR(); \
    constexpr bool GL_ = GL; \
    if (GK) { DMA_K((t) + 3, i_cur); } if (GV) { DMA_V((t) + 1, i_next); } \
    const lds_cptr vp_ = vp0 + i_prev * VSLOT; const lds_cptr kn_ = kp0 + i_next * KS8, krn_ = kr0 + i_next * KS8; \
      \
    QK0(C0, 0); KN8(0); ADD4(P0, 0); CVT2(P0, 0, pw0, 0); ADD4(P0, 4); CVT2(P0, 4, pw0, 2); ATT_SBAR(); \
    QKN(C0, 0, 0); KNR(0); ADD4(P0, 8); CVT2(P0, 8, pw1, 0); ATT_SBAR(); \
    QKN(C0, 2, 1); KNR(2); ADD4(P0, 12); CVT2(P0, 12, pw1, 2); ATT_SBAR(); \
    QK0(C1, 1); KN8(1); CVT2(P1, 0, pw2, 0); CVT2(P1, 4, pw2, 2); LSUM(0); LSUM(1); ATT_SBAR(); \
    if (__builtin_expect(shift, 0)) { _Pragma("unroll") for (int r_ = 0; r_ < 16; ++r_) C0[r_] += nb; PIN(C0); } ATT_SBAR(); \
    QKN(C1, 1, 0); KNR(1); ADD4(P1, 8); CVT2(P1, 8, pw3, 0); C0[0] = EX(C0[0]); C0[1] = EX(C0[1]); VRD(0, 0); ATT_SBAR(); \
    QKN(C1, 3, 1); KNR(3); ADD4(P1, 12); CVT2(P1, 12, pw3, 2); C0[2] = EX(C0[2]); C0[3] = EX(C0[3]); VRD(1, 4); ATT_SBAR(); \
    VRD(2, 1); C0[4] = EX(C0[4]); C0[5] = EX(C0[5]); C0[6] = EX(C0[6]); C0[7] = EX(C0[7]); PIN(C0); LSUM(2); LSUM(3); ATT_SBAR(); \
    if (__builtin_expect(shift, 0)) { _Pragma("unroll") for (int r_ = 0; r_ < 16; ++r_) C1[r_] += nb; PIN(C1); } ATT_SBAR(); \
    GB(o[0] = __builtin_amdgcn_mfma_f32_32x32x16_bf16(PAF(0), VFR(0), o[0], 0, 0, 0), VRD(3, 5), C0[8] = EX(C0[8]), C0[9] = EX(C0[9]), C0[10] = EX(C0[10])); \
    GB(o[1] = __builtin_amdgcn_mfma_f32_32x32x16_bf16(PAF(0), VFR(1), o[1], 0, 0, 0), VRD(0, 2), C0[11] = EX(C0[11]), C0[12] = EX(C0[12]), C0[13] = EX(C0[13])); \
    GB(o[0] = __builtin_amdgcn_mfma_f32_32x32x16_bf16(PAF(1), VFR(2), o[0], 0, 0, 0), VRD(1, 6), C0[14] = EX(C0[14]), C0[15] = EX(C0[15]), C1[0] = EX(C1[0])); \
    GB(o[1] = __builtin_amdgcn_mfma_f32_32x32x16_bf16(PAF(1), VFR(3), o[1], 0, 0, 0), VRD(2, 3), C1[1] = EX(C1[1]), C1[2] = EX(C1[2]), C1[3] = EX(C1[3])); \
    GB(o[0] = __builtin_amdgcn_mfma_f32_32x32x16_bf16(PAF(2), VFR(0), o[0], 0, 0, 0), VRD(3, 7), C1[4] = EX(C1[4]), C1[5] = EX(C1[5]), C1[6] = EX(C1[6])); \
    GB(o[1] = __builtin_amdgcn_mfma_f32_32x32x16_bf16(PAF(2), VFR(1), o[1], 0, 0, 0), NOP_, C1[7] = EX(C1[7]), C1[8] = EX(C1[8]), C1[9] = EX(C1[9])); \
    GB(o[0] = __builtin_amdgcn_mfma_f32_32x32x16_bf16(PAF(3), VFR(2), o[0], 0, 0, 0), NOP_, C1[10] = EX(C1[10]), C1[11] = EX(C1[11]), C1[12] = EX(C1[12])); \
    GB(o[1] = __builtin_amdgcn_mfma_f32_32x32x16_bf16(PAF(3), VFR(3), o[1], 0, 0, 0), NOP_, C1[13] = EX(C1[13]), C1[14] = EX(C1[14]), C1[15] = EX(C1[15])); \
    PIN(C0); PIN(C1); \
    } while (0)
    const bool cv_on = cj.item0 >= 0;
    int cv_p = 0, cv_j = 0; const float* cv_src = nullptr; unsigned char* cv_dst = nullptr; float cv_sc = 0.f;
    LAS float* const cvf = (LAS float*)(lds + CV_F32 + wid * 2048);
    LAS unsigned* const cv8 = (LAS unsigned*)(lds + CV_F8 + wid * 2176);
    const unsigned cv_loff = (unsigned)(lane >> 3) * 4096u + (unsigned)(lane & 7) * 16u;
#define CONV() do { \
    if (cv_p == 0) { const int r_ = cj.item0 + cv_j, e_ = r_ / 1536, q_ = r_ % 1536, wh_ = q_ >> 9, it_ = q_ & 511, k0_ = (it_ >> 5) * 64, n0_ = (it_ & 31) * 32; \
        const unsigned char* ka_ = (const unsigned char*)__builtin_amdgcn_kernarg_segment_ptr();     \
        const float* w_ = *(const float* const*)(ka_ + 8 * (20 + wh_)); unsigned char* ws_ = *(unsigned char* const*)(ka_ + 8 * 24); cv_src = w_ + (size_t)e_ * 1048576 + (size_t)k0_ * 1024 + n0_; \
        if (wh_ < 2) { cv_dst = ws_ + WS_WGU + (size_t)e_ * 2097152 + (size_t)((n0_ >> 7) * 256 + wh_ * 128 + (n0_ & 127)) * 1024 + k0_; cv_sc = 32.0f; } \
        else { cv_dst = ws_ + WS_WD + (size_t)e_ * 1048576 + (size_t)n0_ * 1024 + k0_; cv_sc = 16.0f; } } \
    if (cv_p >= 1 && cv_p <= 8) { const int d_ = cv_p - 1; const LAS float* s_ = cvf + (d_ & 1) * 256 + hi * 128 + r32; \
        cv8[r32 * 17 + 2 * d_ + hi] = pg8::pk4_fp8_nc(cv_sc * s_[0], cv_sc * s_[32], cv_sc * s_[64], cv_sc * s_[96]); } \
    if (cv_p < 8) { glds16s_nt(cv_src + (size_t)(8 * cv_p) * 1024, cv_loff, rfl(lds0 + CV_F32 + wid * 2048 + (cv_p & 1) * 1024)); } \
    else { const int id_ = lane + 64 * (cv_p - 8), n2_ = id_ >> 2, c_ = id_ & 3; const LAS unsigned* q2_ = cv8 + n2_ * 17 + 4 * c_; \
        v4u w4_; w4_.x = q2_[0]; w4_.y = q2_[1]; w4_.z = q2_[2]; w4_.w = q2_[3]; *(GAS v4u*)(cv_dst + (size_t)n2_ * 1024 + 16 * c_) = w4_; } \
    if (++cv_p == 10) { cv_p = 0; ++cv_j; } } while (0)
    int t = 1;
    for (; t + 3 < NT; t += 2) {
        STEP(pB0, pB1, pA0, pA1, t, true, true, true);      WAITB(3, 2); ROT();
        if (cv_on) { CONV(); }
        STEP(pA0, pA1, pB0, pB1, t + 1, true, true, true);  if (cv_on) WAITB(4, 3); else WAITB(3, 2); ROT();
    }
#undef CONV
    STEP(pB0, pB1, pA0, pA1, NT - 3, false, true, true);   ATT_WAIT_BAR(1); ROT();
    STEP(pA0, pA1, pB0, pB1, NT - 2, false, true, true);   ATT_WAIT_BAR(1); ROT();
    STEP(pB0, pB1, pA0, pA1, NT - 1, false, false, false); ATT_WAIT_BAR(0); ROT();
    { const u32x4 w0 = pack_p(pB0, 0), w1 = pack_p(pB0, 8), w2 = pack_p(pB1, 0), w3 = pack_p(pB1, 8);
      ls = __builtin_amdgcn_mfma_f32_16x16x32_bf16(__builtin_bit_cast(bf16x8, w0), bsel, ls, 0, 0, 0); ls = __builtin_amdgcn_mfma_f32_16x16x32_bf16(__builtin_bit_cast(bf16x8, w1), bsel, ls, 0, 0, 0);
      ls = __builtin_amdgcn_mfma_f32_16x16x32_bf16(__builtin_bit_cast(bf16x8, w2), bsel, ls, 0, 0, 0); ls = __builtin_amdgcn_mfma_f32_16x16x32_bf16(__builtin_bit_cast(bf16x8, w3), bsel, ls, 0, 0, 0);
      ls += ls2;
      pv(o, (int)(lds0 + LV) + ((lane >> 4) & 1) * 32 + (lane & 3) * 8 + (4 * hi + ((lane & 15) >> 2)) * 64 + i_prev * VSLOT,
         __builtin_bit_cast(bf16x8, w0), __builtin_bit_cast(bf16x8, w1), __builtin_bit_cast(bf16x8, w2), __builtin_bit_cast(bf16x8, w3)); }
#undef STEP
#undef NOP_
#undef GB
#undef ADD4
#undef LSUM
#undef CVT2
#undef KN8
#undef KNR
#undef QK0
#undef QKN
#undef QKF8
#undef KLD8
#undef KLDR
#undef CAT8
#undef EX
#undef PAF
#undef VFR
#undef VRD
#undef VOFF
#undef PIN
#undef ROT
#undef WAITB
#undef DMA_K
#undef DMA_V
    const int le = lane_id();
    const int r32e = le & 31, hie = le >> 5;
    LAS float* wsf = (LAS float*)(lds + LWS) + wid * 64;
    if ((le & 7) == 0) { LAS float* wq = wsf + ((le & 8) ? 16 : 0) + 4 * (le >> 4); wq[0] = ls[0]; wq[1] = ls[1]; wq[2] = ls[2]; wq[3] = ls[3]; }
    asm volatile("s_waitcnt lgkmcnt(0)" ::: "memory");
    bf16* Ow = (bf16*)sptr(O + (rowb + q0 + 32 * wid) * DM + 512 + VD * h);
    float part[16];
#pragma unroll
    for (int r = 0; r < 16; ++r) { const int q = crow(r, hie); const float il = __builtin_amdgcn_rcpf(wsf[q]); const unsigned off = (unsigned)(q * DM + r32e); const float v0 = o[0][r] * il, v1 = o[1][r] * il;
        part[r] = v0 * v0 + v1 * v1; Ow[off] = (bf16)f2bf(v0); Ow[off + 32] = (bf16)f2bf(v1); }
    ssq_accum(part, le, SSQ + 2 * (rowb + q0 + 32 * wid) + 1);
    asm volatile("s_waitcnt lgkmcnt(0)\n\ts_barrier" ::: "memory");
}

__device__ __forceinline__ void swa_fill_table(LAS unsigned char* lds, int g, const float* TAB, int tid) {
    const float bnd = TAB[TAB_CONST + 0]; LAS float* tb = (LAS float*)(lds + LTAB);
    for (int i = tid; i < 4 * 512; i += NWAVES * 64) { const int hh = i >> 9, idx = (i & 511) - 63; tb[i] = (idx >= 0 && idx <= 2 * WINDOW) ? TAB[TAB_BIAS + (4 * g + hh) * NTAB + idx] - bnd : -1e30f; }
}
__device__ __forceinline__ void swa_unit(LAS unsigned char* lds, int b, int nh, int g, const bf16* QA, const bf16* KA, const bf16* VA, bf16* O, float* SSQ, const float* TAB, const float* sink, int wid, int lane, int tid) {
    const int r32 = lane & 31, hi = lane >> 5, hr = wid >> 1, rh = wid & 1, h = 4 * g + hr;
    const unsigned lds0 = (unsigned)(uintptr_t)lds;
    const size_t rowb = (size_t)b * SEQ;
    const int kt0 = (nh - 2 < 0) ? 0 : nh - 2, kt1 = (nh + 3 > SEQ / 64) ? SEQ / 64 : nh + 3, NT = kt1 - kt0;
    const bf16* ksrc = sptr(KA + (rowb + (size_t)kt0 * 64) * 128 + 64 * g + 8 * wid);
    const bf16* vsrc = sptr(VA + (rowb + (size_t)kt0 * 64 + 16 * (wid & 3)) * 128 + 64 * g + (wid >> 2) * 32);
    const unsigned kl = lane * 256u, vl = (lane >> 2) * 256u + (lane & 3) * 16u;
    constexpr int SK = 0, SV = 73728, SSLOT = 8192;
    const unsigned kdst = lds0 + SK + wid * 1024, vdst = lds0 + SV + wid * 1024;
#define SWA_DMA(t, sl) do { glds16s(ksrc + (size_t)(t) * 64 * 128, kl, rfl(kdst + (sl) * SSLOT)); glds16s(vsrc + (size_t)(t) * 64 * 128, vl, rfl(vdst + (sl) * SSLOT)); } while (0)
    for (int t_ = 0; t_ < NT; ++t_) SWA_DMA(t_, t_);
    const float bnd = TAB[TAB_CONST + 0];
    bf16x8 qf[4];
    { const bf16* qp = QA + (rowb + 64 * nh + 32 * rh + r32) * 512 + HD * h + 8 * hi;
#pragma unroll
      for (int s = 0; s < 4; ++s) qf[s] = *(const bf16x8*)(qp + 16 * s); }
    f32x16 o[2]; o[0] = f32x16{}; o[1] = f32x16{};
    float l = 0.f;
    const LAS unsigned char* kbase = lds + SK + hi * 1024 + r32 * 16;
    const int vb0 = (int)(lds0 + SV) + ((lane >> 4) & 1) * 32 + (lane & 3) * 8 + (4 * hi + ((lane & 15) >> 2)) * 64;
    const LAS float* tbl = (const LAS float*)(lds + LTAB) + hr * 512 + 63 + 4 * hi - 32 * rh - r32 + 64 * (kt0 - (nh - 2));
    for (int t = 0; t < NT; ++t) {
        { const int rem = NT - 1 - t;
          if (rem == 4) ATT_WAIT_BAR(8); else if (rem == 3) ATT_WAIT_BAR(6); else if (rem == 2) ATT_WAIT_BAR(4); else if (rem == 1) ATT_WAIT_BAR(2); else ATT_WAIT_BAR(0); }
        const int sl = t;
        const LAS unsigned char* kp = kbase + sl * SSLOT;
        const LAS float* tt = tbl + 64 * t;
        f32x16 p0, p1;
#pragma unroll
        for (int r = 0; r < 16; ++r) { const int off = (r & 3) + 8 * (r >> 2); p0[r] = tt[off]; p1[r] = tt[off + 32]; }
#pragma unroll
        for (int s = 0; s < 4; ++s) { const bf16x8 a0 = *(const LAS bf16x8*)(kp + s * 2048), a1 = *(const LAS bf16x8*)(kp + s * 2048 + 512);
            p0 = __builtin_amdgcn_mfma_f32_32x32x16_bf16(a0, qf[s], p0, 0, 0, 0); p1 = __builtin_amdgcn_mfma_f32_32x32x16_bf16(a1, qf[s], p1, 0, 0, 0); }
        float sa = 0.f, sb = 0.f;
#pragma unroll
        for (int r = 0; r < 16; ++r) { p0[r] = __builtin_amdgcn_exp2f(p0[r]); p1[r] = __builtin_amdgcn_exp2f(p1[r]); sa += p0[r]; sb += p1[r]; }
        l += sa + sb;
        const u32x4 w0 = pack_p(p0, 0), w1 = pack_p(p0, 8), w2 = pack_p(p1, 0), w3 = pack_p(p1, 8);
        pv(o, vb0 + sl * SSLOT, __builtin_bit_cast(bf16x8, w0), __builtin_bit_cast(bf16x8, w1), __builtin_bit_cast(bf16x8, w2), __builtin_bit_cast(bf16x8, w3));
    }
#undef SWA_DMA
    l += __shfl_xor(l, 32); l += __builtin_amdgcn_exp2f(sink[h] * LOG2E - bnd);
    const int le = lane_id();
    const int r32e = le & 31, hie = le >> 5;
    LAS float* wsf = (LAS float*)(lds + LWS) + wid * 64;
    if (hie == 0) wsf[r32e] = l;
    asm volatile("s_waitcnt lgkmcnt(0)" ::: "memory");
    bf16* Ow = (bf16*)sptr(O + (rowb + 64 * nh + 32 * rh) * DM + HD * h);
    float part[16];
#pragma unroll
    for (int r = 0; r < 16; ++r) { const int q = crow(r, hie); const float il = __builtin_amdgcn_rcpf(wsf[q]); const unsigned off = (unsigned)(q * DM + r32e); const float v0 = o[0][r] * il, v1 = o[1][r] * il;
        part[r] = v0 * v0 + v1 * v1; Ow[off] = (bf16)f2bf(v0); Ow[off + 32] = (bf16)f2bf(v1); }
    ssq_accum(part, le, SSQ + 2 * (rowb + 64 * nh + 32 * rh));
    asm volatile("s_waitcnt lgkmcnt(0)\n\ts_barrier" ::: "memory");
}
__device__ __forceinline__ void swa_unit3(LAS unsigned char* lds, int b, int n128, int g, const bf16* QA, const bf16* KA, const bf16* VA, bf16* O, float* SSQ, const float* TAB, const float* sink, int wid, int lane) {
    const int r32 = lane & 31, hi = lane >> 5, hr = wid >> 1, rh = wid & 1, h = 4 * g + hr;
    const unsigned lds0 = (unsigned)(uintptr_t)lds;
    const size_t rowb = (size_t)b * SEQ;
    const int kta = (2 * n128 - 2 < 0) ? 0 : 2 * n128 - 2, ktb = (2 * n128 + 4 > SEQ / 64) ? SEQ / 64 : 2 * n128 + 4, NTA = ktb - kta;
    const bf16* ksrc = sptr(KA + (rowb + (size_t)kta * 64) * 128 + 64 * g + 8 * wid);
    const bf16* vsrc = sptr(VA + (rowb + (size_t)kta * 64 + 16 * (wid & 3)) * 128 + 64 * g + (wid >> 2) * 32);
    const unsigned kl = lane * 256u, vl = (lane >> 2) * 256u + (lane & 3) * 16u;
    constexpr int SK = 0, SV = 73728, SSLOT = 8192;
    const unsigned kdst = lds0 + SK + wid * 1024, vdst = lds0 + SV + wid * 1024;
#define DMA_K(t, sl) glds16s(ksrc + (size_t)(t) * 64 * 128, kl, rfl(kdst + (sl) * SSLOT))
#define DMA_V(t, sl) glds16s(vsrc + (size_t)(t) * 64 * 128, vl, rfl(vdst + (sl) * SSLOT))
    for (int t_ = 0; t_ < NTA; ++t_) DMA_K(t_, t_);
    for (int t_ = 0; t_ < NTA; ++t_) DMA_V(t_, t_);
    const float bnd = TAB[TAB_CONST + 0];
    for (int sub = 0; sub < 2; ++sub) {
    const int nh = 2 * n128 + sub; const int kt0 = (nh - 2 < 0) ? 0 : nh - 2, kt1 = (nh + 3 > SEQ / 64) ? SEQ / 64 : nh + 3, NT = kt1 - kt0, s0 = kt0 - kta;
    bf16x8 qf[4];
    { const bf16* qp = QA + (rowb + 64 * nh + 32 * rh + r32) * 512 + HD * h + 8 * hi;
#pragma unroll
      for (int s = 0; s < 4; ++s) qf[s] = *(const bf16x8*)(qp + 16 * s); }
    f32x16 o[2]; o[0] = f32x16{}; o[1] = f32x16{};
    float l_reg = 0.f;
    const lds_cptr kp0 = (lds_cptr)lds + SK + s0 * SSLOT + hi * 1024 + r32 * 16;
    const lds_cptr vp0 = (lds_cptr)lds + SV + s0 * SSLOT + ((lane >> 4) & 1) * 32 + (lane & 3) * 8 + (4 * hi + ((lane & 15) >> 2)) * 64;
    const LAS float* tbl = (const LAS float*)(lds + LTAB) + hr * 512 + 63 + 4 * hi - 32 * rh - r32 + 64 * (kt0 - (nh - 2));
    bf16x8 kf[8];
#define KLD(kp, i) kf[i] = *(const __attribute__((address_space(3))) bf16x8*)((kp) + ((i) >> 1) * 2048 + ((i) & 1) * 512)
#define BIAS(C0, C1, tt_) do { _Pragma("unroll") for (int r_ = 0; r_ < 16; ++r_) { C0[r_] = (tt_)[(r_ & 3) + 8 * (r_ >> 2)]; C1[r_] = (tt_)[(r_ & 3) + 8 * (r_ >> 2) + 32]; } } while (0)
    if (sub == 0) { if (NTA == 6) ATT_WAIT_BAR(11); else ATT_WAIT_BAR(7); }
#pragma unroll
    for (int i = 0; i < 8; ++i) KLD(kp0, i);
    f32x16 pA0, pA1, pB0, pB1;
    BIAS(pA0, pA1, tbl);
#pragma unroll
    for (int s = 0; s < 4; ++s) { pA0 = __builtin_amdgcn_mfma_f32_32x32x16_bf16(kf[2 * s], qf[s], pA0, 0, 0, 0); pA1 = __builtin_amdgcn_mfma_f32_32x32x16_bf16(kf[2 * s + 1], qf[s], pA1, 0, 0, 0); }
#pragma unroll
    for (int r = 0; r < 16; ++r) { pA0[r] = __builtin_amdgcn_exp2f(pA0[r]); pA1[r] = __builtin_amdgcn_exp2f(pA1[r]); }
    BIAS(pB0, pB1, tbl + 64);
    if (sub == 0) ATT_WAIT_BAR(0);
#pragma unroll
    for (int i = 0; i < 8; ++i) KLD(kp0 + SSLOT, i);
    s16x4 vl0, vh0, vl1, vh1, vl2, vh2, vl3, vh3; u32x4 pw0, pw1, pw2, pw3;
#define ROT() do { } while (0)
#define PIN(x) asm volatile("" : "+v"(x))
#define VOFF(i) (((i) >> 2) * 4096 + ((i) & 3) * 1024)
#define VRD(B, i) do { vl##B = vtr(vp_ + VOFF(i)); vh##B = vtr(vp_ + VOFF(i) + 512); } while (0)
#define VFR(B) (bf16x8){vl##B[0], vl##B[1], vl##B[2], vl##B[3], vh##B[0], vh##B[1], vh##B[2], vh##B[3]}
#define PAF(k) __builtin_bit_cast(bf16x8, pw##k)
#define EX(v) __builtin_amdgcn_exp2f(v)
#define QKN(C, i, s) C = __builtin_amdgcn_mfma_f32_32x32x16_bf16(kf[i], qf[s], C, 0, 0, 0)
#define KN(i) do { if (gl_) { KLD(kn_, i); } } while (0)
#define GA(MF, KI, P, B, PW, W, X0, X1) do { MF; KN(KI); sacc += P[B]; sacc += P[B + 1]; sacc += P[B + 2]; sacc += P[B + 3]; PIN(sacc); PW[W] = cvtpk(P[B], P[B + 1]); PW[W + 1] = cvtpk(P[B + 2], P[B + 3]); PIN(PW); X0; X1; ATT_SBAR(); } while (0)
#define GB(MF, RD, E0, E1, E2, E3, NB) do { MF; RD; E0; E1; E2; E3; NB; ATT_SBAR(); } while (0)
#define NOP_ (void)0
#define NBIAS(P0, P1, q) do { if (gl_) { P0[2 * (q)] = tn_[((2 * (q)) & 3) + 8 * ((2 * (q)) >> 2)]; P0[2 * (q) + 1] = tn_[((2 * (q) + 1) & 3) + 8 * ((2 * (q) + 1) >> 2)]; \
        P1[2 * (q)] = tn_[((2 * (q)) & 3) + 8 * ((2 * (q)) >> 2) + 32]; P1[2 * (q) + 1] = tn_[((2 * (q) + 1) & 3) + 8 * ((2 * (q) + 1) >> 2) + 32]; } } while (0)
#define STEP(C0, C1, P0, P1, t) do { ATT_SBAR(); \
    const bool gl_ = (t) + 1 < NT; \
    const lds_cptr vp_ = vp0 + ((t) - 1) * SSLOT; const lds_cptr kn_ = kp0 + ((t) + 1) * SSLOT; const LAS float* tn_ = tbl + 64 * ((t) + 1); \
    float sacc = 0.f; \
    GA(QKN(C0, 0, 0), 0, P0, 0, pw0, 0, NOP_, NOP_); \
    GA(QKN(C0, 2, 1), 2, P0, 4, pw0, 2, NOP_, NOP_); \
    GA(QKN(C0, 4, 2), 4, P0, 8, pw1, 0, NOP_, NOP_); \
    GA(QKN(C0, 6, 3), 6, P0, 12, pw1, 2, NOP_, NOP_); \
    GA(QKN(C1, 1, 0), 1, P1, 0, pw2, 0, NOP_, NOP_); \
    GA(QKN(C1, 3, 1), 3, P1, 4, pw2, 2, NOP_, VRD(0, 0)); \
    GA(QKN(C1, 5, 2), 5, P1, 8, pw3, 0, C0[0] = EX(C0[0]), VRD(1, 4)); \
    GA(QKN(C1, 7, 3), 7, P1, 12, pw3, 2, C0[1] = EX(C0[1]), VRD(2, 1)); \
    l_reg += sacc; C0[2] = EX(C0[2]); C0[3] = EX(C0[3]); PIN(C0); ATT_SBAR(); \
    GB(o[0] = __builtin_amdgcn_mfma_f32_32x32x16_bf16(PAF(0), VFR(0), o[0], 0, 0, 0), VRD(3, 5), C0[4] = EX(C0[4]), C0[5] = EX(C0[5]), C0[6] = EX(C0[6]), C0[7] = EX(C0[7]), NBIAS(P0, P1, 0)); \
    GB(o[1] = __builtin_amdgcn_mfma_f32_32x32x16_bf16(PAF(0), VFR(1), o[1], 0, 0, 0), VRD(0, 2), C0[8] = EX(C0[8]), C0[9] = EX(C0[9]), C0[10] = EX(C0[10]), C0[11] = EX(C0[11]), NBIAS(P0, P1, 1)); \
    GB(o[0] = __builtin_amdgcn_mfma_f32_32x32x16_bf16(PAF(1), VFR(2), o[0], 0, 0, 0), VRD(1, 6), C0[12] = EX(C0[12]), C0[13] = EX(C0[13]), C0[14] = EX(C0[14]), C0[15] = EX(C0[15]), NBIAS(P0, P1, 2)); \
    GB(o[1] = __builtin_amdgcn_mfma_f32_32x32x16_bf16(PAF(1), VFR(3), o[1], 0, 0, 0), VRD(2, 3), C1[0] = EX(C1[0]), C1[1] = EX(C1[1]), C1[2] = EX(C1[2]), C1[3] = EX(C1[3]), NBIAS(P0, P1, 3)); \
    GB(o[0] = __builtin_amdgcn_mfma_f32_32x32x16_bf16(PAF(2), VFR(0), o[0], 0, 0, 0), VRD(3, 7), C1[4] = EX(C1[4]), C1[5] = EX(C1[5]), C1[6] = EX(C1[6]), C1[7] = EX(C1[7]), NBIAS(P0, P1, 4)); \
    GB(o[1] = __builtin_amdgcn_mfma_f32_32x32x16_bf16(PAF(2), VFR(1), o[1], 0, 0, 0), NOP_, C1[8] = EX(C1[8]), C1[9] = EX(C1[9]), C1[10] = EX(C1[10]), C1[11] = EX(C1[11]), NBIAS(P0, P1, 5)); \
    GB(o[0] = __builtin_amdgcn_mfma_f32_32x32x16_bf16(PAF(3), VFR(2), o[0], 0, 0, 0), NOP_, C1[12] = EX(C1[12]), C1[13] = EX(C1[13]), NOP_, NOP_, NBIAS(P0, P1, 6)); \
    GB(o[1] = __builtin_amdgcn_mfma_f32_32x32x16_bf16(PAF(3), VFR(3), o[1], 0, 0, 0), NOP_, C1[14] = EX(C1[14]), C1[15] = EX(C1[15]), NOP_, NOP_, NBIAS(P0, P1, 7)); \
    PIN(C0); PIN(C1); \
    } while (0)
#define DRAIN(P0, P1) do { float sacc = 0.f; _Pragma("unroll") for (int r_ = 0; r_ < 16; ++r_) sacc += P0[r_] + P1[r_]; l_reg += sacc; \
      const u32x4 w0 = pack_p(P0, 0), w1 = pack_p(P0, 8), w2 = pack_p(P1, 0), w3 = pack_p(P1, 8); \
      pv(o, (int)(lds0 + SV) + ((lane >> 4) & 1) * 32 + (lane & 3) * 8 + (4 * hi + ((lane & 15) >> 2)) * 64 + (s0 + NT - 1) * SSLOT, \
         __builtin_bit_cast(bf16x8, w0), __builtin_bit_cast(bf16x8, w1), __builtin_bit_cast(bf16x8, w2), __builtin_bit_cast(bf16x8, w3)); } while (0)
    STEP(pB0, pB1, pA0, pA1, 1);
    STEP(pA0, pA1, pB0, pB1, 2);
    if (NT > 3) { STEP(pB0, pB1, pA0, pA1, 3);
        if (NT > 4) { STEP(pA0, pA1, pB0, pB1, 4); DRAIN(pA0, pA1); } else { DRAIN(pB0, pB1); } }
    else { DRAIN(pA0, pA1); }
#undef DRAIN
#undef STEP
#undef NBIAS
#undef NOP_
#undef GB
#undef GA
#undef KN
#undef QKN
#undef EX
#undef PAF
#undef VFR
#undef VRD
#undef VOFF
#undef PIN
#undef ROT
#undef BIAS
#undef KLD
#undef DMA_K
#undef DMA_V
    float l = l_reg; l += __shfl_xor(l, 32); l += __builtin_amdgcn_exp2f(sink[h] * LOG2E - bnd);
    const int le = lane_id();
    const int r32e = le & 31, hie = le >> 5;
    LAS float* wsf = (LAS float*)(lds + LWS) + wid * 64;
    if (hie == 0) wsf[r32e] = l;
    asm volatile("s_waitcnt lgkmcnt(0)" ::: "memory");
    bf16* Ow = (bf16*)sptr(O + (rowb + 64 * nh + 32 * rh) * DM + HD * h);
    float part[16];
#pragma unroll
    for (int r = 0; r < 16; ++r) { const int q = crow(r, hie); const float il = __builtin_amdgcn_rcpf(wsf[q]); const unsigned off = (unsigned)(q * DM + r32e); const float v0 = o[0][r] * il, v1 = o[1][r] * il;
        part[r] = v0 * v0 + v1 * v1; Ow[off] = (bf16)f2bf(v0); Ow[off + 32] = (bf16)f2bf(v1); }
    ssq_accum(part, le, SSQ + 2 * (rowb + 64 * nh + 32 * rh));
    }
    asm volatile("s_waitcnt lgkmcnt(0)\n\ts_barrier" ::: "memory");
}

#undef ATT_SBAR
#undef ATT_WAIT_BAR
}

__device__ __forceinline__ void p5_attention(Frame& F, bool probe_dup = false) {
    const int lane_ = lane_id();
    const bf16* QB = WSP(bf16, WS_QB); const unsigned char* KN8 = WSP(unsigned char, WS_KBN); const unsigned char* QN8 = WSP(unsigned char, WS_QN8); const bf16* KR = WSP(bf16, WS_KR); const bf16* VB = WSP(bf16, WS_VB);
    const bf16* QA = WSP(bf16, WS_QA); const bf16* KA = WSP(bf16, WS_KA); const bf16* VA = WSP(bf16, WS_VA); bf16* O = WSP(bf16, WS_O);
    const float* TAB = WSP(float, WS_TAB); float* SSQ = probe_dup ? WSP(float, WS_KVRAW) : WSP(float, WS_SSQ);
    constexpr int NU_B = BATCH * BH * (SEQ / 256), NU_A = BATCH * (SEQ / 64) * A_KV;
#ifndef NO_MLA
    { const float bndB = __uint_as_float((unsigned)__builtin_amdgcn_readfirstlane((int)__float_as_uint(TAB[TAB_CONST + 1])));
      const bool shift = bndB > 64.0f; const float nb = shift ? -bndB : 0.f;
      for (int i = 0; i < (NU_B + F.G - 1) / F.G; ++i) {
        const int u = (F.G == 256) ? (F.vcu >> 2) * 16 + (F.vcu & 3) * 4 + i : i * F.G + F.vcu;
        if (u >= NU_B) break;
        const att::ConvJob cj{(F.G == 256 && !probe_dup) ? ((F.vcu * 4 + i) * NWAVES + F.wave) * 3 : -1};
        att::mla_unit2(F.lds + RING_OFF, (u >> 4) / BH, (u >> 4) % BH, u & 15, QB, QN8, KN8, KR, VB, O, SSQ, shift, nb, cj, F.wave, lane_);
      } }
#endif
#ifndef NO_SWA
    { const int lane2 = lane_id();
      int gcur = -1;
      for (int u = F.vcu; u < NU_A / 2; u += F.G) { if ((u & 1) != gcur) { gcur = u & 1; asm volatile("s_waitcnt lgkmcnt(0)\n\ts_barrier" ::: "memory"); att::swa_fill_table(F.lds + RING_OFF, gcur, TAB, F.wave * 64 + lane2); }
        att::swa_unit3(F.lds + RING_OFF, u >> 6, (u >> 1) & 31, u & 1, QA, KA, VA, O, SSQ, TAB, F.in[6], F.wave, lane2); } }
#endif
}

struct Args { const float* in[23]; float* out; unsigned char* ws; int ph_lo, ph_hi, li, pad; };
constexpr int N_PHASES = 13;
__global__ void __launch_bounds__(NWAVES * 64, 2) skel_fwd(Args args) {
    extern __shared__ __attribute__((aligned(16))) unsigned char lds[];
    Frame F;
    F.lds = (LAS unsigned char*)lds;
    F.MISC = (volatile LAS unsigned*)(F.lds + MISC_OFF);
    F.wave = __builtin_amdgcn_readfirstlane((int)(threadIdx.x >> 6));
    F.G = gridDim.x; { const int bx = blockIdx.x; F.vcu = (F.G % 8 == 0) ? (bx % 8) * (F.G / 8) + bx / 8 : bx; }
    F.ws = args.ws; F.out = args.out;
#pragma unroll
    for (int i = 0; i < 23; ++i) F.in[i] = args.in[i];
    F.ctl = (gu32*)(F.ws + WS_CTL);
    for (int u = threadIdx.x; u < (LDS_BYTES - LDSCTL_OFF) / 4; u += NWAVES * 64) ((LAS unsigned*)(F.lds + LDSCTL_OFF))[u] = 0u;
    __syncthreads();
    XcdBarrier bar = xcd_barrier_post((unsigned*)(F.ctl + CW_BAR) + args.li * XCD_BAR_WORDS, F.MISC + 8);
    const int lo = args.ph_lo, hi = args.ph_hi;
#define IN(k) (lo <= (k) && (k) < hi)
#define SEAM(k) do { if (IN(k) && IN((k) + 1)) xcd_barrier(bar); } while (0)

#define PH(k, ...) do { if (IN(k)) { __VA_ARGS__; if ((PROBE_MASK >> (k)) & 1) { xcd_barrier(bar); __VA_ARGS__; } } SEAM(k); } while (0)
    PH(0, p0_prologue(F));
    PH(1, {
        pg8::Gemm g{WSP(bf16, WS_XN), WSP(bf16, WS_WIN), T, NZ, DM, 0, nullptr, nullptr, 0, 0, 0, F.wave}; pg8::StaticOrder S; S.init(T, NZ, F.G, (int)blockIdx.x);
        pg8::EpiInProj E{F.ws, F.in[4], F.in[5], F.in[14]};
        pg8::gemm_phase<pg8::EpiInProj, pg8::StaticOrder, true, true>(F.lds + RING_OFF, g, S, E); });
    PH(3, {
        { pg8::Gemm g{WSP(bf16, WS_CQ), WSP(bf16, WS_WQB), T, BH * QKD, QL, 0, nullptr, nullptr, 0, 0, 0, F.wave}; pg8::StaticOrder S; S.init(T, BH * QKD, F.G, (int)blockIdx.x);
          pg8::EpiQB E{F.ws, F.in[11], F.in[12]};
          pg8::gemm_phase<pg8::EpiQB, pg8::StaticOrder, true, true>(F.lds + RING_OFF, g, S, E); }
        __syncthreads();
        { pg8::Gemm g{WSP(bf16, WS_CKV), WSP(bf16, WS_WKVB), T, BH * 128, KVL, 0, nullptr, nullptr, 0, 0, 0, F.wave}; pg8::StaticOrder S; S.init(T, BH * 128, F.G, (int)(F.G - 1 - blockIdx.x));
          pg8::EpiKVB E{F.ws, F.in[13]};
          pg8::gemm_phase<pg8::EpiKVB, pg8::StaticOrder, true, true>(F.lds + RING_OFF, g, S, E); } });
#if !NAIVE_ATTN
    PH(5, p5_attention(F));
#if PROBE_ATT
    xcd_barrier(bar); p5_attention(F, true); xcd_barrier(bar);
#endif
#endif
    PH(7, {
        pg8::Gemm g{WSP(bf16, WS_O), WSP(bf16, WS_WO), T, DM, DM, 0, nullptr, WSP(float, WS_SSQ), 0, 0, 0, F.wave}; pg8::StaticOrder S; S.init(T, DM, F.G, (int)blockIdx.x);
        pg8::EpiNormBf16 E{WSP(bf16, WS_ATT), DM, WSP(float, WS_SSQ)};
        pg8::gemm_phase<pg8::EpiNormBf16, pg8::StaticOrder, true, true, 2>(F.lds + RING_OFF, g, S, E); });
    PH(8, p8_router(F));
    PH(9, p9_topk(F));
    PH(11, {
        pg8::Gemm g{WSP(bf16, WS_H2), WSP(bf16, WS_WGU), MX, 2 * FF, DM / 2, (size_t)2 * FF * DM, WSP(int, WS_IDX), nullptr, 0x7a7a7a7a, 0x7a7a7a7a, (unsigned)(LDSCTL_OFF + 1024 - RING_OFF), F.wave}; pg8::StaticOrder S; S.init(MX, 2 * FF, F.G, (int)blockIdx.x, 16);
        pg8::EpiSwiGLU8 E{WSP(unsigned char, WS_ACT), FF, 16.0f};
        pg8::gemm_phase<pg8::EpiSwiGLU8, pg8::StaticOrder, true, true, 1, true>(F.lds + RING_OFF, g, S, E); });
    PH(12, {
        pg8::Gemm g{WSP(bf16, WS_ACT), WSP(bf16, WS_WD), MX, DM, FF / 2, (size_t)DM * FF, nullptr, nullptr, 0x7b7b7b7b, 0x7b7b7b7b, 0, F.wave}; pg8::StaticOrder S; S.init(MX, DM, F.G, (int)blockIdx.x, 16);
        pg8::EpiRowScaleF8 E{WSP(unsigned char, WS_YE), DM, WSP(float, WS_GATEV), 64.0f};
        pg8::gemm_phase<pg8::EpiRowScaleF8, pg8::StaticOrder, true, true, 0, true>(F.lds + RING_OFF, g, S, E); });
    PH(13, p12_combine(F));
#undef PH
#undef IN
#undef SEAM
}

#if NAIVE_ATTN
__device__ __forceinline__ float bf2f(bf16 v) { return __uint_as_float((unsigned)v << 16); }
__global__ void __launch_bounds__(256) naive_attn_a(const bf16* __restrict__ QA, const bf16* __restrict__ KA, const bf16* __restrict__ VA, const float* __restrict__ TAB, const float* __restrict__ sink, bf16* __restrict__ O) {
    const int s = (blockIdx.x % (SEQ / 256)) * 256 + threadIdx.x, bh = blockIdx.x / (SEQ / 256), h = bh % A_HEADS, b = bh / A_HEADS, g = h / (A_HEADS / A_KV);
    const size_t m = (size_t)b * SEQ + s;
    float q[HD], o[HD];
#pragma unroll
    for (int d = 0; d < HD; ++d) { q[d] = bf2f(QA[m * 512 + h * HD + d]); o[d] = 0.f; }
    const float bnd = TAB[TAB_CONST + 0];
    float l = exp2f(sink[h] * LOG2E - bnd);
    for (int rel = -WINDOW; rel <= WINDOW; ++rel) { const int j = s + rel; if (j < 0 || j >= SEQ) continue;
        const bf16* kr = KA + ((size_t)b * SEQ + j) * 128 + g * HD; const bf16* vr = VA + ((size_t)b * SEQ + j) * 128 + g * HD;
        float sc = 0.f;
#pragma unroll
        for (int d = 0; d < HD; ++d) sc += q[d] * bf2f(kr[d]);
        const float p = exp2f(sc + TAB[TAB_BIAS + h * NTAB + rel + 128] - bnd); l += p;
#pragma unroll
        for (int d = 0; d < HD; ++d) o[d] += p * bf2f(vr[d]); }
    const float il = 1.0f / l;
#pragma unroll
    for (int d = 0; d < HD; ++d) O[m * DM + h * HD + d] = (bf16)f2bf(o[d] * il);
}
__global__ void __launch_bounds__(256) naive_attn_b(const bf16* __restrict__ QB, const bf16* __restrict__ KBN, const bf16* __restrict__ KR, const bf16* __restrict__ VB, const float* __restrict__ TAB, bf16* __restrict__ O) {
    const int s = (blockIdx.x % (SEQ / 256)) * 256 + threadIdx.x, bh = blockIdx.x / (SEQ / 256), h = bh % BH, b = bh / BH;
    const size_t m = (size_t)b * SEQ + s;
    float q[QKD], o[VD];
#pragma unroll
    for (int d = 0; d < QKD; ++d) q[d] = bf2f(QB[m * (BH * QKD) + h * QKD + d]);
#pragma unroll
    for (int d = 0; d < VD; ++d) o[d] = 0.f;
    const float bnd = TAB[TAB_CONST + 1];
    float l = 0.f;
    for (int j = 0; j < SEQ; ++j) { const size_t mj = (size_t)b * SEQ + j;
        const bf16* kn = KBN + mj * 512 + h * NOPE; const bf16* kr = KR + mj * ROPE; const bf16* vr = VB + mj * 512 + h * VD;
        float sc = 0.f;
#pragma unroll
        for (int d = 0; d < NOPE; ++d) sc += q[d] * bf2f(kn[d]);
#pragma unroll
        for (int d = 0; d < ROPE; ++d) sc += q[NOPE + d] * bf2f(kr[d]);
        const float p = exp2f(sc - bnd); l += p;
#pragma unroll
        for (int d = 0; d < VD; ++d) o[d] += p * bf2f(vr[d]); }
    const float il = 1.0f / l;
#pragma unroll
    for (int d = 0; d < VD; ++d) O[m * DM + 512 + h * VD + d] = (bf16)f2bf(o[d] * il);
}

#endif
extern "C" void kernel_launch(void* const* d_in, const int* in_sizes, int n_in, void* d_out, int out_size, void* d_ws, size_t ws_size, hipStream_t stream) {
    static int grid = 0;
    if (grid == 0) {
        if (n_in != 23 || in_sizes[0] != T * DM || out_size != T * DM || ws_size < WS_END) { fprintf(stderr, "kernel_launch: unexpected shapes (n_in %d, in0 %d, out %d, ws %zu)\n", n_in, n_in > 0 ? in_sizes[0] : -1, out_size, ws_size); grid = -1; return; }
        int dev = 0, cus = 0, per_cu = 0;
        if (hipGetDevice(&dev) != hipSuccess || hipDeviceGetAttribute(&cus, hipDeviceAttributeMultiprocessorCount, dev) != hipSuccess) { grid = -1; return; }
        if (hipFuncSetAttribute((const void*)skel_fwd, hipFuncAttributeMaxDynamicSharedMemorySize, LDS_BYTES) != hipSuccess) { fprintf(stderr, "kernel_launch: hipFuncSetAttribute failed\n"); grid = -1; return; }
        if (hipOccupancyMaxActiveBlocksPerMultiprocessor(&per_cu, (const void*)skel_fwd, NWAVES * 64, LDS_BYTES) != hipSuccess || per_cu < 1) fprintf(stderr, "kernel_launch: occupancy query says %d\n", per_cu);
        (void)hipGetLastError();
        grid = cus;
    }
    if (grid < 0) return;
    if (hipMemsetAsync((char*)d_ws + WS_CTL, 0, CTL_ZERO_BYTES, stream) != hipSuccess) return;
    Args a{};
    for (int i = 0; i < 23; ++i) a.in[i] = (const float*)d_in[i];
    a.out = (float*)d_out; a.ws = (unsigned char*)d_ws;
    unsigned char* ws = (unsigned char*)d_ws;
#if NAIVE_ATTN
    a.ph_lo = 0; a.ph_hi = 5; a.li = 0;
    hipLaunchKernelGGL(skel_fwd, dim3(grid), dim3(NWAVES * 64), LDS_BYTES, stream, a);
    hipLaunchKernelGGL(naive_attn_a, dim3(BATCH * A_HEADS * (SEQ / 256)), dim3(256), 0, stream, (const bf16*)(ws + WS_QA), (const bf16*)(ws + WS_KA), (const bf16*)(ws + WS_VA), (const float*)(ws + WS_TAB), (const float*)d_in[6], (bf16*)(ws + WS_O));
    hipLaunchKernelGGL(naive_attn_b, dim3(BATCH * BH * (SEQ / 256)), dim3(256), 0, stream, (const bf16*)(ws + WS_QB), (const bf16*)(ws + WS_KBN), (const bf16*)(ws + WS_KR), (const bf16*)(ws + WS_VB), (const float*)(ws + WS_TAB), (bf16*)(ws + WS_O));
    a.ph_lo = 6; a.ph_hi = 14; a.li = 1;
    hipLaunchKernelGGL(skel_fwd, dim3(grid), dim3(NWAVES * 64), LDS_BYTES, stream, a);
#else
    a.ph_lo = 0; a.ph_hi = 14; a.li = 0;
    hipLaunchKernelGGL(skel_fwd, dim3(grid), dim3(NWAVES * 64), LDS_BYTES, stream, a);
#endif
}
```
